# Optimizing an MI355X kernel written in HIP

```python
import math
import jax
import jax.numpy as jnp
from jax import lax
import numpy as np

D_MODEL = 1024
BATCH = 2
SEQ = 16384
DEPTH = 2

GRID_W = 64
CTX_LEN = 256
NORM_EPS = 1e-6
MASK_VALUE = -1e30
Q_BLOCK = 128
N_BRANCH = 4
BRANCH_WIDTH = D_MODEL // 4

MLA_HEADS = 4
MLA_Q_RANK = D_MODEL // 4
MLA_KV_RANK = D_MODEL // 8
MLA_NOPE = 64
MLA_ROPE = 32
MLA_V = BRANCH_WIDTH // MLA_HEADS
MLA_SCALE = 1.0 / math.sqrt(MLA_NOPE + MLA_ROPE)
ROPE_BASE = 10000.0

HY_WIDTH = BRANCH_WIDTH
HY_ORDER = 2
HY_BANDS = 16
HY_EMB = 1 + 2 * HY_BANDS
HY_HIDDEN = 64
HY_DECAY_TARGET = 1e-2
HY_DECAY_SHORT_PCT = 0.3
HY_DECAY_LONG_PCT = 1.5

FN_GROUPS = 4
FN_GROUP_DIM = BRANCH_WIDTH // FN_GROUPS

NA_HEADS = 4
NA_HEAD_DIM = BRANCH_WIDTH // NA_HEADS
NA_KH = 8
NA_KW = 16
NA_SCALE = 1.0 / math.sqrt(NA_HEAD_DIM)

MOE_GROUPS = 4
MOE_PER_GROUP = 4
MOE_EXPERTS = MOE_GROUPS * MOE_PER_GROUP
MOE_TOPK = 2
MOE_HIDDEN = 256

MLA_IN = MLA_Q_RANK + MLA_KV_RANK + MLA_ROPE
HY_IN = (HY_ORDER + 1) * HY_WIDTH
FN_IN = BRANCH_WIDTH
NA_IN = 3 * BRANCH_WIDTH
GATE_IN = N_BRANCH * D_MODEL
IN_WIDTH = MLA_IN + HY_IN + FN_IN + NA_IN + GATE_IN

kernel_name = 'hybrid_flow_backbone'


def rmsnorm(x, g):
    xf = x.astype(jnp.float32)
    y = xf * lax.rsqrt(jnp.mean(xf * xf, axis=-1, keepdims=True) + NORM_EPS)
    return (y * g.astype(jnp.float32)).astype(x.dtype)


def modulate(h, shift, scale):
    return h * (1.0 + scale) + shift


def split_columns(p):
    bounds = (MLA_Q_RANK, MLA_Q_RANK + MLA_KV_RANK, MLA_IN, MLA_IN + HY_IN,
              MLA_IN + HY_IN + FN_IN, MLA_IN + HY_IN + FN_IN + NA_IN)
    return jnp.split(p, bounds, axis=-1)


def axial_rope(n_tokens):
    t = jnp.arange(n_tokens, dtype=jnp.int32)
    row = (t // GRID_W).astype(jnp.float32)
    col = (t % GRID_W).astype(jnp.float32)
    n_freq = MLA_ROPE // 4
    inv = ROPE_BASE ** (-jnp.arange(n_freq, dtype=jnp.float32) / n_freq)
    ang = jnp.concatenate([row[:, None] * inv, col[:, None] * inv], axis=-1)
    return jnp.cos(ang), jnp.sin(ang)


def apply_rope(x, cos, sin):
    xf = x.astype(jnp.float32)
    xe, xo = xf[..., 0::2], xf[..., 1::2]
    c = cos[None, :, None, :]
    s = sin[None, :, None, :]
    out = jnp.stack([xe * c - xo * s, xe * s + xo * c], axis=-1).reshape(x.shape)
    return out.astype(x.dtype)


def blocked_attention(q, k, v, scale):
    b, n_q, h, dk = q.shape
    n_blocks = n_q // Q_BLOCK
    q_blocks = jnp.moveaxis(q.reshape(b, n_blocks, Q_BLOCK, h, dk), 1, 0)

    def one_block(qb):
        s = jnp.einsum('bqhd,bkhd->bhqk', qb, k).astype(jnp.float32) * scale
        p = jax.nn.softmax(s, axis=-1).astype(v.dtype)
        return jnp.einsum('bhqk,bkhd->bqhd', p, v)

    o = lax.map(one_block, q_blocks)
    return jnp.moveaxis(o, 0, 1).reshape(b, n_q, h * v.shape[-1])


def mla_qkv(cq, ckv, kr, q_norm, w_uq, kv_norm, w_ukv, rope):
    b, n, _ = cq.shape
    q = (rmsnorm(cq, q_norm) @ w_uq).reshape(b, n, MLA_HEADS, MLA_NOPE + MLA_ROPE)
    kv = (rmsnorm(ckv, kv_norm) @ w_ukv).reshape(b, n, MLA_HEADS, MLA_NOPE + MLA_V)
    q_nope, q_rot = q[..., :MLA_NOPE], q[..., MLA_NOPE:]
    k_nope, v = kv[..., :MLA_NOPE], kv[..., MLA_NOPE:]
    k_rot = kr[:, :, None, :]
    if rope is not None:
        cos, sin = rope
        q_rot = apply_rope(q_rot, cos, sin)
        k_rot = apply_rope(k_rot, cos, sin)
    k_rot = jnp.broadcast_to(k_rot, (b, n, MLA_HEADS, MLA_ROPE))
    return (jnp.concatenate([q_nope, q_rot], axis=-1),
            jnp.concatenate([k_nope, k_rot], axis=-1), v)


def split_heads_qkv(p):
    b, n, _ = p.shape
    q, k, v = jnp.split(p, 3, axis=-1)
    shape = (b, n, NA_HEADS, NA_HEAD_DIM)
    return q.reshape(shape), k.reshape(shape), v.reshape(shape)


def neighbourhood_attention(q, k, v, k_ctx, v_ctx, rpb):
    b, n, h, dh = q.shape
    rows = n // GRID_W
    kh = min(NA_KH, rows)
    r = jnp.arange(rows)
    row_idx = jnp.clip(r - kh // 2, 0, rows - kh)[:, None] + jnp.arange(kh)[None, :]
    col = jnp.arange(GRID_W)
    col_start = jnp.clip(col - NA_KW // 2, 0, GRID_W - NA_KW)
    col_ok = (col[None, :] >= col_start[:, None]) & (col[None, :] < col_start[:, None] + NA_KW)
    dr = row_idx - r[:, None]
    dc = jnp.clip(col[None, :] - col[:, None], -(NA_KW - 1), NA_KW - 1)
    bias = rpb[:, :, dc + NA_KW - 1][:, dr + NA_KH - 1]
    bias = jnp.transpose(bias, (0, 1, 3, 2, 4)).astype(jnp.float32)
    qg = q.reshape(b, rows, GRID_W, h, dh)
    kg = k.reshape(b, rows, GRID_W, h, dh)[:, row_idx]
    vg = v.reshape(b, rows, GRID_W, h, dh)[:, row_idx]
    s_loc = jnp.einsum('brqhd,brjkhd->bhrqjk', qg, kg).astype(jnp.float32) * NA_SCALE + bias[None]
    s_loc = jnp.where(col_ok[:, None, :], s_loc, MASK_VALUE)
    s_ctx = jnp.einsum('brqhd,bchd->bhrqc', qg, k_ctx).astype(jnp.float32) * NA_SCALE
    n_loc = kh * GRID_W
    s = jnp.concatenate([s_loc.reshape(b, h, rows, GRID_W, n_loc), s_ctx], axis=-1)
    p = jax.nn.softmax(s, axis=-1).astype(v.dtype)
    p_loc = p[..., :n_loc].reshape(b, h, rows, GRID_W, kh, GRID_W)
    p_ctx = p[..., n_loc:]
    o = (jnp.einsum('bhrqjk,brjkhd->brqhd', p_loc, vg)
         + jnp.einsum('bhrqc,bchd->brqhd', p_ctx, v_ctx))
    return o.reshape(b, n, h * dh)


def short_conv(u, w):
    up = jnp.pad(u, ((0, 0), (1, 1), (0, 0)))
    return up[:, :-2] * w[0] + up[:, 1:-1] * w[1] + up[:, 2:] * w[2]


def hyena_filters(n_tokens, w1, b1, freq1, w2, b2, freq2, w3):
    f32 = jnp.float32
    t = jnp.linspace(0.0, 1.0, n_tokens, dtype=f32)[:, None]
    bands = jnp.linspace(1e-4, HY_BANDS - 1, HY_BANDS, dtype=f32)
    ang = (2.0 * math.pi / n_tokens) * jnp.arange(n_tokens, dtype=f32)[:, None] * bands
    z = jnp.concatenate([t, jnp.cos(ang), -jnp.sin(ang)], axis=-1)
    h = jnp.sin(freq1.astype(f32) * (z @ w1.astype(f32) + b1.astype(f32)))
    h = jnp.sin(freq2.astype(f32) * (h @ w2.astype(f32) + b2.astype(f32)))
    h = h @ w3.astype(f32)
    deltas = jnp.linspace(math.log(HY_DECAY_TARGET) / HY_DECAY_LONG_PCT,
                          math.log(HY_DECAY_TARGET) / HY_DECAY_SHORT_PCT, HY_WIDTH, dtype=f32)
    window = jnp.exp(-t * jnp.abs(deltas))
    return h.reshape(n_tokens, 2, HY_ORDER, HY_WIDTH) * window[:, None, None, :]


def bidir_fftconv(u, h_fwd, h_bwd):
    n = u.shape[1]
    g = jnp.concatenate([h_fwd, jnp.zeros_like(h_fwd[:1]), h_bwd[:0:-1]], axis=0)
    g = g * lax.rsqrt(jnp.sum(g * g, axis=0, keepdims=True) + NORM_EPS)
    u_f = jnp.fft.rfft(u.astype(jnp.float32), n=2 * n, axis=1)
    g_f = jnp.fft.rfft(g, n=2 * n, axis=0)
    return jnp.fft.irfft(u_f * g_f[None], n=2 * n, axis=1)[:, :n]


def hyena(u, short_w, filt, bias):
    u = short_conv(u, short_w)
    v, x1, x2 = jnp.split(u, 3, axis=-1)
    z = v
    for n, gate in enumerate((x1, x2)):
        y = bidir_fftconv(z, filt[:, 0, n], filt[:, 1, n]).astype(z.dtype) + z * bias[n]
        z = gate * y
    return z


def fnet_mix(u):
    b, n, _ = u.shape
    ug = u.astype(jnp.float32).reshape(b, n, FN_GROUPS, FN_GROUP_DIM)
    y = jnp.fft.fftn(ug, axes=(1, 3), norm='ortho').real
    return y.reshape(b, n, FN_GROUPS * FN_GROUP_DIM).astype(u.dtype)


def merge_branches(outs, gate_logits, w_branch, w_out):
    o = jnp.stack(outs, axis=2)
    proj = jnp.einsum('blnc,ncd->blnd', o, w_branch)
    g = jax.nn.sigmoid(gate_logits.reshape(proj.shape))
    return jnp.sum(g * proj, axis=2) @ w_out


def token_mixers(h_lat, h_ctx, w_in, mla_q_norm, mla_w_uq, mla_kv_norm, mla_w_ukv,
                 hy_short_w, hy_w1, hy_b1, hy_freq1, hy_w2, hy_b2, hy_freq2, hy_w3, hy_bias,
                 na_rpb, w_branch, w_out, update_ctx):
    n_lat = h_lat.shape[1]
    n_ctx = h_ctx.shape[1]
    cq_l, ckv_l, kr_l, hy_l, fn_l, na_l, gate_l = split_columns(h_lat @ w_in)
    cq_c, ckv_c, kr_c, hy_c, fn_c, na_c, gate_c = split_columns(h_ctx @ w_in)

    qa_l, ka_l, va_l = mla_qkv(cq_l, ckv_l, kr_l, mla_q_norm, mla_w_uq, mla_kv_norm, mla_w_ukv,
                               axial_rope(n_lat))
    qa_c, ka_c, va_c = mla_qkv(cq_c, ckv_c, kr_c, mla_q_norm, mla_w_uq, mla_kv_norm, mla_w_ukv, None)
    oa_l = blocked_attention(qa_l, jnp.concatenate([ka_l, ka_c], axis=1),
                             jnp.concatenate([va_l, va_c], axis=1), MLA_SCALE)
    qd_l, kd_l, vd_l = split_heads_qkv(na_l)
    qd_c, kd_c, vd_c = split_heads_qkv(na_c)
    od_l = neighbourhood_attention(qd_l, kd_l, vd_l, kd_c, vd_c, na_rpb)
    filt_l = hyena_filters(n_lat, hy_w1, hy_b1, hy_freq1, hy_w2, hy_b2, hy_freq2, hy_w3)
    ob_l = hyena(hy_l, hy_short_w, filt_l, hy_bias)
    oc_l = fnet_mix(fn_l)
    m_lat = merge_branches((oa_l, ob_l, oc_l, od_l), gate_l, w_branch, w_out)

    m_ctx = None
    if update_ctx:
        oa_c = blocked_attention(qa_c, ka_c, va_c, MLA_SCALE)
        filt_c = hyena_filters(n_ctx, hy_w1, hy_b1, hy_freq1, hy_w2, hy_b2, hy_freq2, hy_w3)
        ob_c = hyena(hy_c, hy_short_w, filt_c, hy_bias)
        oc_c = fnet_mix(fn_c)
        od_c = blocked_attention(qd_c, kd_c, vd_c, NA_SCALE)
        m_ctx = merge_branches((oa_c, ob_c, oc_c, od_c), gate_c, w_branch, w_out)
    return m_lat, m_ctx


def hier_moe(h, w_group, b_group, w_expert, b_expert, w_gate, w_up, w_down):
    t_count = h.shape[0]
    f32 = jnp.float32
    g_prob = jax.nn.softmax((h @ w_group).astype(f32) + b_group.astype(f32), axis=-1)
    g_p, g_idx = lax.top_k(g_prob, 1)
    g_onehot = jax.nn.one_hot(g_idx[:, 0], MOE_GROUPS, dtype=f32)
    e_logits = ((h @ w_expert).astype(f32) + b_expert.astype(f32)).reshape(
        t_count, MOE_GROUPS, MOE_PER_GROUP)
    e_sel = jnp.sum(e_logits * g_onehot[:, :, None], axis=1)
    e_p, e_idx = lax.top_k(jax.nn.softmax(e_sel, axis=-1), MOE_TOPK)
    e_p = e_p / jnp.sum(e_p, axis=-1, keepdims=True)
    w_local = jnp.sum(jax.nn.one_hot(e_idx, MOE_PER_GROUP, dtype=f32) * e_p[..., None], axis=1)
    weights = (g_onehot[:, :, None] * (g_p * w_local)[:, None, :]).astype(h.dtype)
    out = jnp.zeros_like(h)
    for gi in range(MOE_GROUPS):
        sl = slice(gi * MOE_PER_GROUP, (gi + 1) * MOE_PER_GROUP)
        a = jnp.einsum('td,edf->tef', h, w_gate[sl])
        u = jnp.einsum('td,edf->tef', h, w_up[sl])
        act = jax.nn.silu(a) * u * weights[:, gi, :, None]
        out = out + jnp.einsum('tef,efd->td', act, w_down[sl])
    return out


def setup_inputs(seed: int = 0) -> dict:
    key = jax.random.key(seed)
    ks = jax.random.split(key, 33)

    def nrm(k, shape, scale):
        return scale * jax.random.normal(k, shape, jnp.float32)

    D, L = D_MODEL, DEPTH
    E, F = MOE_EXPERTS, MOE_HIDDEN
    return {
        'x': nrm(ks[0], (BATCH, SEQ, D), 1.0),
        'c': nrm(ks[1], (BATCH, D), 1.0),
        'ctx': nrm(ks[2], (BATCH, CTX_LEN, D), 1.0),
        'c_ctx': nrm(ks[3], (D,), 1.0),
        'ada_w': nrm(ks[4], (L, D, 6 * D), 0.5 * D ** -0.5),
        'ada_b': nrm(ks[5], (L, 6 * D), 0.02),
        'norm1_g': 1.0 + nrm(ks[6], (L, D), 0.1),
        'norm2_g': 1.0 + nrm(ks[7], (L, D), 0.1),
        'w_in': nrm(ks[8], (L, D, IN_WIDTH), D ** -0.5),
        'mla_q_norm': 1.0 + nrm(ks[9], (L, MLA_Q_RANK), 0.1),
        'mla_w_uq': nrm(ks[10], (L, MLA_Q_RANK, MLA_HEADS * (MLA_NOPE + MLA_ROPE)), MLA_Q_RANK ** -0.5),
        'mla_kv_norm': 1.0 + nrm(ks[11], (L, MLA_KV_RANK), 0.1),
        'mla_w_ukv': nrm(ks[12], (L, MLA_KV_RANK, MLA_HEADS * (MLA_NOPE + MLA_V)), MLA_KV_RANK ** -0.5),
        'hy_short_w': nrm(ks[13], (L, 3, HY_IN), 3 ** -0.5),
        'hy_w1': nrm(ks[14], (L, HY_EMB, HY_HIDDEN), HY_EMB ** -0.5),
        'hy_b1': nrm(ks[15], (L, HY_HIDDEN), 0.1),
        'hy_freq1': 1.0 + nrm(ks[16], (L, HY_HIDDEN), 0.1),
        'hy_w2': nrm(ks[17], (L, HY_HIDDEN, HY_HIDDEN), HY_HIDDEN ** -0.5),
        'hy_b2': nrm(ks[18], (L, HY_HIDDEN), 0.1),
        'hy_freq2': 1.0 + nrm(ks[19], (L, HY_HIDDEN), 0.1),
        'hy_w3': nrm(ks[20], (L, HY_HIDDEN, 2 * HY_ORDER * HY_WIDTH), HY_HIDDEN ** -0.5),
        'hy_bias': nrm(ks[21], (L, HY_ORDER, HY_WIDTH), 0.5),
        'na_rpb': nrm(ks[22], (L, NA_HEADS, 2 * NA_KH - 1, 2 * NA_KW - 1), 0.1),
        'w_branch': nrm(ks[23], (L, N_BRANCH, BRANCH_WIDTH, D), BRANCH_WIDTH ** -0.5),
        'w_out': nrm(ks[24], (L, D, D), D ** -0.5),
        'moe_w_group': nrm(ks[25], (L, D, MOE_GROUPS), D ** -0.5),
        'moe_b_group': nrm(ks[26], (L, MOE_GROUPS), 0.01),
        'moe_w_expert': nrm(ks[27], (L, D, E), D ** -0.5),
        'moe_b_expert': nrm(ks[28], (L, E), 0.01),
        'moe_w_gate': nrm(ks[29], (L, E, D, F), D ** -0.5),
        'moe_w_up': nrm(ks[30], (L, E, D, F), D ** -0.5),
        'moe_w_down': nrm(ks[31], (L, E, F, D), F ** -0.5),
        'final_norm_g': 1.0 + nrm(ks[32], (D,), 0.1),
    }


def reference(x, c, ctx, c_ctx, ada_w, ada_b, norm1_g, norm2_g, w_in,
              mla_q_norm, mla_w_uq, mla_kv_norm, mla_w_ukv,
              hy_short_w, hy_w1, hy_b1, hy_freq1, hy_w2, hy_b2, hy_freq2, hy_w3, hy_bias,
              na_rpb, w_branch, w_out,
              moe_w_group, moe_b_group, moe_w_expert, moe_b_expert, moe_w_gate, moe_w_up, moe_w_down,
              final_norm_g):
    n_lat_tokens = x.shape[0] * x.shape[1]
    for l in range(DEPTH):
        last = l == DEPTH - 1
        mod_lat = jax.nn.silu(c) @ ada_w[l] + ada_b[l]
        mod_ctx = jax.nn.silu(c_ctx) @ ada_w[l] + ada_b[l]
        sh1, sc1, gt1, sh2, sc2, gt2 = jnp.split(mod_lat[:, None, :], 6, axis=-1)
        sh1c, sc1c, gt1c, sh2c, sc2c, gt2c = jnp.split(mod_ctx, 6, axis=-1)

        h_lat = modulate(rmsnorm(x, norm1_g[l]), sh1, sc1)
        h_ctx = modulate(rmsnorm(ctx, norm1_g[l]), sh1c, sc1c)
        m_lat, m_ctx = token_mixers(h_lat, h_ctx, w_in[l], mla_q_norm[l], mla_w_uq[l], mla_kv_norm[l],
                                    mla_w_ukv[l], hy_short_w[l], hy_w1[l], hy_b1[l], hy_freq1[l],
                                    hy_w2[l], hy_b2[l], hy_freq2[l], hy_w3[l], hy_bias[l],
                                    na_rpb[l], w_branch[l], w_out[l], not last)
        x = x + gt1 * m_lat

        h_lat = modulate(rmsnorm(x, norm2_g[l]), sh2, sc2).reshape(-1, D_MODEL)
        if last:
            f = hier_moe(h_lat, moe_w_group[l], moe_b_group[l], moe_w_expert[l], moe_b_expert[l],
                         moe_w_gate[l], moe_w_up[l], moe_w_down[l])
            x = x + gt2 * f.reshape(x.shape)
        else:
            ctx = ctx + gt1c * m_ctx
            h_ctx = modulate(rmsnorm(ctx, norm2_g[l]), sh2c, sc2c).reshape(-1, D_MODEL)
            f = hier_moe(jnp.concatenate([h_lat, h_ctx], axis=0), moe_w_group[l], moe_b_group[l],
                         moe_w_expert[l], moe_b_expert[l], moe_w_gate[l], moe_w_up[l], moe_w_down[l])
            x = x + gt2 * f[:n_lat_tokens].reshape(x.shape)
            ctx = ctx + gt2c * f[n_lat_tokens:].reshape(ctx.shape)
    return rmsnorm(x, final_norm_g)
```

```cpp
#include <hip/hip_runtime.h>
#include <cstdio>
#include <cstdint>

#ifndef ONE_LAUNCH
#define ONE_LAUNCH 1
#endif
#ifndef REP_PHASE
#define REP_PHASE 0
#endif
#ifndef DBG_NO_MIX
#define DBG_NO_MIX 0
#endif
#ifndef DBG_BR
#define DBG_BR 15
#endif
#ifndef DBG_FN_COPY
#define DBG_FN_COPY 0
#endif
#ifndef DBG_NO_MOE
#define DBG_NO_MOE 0
#endif

constexpr int D = 1024, SEQ = 16384, NCTX = 256, TPB = SEQ + NCTX, T = 2 * TPB, NLAYER = 2;
constexpr int NTILE = T / 128;
constexpr int PLD = 1280;
constexpr int IN_W = 6304;

typedef unsigned short bf16_t;
typedef short bf16x8 __attribute__((ext_vector_type(8)));
typedef short s16x4 __attribute__((ext_vector_type(4)));
typedef float f32x4 __attribute__((ext_vector_type(4)));
typedef float f32x16 __attribute__((ext_vector_type(16)));
typedef unsigned u32x4 __attribute__((ext_vector_type(4)));
typedef unsigned u32x2 __attribute__((ext_vector_type(2)));
typedef _Float16 h16x2 __attribute__((ext_vector_type(2)));

constexpr size_t al256(size_t x) { return (x + 255) & ~(size_t)255; }
constexpr size_t OFF_BAR = 0;
constexpr size_t OFF_CNT = 16384;
constexpr size_t ZERO_BYTES = 32768;
constexpr size_t OFF_MOD = 32768;
constexpr size_t OFF_ROPE = OFF_MOD + al256((size_t)2 * 3 * 6144 * 4);
constexpr size_t OFF_H2L = OFF_ROPE + al256(256 * 8 * 8);
constexpr size_t OFF_W3T = OFF_H2L + (size_t)2 * 16384 * 64 * 2;
constexpr size_t OFF_H2C = OFF_H2L + al256((size_t)2 * 16384 * 64 * 4);
constexpr size_t OFF_CTXS = OFF_H2C + al256((size_t)2 * 256 * 64 * 4);
constexpr size_t OFF_TOKW = OFF_CTXS + al256((size_t)512 * 1024 * 4);
constexpr size_t OFF_LISTS = OFF_TOKW + al256((size_t)T * 2 * 4);
constexpr size_t OFF_WTS_OLD = OFF_LISTS + al256((size_t)24 * T * 4);
constexpr size_t WE_W1T = 0;
constexpr size_t WE_WGT = WE_W1T + (size_t)2304 * 1024;
constexpr size_t WE_WUQ = WE_WGT + (size_t)4096 * 1024;
constexpr size_t WE_WUKV = WE_WUQ + (size_t)384 * 256;
constexpr size_t WE_WBA = WE_WUKV + (size_t)512 * 128;
constexpr size_t WE_WBB = WE_WBA + (size_t)1024 * 256;
constexpr size_t WE_WBD = WE_WBB + (size_t)1024 * 256;
constexpr size_t WE_WBC = WE_WBD + (size_t)1024 * 256;
constexpr size_t WE_WOUT = WE_WBC + (size_t)1024 * 512;
constexpr size_t WE_WGU = WE_WOUT + (size_t)1024 * 1024;
constexpr size_t WE_WDN = WE_WGU + (size_t)16 * 512 * 1024;
constexpr size_t WE_TOTAL = WE_WDN + (size_t)16 * 1024 * 256;
constexpr size_t OFF_H = OFF_WTS_OLD;
constexpr size_t OFF_P = OFF_H + al256((size_t)T * 1024 * 2);
constexpr size_t OFF_HYFN = OFF_P + al256((size_t)T * PLD * 2);
constexpr size_t OFF_Q = OFF_HYFN + al256((size_t)2 * 1024 * TPB * 2);
constexpr size_t OFF_K = OFF_Q + al256((size_t)T * 384 * 2);
constexpr size_t OFF_V = OFF_K + al256((size_t)T * 384 * 2);
constexpr size_t OFF_OAD = OFF_V + al256((size_t)T * 256 * 2);
constexpr size_t OFF_OBT = OFF_OAD + al256((size_t)T * 512 * 2);
constexpr size_t OFF_OCT = OFF_OBT + al256((size_t)2 * 256 * TPB * 2);
constexpr size_t OFF_HYS = OFF_OCT + al256((size_t)2 * 512 * TPB * 2);
constexpr size_t OFF_WTS = OFF_HYS + al256((size_t)256 * 4 * 16384 * 4);
constexpr size_t OFF_FILT = OFF_WTS + al256(WE_TOTAL * 2);
constexpr size_t WS_TOTAL = OFF_FILT + al256((size_t)1024 * 16384 * 2);
constexpr int ACT_ROWS = 36352;
static_assert((size_t)ACT_ROWS * 512 * 2 <= (size_t)T * PLD * 2, "act must fit in P");

struct Params { const float* in[33]; float* out; unsigned char* ws; };
enum { I_X = 0, I_C, I_CTX, I_CCTX, I_ADAW, I_ADAB, I_N1G, I_N2G, I_WIN, I_QNORM, I_WUQ, I_KVNORM, I_WUKV, I_HYSW, I_HYW1, I_HYB1, I_HYF1, I_HYW2, I_HYB2, I_HYF2, I_HYW3, I_HYBIAS,
       I_RPB, I_WBR, I_WOUT, I_MWG, I_MBG, I_MWE, I_MBE, I_MGATE, I_MUP, I_MDOWN, I_FNG };

#define WSP(TYPE, off) ((TYPE*)(p.ws + (off)))
__device__ __forceinline__ bf16_t* wts(const Params& p, int l, size_t we) { (void)l; return (bf16_t*)(p.ws + OFF_WTS) + we; }

typedef float f32x2 __attribute__((ext_vector_type(2))); typedef int i32x8 __attribute__((ext_vector_type(8)));
typedef __bf16 bf16x2_t __attribute__((ext_vector_type(2)));
__device__ __forceinline__ unsigned cvt_pk_bf16(float lo, float hi) { const f32x2 v = {lo, hi}; return __builtin_bit_cast(unsigned, __builtin_convertvector(v, bf16x2_t)); }
__device__ __forceinline__ bf16_t f2bf(float x) { return (bf16_t)(cvt_pk_bf16(x, 0.f) & 0xffffu); }
__device__ __forceinline__ float bf2f(bf16_t v) { return __uint_as_float((unsigned)v << 16); }
__device__ __forceinline__ float wave_sum(float v) {
#pragma unroll
    for (int o = 32; o >= 1; o >>= 1) v += __shfl_xor(v, o);
    return v;
}
__device__ __forceinline__ float silu_f(float x) { return x / (1.f + __expf(-x)); }
__device__ __forceinline__ float sigmoid_f(float x) { return __builtin_amdgcn_rcpf(1.f + __builtin_amdgcn_exp2f(x * -1.4426950408889634f)); }
__device__ __forceinline__ void sincos_turns(float turns, float& s, float& c) { const float f = turns - floorf(turns); sincospif(2.f * f, &s, &c); }
__device__ __forceinline__ void sincos_rad(float x, float& s, float& c) { sincos_turns(x * 0.15915494309189535f, s, c); }

__device__ __forceinline__ const float* xrow_in(const Params& p, int r) {
    const int b = r >= TPB ? 1 : 0, t = r - b * TPB;
    return t < SEQ ? p.in[I_X] + ((size_t)b * SEQ + t) * D : p.in[I_CTX] + ((size_t)b * NCTX + (t - SEQ)) * D;
}
__device__ __forceinline__ float* xrow_st(const Params& p, int r) {
    const int b = r >= TPB ? 1 : 0, t = r - b * TPB;
    return t < SEQ ? p.out + ((size_t)b * SEQ + t) * D : WSP(float, OFF_CTXS) + ((size_t)b * NCTX + (t - SEQ)) * D;
}
__device__ __forceinline__ bool row_is_ctx(int r) { const int b = r >= TPB ? 1 : 0; return (r - b * TPB) >= SEQ; }
__device__ __forceinline__ const float* modvec(const Params& p, int l, int r) {
    const int b = r >= TPB ? 1 : 0, t = r - b * TPB; const int mi = t < SEQ ? b : 2;
    return WSP(float, OFF_MOD) + ((size_t)l * 3 + mi) * 6144;
}

#define XB_TMO      128
#define XB_XCNT(j)  (256  + 64 * (j))
#define XB_XSUB(j)  (1280 + 64 * (j))
#define XB_XGEN(j)  (2304 + 64 * (j))
#define XB_TOP      3328
#define XB_TOPGEN   3392
#define XCD_BAR_WORDS 3456
#define XB_SPIN_CAP (1u << 22)
#define LAS __attribute__((address_space(3)))
__device__ __forceinline__ unsigned xb_ld(unsigned* p)              { return __hip_atomic_load(p, __ATOMIC_RELAXED, __HIP_MEMORY_SCOPE_AGENT); }
__device__ __forceinline__ unsigned xb_add(unsigned* p, unsigned v) { return __hip_atomic_fetch_add(p, v, __ATOMIC_RELAXED, __HIP_MEMORY_SCOPE_AGENT); }
__device__ __forceinline__ unsigned xb_xcc_id() { return (unsigned)__builtin_amdgcn_s_getreg((3 << 11) | 20) & 0xFu; }
#define XB_SPIN(cond, bar) do { unsigned _sp = 0; while (cond) { __builtin_amdgcn_s_sleep(1); \
    if ((++_sp & 255u) == 0u) { if (xb_ld(&(bar)[XB_TMO])) break; if (_sp > XB_SPIN_CAP) { atomicAdd(&(bar)[XB_TMO], 1u); break; } } } } while (0)
struct XcdBarrier { unsigned* bar; unsigned x; volatile LAS unsigned* st; };
__device__ __forceinline__ XcdBarrier xcd_barrier_post(unsigned* bar, volatile LAS unsigned* st) {
    XcdBarrier b; b.bar = bar; b.x = xb_xcc_id(); b.st = st;
    if (threadIdx.x == 0) (void)xb_add(&bar[XB_XCNT(b.x)], 1u);
    return b;
}
__device__ __forceinline__ void xcd_barrier_complete(unsigned* bar, unsigned x, unsigned& nloc, unsigned& nx) {
    const unsigned G = gridDim.x * gridDim.y * gridDim.z;
    unsigned sum, cnt, mine, sp = 0u;
    for (;;) {
        sum = 0u; cnt = 0u; mine = 0u;
#pragma unroll
        for (unsigned j = 0; j < 16; ++j) { const unsigned c = xb_ld(&bar[XB_XCNT(j)]); sum += c; cnt += (c > 0u) ? 1u : 0u; mine = (j == x) ? c : mine; }
        if (sum == G) break;
        __builtin_amdgcn_s_sleep(1);
        if ((++sp & 255u) == 0u) { if (xb_ld(&bar[XB_TMO])) break; if (sp > XB_SPIN_CAP) { atomicAdd(&bar[XB_TMO], 1u); break; } }
    }
    nloc = mine > 0u ? mine : 1u; nx = cnt > 0u ? cnt : 1u;
}
__device__ __forceinline__ void xcd_barrier(const XcdBarrier& b) {
    asm volatile("s_waitcnt vmcnt(0)" ::: "memory");
    __syncthreads();
    if (threadIdx.x == 0) {
        unsigned* bar = b.bar;
        __builtin_amdgcn_s_waitcnt(0);
        unsigned nloc = b.st[0], nx = b.st[1];
        if (nloc == 0u) { xcd_barrier_complete(bar, b.x, nloc, nx); b.st[0] = nloc; b.st[1] = nx; }
        const unsigned old = xb_add(&bar[XB_XSUB(b.x)], 1u);
        const unsigned gen = old / nloc;
        if (old + 1u == (gen + 1u) * nloc) {
            __builtin_amdgcn_fence(__ATOMIC_RELEASE, "agent");
            asm volatile("s_waitcnt vmcnt(0)" ::: "memory");
            const unsigned og = xb_add(&bar[XB_TOP], 1u);
            const unsigned tg = og / nx;
            if (og + 1u == (tg + 1u) * nx) xb_add(&bar[XB_TOPGEN], 1u);
            else XB_SPIN(xb_ld(&bar[XB_TOPGEN]) == tg, bar);
            __builtin_amdgcn_fence(__ATOMIC_ACQUIRE, "agent");
            xb_add(&bar[XB_XGEN(b.x)], 1u);
            asm volatile("s_waitcnt vmcnt(0)" ::: "memory");
        } else {
            XB_SPIN(xb_ld(&bar[XB_XGEN(b.x)]) == gen, bar);
            __builtin_amdgcn_fence(__ATOMIC_ACQUIRE, "agent");
            asm volatile("s_waitcnt vmcnt(0)" ::: "memory");
        }
    }
    __syncthreads();
}

__device__ __forceinline__ int tidx() { int r; asm volatile("v_mov_b32 %0, %1" : "=v"(r) : "v"((int)threadIdx.x)); return r; }
__device__ __forceinline__ int bidx() { int r; asm volatile("s_mov_b32 %0, %1" : "=s"(r) : "s"((int)blockIdx.x)); return r; }
__device__ __forceinline__ int gdim() { int r; asm volatile("s_mov_b32 %0, %1" : "=s"(r) : "s"((int)gridDim.x)); return r; }
extern __shared__ __attribute__((aligned(16))) char lds_dyn[];
constexpr int G_TILE = 128 * 128;
constexpr int G_STAGE = 2 * G_TILE;
constexpr int G_LDS = 4 * G_STAGE;
__device__ __forceinline__ int g_lds_byte(int r, int c) { const int ob = (r & 15) * 64 + (c & 31) * 2; return ((r >> 4) * 2 + (c >> 5)) * 1024 + (ob ^ (((ob >> 9) & 1) << 5)); }
__device__ __forceinline__ int g_srow() { const int t = tidx(), ln = t & 63, p = ln * 16, ob = p ^ (((p >> 9) & 1) << 5); return ((t >> 6) >> 1) * 16 + (ob >> 6); }
__device__ __forceinline__ int g_skc() { const int t = tidx(), ln = t & 63, p = ln * 16, ob = p ^ (((p >> 9) & 1) << 5); return ((t >> 6) & 1) * 4 + ((ob & 63) >> 4); }

template <int SWAP>
__device__ __forceinline__ void mma_tile(f32x4 (&acc)[4][2], const char* As, const char* Bs, int a_rd, int b_rd) {
#pragma unroll
    for (int ks = 0; ks < 2; ++ks) {
        bf16x8 af[4], bfr[2];
#pragma unroll
        for (int mt = 0; mt < 4; ++mt) af[mt] = *(const bf16x8*)(As + a_rd + mt * 2048 + ks * 1024);
#pragma unroll
        for (int nt = 0; nt < 2; ++nt) bfr[nt] = *(const bf16x8*)(Bs + b_rd + nt * 2048 + ks * 1024);
#pragma unroll
        for (int mt = 0; mt < 4; ++mt)
#pragma unroll
            for (int nt = 0; nt < 2; ++nt)
                acc[mt][nt] = SWAP ? __builtin_amdgcn_mfma_f32_16x16x32_bf16(bfr[nt], af[mt], acc[mt][nt], 0, 0, 0)
                                   : __builtin_amdgcn_mfma_f32_16x16x32_bf16(af[mt], bfr[nt], acc[mt][nt], 0, 0, 0);
    }
}
struct GFrag { bf16x8 a[4], b[2]; };
__device__ __forceinline__ void gf_load(GFrag& f, const char* As, const char* Bs, int a_rd, int b_rd, int ks) {
#pragma unroll
    for (int mt = 0; mt < 4; ++mt) f.a[mt] = *(const bf16x8*)(As + a_rd + mt * 2048 + ks * 1024);
#pragma unroll
    for (int nt = 0; nt < 2; ++nt) f.b[nt] = *(const bf16x8*)(Bs + b_rd + nt * 2048 + ks * 1024);
}
template <int SWAP = 1>
__device__ __forceinline__ void gf_mma(f32x4 (&acc)[4][2], const GFrag& f) {
#pragma unroll
    for (int mt = 0; mt < 4; ++mt)
#pragma unroll
        for (int nt = 0; nt < 2; ++nt) acc[mt][nt] = SWAP ? __builtin_amdgcn_mfma_f32_16x16x32_bf16(f.b[nt], f.a[mt], acc[mt][nt], 0, 0, 0)
                                                           : __builtin_amdgcn_mfma_f32_16x16x32_bf16(f.a[mt], f.b[nt], acc[mt][nt], 0, 0, 0);
}
__device__ __forceinline__ void gf_zero(GFrag& f) {
#pragma unroll
    for (int mt = 0; mt < 4; ++mt) f.a[mt] = (bf16x8)(0);
#pragma unroll
    for (int nt = 0; nt < 2; ++nt) f.b[nt] = (bf16x8)(0);
}
#define SB() __builtin_amdgcn_sched_barrier(0)
#define GF_STAGE(ACCP, ACC, AS, BS) do { gf_load(f0, (AS), (BS), a_rd, b_rd, 0); SB(); gf_mma(ACCP, f1); SB(); gf_load(f1, (AS), (BS), a_rd, b_rd, 1); SB(); gf_mma(ACC, f0); SB(); } while (0)

struct GFrag2 { bf16x8 a[4], b[4]; };
__device__ __forceinline__ void gf2_load(GFrag2& f, const char* As, const char* Bs, int a_rd, int b_rd, int ks) {
#pragma unroll
    for (int mt = 0; mt < 4; ++mt) f.a[mt] = *(const bf16x8*)(As + a_rd + mt * 2048 + ks * 1024);
#pragma unroll
    for (int nt = 0; nt < 4; ++nt) f.b[nt] = *(const bf16x8*)(Bs + b_rd + nt * 2048 + ks * 1024);
}
template <int SWAP>
__device__ __forceinline__ void gf2_mma(f32x4 (&acc)[4][4], const GFrag2& f) {
#pragma unroll
    for (int mt = 0; mt < 4; ++mt)
#pragma unroll
        for (int nt = 0; nt < 4; ++nt) acc[mt][nt] = SWAP ? __builtin_amdgcn_mfma_f32_16x16x32_bf16(f.b[nt], f.a[mt], acc[mt][nt], 0, 0, 0)
                                                           : __builtin_amdgcn_mfma_f32_16x16x32_bf16(f.a[mt], f.b[nt], acc[mt][nt], 0, 0, 0);
}
__device__ __forceinline__ void gf2_zero(GFrag2& f) {
#pragma unroll
    for (int mt = 0; mt < 4; ++mt) f.a[mt] = (bf16x8)(0);
#pragma unroll
    for (int nt = 0; nt < 4; ++nt) f.b[nt] = (bf16x8)(0);
}
#define G_WAITV(n) asm volatile("s_waitcnt vmcnt(" #n ")\n\ts_waitcnt lgkmcnt(0)" ::: "memory")
template <int SWAP, int AT>
__device__ __forceinline__ void mma_seg(f32x4 (&acc)[4][2], const bf16_t* __restrict__ a0, const bf16_t* __restrict__ a1, long ldt,
                                        const bf16_t* __restrict__ b0, const bf16_t* __restrict__ b1, int K, char* lds) {
    const int tid = tidx(), lane = tid & 63, wid = __builtin_amdgcn_readfirstlane(tid >> 6), wm = wid >> 2, wn = wid & 3;
    const int fr = lane & 15, fq = lane >> 4;
    const int a_rd = g_lds_byte(wm * 64 + fr, fq * 8), b_rd = g_lds_byte(wn * 32 + fr, fq * 8);
    const int nk = K >> 6;
    if (!AT) {
        LAS char* L = (LAS char*)lds_dyn + ((wid >> 1) * 2 + (wid & 1)) * 1024;
        auto issue = [&](int st) { const int k0 = st << 6; LAS char* Lb = L + (st & 3) * G_STAGE;
            __builtin_amdgcn_global_load_lds((const unsigned*)(a0 + k0), (LAS unsigned*)(Lb), 16, 0, 0);
            __builtin_amdgcn_global_load_lds((const unsigned*)(a1 + k0), (LAS unsigned*)(Lb + 8192), 16, 0, 0);
            __builtin_amdgcn_global_load_lds((const unsigned*)(b0 + k0), (LAS unsigned*)(Lb + G_TILE), 16, 0, 0);
            __builtin_amdgcn_global_load_lds((const unsigned*)(b1 + k0), (LAS unsigned*)(Lb + G_TILE + 8192), 16, 0, 0); };
        GFrag f0, f1; gf_zero(f1);
        issue(0); if (nk > 1) issue(1); if (nk > 2) issue(2);
        for (int kt = 0; kt < nk; ++kt) {
            if (kt + 2 < nk) G_WAITV(8); else if (kt + 1 < nk) G_WAITV(4); else G_WAITV(0);
            __builtin_amdgcn_s_barrier();
            asm volatile("" ::: "memory");
            if (kt + 3 < nk) issue(kt + 3);
            const char* As = lds + (kt & 3) * G_STAGE;
            gf_load(f0, As, As + G_TILE, a_rd, b_rd, 0); SB(); gf_mma<SWAP>(acc, f1); SB(); gf_load(f1, As, As + G_TILE, a_rd, b_rd, 1); SB(); gf_mma<SWAP>(acc, f0); SB();
        }
        gf_mma<SWAP>(acc, f1);
        __syncthreads();
    } else {
        const int w0 = g_lds_byte(g_srow(), g_skc() * 8), w1 = w0 + 4 * 2048;
        const int tk = tid >> 4, tt = tid & 15;
        u32x4 ra0, ra1, rb0, rb1;
        auto gld = [&](int k0) {
            ra0 = *(const u32x4*)(a0 + (long)(k0 + tk) * ldt + tt * 8); ra1 = *(const u32x4*)(a0 + (long)(k0 + tk + 32) * ldt + tt * 8);
            rb0 = *(const u32x4*)(b0 + k0); rb1 = *(const u32x4*)(b1 + k0);
        };
        auto lst = [&](int buf) {
            char* A = lds + buf * G_STAGE; char* B = A + G_TILE;
#pragma unroll
            for (int i = 0; i < 8; ++i) {
                const unsigned wa = ra0[i >> 1], wb = ra1[i >> 1];
                *(bf16_t*)(A + g_lds_byte(tt * 8 + i, tk)) = (bf16_t)((i & 1) ? (wa >> 16) : (wa & 0xffffu));
                *(bf16_t*)(A + g_lds_byte(tt * 8 + i, tk + 32)) = (bf16_t)((i & 1) ? (wb >> 16) : (wb & 0xffffu));
            }
            *(u32x4*)(B + w0) = rb0; *(u32x4*)(B + w1) = rb1;
        };
        gld(0); lst(0); __syncthreads();
        for (int kt = 0; kt < nk; ++kt) {
            if (kt + 1 < nk) gld((kt + 1) << 6);
            __builtin_amdgcn_sched_barrier(0);
            mma_tile<SWAP>(acc, lds + (kt & 1) * G_STAGE, lds + (kt & 1) * G_STAGE + G_TILE, a_rd, b_rd);
            __builtin_amdgcn_sched_barrier(0);
            if (kt + 1 < nk) lst((kt + 1) & 1);
            __syncthreads();
        }
    }
}
__device__ __forceinline__ void mma_pair(f32x4 (&ag)[4][2], f32x4 (&ap)[4][2], const bf16_t* __restrict__ ga0, const bf16_t* __restrict__ ga1, const bf16_t* __restrict__ gb0, const bf16_t* __restrict__ gb1, int nkg,
                                         const bf16_t* __restrict__ pa0, const bf16_t* __restrict__ pa1, const bf16_t* __restrict__ pb0, const bf16_t* __restrict__ pb1, int nkp, char* lds) {
    const int tid = tidx(), lane = tid & 63, wid = __builtin_amdgcn_readfirstlane(tid >> 6), wm = wid >> 2, wn = wid & 3;
    const int fr = lane & 15, fq = lane >> 4;
    const int a_rd = g_lds_byte(wm * 64 + fr, fq * 8), b_rd = g_lds_byte(wn * 32 + fr, fq * 8);
    const int ns = nkg + nkp;
    LAS char* L = (LAS char*)lds_dyn + ((wid >> 1) * 2 + (wid & 1)) * 1024;
    auto issue = [&](int st) { const bool g = st < nkg; const int k0 = (g ? st : st - nkg) << 6; LAS char* Lb = L + (st & 3) * G_STAGE;
        __builtin_amdgcn_global_load_lds((const unsigned*)((g ? ga0 : pa0) + k0), (LAS unsigned*)(Lb), 16, 0, 0);
        __builtin_amdgcn_global_load_lds((const unsigned*)((g ? ga1 : pa1) + k0), (LAS unsigned*)(Lb + 8192), 16, 0, 0);
        __builtin_amdgcn_global_load_lds((const unsigned*)((g ? gb0 : pb0) + k0), (LAS unsigned*)(Lb + G_TILE), 16, 0, 0);
        __builtin_amdgcn_global_load_lds((const unsigned*)((g ? gb1 : pb1) + k0), (LAS unsigned*)(Lb + G_TILE + 8192), 16, 0, 0); };
    issue(0); issue(1); issue(2);
    for (int st = 0; st < nkg; ++st) {
        if (st + 2 < ns) G_WAITV(8); else if (st + 1 < ns) G_WAITV(4); else G_WAITV(0);
        __builtin_amdgcn_s_barrier(); asm volatile("" ::: "memory");
        if (st + 3 < ns) issue(st + 3);
        mma_tile<1>(ag, lds + (st & 3) * G_STAGE, lds + (st & 3) * G_STAGE + G_TILE, a_rd, b_rd);
    }
    for (int st = nkg; st < ns; ++st) {
        if (st + 2 < ns) G_WAITV(8); else if (st + 1 < ns) G_WAITV(4); else G_WAITV(0);
        __builtin_amdgcn_s_barrier(); asm volatile("" ::: "memory");
        if (st + 3 < ns) issue(st + 3);
        mma_tile<1>(ap, lds + (st & 3) * G_STAGE, lds + (st & 3) * G_STAGE + G_TILE, a_rd, b_rd);
    }
    __syncthreads();
}
constexpr int G2_STAGE = 3 * G_TILE;
constexpr int G2_LDS = 3 * G2_STAGE;
template <int SWAP>
__device__ __forceinline__ void mma_tile256(f32x4 (&acc)[4][4], const char* As, const char* Bs, int a_rd, int b_rd) {
#pragma unroll
    for (int ks = 0; ks < 2; ++ks) {
        bf16x8 af[4], bfr[4];
#pragma unroll
        for (int mt = 0; mt < 4; ++mt) af[mt] = *(const bf16x8*)(As + a_rd + mt * 2048 + ks * 1024);
#pragma unroll
        for (int nt = 0; nt < 4; ++nt) bfr[nt] = *(const bf16x8*)(Bs + b_rd + nt * 2048 + ks * 1024);
#pragma unroll
        for (int mt = 0; mt < 4; ++mt)
#pragma unroll
            for (int nt = 0; nt < 4; ++nt)
                acc[mt][nt] = SWAP ? __builtin_amdgcn_mfma_f32_16x16x32_bf16(bfr[nt], af[mt], acc[mt][nt], 0, 0, 0)
                                   : __builtin_amdgcn_mfma_f32_16x16x32_bf16(af[mt], bfr[nt], acc[mt][nt], 0, 0, 0);
    }
}
#define G2_WAITV(n) asm volatile("s_waitcnt vmcnt(" #n ")\n\ts_waitcnt lgkmcnt(0)" ::: "memory")
template <int SWAP>
__device__ __forceinline__ void mma_seg256(f32x4 (&acc)[4][4], const bf16_t* __restrict__ a0, size_t astep, const bf16_t* __restrict__ b0, size_t bstep, int K, char* lds) {
    const int tid = tidx(), lane = tid & 63, wid = __builtin_amdgcn_readfirstlane(tid >> 6), wm = wid >> 1, wn = wid & 1;
    const int fr = lane & 15, fq = lane >> 4;
    const int a_rd = g_lds_byte(wm * 64 + fr, fq * 8), b_rd = g_lds_byte(wn * 64 + fr, fq * 8);
    const int nk = K >> 6;
    LAS char* L = (LAS char*)lds_dyn + ((wid >> 1) * 2 + (wid & 1)) * 1024;
    auto issue = [&](int st) { const int k0 = st << 6; LAS char* Lb = L + (st % 3) * G2_STAGE;
#pragma unroll
        for (int i = 0; i < 4; ++i) __builtin_amdgcn_global_load_lds((const unsigned*)(a0 + i * astep + k0), (LAS unsigned*)(Lb + i * 8192), 16, 0, 0);
#pragma unroll
        for (int i = 0; i < 2; ++i) __builtin_amdgcn_global_load_lds((const unsigned*)(b0 + i * bstep + k0), (LAS unsigned*)(Lb + 2 * G_TILE + i * 8192), 16, 0, 0); };
    GFrag2 f0, f1; gf2_zero(f1);
    issue(0); if (nk > 1) issue(1);
    for (int kt = 0; kt < nk; ++kt) {
        if (kt + 1 < nk) G2_WAITV(6); else G2_WAITV(0);
        __builtin_amdgcn_s_barrier(); asm volatile("" ::: "memory");
        if (kt + 2 < nk) issue(kt + 2);
        const char* As = lds + (kt % 3) * G2_STAGE; const char* Bs = As + 2 * G_TILE;
        gf2_load(f0, As, Bs, a_rd, b_rd, 0); SB(); gf2_mma<SWAP>(acc, f1); SB(); gf2_load(f1, As, Bs, a_rd, b_rd, 1); SB(); gf2_mma<SWAP>(acc, f0); SB();
    }
    gf2_mma<SWAP>(acc, f1);
    __syncthreads();
}
__device__ __forceinline__ void acc_zero256(f32x4 (&acc)[4][4]) {
#pragma unroll
    for (int mt = 0; mt < 4; ++mt)
#pragma unroll
        for (int nt = 0; nt < 4; ++nt) acc[mt][nt] = (f32x4){0.f, 0.f, 0.f, 0.f};
}
__device__ __forceinline__ void acc_zero(f32x4 (&acc)[4][2]) {
#pragma unroll
    for (int mt = 0; mt < 4; ++mt)
#pragma unroll
        for (int nt = 0; nt < 2; ++nt) acc[mt][nt] = (f32x4){0.f, 0.f, 0.f, 0.f};
}

typedef _Float16 f16x8 __attribute__((ext_vector_type(8)));
constexpr int FRS = 130;
#define FBI(n) ((((n) >> 7) * FRS) + ((n) & 127))
constexpr int FFT_BUF_BYTES = 128 * FRS * 8;
struct FFrag { int unused; };
__device__ __forceinline__ float2 cmulf(float2 a, float2 b) { return make_float2(a.x * b.x - a.y * b.y, a.x * b.y + a.y * b.x); }
__device__ __forceinline__ float2 cmulcf(float2 a, float2 b) { return make_float2(a.x * b.x + a.y * b.y, a.y * b.x - a.x * b.y); }
__device__ __forceinline__ float2 tw16k(const float2* thi, const float2* tlo, int idx) { return cmulf(thi[idx >> 7], tlo[idx & 127]); }
__device__ __forceinline__ void mfft_frags(FFrag& F, const float2*) { F.unused = 0; }
template <int CONJ, int TW>
__device__ __forceinline__ void mfft_left(float2* buf, const FFrag& F, const float2* thi, const float2* tlo) {
    const int tid = tidx(), lane = tid & 63, wid = tid >> 6, i = wid >> 1, hi = lane >> 5, l31 = lane & 31, fa = 32 * i + l31;
    f32x16 yr0 = {}, yi0 = {}, yr1 = {}, yi1 = {};
#pragma unroll
    for (int ks = 0; ks < 8; ++ks) {
        f16x8 fr, fi;
#pragma unroll
        for (int j = 0; j < 8; ++j) { const float2 w = thi[(fa * (16 * ks + 8 * hi + j)) & 127]; fr[j] = (_Float16)w.x; fi[j] = (_Float16)(CONJ ? -w.y : w.y); }
        const f16x8 nfi = -fi;
#pragma unroll
        for (int t = 0; t < 2; ++t) {
            const float2* xp = buf + (16 * ks + 8 * hi) * FRS + 32 * (2 * (wid & 1) + t) + l31;
            f16x8 xr, xi;
#pragma unroll
            for (int j = 0; j < 8; ++j) { const float2 v = xp[j * FRS]; xr[j] = (_Float16)v.x; xi[j] = (_Float16)v.y; }
            if (t == 0) { yr0 = __builtin_amdgcn_mfma_f32_32x32x16_f16(fr, xr, yr0, 0, 0, 0); yr0 = __builtin_amdgcn_mfma_f32_32x32x16_f16(nfi, xi, yr0, 0, 0, 0);
                          yi0 = __builtin_amdgcn_mfma_f32_32x32x16_f16(fr, xi, yi0, 0, 0, 0); yi0 = __builtin_amdgcn_mfma_f32_32x32x16_f16(fi, xr, yi0, 0, 0, 0); }
            else        { yr1 = __builtin_amdgcn_mfma_f32_32x32x16_f16(fr, xr, yr1, 0, 0, 0); yr1 = __builtin_amdgcn_mfma_f32_32x32x16_f16(nfi, xi, yr1, 0, 0, 0);
                          yi1 = __builtin_amdgcn_mfma_f32_32x32x16_f16(fr, xi, yi1, 0, 0, 0); yi1 = __builtin_amdgcn_mfma_f32_32x32x16_f16(fi, xr, yi1, 0, 0, 0); }
        }
    }
    __syncthreads();
#pragma unroll
    for (int t = 0; t < 2; ++t)
#pragma unroll
        for (int r = 0; r < 16; ++r) { const int row = 32 * i + (r & 3) + 8 * (r >> 2) + 4 * hi, col = 32 * (2 * (wid & 1) + t) + l31;
            float2 v = t == 0 ? make_float2(yr0[r], yi0[r]) : make_float2(yr1[r], yi1[r]);
            if (TW) { const float2 tv = tw16k(thi, tlo, row * col); v = TW > 0 ? cmulf(v, tv) : cmulcf(v, tv); }
            buf[row * FRS + col] = v; }
    __syncthreads();
}
template <int CONJ, int TW>
__device__ __forceinline__ void mfft_right(float2* buf, const FFrag& F, const float2* thi, const float2* tlo) {
    const int tid = tidx(), lane = tid & 63, wid = tid >> 6, jb = wid >> 1, hi = lane >> 5, l31 = lane & 31, fa = 32 * jb + l31;
    f32x16 yr0 = {}, yi0 = {}, yr1 = {}, yi1 = {};
#pragma unroll
    for (int ks = 0; ks < 8; ++ks) {
        f16x8 fr, fi;
#pragma unroll
        for (int j = 0; j < 8; ++j) { const float2 w = thi[(fa * (16 * ks + 8 * hi + j)) & 127]; fr[j] = (_Float16)w.x; fi[j] = (_Float16)(CONJ ? -w.y : w.y); }
        const f16x8 nfi = -fi;
#pragma unroll
        for (int t = 0; t < 2; ++t) {
            const f32x4* xp = (const f32x4*)(buf + (32 * (2 * (wid & 1) + t) + l31) * FRS + 16 * ks + 8 * hi);
            const f32x4 q0 = xp[0], q1 = xp[1], q2 = xp[2], q3 = xp[3];
            f16x8 xr, xi;
            xr[0] = (_Float16)q0[0]; xi[0] = (_Float16)q0[1]; xr[1] = (_Float16)q0[2]; xi[1] = (_Float16)q0[3]; xr[2] = (_Float16)q1[0]; xi[2] = (_Float16)q1[1]; xr[3] = (_Float16)q1[2]; xi[3] = (_Float16)q1[3];
            xr[4] = (_Float16)q2[0]; xi[4] = (_Float16)q2[1]; xr[5] = (_Float16)q2[2]; xi[5] = (_Float16)q2[3]; xr[6] = (_Float16)q3[0]; xi[6] = (_Float16)q3[1]; xr[7] = (_Float16)q3[2]; xi[7] = (_Float16)q3[3];
            if (t == 0) { yr0 = __builtin_amdgcn_mfma_f32_32x32x16_f16(xr, fr, yr0, 0, 0, 0); yr0 = __builtin_amdgcn_mfma_f32_32x32x16_f16(xi, nfi, yr0, 0, 0, 0);
                          yi0 = __builtin_amdgcn_mfma_f32_32x32x16_f16(xr, fi, yi0, 0, 0, 0); yi0 = __builtin_amdgcn_mfma_f32_32x32x16_f16(xi, fr, yi0, 0, 0, 0); }
            else        { yr1 = __builtin_amdgcn_mfma_f32_32x32x16_f16(xr, fr, yr1, 0, 0, 0); yr1 = __builtin_amdgcn_mfma_f32_32x32x16_f16(xi, nfi, yr1, 0, 0, 0);
                          yi1 = __builtin_amdgcn_mfma_f32_32x32x16_f16(xr, fi, yi1, 0, 0, 0); yi1 = __builtin_amdgcn_mfma_f32_32x32x16_f16(xi, fr, yi1, 0, 0, 0); }
        }
    }
    __syncthreads();
#pragma unroll
    for (int t = 0; t < 2; ++t)
#pragma unroll
        for (int r = 0; r < 16; ++r) { const int row = 32 * (2 * (wid & 1) + t) + (r & 3) + 8 * (r >> 2) + 4 * hi, col = 32 * jb + l31;
            float2 v = t == 0 ? make_float2(yr0[r], yi0[r]) : make_float2(yr1[r], yi1[r]);
            if (TW) { const float2 tv = tw16k(thi, tlo, row * col); v = TW > 0 ? cmulf(v, tv) : cmulcf(v, tv); }
            buf[row * FRS + col] = v; }
    __syncthreads();
}
__device__ __forceinline__ void fft_fwd_blk(float2* buf, const FFrag& F, const float2* thi, const float2* tlo) { mfft_left<0, 1>(buf, F, thi, tlo); mfft_right<0, 0>(buf, F, thi, tlo); }
__device__ __forceinline__ void fft_inv_blk(float2* buf, const FFrag& F, const float2* thi, const float2* tlo) { mfft_right<1, -1>(buf, F, thi, tlo); mfft_left<1, 0>(buf, F, thi, tlo); }
constexpr int FFT_LDS_TAB = FFT_BUF_BYTES;
constexpr int FFT_LDS_EXTRA = FFT_LDS_TAB + 4096;
__device__ __forceinline__ void fft_tables(char* lds) {
    float2* thi = (float2*)(lds + FFT_LDS_TAB); float2* tlo = thi + 128;
    const int t = tidx();
    if (t < 128) { float s, c; sincospif(2.f * (float)t / 128.f, &s, &c); thi[t] = make_float2(c, -s); }
    else if (t < 256) { float s, c; sincospif(2.f * (float)(t - 128) / 16384.f, &s, &c); tlo[t - 128] = make_float2(c, -s); }
    else if (t < 384) { float s, c; sincospif((float)(t - 256) / 128.f, &s, &c); tlo[128 + (t - 256)] = make_float2(c, -s); }
    else { float s, c; sincospif((float)(t - 384) / 16384.f, &s, &c); tlo[256 + (t - 384)] = make_float2(c, -s); }
    __syncthreads();
}
__device__ __forceinline__ float block_sum(float v, float* red) {
    v = wave_sum(v);
    __syncthreads();
    if ((tidx() & 63) == 0) red[tidx() >> 6] = v;
    __syncthreads();
    float s = 0.f;
#pragma unroll
    for (int i = 0; i < 8; ++i) s += red[i];
    return s;
}

#if ONE_LAUNCH
#define PHASE_FN __device__ __forceinline__
#else
#define PHASE_FN __device__
#endif
__device__ __forceinline__ const float* wsrc(const Params& p, int l, int job, int n, int& ld) {
    switch (job) {
    case 0: { ld = IN_W; const float* w = p.in[I_WIN] + (size_t)l * 1024 * IN_W; int c;
        if (n < 768) c = 1440 + n; else if (n < 1024) c = n - 768; else if (n < 1152) c = 256 + (n - 1024); else if (n < 1184) c = 384 + (n - 1152);
        else if (n < 1280) return nullptr; else if (n < 2048) c = 416 + (n - 1280); else c = 1184 + (n - 2048);
        return w + c; }
    case 1: ld = IN_W; return p.in[I_WIN] + (size_t)l * 1024 * IN_W + 2208 + n;
    case 2: ld = 384; return p.in[I_WUQ] + (size_t)l * 256 * 384 + n;
    case 3: ld = 512; return p.in[I_WUKV] + (size_t)l * 128 * 512 + n;
    case 4: ld = 1024; return p.in[I_WBR] + ((size_t)l * 4 + 0) * 256 * 1024 + n;
    case 5: ld = 1024; return p.in[I_WBR] + ((size_t)l * 4 + 1) * 256 * 1024 + n;
    case 6: ld = 1024; return p.in[I_WBR] + ((size_t)l * 4 + 3) * 256 * 1024 + n;
    case 7: ld = 1024; return p.in[I_WOUT] + (size_t)l * 1024 * 1024 + n;
    case 8: { ld = 256; const int e = n >> 9, r = n & 511; const int t = r >> 7, wn = (r & 127) >> 5, nt = (r & 31) >> 4, i = r & 15; const int f = t * 64 + wn * 16 + i;
        return (nt ? p.in[I_MUP] : p.in[I_MGATE]) + ((size_t)l * 16 + e) * 1024 * 256 + f; }
    default: { ld = 1024; const int e = n >> 10, c = n & 1023; return p.in[I_MDOWN] + ((size_t)l * 16 + e) * 256 * 1024 + c; }
    }
}
PHASE_FN void ph_prologue(const Params& p, char* lds_unused) {
    char* lds = lds_dyn; (void)lds_unused;
    const int tid = tidx(), bid = bidx(), G = gdim();
    {
        float* sc = (float*)lds;
        float* red = sc + 3072;
        for (int i = tid; i < 3072; i += 512) { const int v = i >> 10, k = i & 1023; const float x = v < 2 ? p.in[I_C][v * 1024 + k] : p.in[I_CCTX][k]; sc[i] = silu_f(x); }
        __syncthreads();
        for (int u = bid; u < 192; u += G) {
            const int l = u / 96, j0 = (u % 96) * 64, kg = tid >> 6, j = tid & 63;
            const float* w = p.in[I_ADAW] + (size_t)l * 1024 * 6144 + j0 + j;
            float a0 = 0.f, a1 = 0.f, a2 = 0.f;
#pragma unroll 8
            for (int k = kg * 128; k < kg * 128 + 128; ++k) { const float wv = w[(size_t)k * 6144]; a0 += sc[k] * wv; a1 += sc[1024 + k] * wv; a2 += sc[2048 + k] * wv; }
            red[(0 * 8 + kg) * 64 + j] = a0; red[(1 * 8 + kg) * 64 + j] = a1; red[(2 * 8 + kg) * 64 + j] = a2;
            __syncthreads();
            if (tid < 192) { const int v = tid >> 6, jj = tid & 63; float s = p.in[I_ADAB][(size_t)l * 6144 + j0 + jj];
#pragma unroll
                for (int g = 0; g < 8; ++g) s += red[(v * 8 + g) * 64 + jj];
                WSP(float, OFF_MOD)[((size_t)l * 3 + v) * 6144 + j0 + jj] = s; }
            __syncthreads();
        }
    }
    for (int i = bid * 512 + tid; i < 2048; i += G * 512) {
        const int pos = i >> 3, f = i & 7; const float inv = powf(10000.f, -(float)f / 8.f); float s, c; sincos_rad((float)pos * inv, s, c);
        WSP(float2, OFF_ROPE)[i] = make_float2(c, s);
    }
    for (int i = bid * 512 + tidx(); i < NLAYER * 1024 * 64; i += G * 512) { const int l = i >> 16, col = (i >> 6) & 1023, j = i & 63;
        WSP(bf16_t, OFF_W3T)[i] = f2bf(p.in[I_HYW3][(size_t)l * 64 * 1024 + (size_t)j * 1024 + col]); }
    {
        float* w1 = (float*)lds;
        float* w2 = w1 + 33 * 64;
        float* vb = w2 + 64 * 64;
        float* zz = vb + 256;
        float* h1 = zz + 8 * 36;
        for (int l = 0; l < NLAYER; ++l) {
            __syncthreads();
            for (int i = tid; i < 33 * 64; i += 512) w1[i] = p.in[I_HYW1][(size_t)l * 33 * 64 + i];
            for (int i = tid; i < 64 * 64; i += 512) w2[i] = p.in[I_HYW2][(size_t)l * 64 * 64 + i];
            if (tid < 64) { vb[tid] = p.in[I_HYB1][l * 64 + tid]; vb[64 + tid] = p.in[I_HYF1][l * 64 + tid]; vb[128 + tid] = p.in[I_HYB2][l * 64 + tid]; vb[192 + tid] = p.in[I_HYF2][l * 64 + tid]; }
            __syncthreads();
            const int nchunks = (16384 + 256) / 8;
            for (int ch = bid; ch < nchunks; ch += G) {
                const bool isc = ch >= 2048; const int L = isc ? 256 : 16384; const int n = (isc ? ch - 2048 : ch) * 8 + (tid >> 6);
                const int nl = tid >> 6, j = tid & 63;
                if (j < 33) {
                    float v;
                    if (j == 0) v = (float)n / (float)(L - 1);
                    else { const int bi = (j - 1) & 15; const float band = 1e-4f + (float)bi * ((15.f - 1e-4f) / 15.f); float s, c; sincos_turns((float)n * band / (float)L, s, c); v = j <= 16 ? c : -s; }
                    zz[nl * 36 + j] = v;
                }
                __syncthreads();
                { float a = vb[j];
#pragma unroll
                  for (int i = 0; i < 33; ++i) a += zz[nl * 36 + i] * w1[i * 64 + j];
                  h1[nl * 64 + j] = sinf(vb[64 + j] * a); }
                __syncthreads();
                { float a = vb[128 + j];
#pragma unroll 16
                  for (int i = 0; i < 64; ++i) a += h1[nl * 64 + i] * w2[i * 64 + j];
                  const float r = sinf(vb[192 + j] * a);
                  if (isc) WSP(float, OFF_H2C)[((size_t)l * 256 + n) * 64 + j] = r; else WSP(bf16_t, OFF_H2L)[((size_t)l * 16384 + n) * 64 + j] = f2bf(r); }
                __syncthreads();
            }
        }
    }
}
template <int JOB, int N, int K>
__device__ __forceinline__ void wconv_job(const Params& p, int l, size_t we, const float* scale, char* lds) {
    float* tile = (float*)lds;
    const int tid = tidx();
    constexpr int NKT = K / 64, NT = (N / 64) * NKT;
    float xa[8], xb[8];
    auto fetch = [&](int v, float (&x)[8]) { const int n0 = (v / NKT) * 64, k0 = (v % NKT) * 64; const int nn = tid & 63, kk = tid >> 6; int ld; const float* src = wsrc(p, l, JOB, n0 + nn, ld);
#pragma unroll
        for (int i = 0; i < 8; ++i) { const int k = kk + 8 * i; float t = src ? src[(size_t)(k0 + k) * ld] : 0.f; if (scale) t *= scale[k0 + k]; x[i] = t; } };
    if (bidx() < NT) fetch(bidx(), xa);
    for (int v = bidx(); v < NT; v += gdim()) {
        const int n0 = (v / NKT) * 64, k0 = (v % NKT) * 64;
        if (v + gdim() < NT) fetch(v + gdim(), xb);
        __syncthreads();
        { const int nn = tid & 63, kk = tid >> 6;
#pragma unroll
          for (int i = 0; i < 8; ++i) { const int k = kk + 8 * i; tile[k * 65 + nn] = xa[i]; } }
#pragma unroll
        for (int i = 0; i < 8; ++i) xa[i] = xb[i];
        __syncthreads();
        if (JOB == 1) {
          const int nn = tid >> 3, kc = tid & 7; float v[8];
#pragma unroll
          for (int i = 0; i < 8; ++i) v[i] = tile[(kc * 8 + i) * 65 + nn] * 64.f;
          u32x2 w; int t0 = 0, t1 = 0;
          t0 = __builtin_amdgcn_cvt_pk_fp8_f32(v[0], v[1], t0, false); t0 = __builtin_amdgcn_cvt_pk_fp8_f32(v[2], v[3], t0, true);
          t1 = __builtin_amdgcn_cvt_pk_fp8_f32(v[4], v[5], t1, false); t1 = __builtin_amdgcn_cvt_pk_fp8_f32(v[6], v[7], t1, true);
          w.x = (unsigned)t0; w.y = (unsigned)t1;
          *(u32x2*)((char*)wts(p, l, we) + (size_t)(n0 + nn) * K + k0 + kc * 8) = w;
        } else
        { const int nn = tid >> 3, kc = tid & 7; u32x4 w;
          w.x = cvt_pk_bf16(tile[(kc * 8 + 0) * 65 + nn], tile[(kc * 8 + 1) * 65 + nn]); w.y = cvt_pk_bf16(tile[(kc * 8 + 2) * 65 + nn], tile[(kc * 8 + 3) * 65 + nn]);
          w.z = cvt_pk_bf16(tile[(kc * 8 + 4) * 65 + nn], tile[(kc * 8 + 5) * 65 + nn]); w.w = cvt_pk_bf16(tile[(kc * 8 + 6) * 65 + nn], tile[(kc * 8 + 7) * 65 + nn]);
          *(u32x4*)(wts(p, l, we) + (size_t)(n0 + nn) * K + k0 + kc * 8) = w; }
    }
}
PHASE_FN void ph_wconv(const Params& p, int l, char* lds_unused) {
    char* lds = lds_dyn; (void)lds_unused;
    const int tid = tidx(), bid = bidx(), G = gdim();
    wconv_job<0, 2304, 1024>(p, l, WE_W1T, nullptr, lds);
    wconv_job<1, 4096, 1024>(p, l, WE_WGT, nullptr, lds);
    wconv_job<2, 384, 256>(p, l, WE_WUQ, p.in[I_QNORM] + l * 256, lds);
    wconv_job<3, 512, 128>(p, l, WE_WUKV, p.in[I_KVNORM] + l * 128, lds);
    wconv_job<4, 1024, 256>(p, l, WE_WBA, nullptr, lds);
    wconv_job<5, 1024, 256>(p, l, WE_WBB, nullptr, lds);
    wconv_job<6, 1024, 256>(p, l, WE_WBD, nullptr, lds);
    wconv_job<7, 1024, 1024>(p, l, WE_WOUT, nullptr, lds);
    wconv_job<8, 8192, 1024>(p, l, WE_WGU, nullptr, lds);
    wconv_job<9, 16384, 256>(p, l, WE_WDN, nullptr, lds);
    __syncthreads();
    {
        float* cs = (float*)lds;
        __syncthreads();
        if (tid < 64) { float s, c; sincospif(2.f * (float)tid / 64.f, &s, &c); cs[tid] = c; cs[64 + tid] = s; }
        __syncthreads();
        for (int idx = bid * 512 + tid; idx < 512 * 1024; idx += G * 512) {
            const int r = idx; const int n = r & 1023, kp = r >> 10; const int part = kp >> 8, g = (kp & 255) >> 6, c = kp & 63;
            const float* wb = p.in[I_WBR] + ((size_t)l * 4 + 2) * 256 * 1024 + (size_t)(g * 64) * 1024 + n;
            float s = 0.f;
#pragma unroll 8
            for (int k2 = 0; k2 < 64; ++k2) s += cs[part * 64 + ((k2 * c) & 63)] * wb[(size_t)k2 * 1024];
            wts(p, l, WE_WBC)[(size_t)n * 512 + kp] = f2bf(s * (1.f / 1024.f));
        }
    }
}

__device__ __forceinline__ bool skip_tile(int l, int tile) { return (l == NLAYER - 1) && ((tile % 130) >= 128); }
__device__ __forceinline__ float row16_sum(float x) {
    x += __int_as_float(__builtin_amdgcn_update_dpp(0, __float_as_int(x), 0xB1, 0xf, 0xf, true));
    x += __int_as_float(__builtin_amdgcn_update_dpp(0, __float_as_int(x), 0x4E, 0xf, 0xf, true));
    x += __int_as_float(__builtin_amdgcn_update_dpp(0, __float_as_int(x), 0x141, 0xf, 0xf, true));
    x += __int_as_float(__builtin_amdgcn_update_dpp(0, __float_as_int(x), 0x140, 0xf, 0xf, true));
    return x;
}
template <int WHICH>
PHASE_FN void ph_norm(const Params& p, int l, char* lds_unused) {
    char* lds = lds_dyn; (void)lds_unused;
    const int tid = tidx(), wid = tid >> 6, lane = tid & 63, sub = lane >> 4, l16 = lane & 15;
    float* Wr = (float*)lds;
    int* lcount = (int*)(lds + 81920);
    int* lbase = lcount + 32;
    int* pidl = lbase + 32;
    int* rankl = pidl + 128;
    if (WHICH >= 1) {
        for (int i = tid; i < 20 * 1024; i += 512) { const int j = i >> 10, k = i & 1023;
            Wr[i] = j < 4 ? p.in[I_MWG][(size_t)l * 4096 + k * 4 + j] : p.in[I_MWE][(size_t)l * 16384 + k * 16 + (j - 4)]; }
        __syncthreads();
    }
    const float* gain = (WHICH == 0 ? p.in[I_N1G] : p.in[I_N2G]) + l * 1024; float sink = 0.f;
    bf16_t* H = WSP(bf16_t, OFF_H);
    f32x4 vn[16]; bool have = false;
#pragma unroll
    for (int i = 0; i < 16; ++i) vn[i] = (f32x4){0.f, 0.f, 0.f, 0.f};
    for (int tile = bidx(); tile < NTILE * 4; tile += gdim()) {
        if (WHICH >= 1 && skip_tile(l, tile >> 2)) continue;
        if (WHICH == 1) { __syncthreads(); if (tid < 24) lcount[tid] = 0; __syncthreads(); }
        {
            const int rloc = wid * 4 + sub, r = tile * 32 + rloc;
            const float* xr = (WHICH == 0 && l == 0) ? xrow_in(p, r) : xrow_st(p, r);
            const float* mv = modvec(p, l, r) + (WHICH == 0 ? 0 : 3072);
            f32x4 v[16]; float ss = 0.f;
            if (WHICH >= 1 && have) {
#pragma unroll
                for (int i = 0; i < 16; ++i) { v[i] = vn[i]; ss += v[i][0] * v[i][0] + v[i][1] * v[i][1] + v[i][2] * v[i][2] + v[i][3] * v[i][3]; }
            } else {
#pragma unroll
                for (int i = 0; i < 16; ++i) { v[i] = *(const f32x4*)(xr + 4 * (l16 + 16 * i)); ss += v[i][0] * v[i][0] + v[i][1] * v[i][1] + v[i][2] * v[i][2] + v[i][3] * v[i][3]; }
            }
            ss = row16_sum(ss);
            const float rinv = rsqrtf(ss * (1.f / 1024.f) + 1e-6f);
#pragma unroll
            for (int i = 0; i < 16; ++i) {
                const int c0 = 4 * (l16 + 16 * i);
                const f32x4 g = *(const f32x4*)(gain + c0), sh = *(const f32x4*)(mv + c0), sc = *(const f32x4*)(mv + 1024 + c0);
#pragma unroll
                for (int e = 0; e < 4; ++e) v[i][e] = (v[i][e] * rinv * g[e]) * (1.f + sc[e]) + sh[e];
                u32x2 w; w.x = cvt_pk_bf16(v[i][0], v[i][1]); w.y = cvt_pk_bf16(v[i][2], v[i][3]);
                *(u32x2*)(H + (size_t)r * 1024 + c0) = w;
                if ((i & 3) == 3) __builtin_amdgcn_sched_barrier(0);
            }
            if (WHICH >= 1) {
                { int nt_ = tile + gdim(); while (nt_ < NTILE * 4 && skip_tile(l, nt_ >> 2)) nt_ += gdim();
                  have = nt_ < NTILE * 4;
                  if (have) { const float* xn = xrow_st(p, nt_ * 32 + rloc);
#pragma unroll
                      for (int i = 0; i < 16; ++i) vn[i] = *(const f32x4*)(xn + 4 * (l16 + 16 * i)); }
                  else {
#pragma unroll
                      for (int i = 0; i < 16; ++i) vn[i] = (f32x4){0.f, 0.f, 0.f, 0.f}; } }
                __builtin_amdgcn_sched_barrier(0);
                float lg[20];
                int wofs = 4 * l16; asm volatile("" : "+v"(wofs));
#pragma unroll
                for (int j = 0; j < 20; ++j) { f32x2 a2 = {0.f, 0.f};
#pragma unroll
                    for (int i = 0; i < 16; ++i) { const f32x4 w = *(const f32x4*)(Wr + j * 1024 + wofs + 64 * i);
                        a2 = __builtin_elementwise_fma(__builtin_shufflevector(v[i], v[i], 0, 1), __builtin_shufflevector(w, w, 0, 1), a2);
                        a2 = __builtin_elementwise_fma(__builtin_shufflevector(v[i], v[i], 2, 3), __builtin_shufflevector(w, w, 2, 3), a2);
                        if ((i & 7) == 7) __builtin_amdgcn_sched_barrier(0); }
                    lg[j] = row16_sum(a2[0] + a2[1]); __builtin_amdgcn_sched_barrier(0); }
#pragma unroll
                for (int j = 0; j < 4; ++j) lg[j] += p.in[I_MBG][l * 4 + j];
#pragma unroll
                for (int j = 0; j < 16; ++j) lg[4 + j] += p.in[I_MBE][l * 16 + j];
                int g = 0; float gm = lg[0];
#pragma unroll
                for (int j = 1; j < 4; ++j) if (lg[j] > gm) { gm = lg[j]; g = j; }
                float gs = 0.f;
#pragma unroll
                for (int j = 0; j < 4; ++j) gs += __expf(lg[j] - gm);
                const float gp = 1.f / gs;
                float e4[4];
#pragma unroll
                for (int j = 0; j < 4; ++j) e4[j] = g == 0 ? lg[4 + j] : g == 1 ? lg[8 + j] : g == 2 ? lg[12 + j] : lg[16 + j];
                int i1 = 0; float m1 = e4[0];
#pragma unroll
                for (int j = 1; j < 4; ++j) if (e4[j] > m1) { m1 = e4[j]; i1 = j; }
                int i2 = -1; float m2 = -3.4e38f;
#pragma unroll
                for (int j = 0; j < 4; ++j) if (j != i1 && e4[j] > m2) { m2 = e4[j]; i2 = j; }
                const float x2 = __expf(m2 - m1); const float pw1 = gp / (1.f + x2), pw2 = gp * x2 / (1.f + x2);
                const int lo = i1 < i2 ? i1 : i2, hi = i1 < i2 ? i2 : i1;
                const float wlo = i1 < i2 ? pw1 : pw2, whi = i1 < i2 ? pw2 : pw1;
                const int pairidx = lo == 0 ? hi - 1 : lo == 1 ? hi + 1 : 5;
                if (WHICH == 2) sink += wlo + whi + (float)pairidx;
                if (l16 == 0 && WHICH == 1) { pidl[rloc] = g * 6 + pairidx; WSP(float, OFF_TOKW)[(size_t)r * 2] = wlo; WSP(float, OFF_TOKW)[(size_t)r * 2 + 1] = whi; }
            }
        }
        if (WHICH == 2) asm volatile("" :: "v"(sink));
        if (WHICH == 1) {
            __syncthreads();
            int mypid = 0;
            if (tid < 32) { mypid = pidl[tid]; rankl[tid] = atomicAdd(&lcount[mypid], 1); }
            __syncthreads();
            if (tid < 24) lbase[tid] = lcount[tid] ? atomicAdd(WSP(int, OFF_CNT) + l * 32 + tid, lcount[tid]) : 0;
            __syncthreads();
            if (tid < 32) WSP(int, OFF_LISTS)[(size_t)mypid * T + lbase[mypid] + rankl[tid]] = tile * 32 + tid;
        }
    }
}

PHASE_FN void ph_filt(const Params& p, int l, char* lds_unused) {
    char* lds = lds_dyn; (void)lds_unused;
    const int tid = tidx(), lane = tid & 63, wid = tid >> 6, wm = wid >> 2, wn = wid & 3, fr = lane & 15, fq = lane >> 4;
    const bf16_t* A = WSP(const bf16_t, OFF_H2L) + (size_t)l * 16384 * 64; const bf16_t* B = WSP(const bf16_t, OFF_W3T) + (size_t)l * 1024 * 64;
    bf16_t* F = WSP(bf16_t, OFF_FILT);
    for (int u = bidx(); u < 128 * 8; u += gdim()) {
        const int n0 = (u >> 3) * 128, c0 = (u & 7) * 128;
        const bf16_t* a0 = A + (size_t)(n0 + g_srow()) * 64 + g_skc() * 8; const bf16_t* b0 = B + (size_t)(c0 + g_srow()) * 64 + g_skc() * 8;
        f32x4 acc[4][2]; acc_zero(acc);
        mma_seg<0, 0>(acc, a0, a0 + (size_t)64 * 64, 0, b0, b0 + (size_t)64 * 64, 64, lds);
#pragma unroll
        for (int mt = 0; mt < 4; ++mt)
#pragma unroll
            for (int nt = 0; nt < 2; ++nt) { const int n = n0 + wm * 64 + mt * 16 + fq * 4, col = c0 + wn * 32 + nt * 16 + fr;
                u32x2 w; w.x = cvt_pk_bf16(acc[mt][nt][0], acc[mt][nt][1]); w.y = cvt_pk_bf16(acc[mt][nt][2], acc[mt][nt][3]);
                *(u32x2*)(F + (size_t)col * 16384 + n) = w; }
    }
}

PHASE_FN void ph_gemm1(const Params& p, int l, char* lds_unused) {
    char* lds = lds_dyn; (void)lds_unused;
    const int tid = tidx(), lane = tid & 63, wid = tid >> 6, wm = wid >> 1, wn = wid & 1, fr = lane & 15, fq = lane >> 4;
    const bf16_t* H = WSP(bf16_t, OFF_H); const bf16_t* W = wts(p, l, WE_W1T);
    for (int u = bidx(); u < (NTILE / 2) * 18; u += gdim()) {
        const int rt = u / 18, ct = u % 18; const int r0 = rt * 256, n0 = ct * 128;
        const bf16_t* a0 = H + (size_t)(r0 + g_srow()) * 1024 + g_skc() * 8; const bf16_t* b0 = W + (size_t)(n0 + g_srow()) * 1024 + g_skc() * 8;
        f32x4 acc[4][4]; acc_zero256(acc);
        if (ct < 10) {
            mma_seg256<1>(acc, a0, (size_t)64 * 1024, b0, (size_t)64 * 1024, 1024, lds);
            bf16_t* P = WSP(bf16_t, OFF_P);
#pragma unroll
            for (int mt = 0; mt < 4; ++mt)
#pragma unroll
                for (int nt = 0; nt < 4; ++nt) { const int row = r0 + wm * 64 + mt * 16 + fr, col = n0 + wn * 64 + nt * 16 + fq * 4;
                    u32x2 w; w.x = cvt_pk_bf16(acc[mt][nt][0], acc[mt][nt][1]); w.y = cvt_pk_bf16(acc[mt][nt][2], acc[mt][nt][3]);
                    *(u32x2*)(P + (size_t)row * PLD + col) = w; }
        } else {
            mma_seg256<0>(acc, a0, (size_t)64 * 1024, b0, (size_t)64 * 1024, 1024, lds);
            const int b = r0 >= TPB ? 1 : 0, t0 = r0 - b * TPB;
            bf16_t* HT = WSP(bf16_t, OFF_HYFN) + (size_t)b * 1024 * TPB;
#pragma unroll
            for (int mt = 0; mt < 4; ++mt)
#pragma unroll
                for (int nt = 0; nt < 4; ++nt) { const int t = t0 + wm * 64 + mt * 16 + fq * 4, ch = (n0 - 1280) + wn * 64 + nt * 16 + fr;
                    u32x2 w; w.x = cvt_pk_bf16(acc[mt][nt][0], acc[mt][nt][1]); w.y = cvt_pk_bf16(acc[mt][nt][2], acc[mt][nt][3]);
                    *(u32x2*)(HT + (size_t)ch * TPB + t) = w; }
        }
    }
}

#define KSWZ(row, colB) ((row) * 256 + ((colB) ^ (((row) & 7) << 4)))
#define SBAR() __builtin_amdgcn_sched_barrier(0)
__device__ __forceinline__ int crow(int r, int hi) { return (r & 3) + 8 * (r >> 2) + 4 * hi; }
__device__ __forceinline__ int v_st(int k, int c) { const int kk = (k & ~0xC) | ((k & 4) << 1) | ((k & 8) >> 1); return ((kk >> 3) * 2 + (c >> 5)) * 512 + ((kk & 7) * 32 + (c & 31)) * 2; }
__device__ __forceinline__ int v_rd_base(int lane) { return ((lane & 3) << 3) | (((lane >> 2) & 3) << 6) | (((lane >> 4) & 1) << 5) | (((lane >> 5) & 1) << 8); }
constexpr int v_rd_off(int d0, int ks, int half) { return d0 * 512 + ks * 2048 + half * 1024; }
template <int OFF> __device__ __forceinline__ s16x4 tr_read(int vb) {
    s16x4 r; asm volatile("ds_read_b64_tr_b16 %0, %1 offset:%2" : "=&v"(r) : "v"(vb), "i"(OFF) : "memory"); return r;
}
template <int D0> __device__ __forceinline__ void pv_one(f32x16& od, int vb, bf16x8 pa0, bf16x8 pa1, bf16x8 pa2, bf16x8 pa3) {
    const s16x4 l0 = tr_read<v_rd_off(D0, 0, 0)>(vb), h0 = tr_read<v_rd_off(D0, 0, 1)>(vb), l1 = tr_read<v_rd_off(D0, 1, 0)>(vb), h1 = tr_read<v_rd_off(D0, 1, 1)>(vb);
    const s16x4 l2 = tr_read<v_rd_off(D0, 2, 0)>(vb), h2 = tr_read<v_rd_off(D0, 2, 1)>(vb), l3 = tr_read<v_rd_off(D0, 3, 0)>(vb), h3 = tr_read<v_rd_off(D0, 3, 1)>(vb);
    asm volatile("s_waitcnt lgkmcnt(0)" ::: "memory"); SBAR();
#define PKV(L, H) (bf16x8){L[0], L[1], L[2], L[3], H[0], H[1], H[2], H[3]}
    od = __builtin_amdgcn_mfma_f32_32x32x16_bf16(pa0, PKV(l0, h0), od, 0, 0, 0);
    od = __builtin_amdgcn_mfma_f32_32x32x16_bf16(pa1, PKV(l1, h1), od, 0, 0, 0);
    od = __builtin_amdgcn_mfma_f32_32x32x16_bf16(pa2, PKV(l2, h2), od, 0, 0, 0);
    od = __builtin_amdgcn_mfma_f32_32x32x16_bf16(pa3, PKV(l3, h3), od, 0, 0, 0);
#undef PKV
}
constexpr int ATT_LDS = 16384 + 32768 + 2048;
constexpr float ATT_THR = 8.f;
template <int DQK, int NA>
__device__ __forceinline__ void attn_unit(const bf16_t* __restrict__ Qb, int ldq, const bf16_t* __restrict__ Kb, int ldk, const bf16_t* __restrict__ Vb, int ldv,
                                          bf16_t* __restrict__ Ob, int ldo, int NT, int nA, int baseA, int baseB, char* lds, const float* biasL, int qrow0, int krow_lo) {
    constexpr float SCALE = DQK == 96 ? 0.10206207261596575f : 0.125f;
    constexpr float C = SCALE * 1.4426950408889634f;
    constexpr int ND = DQK / 16, NKC = DQK / 8;
    const int tid = tidx(), wid = tid >> 6, lane = tid & 63, r32 = lane & 31, hi = lane >> 5;
    char* V_lds = lds; char* K_lds = lds + 16384;
    float* wsf = (float*)(lds + 49152) + wid * 64; float* al_l = wsf; float* li_l = wsf + 32;
    bf16x8 qr[ND];
    { const bf16_t* Qw = Qb + (size_t)(wid * 32 + r32) * ldq + hi * 8;
#pragma unroll
      for (int d0 = 0; d0 < ND; ++d0) qr[d0] = *(const bf16x8*)(Qw + d0 * 16); }
    const int vrow = tid >> 3, vc = (tid & 7) * 8, vst = v_st(vrow, vc);
    const int k0row = tid / NKC, k0c = tid % NKC, kst0 = KSWZ(k0row, k0c * 16);
    const int id1 = tid + 512; const bool has1 = (DQK == 96) && (id1 < 64 * NKC);
    const int k1row = has1 ? id1 / NKC : 0, k1c = has1 ? id1 % NKC : 0, kst1 = KSWZ(k1row, k1c * 16);
    const int vb0 = (int)(uintptr_t)V_lds + v_rd_base(lane);
    bf16x8 sv, sk0, sk1;
    auto SLOAD = [&](int j) { const size_t t0 = (size_t)(j < nA ? baseA + 64 * j : baseB + 64 * (j - nA));
        sv = *(const bf16x8*)(Vb + (t0 + vrow) * ldv + vc); sk0 = *(const bf16x8*)(Kb + (t0 + k0row) * ldk + k0c * 8);
        if (has1) sk1 = *(const bf16x8*)(Kb + (t0 + k1row) * ldk + k1c * 8); };
    auto SWRITE = [&](int b) { *(bf16x8*)(V_lds + b * 8192 + vst) = sv; *(bf16x8*)(K_lds + b * 16384 + kst0) = sk0; if (has1) *(bf16x8*)(K_lds + b * 16384 + kst1) = sk1; };
    float m_reg = -1e30f, l_reg = 0.f; f32x16 o0 = {}, o1 = {};
    __syncthreads();
    SLOAD(0); SWRITE(0); __syncthreads();
    for (int j = 0; j < NT; ++j) {
        const int bsel = j & 1;
        if (j + 1 < NT) SLOAD(j + 1);
        f32x16 p0 = {}, p1 = {};
        { const char* Ks = K_lds + bsel * 16384;
#pragma unroll
          for (int d0 = 0; d0 < ND; ++d0) { const int cb = d0 * 32 + hi * 16;
            const bf16x8 b0 = *(const bf16x8*)(Ks + KSWZ(r32, cb)); const bf16x8 b1 = *(const bf16x8*)(Ks + KSWZ(32 + r32, cb));
            p0 = __builtin_amdgcn_mfma_f32_32x32x16_bf16(b0, qr[d0], p0, 0, 0, 0);
            p1 = __builtin_amdgcn_mfma_f32_32x32x16_bf16(b1, qr[d0], p1, 0, 0, 0); } }
        if (NA) {
            if (j >= nA) {
                const int krow = krow_lo + (j - nA), qrow = qrow0 + (wid >> 1);
                int ws = qrow - 4; ws = ws < 0 ? 0 : (ws > 248 ? 248 : ws);
                const bool rowok = (krow >= ws) && (krow < ws + 8);
                const int qc = 32 * (wid & 1) + r32; int cs = qc - 8; cs = cs < 0 ? 0 : (cs > 48 ? 48 : cs);
                int dri = krow - qrow + 7; dri = dri < 0 ? 0 : (dri > 14 ? 14 : dri);
                const float* brow = biasL + dri * 31 + 15 - qc;
#pragma unroll
                for (int r = 0; r < 16; ++r) { const int kc = crow(r, hi); const bool ok = rowok && kc >= cs && kc < cs + 16; float bv = 0.f; if (ok) bv = brow[kc]; p0[r] = ok ? p0[r] + bv : -1e30f; }
#pragma unroll
                for (int r = 0; r < 16; ++r) { const int kc = 32 + crow(r, hi); const bool ok = rowok && kc >= cs && kc < cs + 16; float bv = 0.f; if (ok) bv = brow[kc]; p1[r] = ok ? p1[r] + bv : -1e30f; }
            }
        }
        float pmax = p0[0];
#pragma unroll
        for (int r = 1; r < 16; ++r) pmax = fmaxf(pmax, p0[r]);
#pragma unroll
        for (int r = 0; r < 16; ++r) pmax = fmaxf(pmax, p1[r]);
        { auto rr = __builtin_amdgcn_permlane32_swap(__float_as_uint(pmax), __float_as_uint(pmax), false, false); pmax = fmaxf(__uint_as_float(rr[0]), __uint_as_float(rr[1])); }
        float mn, alpha;
        if (__all(pmax - m_reg <= ATT_THR / SCALE)) { mn = m_reg; alpha = 1.f; }
        else { mn = fmaxf(m_reg, pmax); alpha = __builtin_amdgcn_exp2f((m_reg - mn) * C); m_reg = mn; }
        const float mnC = -mn * C;
        float ps = 0.f;
#pragma unroll
        for (int r = 0; r < 16; ++r) { p0[r] = __builtin_amdgcn_exp2f(fmaf(p0[r], C, mnC)); ps += p0[r]; }
#pragma unroll
        for (int r = 0; r < 16; ++r) { p1[r] = __builtin_amdgcn_exp2f(fmaf(p1[r], C, mnC)); ps += p1[r]; }
        { auto rr = __builtin_amdgcn_permlane32_swap(__float_as_uint(ps), __float_as_uint(ps), false, false); ps = __uint_as_float(rr[0]) + __uint_as_float(rr[1]); }
        l_reg = l_reg * alpha + ps;
        bf16x8 pa0, pa1, pa2, pa3;
#define PK4(P, BASE, OUT) do { unsigned a0_ = cvt_pk_bf16(P[BASE + 0], P[BASE + 1]), a1_ = cvt_pk_bf16(P[BASE + 2], P[BASE + 3]);   \
        unsigned b0_ = cvt_pk_bf16(P[BASE + 4], P[BASE + 5]), b1_ = cvt_pk_bf16(P[BASE + 6], P[BASE + 7]);                              \
        auto r0_ = __builtin_amdgcn_permlane32_swap(a0_, b0_, false, false); auto r1_ = __builtin_amdgcn_permlane32_swap(a1_, b1_, false, false); \
        u32x4 w_ = {r0_[0], r1_[0], r0_[1], r1_[1]}; OUT = *reinterpret_cast<bf16x8*>(&w_); } while (0)
        PK4(p0, 0, pa0); PK4(p0, 8, pa1); PK4(p1, 0, pa2); PK4(p1, 8, pa3);
#undef PK4
        if (__any(alpha < 1.f)) {
            if (hi == 0) al_l[r32] = alpha;
            asm volatile("s_waitcnt lgkmcnt(0)" ::: "memory");
#pragma unroll
            for (int r = 0; r < 16; ++r) { const float a = al_l[crow(r, hi)]; o0[r] *= a; o1[r] *= a; }
        }
        pv_one<0>(o0, vb0 + bsel * 8192, pa0, pa1, pa2, pa3);
        pv_one<1>(o1, vb0 + bsel * 8192, pa0, pa1, pa2, pa3);
        if (j + 1 < NT) SWRITE(bsel ^ 1);
        __syncthreads();
    }
    if (hi == 0) li_l[r32] = l_reg;
    asm volatile("s_waitcnt lgkmcnt(0)" ::: "memory");
    bf16_t* Ow = Ob + (size_t)(wid * 32) * ldo;
#pragma unroll
    for (int r = 0; r < 16; ++r) { const int orow = crow(r, hi); const float rl = __builtin_amdgcn_rcpf(li_l[orow]);
        Ow[(size_t)orow * ldo + r32] = f2bf(o0[r] * rl); Ow[(size_t)orow * ldo + 32 + r32] = f2bf(o1[r] * rl); }
    __syncthreads();
}

__device__ __forceinline__ void mla_partialSM(f32x16& p0, f32x16& p1, float& m_reg, float& alpha, bool first) {
    constexpr float THR2 = ATT_THR * 1.4426950408889634f;
    float pmax = p0[0];
#pragma unroll
    for (int r = 1; r < 16; ++r) pmax = fmaxf(pmax, p0[r]);
#pragma unroll
    for (int r = 0; r < 16; ++r) pmax = fmaxf(pmax, p1[r]);
    { auto rr = __builtin_amdgcn_permlane32_swap(__float_as_uint(pmax), __float_as_uint(pmax), false, false); pmax = fmaxf(__uint_as_float(rr[0]), __uint_as_float(rr[1])); }
    if (__builtin_expect(!first && __all(pmax <= THR2), 1)) { alpha = 1.f; }
    else { const float d = first ? pmax : fmaxf(pmax, 0.f); alpha = first ? 1.f : __builtin_amdgcn_exp2f(-d); m_reg += d;
#pragma unroll
        for (int r = 0; r < 16; ++r) { p0[r] -= d; p1[r] -= d; } }
#pragma unroll
    for (int r = 0; r < 16; ++r) p0[r] = __builtin_amdgcn_exp2f(p0[r]);
}
__device__ __forceinline__ void mla_finishSM(f32x16& p0, f32x16& p1, float alpha, float& l_reg, bf16x8& pa0, bf16x8& pa1, bf16x8& pa2, bf16x8& pa3) {
#pragma unroll
    for (int r = 0; r < 16; ++r) p1[r] = __builtin_amdgcn_exp2f(p1[r]);
    f32x2 s2 = {p0[0], p0[1]}, t2 = {p1[0], p1[1]};
#pragma unroll
    for (int r = 2; r < 16; r += 2) { s2 += (f32x2){p0[r], p0[r + 1]}; t2 += (f32x2){p1[r], p1[r + 1]}; }
    s2 += t2; float ps = s2[0] + s2[1];
    { auto rr = __builtin_amdgcn_permlane32_swap(__float_as_uint(ps), __float_as_uint(ps), false, false); ps = __uint_as_float(rr[0]) + __uint_as_float(rr[1]); }
    l_reg = l_reg * alpha + ps;
#define PK4(P, BASE, OUT) do { unsigned a0_ = cvt_pk_bf16(P[BASE + 0], P[BASE + 1]), a1_ = cvt_pk_bf16(P[BASE + 2], P[BASE + 3]);   \
    unsigned b0_ = cvt_pk_bf16(P[BASE + 4], P[BASE + 5]), b1_ = cvt_pk_bf16(P[BASE + 6], P[BASE + 7]);                              \
    auto r0_ = __builtin_amdgcn_permlane32_swap(a0_, b0_, false, false); auto r1_ = __builtin_amdgcn_permlane32_swap(a1_, b1_, false, false); \
    u32x4 w_ = {r0_[0], r1_[0], r0_[1], r1_[1]}; OUT = *reinterpret_cast<bf16x8*>(&w_); } while (0)
    PK4(p0, 0, pa0); PK4(p0, 8, pa1); PK4(p1, 0, pa2); PK4(p1, 8, pa3);
#undef PK4
}
__device__ __forceinline__ void mla_qkt(f32x16& p0, f32x16& p1, const char* Ks, const bf16x8* qr, int r32, int hi, float init) {
#pragma unroll
    for (int r = 0; r < 16; ++r) { p0[r] = init; p1[r] = init; }
#pragma unroll
    for (int d0 = 0; d0 < 6; ++d0) { const int cb = d0 * 32 + hi * 16;
        const bf16x8 b0 = *(const bf16x8*)(Ks + KSWZ(r32, cb)); const bf16x8 b1 = *(const bf16x8*)(Ks + KSWZ(32 + r32, cb));
        p0 = __builtin_amdgcn_mfma_f32_32x32x16_bf16(b0, qr[d0], p0, 0, 0, 0);
        p1 = __builtin_amdgcn_mfma_f32_32x32x16_bf16(b1, qr[d0], p1, 0, 0, 0); }
}
__device__ __forceinline__ void mla_unit(const bf16_t* __restrict__ Qb, const bf16_t* __restrict__ Kb, const bf16_t* __restrict__ Vb, bf16_t* __restrict__ Ob,
                                         int NT, int nA, int baseA, int baseB, char* lds) {
    constexpr int ldq = 384, ldk = 384, ldv = 256, ldo = 512;
    const int tid = tidx(), wid = tid >> 6, lane = tid & 63, r32 = lane & 31, hi = lane >> 5;
    char* V_lds = lds; char* K_lds = lds + 16384;
    float* wsf = (float*)(lds + 49152) + wid * 64; float* al_l = wsf; float* li_l = wsf + 32;
    bf16x8 qr[6];
    { const bf16_t* Qw = Qb + (size_t)(wid * 32 + r32) * ldq + hi * 8;
#pragma unroll
      for (int d0 = 0; d0 < 6; ++d0) qr[d0] = *(const bf16x8*)(Qw + d0 * 16); }
    const int vrow = tid >> 3, vc = (tid & 7) * 8, vst = v_st(vrow, vc);
    const int k0row = tid / 12, k0c = tid % 12, kst0 = KSWZ(k0row, k0c * 16);
    const int id1 = tid + 512; const bool has1 = id1 < 768;
    const int k1row = has1 ? id1 / 12 : 0, k1c = has1 ? id1 % 12 : 0, kst1 = KSWZ(k1row, k1c * 16);
    const int vb0 = (int)(uintptr_t)V_lds + v_rd_base(lane);
    bf16x8 sv, sk0, sk1;
    auto SLOAD = [&](int j) { const size_t t0 = (size_t)(j < nA ? baseA + 64 * j : baseB + 64 * (j - nA));
        sv = *(const bf16x8*)(Vb + (t0 + vrow) * ldv + vc); sk0 = *(const bf16x8*)(Kb + (t0 + k0row) * ldk + k0c * 8);
        if (has1) sk1 = *(const bf16x8*)(Kb + (t0 + k1row) * ldk + k1c * 8); };
    auto SWRITE = [&](int b) { *(bf16x8*)(V_lds + b * 8192 + vst) = sv; *(bf16x8*)(K_lds + b * 16384 + kst0) = sk0; if (has1) *(bf16x8*)(K_lds + b * 16384 + kst1) = sk1; };
#define MLA_RESC(a) do { if (__any((a) < 1.f)) { if (hi == 0) al_l[r32] = (a); asm volatile("s_waitcnt lgkmcnt(0)" ::: "memory"); \
    _Pragma("unroll") for (int r = 0; r < 16; ++r) { const float a_ = al_l[crow(r, hi)]; o0[r] *= a_; o1[r] *= a_; } } } while (0)
    float m_reg = 0.f, l_reg = 0.f; f32x16 o0 = {}, o1 = {};
    f32x16 pA0, pA1, pB0, pB1; float alA, alB; bf16x8 pa0, pa1, pa2, pa3;
    __syncthreads();
    SLOAD(0); SWRITE(0); __syncthreads();
    mla_qkt(pA0, pA1, K_lds, qr, r32, hi, 0.f); mla_partialSM(pA0, pA1, m_reg, alA, true);
    SLOAD(1); SWRITE(1); __syncthreads();
    for (int j = 1; j + 1 < NT; j += 2) {
        SBAR(); mla_qkt(pB0, pB1, K_lds + 16384, qr, r32, hi, -m_reg);
        mla_finishSM(pA0, pA1, alA, l_reg, pa0, pa1, pa2, pa3); SBAR();
        SLOAD(j + 1); SBAR();
        pv_one<0>(o0, vb0, pa0, pa1, pa2, pa3); pv_one<1>(o1, vb0, pa0, pa1, pa2, pa3); mla_partialSM(pB0, pB1, m_reg, alB, false);
        __syncthreads(); SWRITE(0);
        MLA_RESC(alB); __syncthreads();
        SBAR(); mla_qkt(pA0, pA1, K_lds, qr, r32, hi, -m_reg);
        mla_finishSM(pB0, pB1, alB, l_reg, pa0, pa1, pa2, pa3); SBAR();
        SLOAD(j + 2); SBAR();
        pv_one<0>(o0, vb0 + 8192, pa0, pa1, pa2, pa3); pv_one<1>(o1, vb0 + 8192, pa0, pa1, pa2, pa3); mla_partialSM(pA0, pA1, m_reg, alA, false);
        __syncthreads(); SWRITE(1);
        MLA_RESC(alA); __syncthreads();
    }
    SBAR(); mla_qkt(pB0, pB1, K_lds + 16384, qr, r32, hi, -m_reg);
    mla_finishSM(pA0, pA1, alA, l_reg, pa0, pa1, pa2, pa3); SBAR();
    pv_one<0>(o0, vb0, pa0, pa1, pa2, pa3); pv_one<1>(o1, vb0, pa0, pa1, pa2, pa3); mla_partialSM(pB0, pB1, m_reg, alB, false);
    __syncthreads(); MLA_RESC(alB);
    mla_finishSM(pB0, pB1, alB, l_reg, pa0, pa1, pa2, pa3); SBAR();
    pv_one<0>(o0, vb0 + 8192, pa0, pa1, pa2, pa3); pv_one<1>(o1, vb0 + 8192, pa0, pa1, pa2, pa3);
#undef MLA_RESC
    if (hi == 0) li_l[r32] = l_reg;
    asm volatile("s_waitcnt lgkmcnt(0)" ::: "memory");
    bf16_t* Ow = Ob + (size_t)(wid * 32) * ldo;
#pragma unroll
    for (int r = 0; r < 16; ++r) { const int orow = crow(r, hi); const float rl = __builtin_amdgcn_rcpf(li_l[orow]);
        Ow[(size_t)orow * ldo + r32] = f2bf(o0[r] * rl); Ow[(size_t)orow * ldo + 32 + r32] = f2bf(o1[r] * rl); }
    __syncthreads();
}

__device__ __forceinline__ void upproj_tile(const Params& p, int l, int tile, int part, char* lds) {
    const int tid = tidx(), lane = tid & 63, wid = tid >> 6, wm = wid >> 2, wn = wid & 3, fr = lane & 15, fq = lane >> 4;
    const int r0 = tile * 128; const bool ctx = row_is_ctx(r0); const int b = r0 >= TPB ? 1 : 0, t0 = r0 - b * TPB;
    float* rq = (float*)(lds + G_LDS); float* rkv = rq + 128;
    const bf16_t* P = WSP(bf16_t, OFF_P); bf16_t* Qo = WSP(bf16_t, OFF_Q); bf16_t* Ko = WSP(bf16_t, OFF_K); bf16_t* Vo = WSP(bf16_t, OFF_V);
    const float2* rope = WSP(float2, OFF_ROPE);
    __syncthreads();
    {
        const int row = tid >> 2, qd = tid & 3; const bf16_t* pr = P + (size_t)(r0 + row) * PLD;
        float sq = 0.f, sk = 0.f;
#pragma unroll
        for (int i = 0; i < 8; ++i) { const bf16x8 v = *(const bf16x8*)(pr + 768 + qd * 64 + i * 8);
#pragma unroll
            for (int e = 0; e < 8; ++e) { const float x = bf2f((bf16_t)v[e]); sq += x * x; } }
#pragma unroll
        for (int i = 0; i < 4; ++i) { const bf16x8 v = *(const bf16x8*)(pr + 1024 + qd * 32 + i * 8);
#pragma unroll
            for (int e = 0; e < 8; ++e) { const float x = bf2f((bf16_t)v[e]); sk += x * x; } }
        sq += __shfl_xor(sq, 1); sq += __shfl_xor(sq, 2); sk += __shfl_xor(sk, 1); sk += __shfl_xor(sk, 2);
        if (qd == 0) { rq[row] = rsqrtf(sq * (1.f / 256.f) + 1e-6f); rkv[row] = rsqrtf(sk * (1.f / 128.f) + 1e-6f); }
    }
    if (part == 0) for (int it = tid; it < 128 * 16; it += 512) {
        const int row = it >> 4, pi = it & 15; const bf16_t* pr = P + (size_t)(r0 + row) * PLD + 1152 + 2 * pi;
        float xe = bf2f(pr[0]), xo = bf2f(pr[1]);
        if (!ctx) { const int t = t0 + row; const int pos = pi < 8 ? (t >> 6) : (t & 63); const float2 cs = rope[pos * 8 + (pi & 7)];
            const float ne = xe * cs.x - xo * cs.y, no = xe * cs.y + xo * cs.x; xe = ne; xo = no; }
        const unsigned w = cvt_pk_bf16(xe, xo);
#pragma unroll
        for (int h = 0; h < 4; ++h) *(unsigned*)(Ko + (size_t)(r0 + row) * 384 + h * 96 + 64 + 2 * pi) = w;
    }
    __syncthreads();
    if (part < 3) { const int ct = part;
        const bf16_t* a0 = P + (size_t)(r0 + g_srow()) * PLD + 768 + g_skc() * 8; const bf16_t* a1 = a0 + (size_t)64 * PLD;
        const bf16_t* b0 = wts(p, l, WE_WUQ) + (size_t)(ct * 128 + g_srow()) * 256 + g_skc() * 8; const bf16_t* b1 = b0 + (size_t)64 * 256;
        f32x4 acc[4][2]; acc_zero(acc);
        mma_seg<1, 0>(acc, a0, a1, 0, b0, b1, 256, lds);
#pragma unroll
        for (int mt = 0; mt < 4; ++mt) { const int row = wm * 64 + mt * 16 + fr; const float rs = rq[row] * 0.14724260355f; const int t = t0 + row;
#pragma unroll
            for (int nt = 0; nt < 2; ++nt) { const int col = ct * 128 + wn * 32 + nt * 16 + fq * 4; const int dd = col % 96;
                float v0 = acc[mt][nt][0] * rs, v1 = acc[mt][nt][1] * rs, v2 = acc[mt][nt][2] * rs, v3 = acc[mt][nt][3] * rs;
                if (dd >= 64 && !ctx) { const int pi = (dd - 64) >> 1;
                    const int posa = pi < 8 ? (t >> 6) : (t & 63), posb = (pi + 1) < 8 ? (t >> 6) : (t & 63);
                    const float2 ca = rope[posa * 8 + (pi & 7)], cb = rope[posb * 8 + ((pi + 1) & 7)];
                    const float n0 = v0 * ca.x - v1 * ca.y, n1 = v0 * ca.y + v1 * ca.x, n2 = v2 * cb.x - v3 * cb.y, n3 = v2 * cb.y + v3 * cb.x; v0 = n0; v1 = n1; v2 = n2; v3 = n3; }
                u32x2 w; w.x = cvt_pk_bf16(v0, v1); w.y = cvt_pk_bf16(v2, v3);
                *(u32x2*)(Qo + (size_t)(r0 + row) * 384 + col) = w; } }
    }
    if (part >= 3) { const int ct = part - 3;
        const bf16_t* a0 = P + (size_t)(r0 + g_srow()) * PLD + 1024 + g_skc() * 8; const bf16_t* a1 = a0 + (size_t)64 * PLD;
        const bf16_t* b0 = wts(p, l, WE_WUKV) + (size_t)(ct * 128 + g_srow()) * 128 + g_skc() * 8; const bf16_t* b1 = b0 + (size_t)64 * 128;
        f32x4 acc[4][2]; acc_zero(acc);
        mma_seg<1, 0>(acc, a0, a1, 0, b0, b1, 128, lds);
#pragma unroll
        for (int mt = 0; mt < 4; ++mt) { const int row = wm * 64 + mt * 16 + fr; const float rs = rkv[row];
#pragma unroll
            for (int nt = 0; nt < 2; ++nt) { const int cc = wn * 32 + nt * 16 + fq * 4;
                u32x2 w; w.x = cvt_pk_bf16(acc[mt][nt][0] * rs, acc[mt][nt][1] * rs); w.y = cvt_pk_bf16(acc[mt][nt][2] * rs, acc[mt][nt][3] * rs);
                if (cc < 64) *(u32x2*)(Ko + (size_t)(r0 + row) * 384 + ct * 96 + cc) = w;
                else *(u32x2*)(Vo + (size_t)(r0 + row) * 256 + ct * 64 + (cc - 64)) = w; } }
    }
}
__device__ __forceinline__ float sconv_lat(const bf16_t* HT, const float* sw, int b, int ch, int n) {
    const bf16_t* r = HT + ((size_t)b * 1024 + ch) * TPB;
    const float um = n > 0 ? bf2f(r[n - 1]) : 0.f, u0 = bf2f(r[n]), up = n < SEQ - 1 ? bf2f(r[n + 1]) : 0.f;
    return sw[ch] * um + sw[768 + ch] * u0 + sw[1536 + ch] * up;
}
__device__ __forceinline__ float2 h2f(unsigned u) { return make_float2((float)__builtin_bit_cast(_Float16, (unsigned short)(u & 0xffffu)), (float)__builtin_bit_cast(_Float16, (unsigned short)(u >> 16))); }
__device__ __forceinline__ unsigned f2h(float2 v) { return __builtin_bit_cast(unsigned, __builtin_amdgcn_cvt_pkrtz(v.x, v.y)); }
__device__ __forceinline__ void hyena_unit(const Params& p, int l, int c, char* lds, const FFrag& FF) {
    float2* buf = (float2*)lds; const float2* thi = (const float2*)(lds + FFT_LDS_TAB); const float2* tlo = thi + 128; const float2* t2hi = thi + 256; const float2* t2lo = thi + 384;
    float* red = (float*)(lds + FFT_LDS_EXTRA);
    const bf16_t* HT = WSP(const bf16_t, OFF_HYFN); const float* sw = p.in[I_HYSW] + (size_t)l * 3 * 768;
    const bf16_t* FL = WSP(const bf16_t, OFF_FILT);
    const float d0 = -3.0701134573253945f, d1 = -15.350567286626973f;
    const float awin = fabsf(d0 + (float)c * ((d1 - d0) / 255.f)) * (1.f / 16383.f);
    unsigned* GS = WSP(unsigned, OFF_HYS) + (size_t)(bidx() & 255) * 65536; unsigned* YS = GS + 16384; unsigned* XS = YS + 16384;
    unsigned Zr[32];
#define HY_W2(n) cmulf(t2hi[(n) >> 7], t2lo[(n) & 127])
#define HY_ST(a, q, v) __hip_atomic_store((a) + (q), (v), __ATOMIC_RELAXED, __HIP_MEMORY_SCOPE_AGENT)
#define HY_LD(a, q) __hip_atomic_load((a) + (q), __ATOMIC_RELAXED, __HIP_MEMORY_SCOPE_AGENT)
    __syncthreads();
#pragma unroll 4
    for (int i = 0; i < 32; ++i) { const int n = tidx() + 512 * i; buf[FBI(n)] = make_float2(sconv_lat(HT, sw, 0, c, n), sconv_lat(HT, sw, 1, c, n)); }
#pragma unroll
    for (int i = 0; i < 32; ++i) Zr[i] = f2h(buf[FBI(tidx() + 512 * i)]);
#pragma unroll 1
    for (int order = 0; order < 2; ++order) {
        const bf16_t* ff = FL + (size_t)(order * 256 + c) * 16384; const bf16_t* fb = FL + (size_t)(512 + order * 256 + c) * 16384;
        float ss = 0.f;
#pragma unroll 4
        for (int i = 0; i < 32; ++i) { const int n = tidx() + 512 * i; const float win = __expf(-(float)n * awin); const float hf = bf2f(ff[n]) * win, hb = bf2f(fb[n]) * win; ss += hf * hf + (n ? hb * hb : 0.f);
            HY_ST(XS, n, f2h(make_float2(sconv_lat(HT, sw, 0, (order + 1) * 256 + c, n), sconv_lat(HT, sw, 1, (order + 1) * 256 + c, n)))); }
        const float tot = block_sum(ss, red);
        const float fac = rsqrtf(tot + 1e-6f) * (16.f / 32768.f);
        const float bias = p.in[I_HYBIAS][(size_t)l * 512 + order * 256 + c];
#pragma unroll 1
        for (int par = 0; par < 2; ++par) {
            __syncthreads();
#pragma unroll 8
            for (int i = 0; i < 32; ++i) { const int n = tidx() + 512 * i; const int nr = 16384 - n;
                const float hf = bf2f(ff[n]) * __expf(-(float)n * awin); const float hbr = n ? bf2f(fb[nr]) * __expf(-(float)nr * awin) : 0.f;
                float2 v; if (par == 0) v = make_float2(hf + hbr, 0.f); else { const float2 w = HY_W2(n); const float d = hf - hbr; v = make_float2(d * w.x, d * w.y); }
                buf[FBI(n)] = v; }
            __syncthreads();
            fft_fwd_blk(buf, FF, thi, tlo);
#pragma unroll 8
            for (int i = 0; i < 32; ++i) { const int q = tidx() + 512 * i; HY_ST(GS, q, f2h(buf[FBI(q)])); }
            __syncthreads();
#pragma unroll
            for (int i = 0; i < 32; ++i) { const int n = tidx() + 512 * i; float2 z = h2f(Zr[i]); z.x *= 0.0625f; z.y *= 0.0625f; if (par) z = cmulf(z, HY_W2(n)); buf[FBI(n)] = z; }
            __syncthreads();
            fft_fwd_blk(buf, FF, thi, tlo);
            asm volatile("s_waitcnt vmcnt(0)" ::: "memory");
#pragma unroll
            for (int hh = 0; hh < 2; ++hh) { unsigned g[16];
#pragma unroll
              for (int i = 0; i < 16; ++i) g[i] = HY_LD(GS, tidx() + 512 * (hh * 16 + i));
#pragma unroll
              for (int i = 0; i < 16; ++i) { const int q = tidx() + 512 * (hh * 16 + i); const float2 pr = cmulf(buf[FBI(q)], h2f(g[i])); buf[FBI(q)] = make_float2(pr.x * fac, pr.y * fac);        }
              __builtin_amdgcn_sched_barrier(0); }
            __syncthreads();
            fft_inv_blk(buf, FF, thi, tlo);
            if (par == 0) {
#pragma unroll 8
                for (int i = 0; i < 32; ++i) { const int q = tidx() + 512 * i; const float2 v = buf[FBI(q)]; HY_ST(YS, q, f2h(v)); }
            } else {
                asm volatile("s_waitcnt vmcnt(0)" ::: "memory");
#pragma unroll
                for (int hh = 0; hh < 2; ++hh) {
                    unsigned y[16], xg[16];
#pragma unroll
                    for (int i = 0; i < 16; ++i) { y[i] = HY_LD(YS, tidx() + 512 * (hh * 16 + i)); xg[i] = HY_LD(XS, tidx() + 512 * (hh * 16 + i)); }
#pragma unroll
                    for (int i = 0; i < 16; ++i) { const int n = tidx() + 512 * (hh * 16 + i); const float2 v = buf[FBI(n)];
                        const float2 t2 = cmulcf(v, HY_W2(n)); const float2 y0 = h2f(y[i]); const float2 z = h2f(Zr[hh * 16 + i]); const float2 g = h2f(xg[i]);
                        Zr[hh * 16 + i] = f2h(make_float2(g.x * (y0.x + t2.x + bias * z.x), g.y * (y0.y + t2.y + bias * z.y))); }
                    __builtin_amdgcn_sched_barrier(0);
                }
            }
        }
    }
#undef HY_W2
#undef HY_ST
#undef HY_LD
    bf16_t* OB = WSP(bf16_t, OFF_OBT);
#pragma unroll
    for (int i = 0; i < 32; ++i) { const int n = tidx() + 512 * i; const float2 z = h2f(Zr[i]); OB[((size_t)0 * 256 + c) * TPB + n] = f2bf(z.x); OB[((size_t)1 * 256 + c) * TPB + n] = f2bf(z.y); }
    __syncthreads();
}
__device__ __forceinline__ void fnet_unit(const Params& p, int c, char* lds, const FFrag& FF) {
    float2* buf = (float2*)lds; const float2* thi = (const float2*)(lds + FFT_LDS_TAB); const float2* tlo = thi + 128;
    const int tid = tidx();
    const bf16_t* HT = WSP(const bf16_t, OFF_HYFN); bf16_t* OC = WSP(bf16_t, OFF_OCT);
    const bf16_t* r0 = HT + ((size_t)0 * 1024 + 768 + c) * TPB; const bf16_t* r1 = HT + ((size_t)1 * 1024 + 768 + c) * TPB;
    if (DBG_FN_COPY) {
        for (int i = 0; i < 32; ++i) { const int n = tid + 512 * i; OC[((size_t)0 * 512 + c) * TPB + n] = r0[n]; OC[((size_t)0 * 512 + 256 + c) * TPB + n] = r1[n]; OC[((size_t)1 * 512 + c) * TPB + n] = r1[n]; OC[((size_t)1 * 512 + 256 + c) * TPB + n] = r0[n]; }
        return;
    }
    __syncthreads();
#pragma unroll 4
    for (int i = 0; i < 32; ++i) { const int n = tid + 512 * i; buf[FBI(n)] = make_float2(bf2f(r0[n]), bf2f(r1[n])); }
    __syncthreads();
    fft_fwd_blk(buf, FF, thi, tlo);
#pragma unroll 4
    for (int i = 0; i < 32; ++i) { const int k = tid + 512 * i; const int km = (16384 - k) & 16383; const float2 X = buf[(k & 127) * FRS + (k >> 7)], Xm = buf[(km & 127) * FRS + (km >> 7)];
        OC[((size_t)0 * 512 + c) * TPB + k] = f2bf(0.5f * (X.x + Xm.x)); OC[((size_t)0 * 512 + 256 + c) * TPB + k] = f2bf(0.5f * (X.y - Xm.y));
        OC[((size_t)1 * 512 + c) * TPB + k] = f2bf(0.5f * (X.y + Xm.y)); OC[((size_t)1 * 512 + 256 + c) * TPB + k] = f2bf(-0.5f * (X.x - Xm.x)); }
    __syncthreads();
}
__device__ __forceinline__ void hyena_ctx_unit(const Params& p, int l, int c, char* lds) {
    float* zs = (float*)lds;
    float* hfs = zs + 512; float* hbs = hfs + 256; float* w3s = hbs + 256; float* red = w3s + 128;
    const int tid = tidx(), b = tid >> 8, t = tid & 255;
    const bf16_t* HT = WSP(const bf16_t, OFF_HYFN); const float* sw = p.in[I_HYSW] + (size_t)l * 3 * 768;
    const float* H2 = WSP(const float, OFF_H2C) + (size_t)l * 256 * 64; const float* w3 = p.in[I_HYW3] + (size_t)l * 64 * 1024;
    const float d0 = -3.0701134573253945f, d1 = -15.350567286626973f;
    const float adelta = fabsf(d0 + (float)c * ((d1 - d0) / 255.f));
    auto sc = [&](int ch) { const bf16_t* r = HT + ((size_t)b * 1024 + ch) * TPB + SEQ;
        const float um = t > 0 ? bf2f(r[t - 1]) : 0.f, u0 = bf2f(r[t]), up = t < 255 ? bf2f(r[t + 1]) : 0.f; return sw[ch] * um + sw[768 + ch] * u0 + sw[1536 + ch] * up; };
    __syncthreads();
    float z = sc(c);
    zs[b * 256 + t] = z;
    for (int order = 0; order < 2; ++order) {
        __syncthreads();
        if (tid < 128) w3s[tid] = w3[(size_t)(tid & 63) * 1024 + (tid >> 6) * 512 + order * 256 + c];
        __syncthreads();
        float ss = 0.f;
        if (tid < 256) { const float* hr = H2 + (size_t)tid * 64; float sf = 0.f, sb = 0.f;
#pragma unroll 16
            for (int j = 0; j < 64; ++j) { sf += hr[j] * w3s[j]; sb += hr[j] * w3s[64 + j]; }
            const float win = __expf(-((float)tid * (1.f / 255.f)) * adelta); const float hf = sf * win, hb = sb * win;
            hfs[tid] = hf; hbs[tid] = hb; ss = hf * hf + (tid ? hb * hb : 0.f); }
        const float tot = block_sum(ss, red);
        const float scale = rsqrtf(tot + 1e-6f);
        __syncthreads();
        float y = 0.f;
        for (int s = 0; s <= t; ++s) y += hfs[t - s] * zs[b * 256 + s];
        for (int s = t + 1; s < 256; ++s) y += hbs[s - t] * zs[b * 256 + s];
        const float bias = p.in[I_HYBIAS][(size_t)l * 512 + order * 256 + c];
        const float g = sc((order + 1) * 256 + c);
        z = g * (y * scale + bias * z);
        __syncthreads();
        zs[b * 256 + t] = z;
    }
    WSP(bf16_t, OFF_OBT)[((size_t)b * 256 + c) * TPB + SEQ + t] = f2bf(z);
    __syncthreads();
}
__device__ __forceinline__ void fnet_ctx_unit(const Params& p, int c, char* lds) {
    float* us = (float*)lds; float* cs = us + 512;
    const int tid = tidx(), b = tid >> 8, k = tid & 255;
    const bf16_t* HT = WSP(const bf16_t, OFF_HYFN);
    __syncthreads();
    us[tid] = bf2f(HT[((size_t)b * 1024 + 768 + c) * TPB + SEQ + k]);
    if (tid < 256) { float s, cc; sincospif(2.f * (float)tid / 256.f, &s, &cc); cs[tid] = cc; cs[256 + tid] = s; }
    __syncthreads();
    float ur = 0.f, ui = 0.f;
    for (int n = 0; n < 256; ++n) { const int m = (k * n) & 255; const float u = us[b * 256 + n]; ur += u * cs[m]; ui -= u * cs[256 + m]; }
    bf16_t* OC = WSP(bf16_t, OFF_OCT);
    OC[((size_t)b * 512 + c) * TPB + SEQ + k] = f2bf(8.f * ur); OC[((size_t)b * 512 + 256 + c) * TPB + SEQ + k] = f2bf(8.f * ui);
    __syncthreads();
}
__device__ __forceinline__ void na_unit(const Params& p, int l, int u, char* lds) {
    const int b = u >> 8, h = (u >> 6) & 3, rb = u & 63, r0 = rb * 4;
    float* biasL = (float*)(lds + ATT_LDS);
    __syncthreads();
    for (int i = tidx(); i < 465; i += 512) biasL[i] = p.in[I_RPB][((size_t)l * 4 + h) * 465 + i] * 8.f;
    const bf16_t* P = WSP(const bf16_t, OFF_P);
    int lo = r0 - 4; lo = lo < 0 ? 0 : (lo > 248 ? 248 : lo);
    int hr = r0 + 3 - 4; hr = hr < 0 ? 0 : (hr > 248 ? 248 : hr); hr += 7;
    const int nloc = hr - lo + 1;
    const size_t tb = (size_t)b * TPB;
    attn_unit<64, 1>(P + (tb + r0 * 64) * PLD + h * 64, PLD, P + tb * PLD + 256 + h * 64, PLD, P + tb * PLD + 512 + h * 64, PLD,
                     WSP(bf16_t, OFF_OAD) + (tb + r0 * 64) * 512 + 256 + h * 64, 512, 4 + nloc, 4, SEQ, lo * 64, lds, biasL, r0, lo);
}
__device__ __forceinline__ void na_ctx_unit(const Params& p, int u, char* lds) {
    const int b = u >> 2, h = u & 3; const bf16_t* P = WSP(const bf16_t, OFF_P); const size_t tb = (size_t)b * TPB;
    attn_unit<64, 0>(P + (tb + SEQ) * PLD + h * 64, PLD, P + tb * PLD + 256 + h * 64, PLD, P + tb * PLD + 512 + h * 64, PLD,
                     WSP(bf16_t, OFF_OAD) + (tb + SEQ) * 512 + 256 + h * 64, 512, 4, 4, SEQ, 0, lds, nullptr, 0, 0);
}
PHASE_FN void ph_mixers(const Params& p, int l, char* lds_unused) {
    char* lds = lds_dyn; (void)lds_unused;
    const int bid = bidx(), G = gdim(); const bool upd_ctx = (l != NLAYER - 1);
    fft_tables(lds);
    { FFrag FF; mfft_frags(FF, (const float2*)(lds + FFT_LDS_TAB));
      for (int rep = 0; rep < (REP_PHASE == 31 ? 2 : 1); ++rep) for (int c = bid; c < 256; c += G) hyena_unit(p, l, c, lds, FF);
      for (int rep = 0; rep < (REP_PHASE == 32 ? 2 : 1); ++rep) for (int c = bid; c < 256; c += G) fnet_unit(p, c, lds, FF); }
    __syncthreads();
    if (upd_ctx) { for (int c = bid; c < 256; c += G) hyena_ctx_unit(p, l, c, lds);
                   for (int c = bid; c < 256; c += G) fnet_ctx_unit(p, c, lds); }
    for (int rep = 0; rep < (REP_PHASE == 33 ? 2 : 1); ++rep) for (int t = bid; t < NTILE * 7; t += G) upproj_tile(p, l, t / 7, t % 7, lds);
    __syncthreads();
    for (int rep = 0; rep < (REP_PHASE == 34 ? 2 : 1); ++rep) for (int u = bid; u < 512; u += G) na_unit(p, l, u, lds);
    if (upd_ctx) for (int u = bid; u < 8; u += G) na_ctx_unit(p, u, lds);
}

__device__ __forceinline__ void transp_unit(const Params& p, int u, char* lds) {
    const int tid = tidx(), rt = u / 12, cg = u % 12, r0 = rt * 128, b = r0 >= TPB ? 1 : 0, t0 = r0 - b * TPB;
    const bf16_t* src = cg < 4 ? WSP(const bf16_t, OFF_OBT) + ((size_t)b * 256 + cg * 64) * TPB + t0 : WSP(const bf16_t, OFF_OCT) + ((size_t)b * 512 + (cg - 4) * 64) * TPB + t0;
    bf16_t* dst = WSP(bf16_t, OFF_P) + (size_t)r0 * 768 + cg * 64;
    char* tl = lds;
    __syncthreads();
    { const int c = tid >> 3, sg = tid & 7; const u32x4 x0 = *(const u32x4*)(src + (size_t)c * TPB + sg * 16), x1 = *(const u32x4*)(src + (size_t)c * TPB + sg * 16 + 8);
      *(u32x4*)(tl + c * 272 + sg * 32) = x0; *(u32x4*)(tl + c * 272 + sg * 32 + 16) = x1; }
    __syncthreads();
    { const int t = tid >> 2, q = tid & 3; unsigned w[8];
#pragma unroll
      for (int i = 0; i < 8; ++i) { const unsigned lo = *(const bf16_t*)(tl + (q * 16 + 2 * i) * 272 + t * 2), hi = *(const bf16_t*)(tl + (q * 16 + 2 * i + 1) * 272 + t * 2); w[i] = lo | (hi << 16); }
      u32x4 y0 = {w[0], w[1], w[2], w[3]}, y1 = {w[4], w[5], w[6], w[7]};
      *(u32x4*)(dst + (size_t)t * 768 + q * 16) = y0; *(u32x4*)(dst + (size_t)t * 768 + q * 16 + 8) = y1; }
}
PHASE_FN void ph_mla(const Params& p, int l, char* lds_unused) {
    char* lds = lds_dyn; (void)lds_unused;
    const bool upd_ctx = (l != NLAYER - 1);
    const bf16_t* Q = WSP(const bf16_t, OFF_Q); const bf16_t* K = WSP(const bf16_t, OFF_K); const bf16_t* V = WSP(const bf16_t, OFF_V); bf16_t* O = WSP(bf16_t, OFF_OAD);
    if (upd_ctx) for (int u = bidx(); u < 8; u += gdim()) { const int b = u >> 2, h = u & 3; const size_t tb = (size_t)b * TPB;
        mla_unit(Q + (tb + SEQ) * 384 + h * 96, K + tb * 384 + h * 96, V + tb * 256 + h * 64, O + (tb + SEQ) * 512 + h * 64, 4, 4, SEQ, 0, lds); }
    for (int u = bidx(); u < 512; u += gdim()) { const int b = u >> 8, h = (u >> 6) & 3, qb = u & 63; const size_t tb = (size_t)b * TPB;
        mla_unit(Q + (tb + qb * 256) * 384 + h * 96, K + tb * 384 + h * 96, V + tb * 256 + h * 64, O + (tb + qb * 256) * 512 + h * 64, 260, 260, 0, 0, lds); }
    __syncthreads();
    for (int u = bidx(); u < NTILE * 12; u += gdim()) { if (skip_tile(l, u / 12)) continue; transp_unit(p, u, lds); }
    { const u32x4* Hs = WSP(const u32x4, OFF_H); u32x2* H8 = WSP(u32x2, OFF_HYS);
      for (int i = bidx() * 512 + tidx(); i < T * 128; i += gdim() * 512) { const u32x4 h = Hs[i]; u32x2 w; int t0 = 0, t1 = 0;
          t0 = __builtin_amdgcn_cvt_pk_fp8_f32(__uint_as_float(h.x << 16), __uint_as_float(h.x & 0xffff0000u), t0, false); t0 = __builtin_amdgcn_cvt_pk_fp8_f32(__uint_as_float(h.y << 16), __uint_as_float(h.y & 0xffff0000u), t0, true);
          t1 = __builtin_amdgcn_cvt_pk_fp8_f32(__uint_as_float(h.z << 16), __uint_as_float(h.z & 0xffff0000u), t1, false); t1 = __builtin_amdgcn_cvt_pk_fp8_f32(__uint_as_float(h.w << 16), __uint_as_float(h.w & 0xffff0000u), t1, true);
          w.x = (unsigned)t0; w.y = (unsigned)t1; H8[i] = w; } }
}

template <int FP8, int NKT>
__device__ __forceinline__ void gate4_stream(f32x4 (&ag)[4][4][2], const char* a0, const char* a1, const char* Wb, const char* Wb2, int ksplit, size_t nstride, int rowstride, int a_rd, int b_rd, char* lds) {
    const int wid = __builtin_amdgcn_readfirstlane(tidx() >> 6);
    LAS char* L = (LAS char*)lds_dyn + ((wid >> 1) * 2 + (wid & 1)) * 1024;
    const int srow = g_srow(), skc = g_skc();
    i32x8 A8[4], B8[2][2];
#pragma unroll
    for (int mt = 0; mt < 4; ++mt) A8[mt] = (i32x8)(0);
    B8[1][0] = (i32x8)(0); B8[1][1] = (i32x8)(0);
    auto issue_h = [&](int s, int h) { const int kt = s >> 2, n = s & 3; LAS char* Bb = L + 32768 + n * 16384 + h * 8192;
        int eo = srow * rowstride + skc * 16; asm volatile("" : "+v"(eo));
        eo += (kt << 7) + h * 64 * rowstride;
        const char* w = (kt < ksplit ? Wb : Wb2) + (size_t)n * nstride + (unsigned)eo;
        __builtin_amdgcn_global_load_lds((const unsigned*)(w), (LAS unsigned*)(Bb), 16, 0, 0);
        if (n == 0) { LAS char* Ab = L + (kt & 1) * 16384 + h * 8192; const char* hp = (h ? a1 : a0) + (kt << 7);
            __builtin_amdgcn_global_load_lds((const unsigned*)(hp), (LAS unsigned*)(Ab), 16, 0, 0); } };
    auto issue = [&](int s) { issue_h(s, 0); issue_h(s, 1); };
    auto ld8 = [&](const char* base) { const u32x4 lo = *(const u32x4*)(base), hi = *(const u32x4*)(base + 1024);
        return (i32x8){(int)lo.x, (int)lo.y, (int)lo.z, (int)lo.w, (int)hi.x, (int)hi.y, (int)hi.z, (int)hi.w}; };
    constexpr int SC1 = 0x7f7f7f7f, SCW = 0x79797979;
    auto mm = [&](f32x4 c, const i32x8& b, const i32x8& a) {
        if (FP8) return __builtin_amdgcn_mfma_scale_f32_16x16x128_f8f6f4(b, a, c, 0, 0, 0, SCW, 0, SC1);
        typedef int i32x4_ __attribute__((ext_vector_type(4)));
        const i32x4_ bl = __builtin_shufflevector(b, b, 0, 1, 2, 3), bh = __builtin_shufflevector(b, b, 4, 5, 6, 7), al = __builtin_shufflevector(a, a, 0, 1, 2, 3), ah = __builtin_shufflevector(a, a, 4, 5, 6, 7);
        c = __builtin_amdgcn_mfma_f32_16x16x32_bf16(__builtin_bit_cast(bf16x8, bl), __builtin_bit_cast(bf16x8, al), c, 0, 0, 0);
        return __builtin_amdgcn_mfma_f32_16x16x32_bf16(__builtin_bit_cast(bf16x8, bh), __builtin_bit_cast(bf16x8, ah), c, 0, 0, 0); };
    issue(0); issue(1); issue(2);
#define MG8_SUB(N, PV, COND, SN) do { const char* Bs_ = lds + 32768 + (N) * 16384 + b_rd;                                       \
        B8[(N) & 1][0] = ld8(Bs_); B8[(N) & 1][1] = ld8(Bs_ + 2048); if (COND) issue_h((SN), 0); SB();                          \
        _Pragma("unroll") for (int mt = 0; mt < 4; ++mt) {                                                                     \
            _Pragma("unroll") for (int nt = 0; nt < 2; ++nt) ag[PV][mt][nt] = mm(ag[PV][mt][nt], B8[((N) & 1) ^ 1][nt], A8[mt]);  \
            if ((N) == 0) A8[mt] = ld8(As + a_rd + mt * 2048); }                                                               \
        if (COND) issue_h((SN), 1); SB(); } while (0)
#define MG8_KT(LASTK) do { const char* As = lds + (kt & 1) * 16384;                                                            \
        G_WAITV(4); __builtin_amdgcn_s_barrier(); asm volatile("" ::: "memory");                                               \
        MG8_SUB(0, 3, true, 4 * kt + 3);                                                                                       \
        G_WAITV(4); __builtin_amdgcn_s_barrier(); asm volatile("" ::: "memory");                                               \
        MG8_SUB(1, 0, !(LASTK), 4 * kt + 4);                                                                                   \
        if (!(LASTK)) G_WAITV(6); else G_WAITV(2);                                                                             \
        __builtin_amdgcn_s_barrier(); asm volatile("" ::: "memory");                                                           \
        MG8_SUB(2, 1, !(LASTK), 4 * kt + 5);                                                                                   \
        if (!(LASTK)) G_WAITV(6); else G_WAITV(0);                                                                             \
        __builtin_amdgcn_s_barrier(); asm volatile("" ::: "memory");                                                           \
        MG8_SUB(3, 2, !(LASTK), 4 * kt + 6); } while (0)
    int kt = 0;
#pragma unroll 1
    for (; kt < NKT - 1; ++kt) MG8_KT(false);
    MG8_KT(true);
#undef MG8_KT
#undef MG8_SUB
#pragma unroll
    for (int mt = 0; mt < 4; ++mt)
#pragma unroll
        for (int nt = 0; nt < 2; ++nt) ag[3][mt][nt] = mm(ag[3][mt][nt], B8[1][nt], A8[mt]);
    __syncthreads();
}

__device__ __forceinline__ void merge_unit(const Params& p, int l, int rt, int ct, char* lds) {
    const int tid = tidx(), lane = tid & 63, wid = __builtin_amdgcn_readfirstlane(tid >> 6), wm = wid >> 2, wn = wid & 3, fr = lane & 15, fq = lane >> 4;
    const int a_rd = g_lds_byte(wm * 64 + fr, fq * 8), b_rd = g_lds_byte(wn * 32 + fr, fq * 8);
    const int r0 = rt * 128, n0 = ct * 128;
    LAS char* L = (LAS char*)lds_dyn + ((wid >> 1) * 2 + (wid & 1)) * 1024;
    const int srow = g_srow(), skc = g_skc();
    GFrag f0, f1;
    unsigned gp[4][4][2][2];
    {
        const char* Hb = WSP(const char, OFF_HYS) + (size_t)(r0 + srow) * 1024 + skc * 16;
        const char* Wb = (const char*)wts(p, l, WE_WGT) + (size_t)n0 * 1024;
        f32x4 ag[4][4][2];
#pragma unroll
        for (int n = 0; n < 4; ++n) acc_zero(ag[n]);
        gate4_stream<1, 8>(ag, Hb, Hb + (size_t)64 * 1024, Wb, Wb, 8, (size_t)1024 * 1024, 1024, a_rd, b_rd, lds);
#pragma unroll
        for (int n = 0; n < 4; ++n) {
#pragma unroll
            for (int mt = 0; mt < 4; ++mt) {
#pragma unroll
                for (int nt = 0; nt < 2; ++nt) { gp[n][mt][nt][0] = cvt_pk_bf16(sigmoid_f(ag[n][mt][nt][0]), sigmoid_f(ag[n][mt][nt][1])); gp[n][mt][nt][1] = cvt_pk_bf16(sigmoid_f(ag[n][mt][nt][2]), sigmoid_f(ag[n][mt][nt][3]));
                    asm volatile("" : "+v"(gp[n][mt][nt][0]), "+v"(gp[n][mt][nt][1])); }
            }
        }
    }
    SB();
    f32x4 am[4][2], ap[4][2]; acc_zero(am); acc_zero(ap);
    {
        const bf16_t* OAD = WSP(const bf16_t, OFF_OAD); const bf16_t* OBC = WSP(const bf16_t, OFF_P);
        auto issue = [&](int s) { const bf16_t* a; const bf16_t* b; unsigned as, bs; int k0;
            int so = srow, sk = skc * 8; asm volatile("" : "+v"(so), "+v"(sk));
            if (s < 4)       { k0 = (s << 6) + sk;        a = OAD + (unsigned)((r0 + so) * 512 + k0);       as = 64 * 512; b = wts(p, l, WE_WBA) + (unsigned)((n0 + so) * 256 + k0); bs = 64 * 256; }
            else if (s < 8)  { k0 = ((s - 4) << 6) + sk;  a = OBC + (unsigned)((r0 + so) * 768 + k0);       as = 64 * 768; b = wts(p, l, WE_WBB) + (unsigned)((n0 + so) * 256 + k0); bs = 64 * 256; }
            else if (s < 16) { k0 = ((s - 8) << 6) + sk;  a = OBC + (unsigned)((r0 + so) * 768 + 256 + k0); as = 64 * 768; b = wts(p, l, WE_WBC) + (unsigned)((n0 + so) * 512 + k0); bs = 64 * 512; }
            else             { k0 = ((s - 16) << 6) + sk; a = OAD + (unsigned)((r0 + so) * 512 + 256 + k0); as = 64 * 512; b = wts(p, l, WE_WBD) + (unsigned)((n0 + so) * 256 + k0); bs = 64 * 256; }
            LAS char* Lb = L + (s & 3) * G_STAGE;
            __builtin_amdgcn_global_load_lds((const unsigned*)(a), (LAS unsigned*)(Lb), 16, 0, 0);
            __builtin_amdgcn_global_load_lds((const unsigned*)(a + as), (LAS unsigned*)(Lb + 8192), 16, 0, 0);
            __builtin_amdgcn_global_load_lds((const unsigned*)(b), (LAS unsigned*)(Lb + G_TILE), 16, 0, 0);
            __builtin_amdgcn_global_load_lds((const unsigned*)(b + bs), (LAS unsigned*)(Lb + G_TILE + 8192), 16, 0, 0); };
        auto combine = [&](const unsigned (&g)[4][2][2]) {
#pragma unroll
            for (int mt = 0; mt < 4; ++mt)
#pragma unroll
                for (int nt = 0; nt < 2; ++nt) {
                    const unsigned g0 = g[mt][nt][0], g1 = g[mt][nt][1];
                    am[mt][nt][0] += __uint_as_float(g0 << 16) * ap[mt][nt][0]; am[mt][nt][1] += __uint_as_float(g0 & 0xffff0000u) * ap[mt][nt][1];
                    am[mt][nt][2] += __uint_as_float(g1 << 16) * ap[mt][nt][2]; am[mt][nt][3] += __uint_as_float(g1 & 0xffff0000u) * ap[mt][nt][3];
                    ap[mt][nt] = (f32x4){0.f, 0.f, 0.f, 0.f};
                    asm volatile("" : "+v"(am[mt][nt])); } };
        gf_zero(f1);
        issue(0); issue(1); issue(2);
        int s = 0;
#pragma unroll
        for (int n = 0; n < 4; ++n) {
            const int send = n == 0 ? 4 : n == 1 ? 8 : n == 2 ? 16 : 20;
#pragma unroll 1
            for (; s < send; ++s) {
                if (s + 2 < 20) G_WAITV(8); else if (s + 1 < 20) G_WAITV(4); else G_WAITV(0);
                __builtin_amdgcn_s_barrier(); asm volatile("" ::: "memory");
                if (s + 3 < 20) issue(s + 3);
                const char* As = lds + (s & 3) * G_STAGE;
                GF_STAGE(ap, ap, As, As + G_TILE);
            }
            gf_mma(ap, f1); SB();
            combine(gp[n]); gf_zero(f1); SB();
        }
        __syncthreads();
    }
    bf16_t* M = WSP(bf16_t, OFF_HYFN);
    const int t2 = tidx(), w2 = t2 >> 6, l2 = t2 & 63;
    int so = (r0 + (w2 >> 2) * 64 + (l2 & 15)) * 1024 + n0 + (w2 & 3) * 32 + (l2 >> 4) * 4;
#pragma unroll
    for (int mt = 0; mt < 4; ++mt)
#pragma unroll
        for (int nt = 0; nt < 2; ++nt) {
            u32x2 w; w.x = cvt_pk_bf16(am[mt][nt][0], am[mt][nt][1]); w.y = cvt_pk_bf16(am[mt][nt][2], am[mt][nt][3]);
            *(u32x2*)(M + (unsigned)(so + mt * 16 * 1024 + nt * 16)) = w; }
    SB();
}
PHASE_FN void ph_merge(const Params& p, int l, char* lds_unused) {
    char* lds = lds_dyn; (void)lds_unused;
    for (int u = bidx(); u < NTILE * 8; u += gdim()) {
        const int rt = u >> 3, ct = u & 7; if (skip_tile(l, rt)) continue;
        merge_unit(p, l, rt, ct, lds);
    }
}

PHASE_FN void ph_wout(const Params& p, int l, char* lds_unused) {
    char* lds = lds_dyn; (void)lds_unused;
    const int tid = tidx(), lane = tid & 63, wid = tid >> 6, wm = wid >> 2, wn = wid & 3, fr = lane & 15, fq = lane >> 4;
    const int a_rd = g_lds_byte(wm * 64 + fr, fq * 8), b_rd = g_lds_byte(wn * 32 + fr, fq * 8);
    const bf16_t* M = WSP(const bf16_t, OFF_HYFN);
    auto epi = [&](const f32x4 (&acc)[4][2], int r0, int n0) {
        const float* gt = modvec(p, l, r0) + 2048;
#pragma unroll
        for (int mt = 0; mt < 4; ++mt) { const int row = r0 + wm * 64 + mt * 16 + fr; const float* xs = (l == 0) ? xrow_in(p, row) : xrow_st(p, row); float* xd = xrow_st(p, row);
#pragma unroll
            for (int nt = 0; nt < 2; ++nt) { const int col = n0 + wn * 32 + nt * 16 + fq * 4; const f32x4 x = *(const f32x4*)(xs + col), g = *(const f32x4*)(gt + col);
                f32x4 o; o[0] = x[0] + g[0] * acc[mt][nt][0]; o[1] = x[1] + g[1] * acc[mt][nt][1]; o[2] = x[2] + g[2] * acc[mt][nt][2]; o[3] = x[3] + g[3] * acc[mt][nt][3];
                if (DBG_NO_MIX) o = x;
                *(f32x4*)(xd + col) = o; } } };
    for (int u = bidx(); u < 512; u += gdim()) {
        const int lt = u >> 1, half = u & 1, rt = lt + (lt >> 7) * 2, r0 = rt * 128;
        const char* a0 = (const char*)(M + (size_t)(r0 + g_srow()) * 1024 + g_skc() * 8);
        const char* Wb = (const char*)(wts(p, l, WE_WOUT) + (size_t)half * 512 * 1024);
        f32x4 ag[4][4][2];
#pragma unroll
        for (int n = 0; n < 4; ++n) acc_zero(ag[n]);
        gate4_stream<0, 16>(ag, a0, a0 + (size_t)64 * 2048, Wb, Wb, 16, (size_t)128 * 2048, 2048, a_rd, b_rd, lds);
#pragma unroll
        for (int n = 0; n < 4; ++n) epi(ag[n], r0, half * 512 + n * 128);
    }
    if (l != NLAYER - 1) for (int u = bidx(); u < 32; u += gdim()) {
        const int rt = 128 + (u >> 4) * 130 + ((u >> 3) & 1), ct = u & 7, r0 = rt * 128, n0 = ct * 128;
        const bf16_t* a0 = M + (size_t)(r0 + g_srow()) * 1024 + g_skc() * 8; const bf16_t* b0 = wts(p, l, WE_WOUT) + (size_t)(n0 + g_srow()) * 1024 + g_skc() * 8;
        f32x4 acc[4][2]; acc_zero(acc);
        mma_seg<1, 0>(acc, a0, a0 + (size_t)64 * 1024, 0, b0, b0 + (size_t)64 * 1024, 1024, lds);
        epi(acc, r0, n0);
    }
}

__device__ __forceinline__ int* moe_sched(const Params& p, int l, char* lds) {
    int* s = (int*)(lds + G_LDS);
    __syncthreads();
    if (tidx() == 0) { int acc = 0; for (int i = 0; i < 24; ++i) { const int c = WSP(const int, OFF_CNT)[l * 32 + i]; s[32 + i] = c; s[i] = acc; acc += (c + 127) >> 7; } s[24] = acc; }
    __syncthreads();
    return s;
}
__device__ __forceinline__ void moe_decode(const int* s, int tg, int& pid, int& tl, int& cnt) {
    pid = 0;
    for (int i = 1; i < 24; ++i) if (tg >= s[i]) pid = i;
    tl = tg - s[pid]; cnt = s[32 + pid];
}
__device__ __forceinline__ void pair_experts(int pid, int& elo, int& ehi) { const int g = pid / 6, pi = pid % 6; const int lo = pi < 3 ? 0 : (pi < 5 ? 1 : 2); const int hi = pi < 3 ? pi + 1 : (pi < 5 ? pi - 1 : 3); elo = g * 4 + lo; ehi = g * 4 + hi; }
PHASE_FN void ph_moe1(const Params& p, int l, char* lds_unused) {
    char* lds = lds_dyn; (void)lds_unused;
    const int tid = tidx(), lane = tid & 63, wid = tid >> 6, wm = wid >> 2, wn = wid & 3, fr = lane & 15, fq = lane >> 4;
    const int a_rd = g_lds_byte(wm * 64 + fr, fq * 8), b_rd = g_lds_byte(wn * 32 + fr, fq * 8);
    const int* s = moe_sched(p, l, lds);
    const bf16_t* H = WSP(const bf16_t, OFF_H); bf16_t* ACT = WSP(bf16_t, OFF_P); const int* lists = WSP(const int, OFF_LISTS); const float* tokw = WSP(const float, OFF_TOKW);
    const int ntiles = s[24];
    for (int u = bidx(); u < ntiles * 2; u += gdim()) {
        const int tg = u >> 1, half = u & 1; int pid, tl, cnt; moe_decode(s, tg, pid, tl, cnt); int elo, ehi; pair_experts(pid, elo, ehi);
        const int e = half ? ehi : elo;
        const int* lst = lists + (size_t)pid * T;
        auto tok = [&](int rowi) { const int sl = tl * 128 + rowi; return lst[sl < cnt ? sl : 0]; };
        const char* a0 = (const char*)(H + (size_t)tok(g_srow()) * 1024 + g_skc() * 8); const char* a1 = (const char*)(H + (size_t)tok(g_srow() + 64) * 1024 + g_skc() * 8);
        const char* Wb = (const char*)(wts(p, l, WE_WGU) + (size_t)e * 512 * 1024);
        f32x4 ag[4][4][2];
#pragma unroll
        for (int n = 0; n < 4; ++n) acc_zero(ag[n]);
        gate4_stream<0, 16>(ag, a0, a1, Wb, Wb, 16, (size_t)128 * 1024 * 2, 2048, a_rd, b_rd, lds);
#pragma unroll
        for (int tt = 0; tt < 4; ++tt)
#pragma unroll
            for (int mt = 0; mt < 4; ++mt) { const int rowi = wm * 64 + mt * 16 + fr; const float w = tokw[(size_t)tok(rowi) * 2 + half];
                float o[4];
#pragma unroll
                for (int j = 0; j < 4; ++j) o[j] = silu_f(ag[tt][mt][0][j]) * ag[tt][mt][1][j] * w;
                u32x2 pk; pk.x = cvt_pk_bf16(o[0], o[1]); pk.y = cvt_pk_bf16(o[2], o[3]);
                *(u32x2*)(ACT + (size_t)(tg * 128 + rowi) * 512 + half * 256 + tt * 64 + wn * 16 + fq * 4) = pk; }
    }
}
PHASE_FN void ph_moe2(const Params& p, int l, char* lds_unused) {
    char* lds = lds_dyn; (void)lds_unused;
    const int tid = tidx(), lane = tid & 63, wid = tid >> 6, wm = wid >> 2, wn = wid & 3, fr = lane & 15, fq = lane >> 4;
    const int a_rd = g_lds_byte(wm * 64 + fr, fq * 8), b_rd = g_lds_byte(wn * 32 + fr, fq * 8);
    const int* s = moe_sched(p, l, lds);
    const bf16_t* ACT = WSP(const bf16_t, OFF_P); const int* lists = WSP(const int, OFF_LISTS);
    const int ntiles = s[24];
    for (int u = bidx(); u < ntiles * 2; u += gdim()) {
        const int tg = u >> 1, half = u & 1; int pid, tl, cnt; moe_decode(s, tg, pid, tl, cnt); int elo, ehi; pair_experts(pid, elo, ehi);
        const int* lst = lists + (size_t)pid * T;
        const char* a0 = (const char*)(ACT + (size_t)(tg * 128 + g_srow()) * 512 + g_skc() * 8);
        const char* Wlo = (const char*)(wts(p, l, WE_WDN) + ((size_t)elo * 1024 + half * 512) * 256);
        const char* Whi = (const char*)(wts(p, l, WE_WDN) + ((size_t)ehi * 1024 + half * 512) * 256) - 4 * 128;
        f32x4 ag[4][4][2];
#pragma unroll
        for (int n = 0; n < 4; ++n) acc_zero(ag[n]);
        gate4_stream<0, 8>(ag, a0, a0 + (size_t)64 * 1024, Wlo, Whi, 4, (size_t)128 * 512, 512, a_rd, b_rd, lds);
#pragma unroll
        for (int n = 0; n < 4; ++n)
#pragma unroll
            for (int mt = 0; mt < 4; ++mt) { const int sl = tl * 128 + wm * 64 + mt * 16 + fr;
                if (sl < cnt) { const int r = lst[sl]; float* xd = xrow_st(p, r); const float* gt = modvec(p, l, r) + 5120;
#pragma unroll
                    for (int nt = 0; nt < 2; ++nt) { const int col = half * 512 + n * 128 + wn * 32 + nt * 16 + fq * 4; const f32x4 x = *(const f32x4*)(xd + col), g = *(const f32x4*)(gt + col);
                        f32x4 o; o[0] = x[0] + g[0] * ag[n][mt][nt][0]; o[1] = x[1] + g[1] * ag[n][mt][nt][1]; o[2] = x[2] + g[2] * ag[n][mt][nt][2]; o[3] = x[3] + g[3] * ag[n][mt][nt][3];
                        if (DBG_NO_MOE) o = x;
                        *(f32x4*)(xd + col) = o; } } }
    }
}

PHASE_FN void ph_final(const Params& p) {
    const int wid = tidx() >> 6, lane = tidx() & 63; const float* g = p.in[I_FNG];
    for (int r = bidx() * 8 + wid; r < 2 * SEQ; r += gdim() * 8) {
        float* xr = p.out + (size_t)r * D; f32x4 v[4]; float ss = 0.f;
#pragma unroll
        for (int i = 0; i < 4; ++i) { v[i] = *(const f32x4*)(xr + i * 256 + lane * 4); ss += v[i][0] * v[i][0] + v[i][1] * v[i][1] + v[i][2] * v[i][2] + v[i][3] * v[i][3]; }
        ss = wave_sum(ss); const float rinv = rsqrtf(ss * (1.f / 1024.f) + 1e-6f);
#pragma unroll
        for (int i = 0; i < 4; ++i) { const f32x4 gg = *(const f32x4*)(g + i * 256 + lane * 4); f32x4 o; o[0] = v[i][0] * rinv * gg[0]; o[1] = v[i][1] * rinv * gg[1]; o[2] = v[i][2] * rinv * gg[2]; o[3] = v[i][3] * rinv * gg[3];
            *(f32x4*)(xr + i * 256 + lane * 4) = o; }
    }
}

__device__ __forceinline__ void ph_dbgcmp(const Params& p, size_t oa, size_t ob, int slot) {
    const u32x4* a = WSP(const u32x4, oa); const u32x4* b = WSP(const u32x4, ob); int bad = 0;
    const size_t n = (size_t)2 * 1024 * TPB * 2 / 16;
    for (size_t i = (size_t)bidx() * 512 + tidx(); i < n; i += (size_t)gdim() * 512) { const u32x4 x = a[i], y = b[i]; if (x.x != y.x || x.y != y.y || x.z != y.z || x.w != y.w) bad = 1; }
    if (bad) atomicAdd(WSP(int, OFF_CNT) + slot, 1);
}
constexpr int LDS_BYTES = 150 * 1024;
template <int PH>
__global__ void __launch_bounds__(512) k_phase(Params p, int l) {
    char* lds = lds_dyn;
    if (PH == 0) ph_prologue(p, lds);
    if (PH == 1) { ph_wconv(p, l, lds); __syncthreads(); ph_filt(p, l, lds); __syncthreads(); ph_norm<0>(p, l, lds); }
    if (PH == 2) ph_gemm1(p, l, lds);
    if (PH == 3) ph_mixers(p, l, lds);
    if (PH == 4) ph_mla(p, l, lds);
    if (PH == 5) ph_merge(p, l, lds);
    if (PH == 6) ph_wout(p, l, lds);
    if (PH == 7) ph_norm<1>(p, l, lds);
    if (PH == 8) ph_moe1(p, l, lds);
    if (PH == 9) ph_moe2(p, l, lds);
    if (PH == 10) ph_final(p);
}

#if ONE_LAUNCH
__global__ void __launch_bounds__(512) k_fused(Params p0) {
    char* lds = lds_dyn;
    volatile LAS unsigned* xbw = (volatile LAS unsigned*)(lds + LDS_BYTES - 16);
    if (threadIdx.x == 0) { xbw[0] = 0u; xbw[1] = 0u; xbw[2] = 0u; xbw[3] = 0u; }
    __syncthreads();
    (void)xcd_barrier_post((unsigned*)(p0.ws + OFF_BAR), xbw);
#define PQ() ({ Params q_ = p0; asm volatile("" : "+s"(q_.ws)); q_; })
#define GRID_BARRIER() do { XcdBarrier bar_; bar_.bar = (unsigned*)(p0.ws + OFF_BAR); bar_.x = xb_xcc_id(); bar_.st = (volatile LAS unsigned*)(lds_dyn + LDS_BYTES - 16); xcd_barrier(bar_); } while (0)
    asm volatile("; PHASE_MARK 0" ::: "memory"); ph_prologue(PQ(), lds);
    if (REP_PHASE == 100) { GRID_BARRIER(); ph_prologue(PQ(), lds); }
    GRID_BARRIER();
#pragma unroll
    for (int l = 0; l < NLAYER; ++l) {
        asm volatile("; PHASE_MARK 1" ::: "memory"); ph_wconv(PQ(), l, lds); __syncthreads(); ph_filt(PQ(), l, lds); __syncthreads(); ph_norm<0>(PQ(), l, lds);
        GRID_BARRIER();
        if (REP_PHASE == 1) { ph_wconv(PQ(), l, lds); __syncthreads(); ph_norm<0>(PQ(), l, lds); GRID_BARRIER(); }
        asm volatile("; PHASE_MARK 2" ::: "memory"); ph_gemm1(PQ(), l, lds);
        GRID_BARRIER();
        if (REP_PHASE == 2) { ph_gemm1(PQ(), l, lds); GRID_BARRIER(); }

        asm volatile("; PHASE_MARK 3" ::: "memory"); ph_mixers(PQ(), l, lds);
        GRID_BARRIER();
        if (REP_PHASE == 3) { ph_mixers(PQ(), l, lds); GRID_BARRIER(); }
        asm volatile("; PHASE_MARK 4" ::: "memory"); ph_mla(PQ(), l, lds);
        GRID_BARRIER();
        if (REP_PHASE == 4) { ph_mla(PQ(), l, lds); GRID_BARRIER(); }
        asm volatile("; PHASE_MARK 5" ::: "memory"); ph_merge(PQ(), l, lds);
        GRID_BARRIER();
        if (REP_PHASE == 5) { ph_merge(PQ(), l, lds); GRID_BARRIER(); }
        asm volatile("; PHASE_MARK 6" ::: "memory"); ph_wout(PQ(), l, lds);
        GRID_BARRIER();
        if (REP_PHASE == 6 && l == 0) { ph_wout(PQ(), l, lds); GRID_BARRIER(); }
        asm volatile("; PHASE_MARK 7" ::: "memory"); ph_norm<1>(PQ(), l, lds);
        GRID_BARRIER();
        if (REP_PHASE == 7) { ph_norm<2>(PQ(), l, lds); GRID_BARRIER(); }
        asm volatile("; PHASE_MARK 8" ::: "memory"); ph_moe1(PQ(), l, lds);
        GRID_BARRIER();
        if (REP_PHASE == 8) { ph_moe1(PQ(), l, lds); GRID_BARRIER(); }
        asm volatile("; PHASE_MARK 9" ::: "memory"); ph_moe2(PQ(), l, lds);
        GRID_BARRIER();
    }
    asm volatile("; PHASE_MARK 10" ::: "memory"); ph_final(PQ());
}
#endif
template <int PH> static void launch_phase(const Params& p, int l, int grid, hipStream_t stream) {
    static bool attr = false;
    if (!attr) { hipFuncSetAttribute((const void*)k_phase<PH>, hipFuncAttributeMaxDynamicSharedMemorySize, LDS_BYTES); attr = true; }
    hipLaunchKernelGGL(k_phase<PH>, dim3(grid), dim3(512), LDS_BYTES, stream, p, l);
}

extern "C" void kernel_launch(void* const* d_in, const int* in_sizes, int n_in, void* d_out, int out_size, void* d_ws, size_t ws_size, hipStream_t stream) {
    if (n_in != 33 || ws_size < WS_TOTAL || out_size != 2 * SEQ * D) { fprintf(stderr, "kernel_launch: unexpected shapes: n_in %d ws %zu (need %zu) out %d\n", n_in, ws_size, WS_TOTAL, out_size); return; }
    Params p{};
    for (int i = 0; i < 33; ++i) p.in[i] = (const float*)d_in[i];
    p.out = (float*)d_out; p.ws = (unsigned char*)d_ws;
    hipMemsetAsync(d_ws, 0, ZERO_BYTES, stream);
#if ONE_LAUNCH
    static int grid1 = 0;
    if (!grid1) {
        int dev = 0, cus = 0, per_cu = 0;
        hipGetDevice(&dev); hipDeviceGetAttribute(&cus, hipDeviceAttributeMultiprocessorCount, dev);
        hipFuncSetAttribute((const void*)k_fused, hipFuncAttributeMaxDynamicSharedMemorySize, LDS_BYTES);
        hipOccupancyMaxActiveBlocksPerMultiprocessor(&per_cu, k_fused, 512, LDS_BYTES);
        if (per_cu < 1 || cus < 256) { fprintf(stderr, "kernel_launch: cannot make the grid resident (cus %d, blocks/cu %d)\n", cus, per_cu); return; }
        grid1 = 256;
    }
    hipLaunchKernelGGL(k_fused, dim3(grid1), dim3(512), LDS_BYTES, stream, p);
    { const hipError_t le = hipPeekAtLastError(); if (le != hipSuccess) fprintf(stderr, "kernel_launch: launch failed: %s\n", hipGetErrorName(le)); }
    return;
#endif
    const int grid = 256;
    launch_phase<0>(p, 0, grid, stream);
    for (int l = 0; l < NLAYER; ++l) {
        launch_phase<1>(p, l, grid, stream);
        launch_phase<2>(p, l, grid, stream);
        launch_phase<3>(p, l, grid, stream);
        launch_phase<4>(p, l, grid, stream);
        launch_phase<5>(p, l, grid, stream);
        launch_phase<6>(p, l, grid, stream);
        launch_phase<7>(p, l, grid, stream);
        launch_phase<8>(p, l, grid, stream);
        launch_phase<9>(p, l, grid, stream);
    }
    launch_phase<10>(p, 0, grid, stream);
    const hipError_t le = hipPeekAtLastError();
    if (le != hipSuccess) fprintf(stderr, "kernel_launch: launch failed: %s\n", hipGetErrorName(le));
}
```

```cpp
#include <hip/hip_runtime.h>
#include <cstdio>
#include <cstdint>

#ifndef ONE_LAUNCH
#define ONE_LAUNCH 1
#endif
#ifndef REP_PHASE
#define REP_PHASE 0
#endif
#ifndef DBG_NO_MIX
#define DBG_NO_MIX 0
#endif
#ifndef DBG_BR
#define DBG_BR 15
#endif
#ifndef DBG_FN_COPY
#define DBG_FN_COPY 0
#endif
#ifndef DBG_NO_MOE
#define DBG_NO_MOE 0
#endif

constexpr int D = 1024, SEQ = 16384, NCTX = 256, TPB = SEQ + NCTX, T = 2 * TPB, NLAYER = 2;
constexpr int NTILE = T / 128;
constexpr int PLD = 1280;
constexpr int IN_W = 6304;

typedef unsigned short bf16_t;
typedef short bf16x8 __attribute__((ext_vector_type(8)));
typedef short s16x4 __attribute__((ext_vector_type(4)));
typedef float f32x4 __attribute__((ext_vector_type(4)));
typedef float f32x16 __attribute__((ext_vector_type(16)));
typedef unsigned u32x4 __attribute__((ext_vector_type(4)));
typedef unsigned u32x2 __attribute__((ext_vector_type(2)));
typedef _Float16 h16x2 __attribute__((ext_vector_type(2)));

constexpr size_t al256(size_t x) { return (x + 255) & ~(size_t)255; }
constexpr size_t OFF_BAR = 0;
constexpr size_t OFF_CNT = 16384;
constexpr size_t ZERO_BYTES = 32768;
constexpr size_t OFF_MOD = 32768;
constexpr size_t OFF_ROPE = OFF_MOD + al256((size_t)2 * 3 * 6144 * 4);
constexpr size_t OFF_H2L = OFF_ROPE + al256(256 * 8 * 8);
constexpr size_t OFF_W3T = OFF_H2L + (size_t)2 * 16384 * 64 * 2;
constexpr size_t OFF_H2C = OFF_H2L + al256((size_t)2 * 16384 * 64 * 4);
constexpr size_t OFF_CTXS = OFF_H2C + al256((size_t)2 * 256 * 64 * 4);
constexpr size_t OFF_TOKW = OFF_CTXS + al256((size_t)512 * 1024 * 4);
constexpr size_t OFF_LISTS = OFF_TOKW + al256((size_t)T * 2 * 4);
constexpr size_t OFF_WTS_OLD = OFF_LISTS + al256((size_t)24 * T * 4);
constexpr size_t WE_W1T = 0;
constexpr size_t WE_WGT = WE_W1T + (size_t)2304 * 1024;
constexpr size_t WE_WUQ = WE_WGT + (size_t)4096 * 1024;
constexpr size_t WE_WUKV = WE_WUQ + (size_t)384 * 256;
constexpr size_t WE_WBA = WE_WUKV + (size_t)512 * 128;
constexpr size_t WE_WBB = WE_WBA + (size_t)1024 * 256;
constexpr size_t WE_WBD = WE_WBB + (size_t)1024 * 256;
constexpr size_t WE_WBC = WE_WBD + (size_t)1024 * 256;
constexpr size_t WE_WOUT = WE_WBC + (size_t)1024 * 512;
constexpr size_t WE_WGU = WE_WOUT + (size_t)1024 * 1024;
constexpr size_t WE_WDN = WE_WGU + (size_t)16 * 512 * 1024;
constexpr size_t WE_TOTAL = WE_WDN + (size_t)16 * 1024 * 256;
constexpr size_t OFF_H = OFF_WTS_OLD;
constexpr size_t OFF_P = OFF_H + al256((size_t)T * 1024 * 2);
constexpr size_t OFF_HYFN = OFF_P + al256((size_t)T * PLD * 2);
constexpr size_t OFF_Q = OFF_HYFN + al256((size_t)2 * 1024 * TPB * 2);
constexpr size_t OFF_K = OFF_Q + al256((size_t)T * 384 * 2);
constexpr size_t OFF_V = OFF_K + al256((size_t)T * 384 * 2);
constexpr size_t OFF_OAD = OFF_V + al256((size_t)T * 256 * 2);
constexpr size_t OFF_OBT = OFF_OAD + al256((size_t)T * 512 * 2);
constexpr size_t OFF_OCT = OFF_OBT + al256((size_t)2 * 256 * TPB * 2);
constexpr size_t OFF_HYS = OFF_OCT + al256((size_t)2 * 512 * TPB * 2);
constexpr size_t OFF_WTS = OFF_HYS + al256((size_t)256 * 4 * 16384 * 4);
constexpr size_t OFF_FILT = OFF_WTS + al256(WE_TOTAL * 2);
constexpr size_t WS_TOTAL = OFF_FILT + al256((size_t)1024 * 16384 * 2);
constexpr int ACT_ROWS = 36352;
static_assert((size_t)ACT_ROWS * 512 * 2 <= (size_t)T * PLD * 2, "act must fit in P");

struct Params { const float* in[33]; float* out; unsigned char* ws; };
enum { I_X = 0, I_C, I_CTX, I_CCTX, I_ADAW, I_ADAB, I_N1G, I_N2G, I_WIN, I_QNORM, I_WUQ, I_KVNORM, I_WUKV, I_HYSW, I_HYW1, I_HYB1, I_HYF1, I_HYW2, I_HYB2, I_HYF2, I_HYW3, I_HYBIAS,
       I_RPB, I_WBR, I_WOUT, I_MWG, I_MBG, I_MWE, I_MBE, I_MGATE, I_MUP, I_MDOWN, I_FNG };

#define WSP(TYPE, off) ((TYPE*)(p.ws + (off)))
__device__ __forceinline__ bf16_t* wts(const Params& p, int l, size_t we) { (void)l; return (bf16_t*)(p.ws + OFF_WTS) + we; }

typedef float f32x2 __attribute__((ext_vector_type(2))); typedef int i32x8 __attribute__((ext_vector_type(8)));
typedef __bf16 bf16x2_t __attribute__((ext_vector_type(2)));
__device__ __forceinline__ unsigned cvt_pk_bf16(float lo, float hi) { const f32x2 v = {lo, hi}; return __builtin_bit_cast(unsigned, __builtin_convertvector(v, bf16x2_t)); }
__device__ __forceinline__ bf16_t f2bf(float x) { return (bf16_t)(cvt_pk_bf16(x, 0.f) & 0xffffu); }
__device__ __forceinline__ float bf2f(bf16_t v) { return __uint_as_float((unsigned)v << 16); }
__device__ __forceinline__ float wave_sum(float v) {
#pragma unroll
    for (int o = 32; o >= 1; o >>= 1) v += __shfl_xor(v, o);
    return v;
}
__device__ __forceinline__ float silu_f(float x) { return x / (1.f + __expf(-x)); }
__device__ __forceinline__ float sigmoid_f(float x) { return __builtin_amdgcn_rcpf(1.f + __builtin_amdgcn_exp2f(x * -1.4426950408889634f)); }
__device__ __forceinline__ void sincos_turns(float turns, float& s, float& c) { const float f = turns - floorf(turns); sincospif(2.f * f, &s, &c); }
__device__ __forceinline__ void sincos_rad(float x, float& s, float& c) { sincos_turns(x * 0.15915494309189535f, s, c); }

__device__ __forceinline__ const float* xrow_in(const Params& p, int r) {
    const int b = r >= TPB ? 1 : 0, t = r - b * TPB;
    return t < SEQ ? p.in[I_X] + ((size_t)b * SEQ + t) * D : p.in[I_CTX] + ((size_t)b * NCTX + (t - SEQ)) * D;
}
__device__ __forceinline__ float* xrow_st(const Params& p, int r) {
    const int b = r >= TPB ? 1 : 0, t = r - b * TPB;
    return t < SEQ ? p.out + ((size_t)b * SEQ + t) * D : WSP(float, OFF_CTXS) + ((size_t)b * NCTX + (t - SEQ)) * D;
}
__device__ __forceinline__ bool row_is_ctx(int r) { const int b = r >= TPB ? 1 : 0; return (r - b * TPB) >= SEQ; }
__device__ __forceinline__ const float* modvec(const Params& p, int l, int r) {
    const int b = r >= TPB ? 1 : 0, t = r - b * TPB; const int mi = t < SEQ ? b : 2;
    return WSP(float, OFF_MOD) + ((size_t)l * 3 + mi) * 6144;
}

#define XB_TMO      128
#define XB_XCNT(j)  (256  + 64 * (j))
#define XB_XSUB(j)  (1280 + 64 * (j))
#define XB_XGEN(j)  (2304 + 64 * (j))
#define XB_TOP      3328
#define XB_TOPGEN   3392
#define XCD_BAR_WORDS 3456
#define XB_SPIN_CAP (1u << 22)
#define LAS __attribute__((address_space(3)))
__device__ __forceinline__ unsigned xb_ld(unsigned* p)              { return __hip_atomic_load(p, __ATOMIC_RELAXED, __HIP_MEMORY_SCOPE_AGENT); }
__device__ __forceinline__ unsigned xb_add(unsigned* p, unsigned v) { return __hip_atomic_fetch_add(p, v, __ATOMIC_RELAXED, __HIP_MEMORY_SCOPE_AGENT); }
__device__ __forceinline__ unsigned xb_xcc_id() { return (unsigned)__builtin_amdgcn_s_getreg((3 << 11) | 20) & 0xFu; }
#define XB_SPIN(cond, bar) do { unsigned _sp = 0; while (cond) { __builtin_amdgcn_s_sleep(1); \
    if ((++_sp & 255u) == 0u) { if (xb_ld(&(bar)[XB_TMO])) break; if (_sp > XB_SPIN_CAP) { atomicAdd(&(bar)[XB_TMO], 1u); break; } } } } while (0)
struct XcdBarrier { unsigned* bar; unsigned x; volatile LAS unsigned* st; };
__device__ __forceinline__ XcdBarrier xcd_barrier_post(unsigned* bar, volatile LAS unsigned* st) {
    XcdBarrier b; b.bar = bar; b.x = xb_xcc_id(); b.st = st;
    if (threadIdx.x == 0) (void)xb_add(&bar[XB_XCNT(b.x)], 1u);
    return b;
}
__device__ __forceinline__ void xcd_barrier_complete(unsigned* bar, unsigned x, unsigned& nloc, unsigned& nx) {
    const unsigned G = gridDim.x * gridDim.y * gridDim.z;
    unsigned sum, cnt, mine, sp = 0u;
    for (;;) {
        sum = 0u; cnt = 0u; mine = 0u;
#pragma unroll
        for (unsigned j = 0; j < 16; ++j) { const unsigned c = xb_ld(&bar[XB_XCNT(j)]); sum += c; cnt += (c > 0u) ? 1u : 0u; mine = (j == x) ? c : mine; }
        if (sum == G) break;
        __builtin_amdgcn_s_sleep(1);
        if ((++sp & 255u) == 0u) { if (xb_ld(&bar[XB_TMO])) break; if (sp > XB_SPIN_CAP) { atomicAdd(&bar[XB_TMO], 1u); break; } }
    }
    nloc = mine > 0u ? mine : 1u; nx = cnt > 0u ? cnt : 1u;
}
__device__ __forceinline__ void xcd_barrier(const XcdBarrier& b) {
    asm volatile("s_waitcnt vmcnt(0)" ::: "memory");
    __syncthreads();
    if (threadIdx.x == 0) {
        unsigned* bar = b.bar;
        __builtin_amdgcn_s_waitcnt(0);
        unsigned nloc = b.st[0], nx = b.st[1];
        if (nloc == 0u) { xcd_barrier_complete(bar, b.x, nloc, nx); b.st[0] = nloc; b.st[1] = nx; }
        const unsigned old = xb_add(&bar[XB_XSUB(b.x)], 1u);
        const unsigned gen = old / nloc;
        if (old + 1u == (gen + 1u) * nloc) {
            __builtin_amdgcn_fence(__ATOMIC_RELEASE, "agent");
            asm volatile("s_waitcnt vmcnt(0)" ::: "memory");
            const unsigned og = xb_add(&bar[XB_TOP], 1u);
            const unsigned tg = og / nx;
            if (og + 1u == (tg + 1u) * nx) xb_add(&bar[XB_TOPGEN], 1u);
            else XB_SPIN(xb_ld(&bar[XB_TOPGEN]) == tg, bar);
            __builtin_amdgcn_fence(__ATOMIC_ACQUIRE, "agent");
            xb_add(&bar[XB_XGEN(b.x)], 1u);
            asm volatile("s_waitcnt vmcnt(0)" ::: "memory");
        } else {
            XB_SPIN(xb_ld(&bar[XB_XGEN(b.x)]) == gen, bar);
            __builtin_amdgcn_fence(__ATOMIC_ACQUIRE, "agent");
            asm volatile("s_waitcnt vmcnt(0)" ::: "memory");
        }
    }
    __syncthreads();
}

__device__ __forceinline__ int tidx() { int r; asm volatile("v_mov_b32 %0, %1" : "=v"(r) : "v"((int)threadIdx.x)); return r; }
__device__ __forceinline__ int bidx() { int r; asm volatile("s_mov_b32 %0, %1" : "=s"(r) : "s"((int)blockIdx.x)); return r; }
__device__ __forceinline__ int gdim() { int r; asm volatile("s_mov_b32 %0, %1" : "=s"(r) : "s"((int)gridDim.x)); return r; }
extern __shared__ __attribute__((aligned(16))) char lds_dyn[];
constexpr int G_TILE = 128 * 128;
constexpr int G_STAGE = 2 * G_TILE;
constexpr int G_LDS = 4 * G_STAGE;
__device__ __forceinline__ int g_lds_byte(int r, int c) { const int ob = (r & 15) * 64 + (c & 31) * 2; return ((r >> 4) * 2 + (c >> 5)) * 1024 + (ob ^ (((ob >> 9) & 1) << 5)); }
__device__ __forceinline__ int g_srow() { const int t = tidx(), ln = t & 63, p = ln * 16, ob = p ^ (((p >> 9) & 1) << 5); return ((t >> 6) >> 1) * 16 + (ob >> 6); }
__device__ __forceinline__ int g_skc() { const int t = tidx(), ln = t & 63, p = ln * 16, ob = p ^ (((p >> 9) & 1) << 5); return ((t >> 6) & 1) * 4 + ((ob & 63) >> 4); }

template <int SWAP>
__device__ __forceinline__ void mma_tile(f32x4 (&acc)[4][2], const char* As, const char* Bs, int a_rd, int b_rd) {
#pragma unroll
    for (int ks = 0; ks < 2; ++ks) {
        bf16x8 af[4], bfr[2];
#pragma unroll
        for (int mt = 0; mt < 4; ++mt) af[mt] = *(const bf16x8*)(As + a_rd + mt * 2048 + ks * 1024);
#pragma unroll
        for (int nt = 0; nt < 2; ++nt) bfr[nt] = *(const bf16x8*)(Bs + b_rd + nt * 2048 + ks * 1024);
#pragma unroll
        for (int mt = 0; mt < 4; ++mt)
#pragma unroll
            for (int nt = 0; nt < 2; ++nt)
                acc[mt][nt] = SWAP ? __builtin_amdgcn_mfma_f32_16x16x32_bf16(bfr[nt], af[mt], acc[mt][nt], 0, 0, 0)
                                   : __builtin_amdgcn_mfma_f32_16x16x32_bf16(af[mt], bfr[nt], acc[mt][nt], 0, 0, 0);
    }
}
struct GFrag { bf16x8 a[4], b[2]; };
__device__ __forceinline__ void gf_load(GFrag& f, const char* As, const char* Bs, int a_rd, int b_rd, int ks) {
#pragma unroll
    for (int mt = 0; mt < 4; ++mt) f.a[mt] = *(const bf16x8*)(As + a_rd + mt * 2048 + ks * 1024);
#pragma unroll
    for (int nt = 0; nt < 2; ++nt) f.b[nt] = *(const bf16x8*)(Bs + b_rd + nt * 2048 + ks * 1024);
}
template <int SWAP = 1>
__device__ __forceinline__ void gf_mma(f32x4 (&acc)[4][2], const GFrag& f) {
#pragma unroll
    for (int mt = 0; mt < 4; ++mt)
#pragma unroll
        for (int nt = 0; nt < 2; ++nt) acc[mt][nt] = SWAP ? __builtin_amdgcn_mfma_f32_16x16x32_bf16(f.b[nt], f.a[mt], acc[mt][nt], 0, 0, 0)
                                                           : __builtin_amdgcn_mfma_f32_16x16x32_bf16(f.a[mt], f.b[nt], acc[mt][nt], 0, 0, 0);
}
__device__ __forceinline__ void gf_zero(GFrag& f) {
#pragma unroll
    for (int mt = 0; mt < 4; ++mt) f.a[mt] = (bf16x8)(0);
#pragma unroll
    for (int nt = 0; nt < 2; ++nt) f.b[nt] = (bf16x8)(0);
}
#define SB() __builtin_amdgcn_sched_barrier(0)
#define GF_STAGE(ACCP, ACC, AS, BS) do { gf_load(f0, (AS), (BS), a_rd, b_rd, 0); SB(); gf_mma(ACCP, f1); SB(); gf_load(f1, (AS), (BS), a_rd, b_rd, 1); SB(); gf_mma(ACC, f0); SB(); } while (0)

struct GFrag2 { bf16x8 a[4], b[4]; };
__device__ __forceinline__ void gf2_load(GFrag2& f, const char* As, const char* Bs, int a_rd, int b_rd, int ks) {
#pragma unroll
    for (int mt = 0; mt < 4; ++mt) f.a[mt] = *(const bf16x8*)(As + a_rd + mt * 2048 + ks * 1024);
#pragma unroll
    for (int nt = 0; nt < 4; ++nt) f.b[nt] = *(const bf16x8*)(Bs + b_rd + nt * 2048 + ks * 1024);
}
template <int SWAP>
__device__ __forceinline__ void gf2_mma(f32x4 (&acc)[4][4], const GFrag2& f) {
#pragma unroll
    for (int mt = 0; mt < 4; ++mt)
#pragma unroll
        for (int nt = 0; nt < 4; ++nt) acc[mt][nt] = SWAP ? __builtin_amdgcn_mfma_f32_16x16x32_bf16(f.b[nt], f.a[mt], acc[mt][nt], 0, 0, 0)
                                                           : __builtin_amdgcn_mfma_f32_16x16x32_bf16(f.a[mt], f.b[nt], acc[mt][nt], 0, 0, 0);
}
__device__ __forceinline__ void gf2_zero(GFrag2& f) {
#pragma unroll
    for (int mt = 0; mt < 4; ++mt) f.a[mt] = (bf16x8)(0);
#pragma unroll
    for (int nt = 0; nt < 4; ++nt) f.b[nt] = (bf16x8)(0);
}
#define G_WAITV(n) asm volatile("s_waitcnt vmcnt(" #n ")\n\ts_waitcnt lgkmcnt(0)" ::: "memory")
template <int SWAP, int AT>
__device__ __forceinline__ void mma_seg(f32x4 (&acc)[4][2], const bf16_t* __restrict__ a0, const bf16_t* __restrict__ a1, long ldt,
                                        const bf16_t* __restrict__ b0, const bf16_t* __restrict__ b1, int K, char* lds) {
    const int tid = tidx(), lane = tid & 63, wid = __builtin_amdgcn_readfirstlane(tid >> 6), wm = wid >> 2, wn = wid & 3;
    const int fr = lane & 15, fq = lane >> 4;
    const int a_rd = g_lds_byte(wm * 64 + fr, fq * 8), b_rd = g_lds_byte(wn * 32 + fr, fq * 8);
    const int nk = K >> 6;
    if (!AT) {
        LAS char* L = (LAS char*)lds_dyn + ((wid >> 1) * 2 + (wid & 1)) * 1024;
        auto issue = [&](int st) { const int k0 = st << 6; LAS char* Lb = L + (st & 3) * G_STAGE;
            __builtin_amdgcn_global_load_lds((const unsigned*)(a0 + k0), (LAS unsigned*)(Lb), 16, 0, 0);
            __builtin_amdgcn_global_load_lds((const unsigned*)(a1 + k0), (LAS unsigned*)(Lb + 8192), 16, 0, 0);
            __builtin_amdgcn_global_load_lds((const unsigned*)(b0 + k0), (LAS unsigned*)(Lb + G_TILE), 16, 0, 0);
            __builtin_amdgcn_global_load_lds((const unsigned*)(b1 + k0), (LAS unsigned*)(Lb + G_TILE + 8192), 16, 0, 0); };
        GFrag f0, f1; gf_zero(f1);
        issue(0); if (nk > 1) issue(1); if (nk > 2) issue(2);
        for (int kt = 0; kt < nk; ++kt) {
            if (kt + 2 < nk) G_WAITV(8); else if (kt + 1 < nk) G_WAITV(4); else G_WAITV(0);
            __builtin_amdgcn_s_barrier();
            asm volatile("" ::: "memory");
            if (kt + 3 < nk) issue(kt + 3);
            const char* As = lds + (kt & 3) * G_STAGE;
            gf_load(f0, As, As + G_TILE, a_rd, b_rd, 0); SB(); gf_mma<SWAP>(acc, f1); SB(); gf_load(f1, As, As + G_TILE, a_rd, b_rd, 1); SB(); gf_mma<SWAP>(acc, f0); SB();
        }
        gf_mma<SWAP>(acc, f1);
        __syncthreads();
    } else {
        const int w0 = g_lds_byte(g_srow(), g_skc() * 8), w1 = w0 + 4 * 2048;
        const int tk = tid >> 4, tt = tid & 15;
        u32x4 ra0, ra1, rb0, rb1;
        auto gld = [&](int k0) {
            ra0 = *(const u32x4*)(a0 + (long)(k0 + tk) * ldt + tt * 8); ra1 = *(const u32x4*)(a0 + (long)(k0 + tk + 32) * ldt + tt * 8);
            rb0 = *(const u32x4*)(b0 + k0); rb1 = *(const u32x4*)(b1 + k0);
        };
        auto lst = [&](int buf) {
            char* A = lds + buf * G_STAGE; char* B = A + G_TILE;
#pragma unroll
            for (int i = 0; i < 8; ++i) {
                const unsigned wa = ra0[i >> 1], wb = ra1[i >> 1];
                *(bf16_t*)(A + g_lds_byte(tt * 8 + i, tk)) = (bf16_t)((i & 1) ? (wa >> 16) : (wa & 0xffffu));
                *(bf16_t*)(A + g_lds_byte(tt * 8 + i, tk + 32)) = (bf16_t)((i & 1) ? (wb >> 16) : (wb & 0xffffu));
            }
            *(u32x4*)(B + w0) = rb0; *(u32x4*)(B + w1) = rb1;
        };
        gld(0); lst(0); __syncthreads();
        for (int kt = 0; kt < nk; ++kt) {
            if (kt + 1 < nk) gld((kt + 1) << 6);
            __builtin_amdgcn_sched_barrier(0);
            mma_tile<SWAP>(acc, lds + (kt & 1) * G_STAGE, lds + (kt & 1) * G_STAGE + G_TILE, a_rd, b_rd);
            __builtin_amdgcn_sched_barrier(0);
            if (kt + 1 < nk) lst((kt + 1) & 1);
            __syncthreads();
        }
    }
}
__device__ __forceinline__ void mma_pair(f32x4 (&ag)[4][2], f32x4 (&ap)[4][2], const bf16_t* __restrict__ ga0, const bf16_t* __restrict__ ga1, const bf16_t* __restrict__ gb0, const bf16_t* __restrict__ gb1, int nkg,
                                         const bf16_t* __restrict__ pa0, const bf16_t* __restrict__ pa1, const bf16_t* __restrict__ pb0, const bf16_t* __restrict__ pb1, int nkp, char* lds) {
    const int tid = tidx(), lane = tid & 63, wid = __builtin_amdgcn_readfirstlane(tid >> 6), wm = wid >> 2, wn = wid & 3;
    const int fr = lane & 15, fq = lane >> 4;
    const int a_rd = g_lds_byte(wm * 64 + fr, fq * 8), b_rd = g_lds_byte(wn * 32 + fr, fq * 8);
    const int ns = nkg + nkp;
    LAS char* L = (LAS char*)lds_dyn + ((wid >> 1) * 2 + (wid & 1)) * 1024;
    auto issue = [&](int st) { const bool g = st < nkg; const int k0 = (g ? st : st - nkg) << 6; LAS char* Lb = L + (st & 3) * G_STAGE;
        __builtin_amdgcn_global_load_lds((const unsigned*)((g ? ga0 : pa0) + k0), (LAS unsigned*)(Lb), 16, 0, 0);
        __builtin_amdgcn_global_load_lds((const unsigned*)((g ? ga1 : pa1) + k0), (LAS unsigned*)(Lb + 8192), 16, 0, 0);
        __builtin_amdgcn_global_load_lds((const unsigned*)((g ? gb0 : pb0) + k0), (LAS unsigned*)(Lb + G_TILE), 16, 0, 0);
        __builtin_amdgcn_global_load_lds((const unsigned*)((g ? gb1 : pb1) + k0), (LAS unsigned*)(Lb + G_TILE + 8192), 16, 0, 0); };
    issue(0); issue(1); issue(2);
    for (int st = 0; st < nkg; ++st) {
        if (st + 2 < ns) G_WAITV(8); else if (st + 1 < ns) G_WAITV(4); else G_WAITV(0);
        __builtin_amdgcn_s_barrier(); asm volatile("" ::: "memory");
        if (st + 3 < ns) issue(st + 3);
        mma_tile<1>(ag, lds + (st & 3) * G_STAGE, lds + (st & 3) * G_STAGE + G_TILE, a_rd, b_rd);
    }
    for (int st = nkg; st < ns; ++st) {
        if (st + 2 < ns) G_WAITV(8); else if (st + 1 < ns) G_WAITV(4); else G_WAITV(0);
        __builtin_amdgcn_s_barrier(); asm volatile("" ::: "memory");
        if (st + 3 < ns) issue(st + 3);
        mma_tile<1>(ap, lds + (st & 3) * G_STAGE, lds + (st & 3) * G_STAGE + G_TILE, a_rd, b_rd);
    }
    __syncthreads();
}
constexpr int G2_STAGE = 3 * G_TILE;
constexpr int G2_LDS = 3 * G2_STAGE;
template <int SWAP>
__device__ __forceinline__ void mma_tile256(f32x4 (&acc)[4][4], const char* As, const char* Bs, int a_rd, int b_rd) {
#pragma unroll
    for (int ks = 0; ks < 2; ++ks) {
        bf16x8 af[4], bfr[4];
#pragma unroll
        for (int mt = 0; mt < 4; ++mt) af[mt] = *(const bf16x8*)(As + a_rd + mt * 2048 + ks * 1024);
#pragma unroll
        for (int nt = 0; nt < 4; ++nt) bfr[nt] = *(const bf16x8*)(Bs + b_rd + nt * 2048 + ks * 1024);
#pragma unroll
        for (int mt = 0; mt < 4; ++mt)
#pragma unroll
            for (int nt = 0; nt < 4; ++nt)
                acc[mt][nt] = SWAP ? __builtin_amdgcn_mfma_f32_16x16x32_bf16(bfr[nt], af[mt], acc[mt][nt], 0, 0, 0)
                                   : __builtin_amdgcn_mfma_f32_16x16x32_bf16(af[mt], bfr[nt], acc[mt][nt], 0, 0, 0);
    }
}
#define G2_WAITV(n) asm volatile("s_waitcnt vmcnt(" #n ")\n\ts_waitcnt lgkmcnt(0)" ::: "memory")
template <int SWAP>
__device__ __forceinline__ void mma_seg256(f32x4 (&acc)[4][4], const bf16_t* __restrict__ a0, size_t astep, const bf16_t* __restrict__ b0, size_t bstep, int K, char* lds) {
    const int tid = tidx(), lane = tid & 63, wid = __builtin_amdgcn_readfirstlane(tid >> 6), wm = wid >> 1, wn = wid & 1;
    const int fr = lane & 15, fq = lane >> 4;
    const int a_rd = g_lds_byte(wm * 64 + fr, fq * 8), b_rd = g_lds_byte(wn * 64 + fr, fq * 8);
    const int nk = K >> 6;
    LAS char* L = (LAS char*)lds_dyn + ((wid >> 1) * 2 + (wid & 1)) * 1024;
    auto issue = [&](int st) { const int k0 = st << 6; LAS char* Lb = L + (st % 3) * G2_STAGE;
#pragma unroll
        for (int i = 0; i < 4; ++i) __builtin_amdgcn_global_load_lds((const unsigned*)(a0 + i * astep + k0), (LAS unsigned*)(Lb + i * 8192), 16, 0, 0);
#pragma unroll
        for (int i = 0; i < 2; ++i) __builtin_amdgcn_global_load_lds((const unsigned*)(b0 + i * bstep + k0), (LAS unsigned*)(Lb + 2 * G_TILE + i * 8192), 16, 0, 0); };
    GFrag2 f0, f1; gf2_zero(f1);
    issue(0); if (nk > 1) issue(1);
    for (int kt = 0; kt < nk; ++kt) {
        if (kt + 1 < nk) G2_WAITV(6); else G2_WAITV(0);
        __builtin_amdgcn_s_barrier(); asm volatile("" ::: "memory");
        if (kt + 2 < nk) issue(kt + 2);
        const char* As = lds + (kt % 3) * G2_STAGE; const char* Bs = As + 2 * G_TILE;
        gf2_load(f0, As, Bs, a_rd, b_rd, 0); SB(); gf2_mma<SWAP>(acc, f1); SB(); gf2_load(f1, As, Bs, a_rd, b_rd, 1); SB(); gf2_mma<SWAP>(acc, f0); SB();
    }
    gf2_mma<SWAP>(acc, f1);
    __syncthreads();
}
__device__ __forceinline__ void acc_zero256(f32x4 (&acc)[4][4]) {
#pragma unroll
    for (int mt = 0; mt < 4; ++mt)
#pragma unroll
        for (int nt = 0; nt < 4; ++nt) acc[mt][nt] = (f32x4){0.f, 0.f, 0.f, 0.f};
}
__device__ __forceinline__ void acc_zero(f32x4 (&acc)[4][2]) {
#pragma unroll
    for (int mt = 0; mt < 4; ++mt)
#pragma unroll
        for (int nt = 0; nt < 2; ++nt) acc[mt][nt] = (f32x4){0.f, 0.f, 0.f, 0.f};
}

typedef _Float16 f16x8 __attribute__((ext_vector_type(8)));
constexpr int FRS = 130;
#define FBI(n) ((((n) >> 7) * FRS) + ((n) & 127))
constexpr int FFT_BUF_BYTES = 128 * FRS * 8;
struct FFrag { int unused; };
__device__ __forceinline__ float2 cmulf(float2 a, float2 b) { return make_float2(a.x * b.x - a.y * b.y, a.x * b.y + a.y * b.x); }
__device__ __forceinline__ float2 cmulcf(float2 a, float2 b) { return make_float2(a.x * b.x + a.y * b.y, a.y * b.x - a.x * b.y); }
__device__ __forceinline__ float2 tw16k(const float2* thi, const float2* tlo, int idx) { return cmulf(thi[idx >> 7], tlo[idx & 127]); }
__device__ __forceinline__ void mfft_frags(FFrag& F, const float2*) { F.unused = 0; }
template <int CONJ, int TW>
__device__ __forceinline__ void mfft_left(float2* buf, const FFrag& F, const float2* thi, const float2* tlo) {
    const int tid = tidx(), lane = tid & 63, wid = tid >> 6, i = wid >> 1, hi = lane >> 5, l31 = lane & 31, fa = 32 * i + l31;
    f32x16 yr0 = {}, yi0 = {}, yr1 = {}, yi1 = {};
#pragma unroll
    for (int ks = 0; ks < 8; ++ks) {
        f16x8 fr, fi;
#pragma unroll
        for (int j = 0; j < 8; ++j) { const float2 w = thi[(fa * (16 * ks + 8 * hi + j)) & 127]; fr[j] = (_Float16)w.x; fi[j] = (_Float16)(CONJ ? -w.y : w.y); }
        const f16x8 nfi = -fi;
#pragma unroll
        for (int t = 0; t < 2; ++t) {
            const float2* xp = buf + (16 * ks + 8 * hi) * FRS + 32 * (2 * (wid & 1) + t) + l31;
            f16x8 xr, xi;
#pragma unroll
            for (int j = 0; j < 8; ++j) { const float2 v = xp[j * FRS]; xr[j] = (_Float16)v.x; xi[j] = (_Float16)v.y; }
            if (t == 0) { yr0 = __builtin_amdgcn_mfma_f32_32x32x16_f16(fr, xr, yr0, 0, 0, 0); yr0 = __builtin_amdgcn_mfma_f32_32x32x16_f16(nfi, xi, yr0, 0, 0, 0);
                          yi0 = __builtin_amdgcn_mfma_f32_32x32x16_f16(fr, xi, yi0, 0, 0, 0); yi0 = __builtin_amdgcn_mfma_f32_32x32x16_f16(fi, xr, yi0, 0, 0, 0); }
            else        { yr1 = __builtin_amdgcn_mfma_f32_32x32x16_f16(fr, xr, yr1, 0, 0, 0); yr1 = __builtin_amdgcn_mfma_f32_32x32x16_f16(nfi, xi, yr1, 0, 0, 0);
                          yi1 = __builtin_amdgcn_mfma_f32_32x32x16_f16(fr, xi, yi1, 0, 0, 0); yi1 = __builtin_amdgcn_mfma_f32_32x32x16_f16(fi, xr, yi1, 0, 0, 0); }
        }
    }
    __syncthreads();
#pragma unroll
    for (int t = 0; t < 2; ++t)
#pragma unroll
        for (int r = 0; r < 16; ++r) { const int row = 32 * i + (r & 3) + 8 * (r >> 2) + 4 * hi, col = 32 * (2 * (wid & 1) + t) + l31;
            float2 v = t == 0 ? make_float2(yr0[r], yi0[r]) : make_float2(yr1[r], yi1[r]);
            if (TW) { const float2 tv = tw16k(thi, tlo, row * col); v = TW > 0 ? cmulf(v, tv) : cmulcf(v, tv); }
            buf[row * FRS + col] = v; }
    __syncthreads();
}
template <int CONJ, int TW>
__device__ __forceinline__ void mfft_right(float2* buf, const FFrag& F, const float2* thi, const float2* tlo) {
    const int tid = tidx(), lane = tid & 63, wid = tid >> 6, jb = wid >> 1, hi = lane >> 5, l31 = lane & 31, fa = 32 * jb + l31;
    f32x16 yr0 = {}, yi0 = {}, yr1 = {}, yi1 = {};
#pragma unroll
    for (int ks = 0; ks < 8; ++ks) {
        f16x8 fr, fi;
#pragma unroll
        for (int j = 0; j < 8; ++j) { const float2 w = thi[(fa * (16 * ks + 8 * hi + j)) & 127]; fr[j] = (_Float16)w.x; fi[j] = (_Float16)(CONJ ? -w.y : w.y); }
        const f16x8 nfi = -fi;
#pragma unroll
        for (int t = 0; t < 2; ++t) {
            const f32x4* xp = (const f32x4*)(buf + (32 * (2 * (wid & 1) + t) + l31) * FRS + 16 * ks + 8 * hi);
            const f32x4 q0 = xp[0], q1 = xp[1], q2 = xp[2], q3 = xp[3];
            f16x8 xr, xi;
            xr[0] = (_Float16)q0[0]; xi[0] = (_Float16)q0[1]; xr[1] = (_Float16)q0[2]; xi[1] = (_Float16)q0[3]; xr[2] = (_Float16)q1[0]; xi[2] = (_Float16)q1[1]; xr[3] = (_Float16)q1[2]; xi[3] = (_Float16)q1[3];
            xr[4] = (_Float16)q2[0]; xi[4] = (_Float16)q2[1]; xr[5] = (_Float16)q2[2]; xi[5] = (_Float16)q2[3]; xr[6] = (_Float16)q3[0]; xi[6] = (_Float16)q3[1]; xr[7] = (_Float16)q3[2]; xi[7] = (_Float16)q3[3];
            if (t == 0) { yr0 = __builtin_amdgcn_mfma_f32_32x32x16_f16(xr, fr, yr0, 0, 0, 0); yr0 = __builtin_amdgcn_mfma_f32_32x32x16_f16(xi, nfi, yr0, 0, 0, 0);
                          yi0 = __builtin_amdgcn_mfma_f32_32x32x16_f16(xr, fi, yi0, 0, 0, 0); yi0 = __builtin_amdgcn_mfma_f32_32x32x16_f16(xi, fr, yi0, 0, 0, 0); }
            else        { yr1 = __builtin_amdgcn_mfma_f32_32x32x16_f16(xr, fr, yr1, 0, 0, 0); yr1 = __builtin_amdgcn_mfma_f32_32x32x16_f16(xi, nfi, yr1, 0, 0, 0);
                          yi1 = __builtin_amdgcn_mfma_f32_32x32x16_f16(xr, fi, yi1, 0, 0, 0); yi1 = __builtin_amdgcn_mfma_f32_32x32x16_f16(xi, fr, yi1, 0, 0, 0); }
        }
    }
    __syncthreads();
#pragma unroll
    for (int t = 0; t < 2; ++t)
#pragma unroll
        for (int r = 0; r < 16; ++r) { const int row = 32 * (2 * (wid & 1) + t) + (r & 3) + 8 * (r >> 2) + 4 * hi, col = 32 * jb + l31;
            float2 v = t == 0 ? make_float2(yr0[r], yi0[r]) : make_float2(yr1[r], yi1[r]);
            if (TW) { const float2 tv = tw16k(thi, tlo, row * col); v = TW > 0 ? cmulf(v, tv) : cmulcf(v, tv); }
            buf[row * FRS + col] = v; }
    __syncthreads();
}
__device__ __forceinline__ void fft_fwd_blk(float2* buf, const FFrag& F, const float2* thi, const float2* tlo) { mfft_left<0, 1>(buf, F, thi, tlo); mfft_right<0, 0>(buf, F, thi, tlo); }
__device__ __forceinline__ void fft_inv_blk(float2* buf, const FFrag& F, const float2* thi, const float2* tlo) { mfft_right<1, -1>(buf, F, thi, tlo); mfft_left<1, 0>(buf, F, thi, tlo); }
constexpr int FFT_LDS_TAB = FFT_BUF_BYTES;
constexpr int FFT_LDS_EXTRA = FFT_LDS_TAB + 4096;
__device__ __forceinline__ void fft_tables(char* lds) {
    float2* thi = (float2*)(lds + FFT_LDS_TAB); float2* tlo = thi + 128;
    const int t = tidx();
    if (t < 128) { float s, c; sincospif(2.f * (float)t / 128.f, &s, &c); thi[t] = make_float2(c, -s); }
    else if (t < 256) { float s, c; sincospif(2.f * (float)(t - 128) / 16384.f, &s, &c); tlo[t - 128] = make_float2(c, -s); }
    else if (t < 384) { float s, c; sincospif((float)(t - 256) / 128.f, &s, &c); tlo[128 + (t - 256)] = make_float2(c, -s); }
    else { float s, c; sincospif((float)(t - 384) / 16384.f, &s, &c); tlo[256 + (t - 384)] = make_float2(c, -s); }
    __syncthreads();
}
__device__ __forceinline__ float block_sum(float v, float* red) {
    v = wave_sum(v);
    __syncthreads();
    if ((tidx() & 63) == 0) red[tidx() >> 6] = v;
    __syncthreads();
    float s = 0.f;
#pragma unroll
    for (int i = 0; i < 8; ++i) s += red[i];
    return s;
}

#if ONE_LAUNCH
#define PHASE_FN __device__ __forceinline__
#else
#define PHASE_FN __device__
#endif
__device__ __forceinline__ const float* wsrc(const Params& p, int l, int job, int n, int& ld) {
    switch (job) {
    case 0: { ld = IN_W; const float* w = p.in[I_WIN] + (size_t)l * 1024 * IN_W; int c;
        if (n < 768) c = 1440 + n; else if (n < 1024) c = n - 768; else if (n < 1152) c = 256 + (n - 1024); else if (n < 1184) c = 384 + (n - 1152);
        else if (n < 1280) return nullptr; else if (n < 2048) c = 416 + (n - 1280); else c = 1184 + (n - 2048);
        return w + c; }
    case 1: ld = IN_W; return p.in[I_WIN] + (size_t)l * 1024 * IN_W + 2208 + n;
    case 2: ld = 384; return p.in[I_WUQ] + (size_t)l * 256 * 384 + n;
    case 3: ld = 512; return p.in[I_WUKV] + (size_t)l * 128 * 512 + n;
    case 4: ld = 1024; return p.in[I_WBR] + ((size_t)l * 4 + 0) * 256 * 1024 + n;
    case 5: ld = 1024; return p.in[I_WBR] + ((size_t)l * 4 + 1) * 256 * 1024 + n;
    case 6: ld = 1024; return p.in[I_WBR] + ((size_t)l * 4 + 3) * 256 * 1024 + n;
    case 7: ld = 1024; return p.in[I_WOUT] + (size_t)l * 1024 * 1024 + n;
    case 8: { ld = 256; const int e = n >> 9, r = n & 511; const int t = r >> 7, wn = (r & 127) >> 5, nt = (r & 31) >> 4, i = r & 15; const int f = t * 64 + wn * 16 + i;
        return (nt ? p.in[I_MUP] : p.in[I_MGATE]) + ((size_t)l * 16 + e) * 1024 * 256 + f; }
    default: { ld = 1024; const int e = n >> 10, c = n & 1023; return p.in[I_MDOWN] + ((size_t)l * 16 + e) * 256 * 1024 + c; }
    }
}
PHASE_FN void ph_prologue(const Params& p, char* lds_unused) {
    char* lds = lds_dyn; (void)lds_unused;
    const int tid = tidx(), bid = bidx(), G = gdim();
    {
        float* sc = (float*)lds;
        float* red = sc + 3072;
        for (int i = tid; i < 3072; i += 512) { const int v = i >> 10, k = i & 1023; const float x = v < 2 ? p.in[I_C][v * 1024 + k] : p.in[I_CCTX][k]; sc[i] = silu_f(x); }
        __syncthreads();
        for (int u = bid; u < 192; u += G) {
            const int l = u / 96, j0 = (u % 96) * 64, kg = tid >> 6, j = tid & 63;
            const float* w = p.in[I_ADAW] + (size_t)l * 1024 * 6144 + j0 + j;
            float a0 = 0.f, a1 = 0.f, a2 = 0.f;
#pragma unroll 8
            for (int k = kg * 128; k < kg * 128 + 128; ++k) { const float wv = w[(size_t)k * 6144]; a0 += sc[k] * wv; a1 += sc[1024 + k] * wv; a2 += sc[2048 + k] * wv; }
            red[(0 * 8 + kg) * 64 + j] = a0; red[(1 * 8 + kg) * 64 + j] = a1; red[(2 * 8 + kg) * 64 + j] = a2;
            __syncthreads();
            if (tid < 192) { const int v = tid >> 6, jj = tid & 63; float s = p.in[I_ADAB][(size_t)l * 6144 + j0 + jj];
#pragma unroll
                for (int g = 0; g < 8; ++g) s += red[(v * 8 + g) * 64 + jj];
                WSP(float, OFF_MOD)[((size_t)l * 3 + v) * 6144 + j0 + jj] = s; }
            __syncthreads();
        }
    }
    for (int i = bid * 512 + tid; i < 2048; i += G * 512) {
        const int pos = i >> 3, f = i & 7; const float inv = powf(10000.f, -(float)f / 8.f); float s, c; sincos_rad((float)pos * inv, s, c);
        WSP(float2, OFF_ROPE)[i] = make_float2(c, s);
    }
    for (int i = bid * 512 + tidx(); i < NLAYER * 1024 * 64; i += G * 512) { const int l = i >> 16, col = (i >> 6) & 1023, j = i & 63;
        WSP(bf16_t, OFF_W3T)[i] = f2bf(p.in[I_HYW3][(size_t)l * 64 * 1024 + (size_t)j * 1024 + col]); }
    {
        float* w1 = (float*)lds;
        float* w2 = w1 + 33 * 64;
        float* vb = w2 + 64 * 64;
        float* zz = vb + 256;
        float* h1 = zz + 8 * 36;
        for (int l = 0; l < NLAYER; ++l) {
            __syncthreads();
            for (int i = tid; i < 33 * 64; i += 512) w1[i] = p.in[I_HYW1][(size_t)l * 33 * 64 + i];
            for (int i = tid; i < 64 * 64; i += 512) w2[i] = p.in[I_HYW2][(size_t)l * 64 * 64 + i];
            if (tid < 64) { vb[tid] = p.in[I_HYB1][l * 64 + tid]; vb[64 + tid] = p.in[I_HYF1][l * 64 + tid]; vb[128 + tid] = p.in[I_HYB2][l * 64 + tid]; vb[192 + tid] = p.in[I_HYF2][l * 64 + tid]; }
            __syncthreads();
            const int nchunks = (16384 + 256) / 8;
            for (int ch = bid; ch < nchunks; ch += G) {
                const bool isc = ch >= 2048; const int L = isc ? 256 : 16384; const int n = (isc ? ch - 2048 : ch) * 8 + (tid >> 6);
                const int nl = tid >> 6, j = tid & 63;
                if (j < 33) {
                    float v;
                    if (j == 0) v = (float)n / (float)(L - 1);
                    else { const int bi = (j - 1) & 15; const float band = 1e-4f + (float)bi * ((15.f - 1e-4f) / 15.f); float s, c; sincos_turns((float)n * band / (float)L, s, c); v = j <= 16 ? c : -s; }
                    zz[nl * 36 + j] = v;
                }
                __syncthreads();
                { float a = vb[j];
#pragma unroll
                  for (int i = 0; i < 33; ++i) a += zz[nl * 36 + i] * w1[i * 64 + j];
                  h1[nl * 64 + j] = sinf(vb[64 + j] * a); }
                __syncthreads();
                { float a = vb[128 + j];
#pragma unroll 16
                  for (int i = 0; i < 64; ++i) a += h1[nl * 64 + i] * w2[i * 64 + j];
                  const float r = sinf(vb[192 + j] * a);
                  if (isc) WSP(float, OFF_H2C)[((size_t)l * 256 + n) * 64 + j] = r; else WSP(bf16_t, OFF_H2L)[((size_t)l * 16384 + n) * 64 + j] = f2bf(r); }
                __syncthreads();
            }
        }
    }
}
template <int JOB, int N, int K>
__device__ __forceinline__ void wconv_job(const Params& p, int l, size_t we, const float* scale, char* lds) {
    float* tile = (float*)lds;
    const int tid = tidx();
    constexpr int NKT = K / 64, NT = (N / 64) * NKT;
    float xa[8], xb[8];
    auto fetch = [&](int v, float (&x)[8]) { const int n0 = (v / NKT) * 64, k0 = (v % NKT) * 64; const int nn = tid & 63, kk = tid >> 6; int ld; const float* src = wsrc(p, l, JOB, n0 + nn, ld);
#pragma unroll
        for (int i = 0; i < 8; ++i) { const int k = kk + 8 * i; float t = src ? src[(size_t)(k0 + k) * ld] : 0.f; if (scale) t *= scale[k0 + k]; x[i] = t; } };
    if (bidx() < NT) fetch(bidx(), xa);
    for (int v = bidx(); v < NT; v += gdim()) {
        const int n0 = (v / NKT) * 64, k0 = (v % NKT) * 64;
        if (v + gdim() < NT) fetch(v + gdim(), xb);
        __syncthreads();
        { const int nn = tid & 63, kk = tid >> 6;
#pragma unroll
          for (int i = 0; i < 8; ++i) { const int k = kk + 8 * i; tile[k * 65 + nn] = xa[i]; } }
#pragma unroll
        for (int i = 0; i < 8; ++i) xa[i] = xb[i];
        __syncthreads();
        if (JOB == 1) {
          const int nn = tid >> 3, kc = tid & 7; float v[8];
#pragma unroll
          for (int i = 0; i < 8; ++i) v[i] = tile[(kc * 8 + i) * 65 + nn] * 64.f;
          u32x2 w; int t0 = 0, t1 = 0;
          t0 = __builtin_amdgcn_cvt_pk_fp8_f32(v[0], v[1], t0, false); t0 = __builtin_amdgcn_cvt_pk_fp8_f32(v[2], v[3], t0, true);
          t1 = __builtin_amdgcn_cvt_pk_fp8_f32(v[4], v[5], t1, false); t1 = __builtin_amdgcn_cvt_pk_fp8_f32(v[6], v[7], t1, true);
          w.x = (unsigned)t0; w.y = (unsigned)t1;
          *(u32x2*)((char*)wts(p, l, we) + (size_t)(n0 + nn) * K + k0 + kc * 8) = w;
        } else
        { const int nn = tid >> 3, kc = tid & 7; u32x4 w;
          w.x = cvt_pk_bf16(tile[(kc * 8 + 0) * 65 + nn], tile[(kc * 8 + 1) * 65 + nn]); w.y = cvt_pk_bf16(tile[(kc * 8 + 2) * 65 + nn], tile[(kc * 8 + 3) * 65 + nn]);
          w.z = cvt_pk_bf16(tile[(kc * 8 + 4) * 65 + nn], tile[(kc * 8 + 5) * 65 + nn]); w.w = cvt_pk_bf16(tile[(kc * 8 + 6) * 65 + nn], tile[(kc * 8 + 7) * 65 + nn]);
          *(u32x4*)(wts(p, l, we) + (size_t)(n0 + nn) * K + k0 + kc * 8) = w; }
    }
}
PHASE_FN void ph_wconv(const Params& p, int l, char* lds_unused) {
    char* lds = lds_dyn; (void)lds_unused;
    const int tid = tidx(), bid = bidx(), G = gdim();
    wconv_job<0, 2304, 1024>(p, l, WE_W1T, nullptr, lds);
    wconv_job<1, 4096, 1024>(p, l, WE_WGT, nullptr, lds);
    wconv_job<2, 384, 256>(p, l, WE_WUQ, p.in[I_QNORM] + l * 256, lds);
    wconv_job<3, 512, 128>(p, l, WE_WUKV, p.in[I_KVNORM] + l * 128, lds);
    wconv_job<4, 1024, 256>(p, l, WE_WBA, nullptr, lds);
    wconv_job<5, 1024, 256>(p, l, WE_WBB, nullptr, lds);
    wconv_job<6, 1024, 256>(p, l, WE_WBD, nullptr, lds);
    wconv_job<7, 1024, 1024>(p, l, WE_WOUT, nullptr, lds);
    wconv_job<8, 8192, 1024>(p, l, WE_WGU, nullptr, lds);
    wconv_job<9, 16384, 256>(p, l, WE_WDN, nullptr, lds);
    __syncthreads();
    {
        float* cs = (float*)lds;
        __syncthreads();
        if (tid < 64) { float s, c; sincospif(2.f * (float)tid / 64.f, &s, &c); cs[tid] = c; cs[64 + tid] = s; }
        __syncthreads();
        for (int idx = bid * 512 + tid; idx < 512 * 1024; idx += G * 512) {
            const int r = idx; const int n = r & 1023, kp = r >> 10; const int part = kp >> 8, g = (kp & 255) >> 6, c = kp & 63;
            const float* wb = p.in[I_WBR] + ((size_t)l * 4 + 2) * 256 * 1024 + (size_t)(g * 64) * 1024 + n;
            float s = 0.f;
#pragma unroll 8
            for (int k2 = 0; k2 < 64; ++k2) s += cs[part * 64 + ((k2 * c) & 63)] * wb[(size_t)k2 * 1024];
            wts(p, l, WE_WBC)[(size_t)n * 512 + kp] = f2bf(s * (1.f / 1024.f));
        }
    }
}

__device__ __forceinline__ bool skip_tile(int l, int tile) { return (l == NLAYER - 1) && ((tile % 130) >= 128); }
__device__ __forceinline__ float row16_sum(float x) {
    x += __int_as_float(__builtin_amdgcn_update_dpp(0, __float_as_int(x), 0xB1, 0xf, 0xf, true));
    x += __int_as_float(__builtin_amdgcn_update_dpp(0, __float_as_int(x), 0x4E, 0xf, 0xf, true));
    x += __int_as_float(__builtin_amdgcn_update_dpp(0, __float_as_int(x), 0x141, 0xf, 0xf, true));
    x += __int_as_float(__builtin_amdgcn_update_dpp(0, __float_as_int(x), 0x140, 0xf, 0xf, true));
    return x;
}
template <int WHICH>
PHASE_FN void ph_norm(const Params& p, int l, char* lds_unused) {
    char* lds = lds_dyn; (void)lds_unused;
    const int tid = tidx(), wid = tid >> 6, lane = tid & 63, sub = lane >> 4, l16 = lane & 15;
    float* Wr = (float*)lds;
    int* lcount = (int*)(lds + 81920);
    int* lbase = lcount + 32;
    int* pidl = lbase + 32;
    int* rankl = pidl + 128;
    if (WHICH >= 1) {
        for (int i = tid; i < 20 * 1024; i += 512) { const int j = i >> 10, k = i & 1023;
            Wr[i] = j < 4 ? p.in[I_MWG][(size_t)l * 4096 + k * 4 + j] : p.in[I_MWE][(size_t)l * 16384 + k * 16 + (j - 4)]; }
        __syncthreads();
    }
    const float* gain = (WHICH == 0 ? p.in[I_N1G] : p.in[I_N2G]) + l * 1024; float sink = 0.f;
    bf16_t* H = WSP(bf16_t, OFF_H);
    float* At = (float*)(lds + 90112); float* Bt = At + 3072;
    for (int i = tid; i < 3072; i += 512) { const int mi = i >> 10, c = i & 1023; const float* mvb = WSP(float, OFF_MOD) + ((size_t)l * 3 + mi) * 6144 + (WHICH == 0 ? 0 : 3072);
        At[i] = gain[c] * (1.f + mvb[1024 + c]); Bt[i] = mvb[c]; }
    __syncthreads();
    f32x4 vn[16]; bool have = false;
#pragma unroll
    for (int i = 0; i < 16; ++i) vn[i] = (f32x4){0.f, 0.f, 0.f, 0.f};
    for (int tile = bidx(); tile < NTILE * 4; tile += gdim()) {
        if (WHICH >= 1 && skip_tile(l, tile >> 2)) continue;
        if (WHICH == 1) { __syncthreads(); if (tid < 24) lcount[tid] = 0; __syncthreads(); }
        {
            const int rloc = wid * 4 + sub, r = tile * 32 + rloc;
            const float* xr = (WHICH == 0 && l == 0) ? xrow_in(p, r) : xrow_st(p, r);
            const int mi = ((tile * 32) % TPB) < SEQ ? (tile * 32 >= TPB ? 1 : 0) : 2;
            f32x4 v[16]; float ss = 0.f;
            if (have) {
#pragma unroll
                for (int i = 0; i < 16; ++i) { v[i] = vn[i]; ss += v[i][0] * v[i][0] + v[i][1] * v[i][1] + v[i][2] * v[i][2] + v[i][3] * v[i][3]; }
            } else {
#pragma unroll
                for (int i = 0; i < 16; ++i) { v[i] = *(const f32x4*)(xr + 4 * (l16 + 16 * i)); ss += v[i][0] * v[i][0] + v[i][1] * v[i][1] + v[i][2] * v[i][2] + v[i][3] * v[i][3]; }
            }
            { int nt_ = tile + gdim(); while (WHICH >= 1 && nt_ < NTILE * 4 && skip_tile(l, nt_ >> 2)) nt_ += gdim();
              have = nt_ < NTILE * 4;
              if (have) { const int rn = nt_ * 32 + rloc; const float* xn = (WHICH == 0 && l == 0) ? xrow_in(p, rn) : xrow_st(p, rn);
#pragma unroll
                  for (int i = 0; i < 16; ++i) vn[i] = *(const f32x4*)(xn + 4 * (l16 + 16 * i)); }
              else {
#pragma unroll
                  for (int i = 0; i < 16; ++i) vn[i] = (f32x4){0.f, 0.f, 0.f, 0.f}; } }
            __builtin_amdgcn_sched_barrier(0);
            ss = row16_sum(ss);
            const float rinv = rsqrtf(ss * (1.f / 1024.f) + 1e-6f);
#pragma unroll
            for (int i = 0; i < 16; ++i) {
                const int c0 = 4 * (l16 + 16 * i);
                const f32x4 a4 = *(const f32x4*)(At + mi * 1024 + c0), b4 = *(const f32x4*)(Bt + mi * 1024 + c0);
#pragma unroll
                for (int e = 0; e < 4; ++e) v[i][e] = (v[i][e] * rinv) * a4[e] + b4[e];
                u32x2 w; w.x = cvt_pk_bf16(v[i][0], v[i][1]); w.y = cvt_pk_bf16(v[i][2], v[i][3]);
                *(u32x2*)(H + (size_t)r * 1024 + c0) = w;
                if ((i & 3) == 3) __builtin_amdgcn_sched_barrier(0);
            }
            if (WHICH >= 1) {
                float lg[20];
                int wofs = 4 * l16; asm volatile("" : "+v"(wofs));
#pragma unroll
                for (int j = 0; j < 20; ++j) { f32x2 a2 = {0.f, 0.f};
#pragma unroll
                    for (int i = 0; i < 16; ++i) { const f32x4 w = *(const f32x4*)(Wr + j * 1024 + wofs + 64 * i);
                        a2 = __builtin_elementwise_fma(__builtin_shufflevector(v[i], v[i], 0, 1), __builtin_shufflevector(w, w, 0, 1), a2);
                        a2 = __builtin_elementwise_fma(__builtin_shufflevector(v[i], v[i], 2, 3), __builtin_shufflevector(w, w, 2, 3), a2);
                        if ((i & 7) == 7) __builtin_amdgcn_sched_barrier(0); }
                    lg[j] = row16_sum(a2[0] + a2[1]); __builtin_amdgcn_sched_barrier(0); }
#pragma unroll
                for (int j = 0; j < 4; ++j) lg[j] += p.in[I_MBG][l * 4 + j];
#pragma unroll
                for (int j = 0; j < 16; ++j) lg[4 + j] += p.in[I_MBE][l * 16 + j];
                int g = 0; float gm = lg[0];
#pragma unroll
                for (int j = 1; j < 4; ++j) if (lg[j] > gm) { gm = lg[j]; g = j; }
                float gs = 0.f;
#pragma unroll
                for (int j = 0; j < 4; ++j) gs += __expf(lg[j] - gm);
                const float gp = 1.f / gs;
                float e4[4];
#pragma unroll
                for (int j = 0; j < 4; ++j) e4[j] = g == 0 ? lg[4 + j] : g == 1 ? lg[8 + j] : g == 2 ? lg[12 + j] : lg[16 + j];
                int i1 = 0; float m1 = e4[0];
#pragma unroll
                for (int j = 1; j < 4; ++j) if (e4[j] > m1) { m1 = e4[j]; i1 = j; }
                int i2 = -1; float m2 = -3.4e38f;
#pragma unroll
                for (int j = 0; j < 4; ++j) if (j != i1 && e4[j] > m2) { m2 = e4[j]; i2 = j; }
                const float x2 = __expf(m2 - m1); const float pw1 = gp / (1.f + x2), pw2 = gp * x2 / (1.f + x2);
                const int lo = i1 < i2 ? i1 : i2, hi = i1 < i2 ? i2 : i1;
                const float wlo = i1 < i2 ? pw1 : pw2, whi = i1 < i2 ? pw2 : pw1;
                const int pairidx = lo == 0 ? hi - 1 : lo == 1 ? hi + 1 : 5;
                if (WHICH == 2) sink += wlo + whi + (float)pairidx;
                if (l16 == 0 && WHICH == 1) { pidl[rloc] = g * 6 + pairidx; WSP(float, OFF_TOKW)[(size_t)r * 2] = wlo; WSP(float, OFF_TOKW)[(size_t)r * 2 + 1] = whi; }
            }
        }
        if (WHICH == 2) asm volatile("" :: "v"(sink));
        if (WHICH == 1) {
            __syncthreads();
            int mypid = 0;
            if (tid < 32) { mypid = pidl[tid]; rankl[tid] = atomicAdd(&lcount[mypid], 1); }
            __syncthreads();
            if (tid < 24) lbase[tid] = lcount[tid] ? atomicAdd(WSP(int, OFF_CNT) + l * 32 + tid, lcount[tid]) : 0;
            __syncthreads();
            if (tid < 32) WSP(int, OFF_LISTS)[(size_t)mypid * T + lbase[mypid] + rankl[tid]] = tile * 32 + tid;
        }
    }
}

PHASE_FN void ph_filt(const Params& p, int l, char* lds_unused) {
    char* lds = lds_dyn; (void)lds_unused;
    const int tid = tidx(), lane = tid & 63, wid = tid >> 6, wm = wid >> 2, wn = wid & 3, fr = lane & 15, fq = lane >> 4;
    const bf16_t* A = WSP(const bf16_t, OFF_H2L) + (size_t)l * 16384 * 64; const bf16_t* B = WSP(const bf16_t, OFF_W3T) + (size_t)l * 1024 * 64;
    bf16_t* F = WSP(bf16_t, OFF_FILT);
    for (int u = bidx(); u < 128 * 8; u += gdim()) {
        const int n0 = (u >> 3) * 128, c0 = (u & 7) * 128;
        const bf16_t* a0 = A + (size_t)(n0 + g_srow()) * 64 + g_skc() * 8; const bf16_t* b0 = B + (size_t)(c0 + g_srow()) * 64 + g_skc() * 8;
        f32x4 acc[4][2]; acc_zero(acc);
        mma_seg<0, 0>(acc, a0, a0 + (size_t)64 * 64, 0, b0, b0 + (size_t)64 * 64, 64, lds);
#pragma unroll
        for (int mt = 0; mt < 4; ++mt)
#pragma unroll
            for (int nt = 0; nt < 2; ++nt) { const int n = n0 + wm * 64 + mt * 16 + fq * 4, col = c0 + wn * 32 + nt * 16 + fr;
                u32x2 w; w.x = cvt_pk_bf16(acc[mt][nt][0], acc[mt][nt][1]); w.y = cvt_pk_bf16(acc[mt][nt][2], acc[mt][nt][3]);
                *(u32x2*)(F + (size_t)col * 16384 + n) = w; }
    }
}

PHASE_FN void ph_gemm1(const Params& p, int l, char* lds_unused) {
    char* lds = lds_dyn; (void)lds_unused;
    const int tid = tidx(), lane = tid & 63, wid = tid >> 6, wm = wid >> 1, wn = wid & 1, fr = lane & 15, fq = lane >> 4;
    const bf16_t* H = WSP(bf16_t, OFF_H); const bf16_t* W = wts(p, l, WE_W1T);
    for (int u = bidx(); u < (NTILE / 2) * 18; u += gdim()) {
        const int rt = u / 18, ct = u % 18; const int r0 = rt * 256, n0 = ct * 128;
        const bf16_t* a0 = H + (size_t)(r0 + g_srow()) * 1024 + g_skc() * 8; const bf16_t* b0 = W + (size_t)(n0 + g_srow()) * 1024 + g_skc() * 8;
        f32x4 acc[4][4]; acc_zero256(acc);
        if (ct < 10) {
            mma_seg256<1>(acc, a0, (size_t)64 * 1024, b0, (size_t)64 * 1024, 1024, lds);
            bf16_t* P = WSP(bf16_t, OFF_P);
#pragma unroll
            for (int mt = 0; mt < 4; ++mt)
#pragma unroll
                for (int nt = 0; nt < 4; ++nt) { const int row = r0 + wm * 64 + mt * 16 + fr, col = n0 + wn * 64 + nt * 16 + fq * 4;
                    u32x2 w; w.x = cvt_pk_bf16(acc[mt][nt][0], acc[mt][nt][1]); w.y = cvt_pk_bf16(acc[mt][nt][2], acc[mt][nt][3]);
                    *(u32x2*)(P + (size_t)row * PLD + col) = w; }
        } else {
            mma_seg256<0>(acc, a0, (size_t)64 * 1024, b0, (size_t)64 * 1024, 1024, lds);
            const int b = r0 >= TPB ? 1 : 0, t0 = r0 - b * TPB;
            bf16_t* HT = WSP(bf16_t, OFF_HYFN) + (size_t)b * 1024 * TPB;
#pragma unroll
            for (int mt = 0; mt < 4; ++mt)
#pragma unroll
                for (int nt = 0; nt < 4; ++nt) { const int t = t0 + wm * 64 + mt * 16 + fq * 4, ch = (n0 - 1280) + wn * 64 + nt * 16 + fr;
                    u32x2 w; w.x = cvt_pk_bf16(acc[mt][nt][0], acc[mt][nt][1]); w.y = cvt_pk_bf16(acc[mt][nt][2], acc[mt][nt][3]);
                    *(u32x2*)(HT + (size_t)ch * TPB + t) = w; }
        }
    }
}

#define KSWZ(row, colB) ((row) * 256 + ((colB) ^ (((row) & 7) << 4)))
#define SBAR() __builtin_amdgcn_sched_barrier(0)
__device__ __forceinline__ int crow(int r, int hi) { return (r & 3) + 8 * (r >> 2) + 4 * hi; }
__device__ __forceinline__ int v_st(int k, int c) { const int kk = (k & ~0xC) | ((k & 4) << 1) | ((k & 8) >> 1); return ((kk >> 3) * 2 + (c >> 5)) * 512 + ((kk & 7) * 32 + (c & 31)) * 2; }
__device__ __forceinline__ int v_rd_base(int lane) { return ((lane & 3) << 3) | (((lane >> 2) & 3) << 6) | (((lane >> 4) & 1) << 5) | (((lane >> 5) & 1) << 8); }
constexpr int v_rd_off(int d0, int ks, int half) { return d0 * 512 + ks * 2048 + half * 1024; }
template <int OFF> __device__ __forceinline__ s16x4 tr_read(int vb) {
    s16x4 r; asm volatile("ds_read_b64_tr_b16 %0, %1 offset:%2" : "=&v"(r) : "v"(vb), "i"(OFF) : "memory"); return r;
}
template <int D0> __device__ __forceinline__ void pv_one(f32x16& od, int vb, bf16x8 pa0, bf16x8 pa1, bf16x8 pa2, bf16x8 pa3) {
    const s16x4 l0 = tr_read<v_rd_off(D0, 0, 0)>(vb), h0 = tr_read<v_rd_off(D0, 0, 1)>(vb), l1 = tr_read<v_rd_off(D0, 1, 0)>(vb), h1 = tr_read<v_rd_off(D0, 1, 1)>(vb);
    const s16x4 l2 = tr_read<v_rd_off(D0, 2, 0)>(vb), h2 = tr_read<v_rd_off(D0, 2, 1)>(vb), l3 = tr_read<v_rd_off(D0, 3, 0)>(vb), h3 = tr_read<v_rd_off(D0, 3, 1)>(vb);
    asm volatile("s_waitcnt lgkmcnt(0)" ::: "memory"); SBAR();
#define PKV(L, H) (bf16x8){L[0], L[1], L[2], L[3], H[0], H[1], H[2], H[3]}
    od = __builtin_amdgcn_mfma_f32_32x32x16_bf16(pa0, PKV(l0, h0), od, 0, 0, 0);
    od = __builtin_amdgcn_mfma_f32_32x32x16_bf16(pa1, PKV(l1, h1), od, 0, 0, 0);
    od = __builtin_amdgcn_mfma_f32_32x32x16_bf16(pa2, PKV(l2, h2), od, 0, 0, 0);
    od = __builtin_amdgcn_mfma_f32_32x32x16_bf16(pa3, PKV(l3, h3), od, 0, 0, 0);
#undef PKV
}
constexpr int ATT_LDS = 16384 + 32768 + 2048;
constexpr float ATT_THR = 8.f;
template <int DQK, int NA>
__device__ __forceinline__ void attn_unit(const bf16_t* __restrict__ Qb, int ldq, const bf16_t* __restrict__ Kb, int ldk, const bf16_t* __restrict__ Vb, int ldv,
                                          bf16_t* __restrict__ Ob, int ldo, int NT, int nA, int baseA, int baseB, char* lds, const float* biasL, int qrow0, int krow_lo) {
    constexpr float SCALE = DQK == 96 ? 0.10206207261596575f : 0.125f;
    constexpr float C = SCALE * 1.4426950408889634f;
    constexpr int ND = DQK / 16, NKC = DQK / 8;
    const int tid = tidx(), wid = tid >> 6, lane = tid & 63, r32 = lane & 31, hi = lane >> 5;
    char* V_lds = lds; char* K_lds = lds + 16384;
    float* wsf = (float*)(lds + 49152) + wid * 64; float* al_l = wsf; float* li_l = wsf + 32;
    bf16x8 qr[ND];
    { const bf16_t* Qw = Qb + (size_t)(wid * 32 + r32) * ldq + hi * 8;
#pragma unroll
      for (int d0 = 0; d0 < ND; ++d0) qr[d0] = *(const bf16x8*)(Qw + d0 * 16); }
    const int vrow = tid >> 3, vc = (tid & 7) * 8, vst = v_st(vrow, vc);
    const int k0row = tid / NKC, k0c = tid % NKC, kst0 = KSWZ(k0row, k0c * 16);
    const int id1 = tid + 512; const bool has1 = (DQK == 96) && (id1 < 64 * NKC);
    const int k1row = has1 ? id1 / NKC : 0, k1c = has1 ? id1 % NKC : 0, kst1 = KSWZ(k1row, k1c * 16);
    const int vb0 = (int)(uintptr_t)V_lds + v_rd_base(lane);
    bf16x8 sv, sk0, sk1;
    auto SLOAD = [&](int j) { const size_t t0 = (size_t)(j < nA ? baseA + 64 * j : baseB + 64 * (j - nA));
        sv = *(const bf16x8*)(Vb + (t0 + vrow) * ldv + vc); sk0 = *(const bf16x8*)(Kb + (t0 + k0row) * ldk + k0c * 8);
        if (has1) sk1 = *(const bf16x8*)(Kb + (t0 + k1row) * ldk + k1c * 8); };
    auto SWRITE = [&](int b) { *(bf16x8*)(V_lds + b * 8192 + vst) = sv; *(bf16x8*)(K_lds + b * 16384 + kst0) = sk0; if (has1) *(bf16x8*)(K_lds + b * 16384 + kst1) = sk1; };
    float m_reg = -1e30f, l_reg = 0.f; f32x16 o0 = {}, o1 = {};
    __syncthreads();
    SLOAD(0); SWRITE(0); __syncthreads();
    for (int j = 0; j < NT; ++j) {
        const int bsel = j & 1;
        if (j + 1 < NT) SLOAD(j + 1);
        f32x16 p0 = {}, p1 = {};
        { const char* Ks = K_lds + bsel * 16384;
#pragma unroll
          for (int d0 = 0; d0 < ND; ++d0) { const int cb = d0 * 32 + hi * 16;
            const bf16x8 b0 = *(const bf16x8*)(Ks + KSWZ(r32, cb)); const bf16x8 b1 = *(const bf16x8*)(Ks + KSWZ(32 + r32, cb));
            p0 = __builtin_amdgcn_mfma_f32_32x32x16_bf16(b0, qr[d0], p0, 0, 0, 0);
            p1 = __builtin_amdgcn_mfma_f32_32x32x16_bf16(b1, qr[d0], p1, 0, 0, 0); } }
        if (NA) {
            if (j >= nA) {
                const int krow = krow_lo + (j - nA), qrow = qrow0 + (wid >> 1);
                int ws = qrow - 4; ws = ws < 0 ? 0 : (ws > 248 ? 248 : ws);
                const bool rowok = (krow >= ws) && (krow < ws + 8);
                const int qc = 32 * (wid & 1) + r32; int cs = qc - 8; cs = cs < 0 ? 0 : (cs > 48 ? 48 : cs);
                int dri = krow - qrow + 7; dri = dri < 0 ? 0 : (dri > 14 ? 14 : dri);
                const float* brow = biasL + dri * 31 + 15 - qc;
#pragma unroll
                for (int r = 0; r < 16; ++r) { const int kc = crow(r, hi); const bool ok = rowok && kc >= cs && kc < cs + 16; float bv = 0.f; if (ok) bv = brow[kc]; p0[r] = ok ? p0[r] + bv : -1e30f; }
#pragma unroll
                for (int r = 0; r < 16; ++r) { const int kc = 32 + crow(r, hi); const bool ok = rowok && kc >= cs && kc < cs + 16; float bv = 0.f; if (ok) bv = brow[kc]; p1[r] = ok ? p1[r] + bv : -1e30f; }
            }
        }
        float pmax = p0[0];
#pragma unroll
        for (int r = 1; r < 16; ++r) pmax = fmaxf(pmax, p0[r]);
#pragma unroll
        for (int r = 0; r < 16; ++r) pmax = fmaxf(pmax, p1[r]);
        { auto rr = __builtin_amdgcn_permlane32_swap(__float_as_uint(pmax), __float_as_uint(pmax), false, false); pmax = fmaxf(__uint_as_float(rr[0]), __uint_as_float(rr[1])); }
        float mn, alpha;
        if (__all(pmax - m_reg <= ATT_THR / SCALE)) { mn = m_reg; alpha = 1.f; }
        else { mn = fmaxf(m_reg, pmax); alpha = __builtin_amdgcn_exp2f((m_reg - mn) * C); m_reg = mn; }
        const float mnC = -mn * C;
        float ps = 0.f;
#pragma unroll
        for (int r = 0; r < 16; ++r) { p0[r] = __builtin_amdgcn_exp2f(fmaf(p0[r], C, mnC)); ps += p0[r]; }
#pragma unroll
        for (int r = 0; r < 16; ++r) { p1[r] = __builtin_amdgcn_exp2f(fmaf(p1[r], C, mnC)); ps += p1[r]; }
        { auto rr = __builtin_amdgcn_permlane32_swap(__float_as_uint(ps), __float_as_uint(ps), false, false); ps = __uint_as_float(rr[0]) + __uint_as_float(rr[1]); }
        l_reg = l_reg * alpha + ps;
        bf16x8 pa0, pa1, pa2, pa3;
#define PK4(P, BASE, OUT) do { unsigned a0_ = cvt_pk_bf16(P[BASE + 0], P[BASE + 1]), a1_ = cvt_pk_bf16(P[BASE + 2], P[BASE + 3]);   \
        unsigned b0_ = cvt_pk_bf16(P[BASE + 4], P[BASE + 5]), b1_ = cvt_pk_bf16(P[BASE + 6], P[BASE + 7]);                              \
        auto r0_ = __builtin_amdgcn_permlane32_swap(a0_, b0_, false, false); auto r1_ = __builtin_amdgcn_permlane32_swap(a1_, b1_, false, false); \
        u32x4 w_ = {r0_[0], r1_[0], r0_[1], r1_[1]}; OUT = *reinterpret_cast<bf16x8*>(&w_); } while (0)
        PK4(p0, 0, pa0); PK4(p0, 8, pa1); PK4(p1, 0, pa2); PK4(p1, 8, pa3);
#undef PK4
        if (__any(alpha < 1.f)) {
            if (hi == 0) al_l[r32] = alpha;
            asm volatile("s_waitcnt lgkmcnt(0)" ::: "memory");
#pragma unroll
            for (int r = 0; r < 16; ++r) { const float a = al_l[crow(r, hi)]; o0[r] *= a; o1[r] *= a; }
        }
        pv_one<0>(o0, vb0 + bsel * 8192, pa0, pa1, pa2, pa3);
        pv_one<1>(o1, vb0 + bsel * 8192, pa0, pa1, pa2, pa3);
        if (j + 1 < NT) SWRITE(bsel ^ 1);
        __syncthreads();
    }
    if (hi == 0) li_l[r32] = l_reg;
    asm volatile("s_waitcnt lgkmcnt(0)" ::: "memory");
    bf16_t* Ow = Ob + (size_t)(wid * 32) * ldo;
#pragma unroll
    for (int r = 0; r < 16; ++r) { const int orow = crow(r, hi); const float rl = __builtin_amdgcn_rcpf(li_l[orow]);
        Ow[(size_t)orow * ldo + r32] = f2bf(o0[r] * rl); Ow[(size_t)orow * ldo + 32 + r32] = f2bf(o1[r] * rl); }
    __syncthreads();
}

__device__ __forceinline__ void mla_partialSM(f32x16& p0, f32x16& p1, float& m_reg, float& alpha, bool first) {
    constexpr float THR2 = ATT_THR * 1.4426950408889634f;
    float pmax = p0[0];
#pragma unroll
    for (int r = 1; r < 16; ++r) pmax = fmaxf(pmax, p0[r]);
#pragma unroll
    for (int r = 0; r < 16; ++r) pmax = fmaxf(pmax, p1[r]);
    { auto rr = __builtin_amdgcn_permlane32_swap(__float_as_uint(pmax), __float_as_uint(pmax), false, false); pmax = fmaxf(__uint_as_float(rr[0]), __uint_as_float(rr[1])); }
    if (__builtin_expect(!first && __all(pmax <= THR2), 1)) { alpha = 1.f; }
    else { const float d = first ? pmax : fmaxf(pmax, 0.f); alpha = first ? 1.f : __builtin_amdgcn_exp2f(-d); m_reg += d;
#pragma unroll
        for (int r = 0; r < 16; ++r) { p0[r] -= d; p1[r] -= d; } }
#pragma unroll
    for (int r = 0; r < 16; ++r) p0[r] = __builtin_amdgcn_exp2f(p0[r]);
}
__device__ __forceinline__ void mla_finishSM(f32x16& p0, f32x16& p1, float alpha, float& l_reg, bf16x8& pa0, bf16x8& pa1, bf16x8& pa2, bf16x8& pa3) {
#pragma unroll
    for (int r = 0; r < 16; ++r) p1[r] = __builtin_amdgcn_exp2f(p1[r]);
    f32x2 s2 = {p0[0], p0[1]}, t2 = {p1[0], p1[1]};
#pragma unroll
    for (int r = 2; r < 16; r += 2) { s2 += (f32x2){p0[r], p0[r + 1]}; t2 += (f32x2){p1[r], p1[r + 1]}; }
    s2 += t2; float ps = s2[0] + s2[1];
    { auto rr = __builtin_amdgcn_permlane32_swap(__float_as_uint(ps), __float_as_uint(ps), false, false); ps = __uint_as_float(rr[0]) + __uint_as_float(rr[1]); }
    l_reg = l_reg * alpha + ps;
#define PK4(P, BASE, OUT) do { unsigned a0_ = cvt_pk_bf16(P[BASE + 0], P[BASE + 1]), a1_ = cvt_pk_bf16(P[BASE + 2], P[BASE + 3]);   \
    unsigned b0_ = cvt_pk_bf16(P[BASE + 4], P[BASE + 5]), b1_ = cvt_pk_bf16(P[BASE + 6], P[BASE + 7]);                              \
    auto r0_ = __builtin_amdgcn_permlane32_swap(a0_, b0_, false, false); auto r1_ = __builtin_amdgcn_permlane32_swap(a1_, b1_, false, false); \
    u32x4 w_ = {r0_[0], r1_[0], r0_[1], r1_[1]}; OUT = *reinterpret_cast<bf16x8*>(&w_); } while (0)
    PK4(p0, 0, pa0); PK4(p0, 8, pa1); PK4(p1, 0, pa2); PK4(p1, 8, pa3);
#undef PK4
}
__device__ __forceinline__ void mla_qkt(f32x16& p0, f32x16& p1, const char* Ks, const bf16x8* qr, int r32, int hi, float init) {
#pragma unroll
    for (int r = 0; r < 16; ++r) { p0[r] = init; p1[r] = init; }
#pragma unroll
    for (int d0 = 0; d0 < 6; ++d0) { const int cb = d0 * 32 + hi * 16;
        const bf16x8 b0 = *(const bf16x8*)(Ks + KSWZ(r32, cb)); const bf16x8 b1 = *(const bf16x8*)(Ks + KSWZ(32 + r32, cb));
        p0 = __builtin_amdgcn_mfma_f32_32x32x16_bf16(b0, qr[d0], p0, 0, 0, 0);
        p1 = __builtin_amdgcn_mfma_f32_32x32x16_bf16(b1, qr[d0], p1, 0, 0, 0); }
}
__device__ __forceinline__ void mla_unit(const bf16_t* __restrict__ Qb, const bf16_t* __restrict__ Kb, const bf16_t* __restrict__ Vb, bf16_t* __restrict__ Ob,
                                         int NT, int nA, int baseA, int baseB, char* lds) {
    constexpr int ldq = 384, ldk = 384, ldv = 256, ldo = 512;
    const int tid = tidx(), wid = tid >> 6, lane = tid & 63, r32 = lane & 31, hi = lane >> 5;
    char* V_lds = lds; char* K_lds = lds + 16384;
    float* wsf = (float*)(lds + 49152) + wid * 64; float* al_l = wsf; float* li_l = wsf + 32;
    bf16x8 qr[6];
    { const bf16_t* Qw = Qb + (size_t)(wid * 32 + r32) * ldq + hi * 8;
#pragma unroll
      for (int d0 = 0; d0 < 6; ++d0) qr[d0] = *(const bf16x8*)(Qw + d0 * 16); }
    const int vrow = tid >> 3, vc = (tid & 7) * 8, vst = v_st(vrow, vc);
    const int k0row = tid / 12, k0c = tid % 12, kst0 = KSWZ(k0row, k0c * 16);
    const int id1 = tid + 512; const bool has1 = id1 < 768;
    const int k1row = has1 ? id1 / 12 : 0, k1c = has1 ? id1 % 12 : 0, kst1 = KSWZ(k1row, k1c * 16);
    const int vb0 = (int)(uintptr_t)V_lds + v_rd_base(lane);
    bf16x8 sv, sk0, sk1;
    auto SLOAD = [&](int j) { const size_t t0 = (size_t)(j < nA ? baseA + 64 * j : baseB + 64 * (j - nA));
        sv = *(const bf16x8*)(Vb + (t0 + vrow) * ldv + vc); sk0 = *(const bf16x8*)(Kb + (t0 + k0row) * ldk + k0c * 8);
        if (has1) sk1 = *(const bf16x8*)(Kb + (t0 + k1row) * ldk + k1c * 8); };
    auto SWRITE = [&](int b) { *(bf16x8*)(V_lds + b * 8192 + vst) = sv; *(bf16x8*)(K_lds + b * 16384 + kst0) = sk0; if (has1) *(bf16x8*)(K_lds + b * 16384 + kst1) = sk1; };
#define MLA_RESC(a) do { if (__any((a) < 1.f)) { if (hi == 0) al_l[r32] = (a); asm volatile("s_waitcnt lgkmcnt(0)" ::: "memory"); \
    _Pragma("unroll") for (int r = 0; r < 16; ++r) { const float a_ = al_l[crow(r, hi)]; o0[r] *= a_; o1[r] *= a_; } } } while (0)
    float m_reg = 0.f, l_reg = 0.f; f32x16 o0 = {}, o1 = {};
    f32x16 pA0, pA1, pB0, pB1; float alA, alB; bf16x8 pa0, pa1, pa2, pa3;
    __syncthreads();
    SLOAD(0); SWRITE(0); __syncthreads();
    mla_qkt(pA0, pA1, K_lds, qr, r32, hi, 0.f); mla_partialSM(pA0, pA1, m_reg, alA, true);
    SLOAD(1); SWRITE(1); __syncthreads();
    for (int j = 1; j + 1 < NT; j += 2) {
        SBAR(); mla_qkt(pB0, pB1, K_lds + 16384, qr, r32, hi, -m_reg);
        mla_finishSM(pA0, pA1, alA, l_reg, pa0, pa1, pa2, pa3); SBAR();
        SLOAD(j + 1); SBAR();
        pv_one<0>(o0, vb0, pa0, pa1, pa2, pa3); pv_one<1>(o1, vb0, pa0, pa1, pa2, pa3); mla_partialSM(pB0, pB1, m_reg, alB, false);
        __syncthreads(); SWRITE(0);
        MLA_RESC(alB); __syncthreads();
        SBAR(); mla_qkt(pA0, pA1, K_lds, qr, r32, hi, -m_reg);
        mla_finishSM(pB0, pB1, alB, l_reg, pa0, pa1, pa2, pa3); SBAR();
        SLOAD(j + 2); SBAR();
        pv_one<0>(o0, vb0 + 8192, pa0, pa1, pa2, pa3); pv_one<1>(o1, vb0 + 8192, pa0, pa1, pa2, pa3); mla_partialSM(pA0, pA1, m_reg, alA, false);
        __syncthreads(); SWRITE(1);
        MLA_RESC(alA); __syncthreads();
    }
    SBAR(); mla_qkt(pB0, pB1, K_lds + 16384, qr, r32, hi, -m_reg);
    mla_finishSM(pA0, pA1, alA, l_reg, pa0, pa1, pa2, pa3); SBAR();
    pv_one<0>(o0, vb0, pa0, pa1, pa2, pa3); pv_one<1>(o1, vb0, pa0, pa1, pa2, pa3); mla_partialSM(pB0, pB1, m_reg, alB, false);
    __syncthreads(); MLA_RESC(alB);
    mla_finishSM(pB0, pB1, alB, l_reg, pa0, pa1, pa2, pa3); SBAR();
    pv_one<0>(o0, vb0 + 8192, pa0, pa1, pa2, pa3); pv_one<1>(o1, vb0 + 8192, pa0, pa1, pa2, pa3);
#undef MLA_RESC
    if (hi == 0) li_l[r32] = l_reg;
    asm volatile("s_waitcnt lgkmcnt(0)" ::: "memory");
    bf16_t* Ow = Ob + (size_t)(wid * 32) * ldo;
#pragma unroll
    for (int r = 0; r < 16; ++r) { const int orow = crow(r, hi); const float rl = __builtin_amdgcn_rcpf(li_l[orow]);
        Ow[(size_t)orow * ldo + r32] = f2bf(o0[r] * rl); Ow[(size_t)orow * ldo + 32 + r32] = f2bf(o1[r] * rl); }
    __syncthreads();
}

__device__ __forceinline__ void upproj_tile(const Params& p, int l, int tile, int part, char* lds) {
    const int tid = tidx(), lane = tid & 63, wid = tid >> 6, wm = wid >> 2, wn = wid & 3, fr = lane & 15, fq = lane >> 4;
    const int r0 = tile * 128; const bool ctx = row_is_ctx(r0); const int b = r0 >= TPB ? 1 : 0, t0 = r0 - b * TPB;
    float* rq = (float*)(lds + G_LDS); float* rkv = rq + 128;
    const bf16_t* P = WSP(bf16_t, OFF_P); bf16_t* Qo = WSP(bf16_t, OFF_Q); bf16_t* Ko = WSP(bf16_t, OFF_K); bf16_t* Vo = WSP(bf16_t, OFF_V);
    const float2* rope = WSP(float2, OFF_ROPE);
    __syncthreads();
    {
        const int row = tid >> 2, qd = tid & 3; const bf16_t* pr = P + (size_t)(r0 + row) * PLD;
        float sq = 0.f, sk = 0.f;
#pragma unroll
        for (int i = 0; i < 8; ++i) { const bf16x8 v = *(const bf16x8*)(pr + 768 + qd * 64 + i * 8);
#pragma unroll
            for (int e = 0; e < 8; ++e) { const float x = bf2f((bf16_t)v[e]); sq += x * x; } }
#pragma unroll
        for (int i = 0; i < 4; ++i) { const bf16x8 v = *(const bf16x8*)(pr + 1024 + qd * 32 + i * 8);
#pragma unroll
            for (int e = 0; e < 8; ++e) { const float x = bf2f((bf16_t)v[e]); sk += x * x; } }
        sq += __shfl_xor(sq, 1); sq += __shfl_xor(sq, 2); sk += __shfl_xor(sk, 1); sk += __shfl_xor(sk, 2);
        if (qd == 0) { rq[row] = rsqrtf(sq * (1.f / 256.f) + 1e-6f); rkv[row] = rsqrtf(sk * (1.f / 128.f) + 1e-6f); }
    }
    if (part == 0) for (int it = tid; it < 128 * 16; it += 512) {
        const int row = it >> 4, pi = it & 15; const bf16_t* pr = P + (size_t)(r0 + row) * PLD + 1152 + 2 * pi;
        float xe = bf2f(pr[0]), xo = bf2f(pr[1]);
        if (!ctx) { const int t = t0 + row; const int pos = pi < 8 ? (t >> 6) : (t & 63); const float2 cs = rope[pos * 8 + (pi & 7)];
            const float ne = xe * cs.x - xo * cs.y, no = xe * cs.y + xo * cs.x; xe = ne; xo = no; }
        const unsigned w = cvt_pk_bf16(xe, xo);
#pragma unroll
        for (int h = 0; h < 4; ++h) *(unsigned*)(Ko + (size_t)(r0 + row) * 384 + h * 96 + 64 + 2 * pi) = w;
    }
    __syncthreads();
    if (part < 3) { const int ct = part;
        const bf16_t* a0 = P + (size_t)(r0 + g_srow()) * PLD + 768 + g_skc() * 8; const bf16_t* a1 = a0 + (size_t)64 * PLD;
        const bf16_t* b0 = wts(p, l, WE_WUQ) + (size_t)(ct * 128 + g_srow()) * 256 + g_skc() * 8; const bf16_t* b1 = b0 + (size_t)64 * 256;
        f32x4 acc[4][2]; acc_zero(acc);
        mma_seg<1, 0>(acc, a0, a1, 0, b0, b1, 256, lds);
#pragma unroll
        for (int mt = 0; mt < 4; ++mt) { const int row = wm * 64 + mt * 16 + fr; const float rs = rq[row] * 0.14724260355f; const int t = t0 + row;
#pragma unroll
            for (int nt = 0; nt < 2; ++nt) { const int col = ct * 128 + wn * 32 + nt * 16 + fq * 4; const int dd = col % 96;
                float v0 = acc[mt][nt][0] * rs, v1 = acc[mt][nt][1] * rs, v2 = acc[mt][nt][2] * rs, v3 = acc[mt][nt][3] * rs;
                if (dd >= 64 && !ctx) { const int pi = (dd - 64) >> 1;
                    const int posa = pi < 8 ? (t >> 6) : (t & 63), posb = (pi + 1) < 8 ? (t >> 6) : (t & 63);
                    const float2 ca = rope[posa * 8 + (pi & 7)], cb = rope[posb * 8 + ((pi + 1) & 7)];
                    const float n0 = v0 * ca.x - v1 * ca.y, n1 = v0 * ca.y + v1 * ca.x, n2 = v2 * cb.x - v3 * cb.y, n3 = v2 * cb.y + v3 * cb.x; v0 = n0; v1 = n1; v2 = n2; v3 = n3; }
                u32x2 w; w.x = cvt_pk_bf16(v0, v1); w.y = cvt_pk_bf16(v2, v3);
                *(u32x2*)(Qo + (size_t)(r0 + row) * 384 + col) = w; } }
    }
    if (part >= 3) { const int ct = part - 3;
        const bf16_t* a0 = P + (size_t)(r0 + g_srow()) * PLD + 1024 + g_skc() * 8; const bf16_t* a1 = a0 + (size_t)64 * PLD;
        const bf16_t* b0 = wts(p, l, WE_WUKV) + (size_t)(ct * 128 + g_srow()) * 128 + g_skc() * 8; const bf16_t* b1 = b0 + (size_t)64 * 128;
        f32x4 acc[4][2]; acc_zero(acc);
        mma_seg<1, 0>(acc, a0, a1, 0, b0, b1, 128, lds);
#pragma unroll
        for (int mt = 0; mt < 4; ++mt) { const int row = wm * 64 + mt * 16 + fr; const float rs = rkv[row];
#pragma unroll
            for (int nt = 0; nt < 2; ++nt) { const int cc = wn * 32 + nt * 16 + fq * 4;
                u32x2 w; w.x = cvt_pk_bf16(acc[mt][nt][0] * rs, acc[mt][nt][1] * rs); w.y = cvt_pk_bf16(acc[mt][nt][2] * rs, acc[mt][nt][3] * rs);
                if (cc < 64) *(u32x2*)(Ko + (size_t)(r0 + row) * 384 + ct * 96 + cc) = w;
                else *(u32x2*)(Vo + (size_t)(r0 + row) * 256 + ct * 64 + (cc - 64)) = w; } }
    }
}
__device__ __forceinline__ float sconv_lat(const bf16_t* HT, const float* sw, int b, int ch, int n) {
    const bf16_t* r = HT + ((size_t)b * 1024 + ch) * TPB;
    const float um = n > 0 ? bf2f(r[n - 1]) : 0.f, u0 = bf2f(r[n]), up = n < SEQ - 1 ? bf2f(r[n + 1]) : 0.f;
    return sw[ch] * um + sw[768 + ch] * u0 + sw[1536 + ch] * up;
}
__device__ __forceinline__ float2 h2f(unsigned u) { return make_float2((float)__builtin_bit_cast(_Float16, (unsigned short)(u & 0xffffu)), (float)__builtin_bit_cast(_Float16, (unsigned short)(u >> 16))); }
__device__ __forceinline__ unsigned f2h(float2 v) { return __builtin_bit_cast(unsigned, __builtin_amdgcn_cvt_pkrtz(v.x, v.y)); }
__device__ __forceinline__ void hyena_unit(const Params& p, int l, int c, char* lds, const FFrag& FF) {
    float2* buf = (float2*)lds; const float2* thi = (const float2*)(lds + FFT_LDS_TAB); const float2* tlo = thi + 128; const float2* t2hi = thi + 256; const float2* t2lo = thi + 384;
    float* red = (float*)(lds + FFT_LDS_EXTRA);
    const bf16_t* HT = WSP(const bf16_t, OFF_HYFN); const float* sw = p.in[I_HYSW] + (size_t)l * 3 * 768;
    const bf16_t* FL = WSP(const bf16_t, OFF_FILT);
    const float d0 = -3.0701134573253945f, d1 = -15.350567286626973f;
    const float awin = fabsf(d0 + (float)c * ((d1 - d0) / 255.f)) * (1.f / 16383.f);
    unsigned* GS = WSP(unsigned, OFF_HYS) + (size_t)(bidx() & 255) * 65536; unsigned* YS = GS + 16384; unsigned* XS = YS + 16384;
    unsigned Zr[32];
#define HY_W2(n) cmulf(t2hi[(n) >> 7], t2lo[(n) & 127])
#define HY_ST(a, q, v) __hip_atomic_store((a) + (q), (v), __ATOMIC_RELAXED, __HIP_MEMORY_SCOPE_AGENT)
#define HY_LD(a, q) __hip_atomic_load((a) + (q), __ATOMIC_RELAXED, __HIP_MEMORY_SCOPE_AGENT)
    __syncthreads();
#pragma unroll 4
    for (int i = 0; i < 32; ++i) { const int n = tidx() + 512 * i; buf[FBI(n)] = make_float2(sconv_lat(HT, sw, 0, c, n), sconv_lat(HT, sw, 1, c, n)); }
#pragma unroll
    for (int i = 0; i < 32; ++i) Zr[i] = f2h(buf[FBI(tidx() + 512 * i)]);
#pragma unroll 1
    for (int order = 0; order < 2; ++order) {
        const bf16_t* ff = FL + (size_t)(order * 256 + c) * 16384; const bf16_t* fb = FL + (size_t)(512 + order * 256 + c) * 16384;
        float ss = 0.f;
#pragma unroll 4
        for (int i = 0; i < 32; ++i) { const int n = tidx() + 512 * i; const float win = __expf(-(float)n * awin); const float hf = bf2f(ff[n]) * win, hb = bf2f(fb[n]) * win; ss += hf * hf + (n ? hb * hb : 0.f);
            HY_ST(XS, n, f2h(make_float2(sconv_lat(HT, sw, 0, (order + 1) * 256 + c, n), sconv_lat(HT, sw, 1, (order + 1) * 256 + c, n)))); }
        const float tot = block_sum(ss, red);
        const float fac = rsqrtf(tot + 1e-6f) * (16.f / 32768.f);
        const float bias = p.in[I_HYBIAS][(size_t)l * 512 + order * 256 + c];
#pragma unroll 1
        for (int par = 0; par < 2; ++par) {
            __syncthreads();
#pragma unroll 8
            for (int i = 0; i < 32; ++i) { const int n = tidx() + 512 * i; const int nr = 16384 - n;
                const float hf = bf2f(ff[n]) * __expf(-(float)n * awin); const float hbr = n ? bf2f(fb[nr]) * __expf(-(float)nr * awin) : 0.f;
                float2 v; if (par == 0) v = make_float2(hf + hbr, 0.f); else { const float2 w = HY_W2(n); const float d = hf - hbr; v = make_float2(d * w.x, d * w.y); }
                buf[FBI(n)] = v; }
            __syncthreads();
            fft_fwd_blk(buf, FF, thi, tlo);
#pragma unroll 8
            for (int i = 0; i < 32; ++i) { const int q = tidx() + 512 * i; HY_ST(GS, q, f2h(buf[FBI(q)])); }
            __syncthreads();
#pragma unroll
            for (int i = 0; i < 32; ++i) { const int n = tidx() + 512 * i; float2 z = h2f(Zr[i]); z.x *= 0.0625f; z.y *= 0.0625f; if (par) z = cmulf(z, HY_W2(n)); buf[FBI(n)] = z; }
            __syncthreads();
            fft_fwd_blk(buf, FF, thi, tlo);
            asm volatile("s_waitcnt vmcnt(0)" ::: "memory");
#pragma unroll
            for (int hh = 0; hh < 2; ++hh) { unsigned g[16];
#pragma unroll
              for (int i = 0; i < 16; ++i) g[i] = HY_LD(GS, tidx() + 512 * (hh * 16 + i));
#pragma unroll
              for (int i = 0; i < 16; ++i) { const int q = tidx() + 512 * (hh * 16 + i); const float2 pr = cmulf(buf[FBI(q)], h2f(g[i])); buf[FBI(q)] = make_float2(pr.x * fac, pr.y * fac);        }
              __builtin_amdgcn_sched_barrier(0); }
            __syncthreads();
            fft_inv_blk(buf, FF, thi, tlo);
            if (par == 0) {
#pragma unroll 8
                for (int i = 0; i < 32; ++i) { const int q = tidx() + 512 * i; const float2 v = buf[FBI(q)]; HY_ST(YS, q, f2h(v)); }
            } else {
                asm volatile("s_waitcnt vmcnt(0)" ::: "memory");
#pragma unroll
                for (int hh = 0; hh < 2; ++hh) {
                    unsigned y[16], xg[16];
#pragma unroll
                    for (int i = 0; i < 16; ++i) { y[i] = HY_LD(YS, tidx() + 512 * (hh * 16 + i)); xg[i] = HY_LD(XS, tidx() + 512 * (hh * 16 + i)); }
#pragma unroll
                    for (int i = 0; i < 16; ++i) { const int n = tidx() + 512 * (hh * 16 + i); const float2 v = buf[FBI(n)];
                        const float2 t2 = cmulcf(v, HY_W2(n)); const float2 y0 = h2f(y[i]); const float2 z = h2f(Zr[hh * 16 + i]); const float2 g = h2f(xg[i]);
                        Zr[hh * 16 + i] = f2h(make_float2(g.x * (y0.x + t2.x + bias * z.x), g.y * (y0.y + t2.y + bias * z.y))); }
                    __builtin_amdgcn_sched_barrier(0);
                }
            }
        }
    }
#undef HY_W2
#undef HY_ST
#undef HY_LD
    bf16_t* OB = WSP(bf16_t, OFF_OBT);
#pragma unroll
    for (int i = 0; i < 32; ++i) { const int n = tidx() + 512 * i; const float2 z = h2f(Zr[i]); OB[((size_t)0 * 256 + c) * TPB + n] = f2bf(z.x); OB[((size_t)1 * 256 + c) * TPB + n] = f2bf(z.y); }
    __syncthreads();
}
__device__ __forceinline__ void fnet_unit(const Params& p, int c, char* lds, const FFrag& FF) {
    float2* buf = (float2*)lds; const float2* thi = (const float2*)(lds + FFT_LDS_TAB); const float2* tlo = thi + 128;
    const int tid = tidx();
    const bf16_t* HT = WSP(const bf16_t, OFF_HYFN); bf16_t* OC = WSP(bf16_t, OFF_OCT);
    const bf16_t* r0 = HT + ((size_t)0 * 1024 + 768 + c) * TPB; const bf16_t* r1 = HT + ((size_t)1 * 1024 + 768 + c) * TPB;
    if (DBG_FN_COPY) {
        for (int i = 0; i < 32; ++i) { const int n = tid + 512 * i; OC[((size_t)0 * 512 + c) * TPB + n] = r0[n]; OC[((size_t)0 * 512 + 256 + c) * TPB + n] = r1[n]; OC[((size_t)1 * 512 + c) * TPB + n] = r1[n]; OC[((size_t)1 * 512 + 256 + c) * TPB + n] = r0[n]; }
        return;
    }
    __syncthreads();
#pragma unroll 4
    for (int i = 0; i < 32; ++i) { const int n = tid + 512 * i; buf[FBI(n)] = make_float2(bf2f(r0[n]), bf2f(r1[n])); }
    __syncthreads();
    fft_fwd_blk(buf, FF, thi, tlo);
#pragma unroll 4
    for (int i = 0; i < 32; ++i) { const int k = tid + 512 * i; const int km = (16384 - k) & 16383; const float2 X = buf[(k & 127) * FRS + (k >> 7)], Xm = buf[(km & 127) * FRS + (km >> 7)];
        OC[((size_t)0 * 512 + c) * TPB + k] = f2bf(0.5f * (X.x + Xm.x)); OC[((size_t)0 * 512 + 256 + c) * TPB + k] = f2bf(0.5f * (X.y - Xm.y));
        OC[((size_t)1 * 512 + c) * TPB + k] = f2bf(0.5f * (X.y + Xm.y)); OC[((size_t)1 * 512 + 256 + c) * TPB + k] = f2bf(-0.5f * (X.x - Xm.x)); }
    __syncthreads();
}
__device__ __forceinline__ void hyena_ctx_unit(const Params& p, int l, int c, char* lds) {
    float* zs = (float*)lds;
    float* hfs = zs + 512; float* hbs = hfs + 256; float* w3s = hbs + 256; float* red = w3s + 128;
    const int tid = tidx(), b = tid >> 8, t = tid & 255;
    const bf16_t* HT = WSP(const bf16_t, OFF_HYFN); const float* sw = p.in[I_HYSW] + (size_t)l * 3 * 768;
    const float* H2 = WSP(const float, OFF_H2C) + (size_t)l * 256 * 64; const float* w3 = p.in[I_HYW3] + (size_t)l * 64 * 1024;
    const float d0 = -3.0701134573253945f, d1 = -15.350567286626973f;
    const float adelta = fabsf(d0 + (float)c * ((d1 - d0) / 255.f));
    auto sc = [&](int ch) { const bf16_t* r = HT + ((size_t)b * 1024 + ch) * TPB + SEQ;
        const float um = t > 0 ? bf2f(r[t - 1]) : 0.f, u0 = bf2f(r[t]), up = t < 255 ? bf2f(r[t + 1]) : 0.f; return sw[ch] * um + sw[768 + ch] * u0 + sw[1536 + ch] * up; };
    __syncthreads();
    float z = sc(c);
    zs[b * 256 + t] = z;
    for (int order = 0; order < 2; ++order) {
        __syncthreads();
        if (tid < 128) w3s[tid] = w3[(size_t)(tid & 63) * 1024 + (tid >> 6) * 512 + order * 256 + c];
        __syncthreads();
        float ss = 0.f;
        if (tid < 256) { const float* hr = H2 + (size_t)tid * 64; float sf = 0.f, sb = 0.f;
#pragma unroll 16
            for (int j = 0; j < 64; ++j) { sf += hr[j] * w3s[j]; sb += hr[j] * w3s[64 + j]; }
            const float win = __expf(-((float)tid * (1.f / 255.f)) * adelta); const float hf = sf * win, hb = sb * win;
            hfs[tid] = hf; hbs[tid] = hb; ss = hf * hf + (tid ? hb * hb : 0.f); }
        const float tot = block_sum(ss, red);
        const float scale = rsqrtf(tot + 1e-6f);
        __syncthreads();
        float y = 0.f;
        for (int s = 0; s <= t; ++s) y += hfs[t - s] * zs[b * 256 + s];
        for (int s = t + 1; s < 256; ++s) y += hbs[s - t] * zs[b * 256 + s];
        const float bias = p.in[I_HYBIAS][(size_t)l * 512 + order * 256 + c];
        const float g = sc((order + 1) * 256 + c);
        z = g * (y * scale + bias * z);
        __syncthreads();
        zs[b * 256 + t] = z;
    }
    WSP(bf16_t, OFF_OBT)[((size_t)b * 256 + c) * TPB + SEQ + t] = f2bf(z);
    __syncthreads();
}
__device__ __forceinline__ void fnet_ctx_unit(const Params& p, int c, char* lds) {
    float* us = (float*)lds; float* cs = us + 512;
    const int tid = tidx(), b = tid >> 8, k = tid & 255;
    const bf16_t* HT = WSP(const bf16_t, OFF_HYFN);
    __syncthreads();
    us[tid] = bf2f(HT[((size_t)b * 1024 + 768 + c) * TPB + SEQ + k]);
    if (tid < 256) { float s, cc; sincospif(2.f * (float)tid / 256.f, &s, &cc); cs[tid] = cc; cs[256 + tid] = s; }
    __syncthreads();
    float ur = 0.f, ui = 0.f;
    for (int n = 0; n < 256; ++n) { const int m = (k * n) & 255; const float u = us[b * 256 + n]; ur += u * cs[m]; ui -= u * cs[256 + m]; }
    bf16_t* OC = WSP(bf16_t, OFF_OCT);
    OC[((size_t)b * 512 + c) * TPB + SEQ + k] = f2bf(8.f * ur); OC[((size_t)b * 512 + 256 + c) * TPB + SEQ + k] = f2bf(8.f * ui);
    __syncthreads();
}
__device__ __forceinline__ void na_unit(const Params& p, int l, int u, char* lds) {
    const int b = u >> 8, h = (u >> 6) & 3, rb = u & 63, r0 = rb * 4;
    float* biasL = (float*)(lds + ATT_LDS);
    __syncthreads();
    for (int i = tidx(); i < 465; i += 512) biasL[i] = p.in[I_RPB][((size_t)l * 4 + h) * 465 + i] * 8.f;
    const bf16_t* P = WSP(const bf16_t, OFF_P);
    int lo = r0 - 4; lo = lo < 0 ? 0 : (lo > 248 ? 248 : lo);
    int hr = r0 + 3 - 4; hr = hr < 0 ? 0 : (hr > 248 ? 248 : hr); hr += 7;
    const int nloc = hr - lo + 1;
    const size_t tb = (size_t)b * TPB;
    attn_unit<64, 1>(P + (tb + r0 * 64) * PLD + h * 64, PLD, P + tb * PLD + 256 + h * 64, PLD, P + tb * PLD + 512 + h * 64, PLD,
                     WSP(bf16_t, OFF_OAD) + (tb + r0 * 64) * 512 + 256 + h * 64, 512, 4 + nloc, 4, SEQ, lo * 64, lds, biasL, r0, lo);
}
__device__ __forceinline__ void na_ctx_unit(const Params& p, int u, char* lds) {
    const int b = u >> 2, h = u & 3; const bf16_t* P = WSP(const bf16_t, OFF_P); const size_t tb = (size_t)b * TPB;
    attn_unit<64, 0>(P + (tb + SEQ) * PLD + h * 64, PLD, P + tb * PLD + 256 + h * 64, PLD, P + tb * PLD + 512 + h * 64, PLD,
                     WSP(bf16_t, OFF_OAD) + (tb + SEQ) * 512 + 256 + h * 64, 512, 4, 4, SEQ, 0, lds, nullptr, 0, 0);
}
PHASE_FN void ph_mixers(const Params& p, int l, char* lds_unused) {
    char* lds = lds_dyn; (void)lds_unused;
    const int bid = bidx(), G = gdim(); const bool upd_ctx = (l != NLAYER - 1);
    fft_tables(lds);
    { FFrag FF; mfft_frags(FF, (const float2*)(lds + FFT_LDS_TAB));
      for (int rep = 0; rep < (REP_PHASE == 31 ? 2 : 1); ++rep) for (int c = bid; c < 256; c += G) hyena_unit(p, l, c, lds, FF);
      for (int rep = 0; rep < (REP_PHASE == 32 ? 2 : 1); ++rep) for (int c = bid; c < 256; c += G) fnet_unit(p, c, lds, FF); }
    __syncthreads();
    if (upd_ctx) { for (int c = bid; c < 256; c += G) hyena_ctx_unit(p, l, c, lds);
                   for (int c = bid; c < 256; c += G) fnet_ctx_unit(p, c, lds); }
    for (int rep = 0; rep < (REP_PHASE == 33 ? 2 : 1); ++rep) for (int t = bid; t < NTILE * 7; t += G) upproj_tile(p, l, t / 7, t % 7, lds);
    __syncthreads();
    for (int rep = 0; rep < (REP_PHASE == 34 ? 2 : 1); ++rep) for (int u = bid; u < 512; u += G) na_unit(p, l, u, lds);
    if (upd_ctx) for (int u = bid; u < 8; u += G) na_ctx_unit(p, u, lds);
}

__device__ __forceinline__ void transp_unit(const Params& p, int u, char* lds) {
    const int tid = tidx(), rt = u / 12, cg = u % 12, r0 = rt * 128, b = r0 >= TPB ? 1 : 0, t0 = r0 - b * TPB;
    const bf16_t* src = cg < 4 ? WSP(const bf16_t, OFF_OBT) + ((size_t)b * 256 + cg * 64) * TPB + t0 : WSP(const bf16_t, OFF_OCT) + ((size_t)b * 512 + (cg - 4) * 64) * TPB + t0;
    bf16_t* dst = WSP(bf16_t, OFF_P) + (size_t)r0 * 768 + cg * 64;
    char* tl = lds;
    __syncthreads();
    { const int c = tid >> 3, sg = tid & 7; const u32x4 x0 = *(const u32x4*)(src + (size_t)c * TPB + sg * 16), x1 = *(const u32x4*)(src + (size_t)c * TPB + sg * 16 + 8);
      *(u32x4*)(tl + c * 272 + sg * 32) = x0; *(u32x4*)(tl + c * 272 + sg * 32 + 16) = x1; }
    __syncthreads();
    { const int t = tid >> 2, q = tid & 3; unsigned w[8];
#pragma unroll
      for (int i = 0; i < 8; ++i) { const unsigned lo = *(const bf16_t*)(tl + (q * 16 + 2 * i) * 272 + t * 2), hi = *(const bf16_t*)(tl + (q * 16 + 2 * i + 1) * 272 + t * 2); w[i] = lo | (hi << 16); }
      u32x4 y0 = {w[0], w[1], w[2], w[3]}, y1 = {w[4], w[5], w[6], w[7]};
      *(u32x4*)(dst + (size_t)t * 768 + q * 16) = y0; *(u32x4*)(dst + (size_t)t * 768 + q * 16 + 8) = y1; }
}
PHASE_FN void ph_mla(const Params& p, int l, char* lds_unused) {
    char* lds = lds_dyn; (void)lds_unused;
    const bool upd_ctx = (l != NLAYER - 1);
    const bf16_t* Q = WSP(const bf16_t, OFF_Q); const bf16_t* K = WSP(const bf16_t, OFF_K); const bf16_t* V = WSP(const bf16_t, OFF_V); bf16_t* O = WSP(bf16_t, OFF_OAD);
    if (upd_ctx) for (int u = bidx(); u < 8; u += gdim()) { const int b = u >> 2, h = u & 3; const size_t tb = (size_t)b * TPB;
        mla_unit(Q + (tb + SEQ) * 384 + h * 96, K + tb * 384 + h * 96, V + tb * 256 + h * 64, O + (tb + SEQ) * 512 + h * 64, 4, 4, SEQ, 0, lds); }
    for (int u = bidx(); u < 512; u += gdim()) { const int b = u >> 8, h = (u >> 6) & 3, qb = u & 63; const size_t tb = (size_t)b * TPB;
        mla_unit(Q + (tb + qb * 256) * 384 + h * 96, K + tb * 384 + h * 96, V + tb * 256 + h * 64, O + (tb + qb * 256) * 512 + h * 64, 260, 260, 0, 0, lds); }
    __syncthreads();
    for (int u = bidx(); u < NTILE * 12; u += gdim()) { if (skip_tile(l, u / 12)) continue; transp_unit(p, u, lds); }
    { const u32x4* Hs = WSP(const u32x4, OFF_H); u32x2* H8 = WSP(u32x2, OFF_HYS);
      for (int i = bidx() * 512 + tidx(); i < T * 128; i += gdim() * 512) { const u32x4 h = Hs[i]; u32x2 w; int t0 = 0, t1 = 0;
          t0 = __builtin_amdgcn_cvt_pk_fp8_f32(__uint_as_float(h.x << 16), __uint_as_float(h.x & 0xffff0000u), t0, false); t0 = __builtin_amdgcn_cvt_pk_fp8_f32(__uint_as_float(h.y << 16), __uint_as_float(h.y & 0xffff0000u), t0, true);
          t1 = __builtin_amdgcn_cvt_pk_fp8_f32(__uint_as_float(h.z << 16), __uint_as_float(h.z & 0xffff0000u), t1, false); t1 = __builtin_amdgcn_cvt_pk_fp8_f32(__uint_as_float(h.w << 16), __uint_as_float(h.w & 0xffff0000u), t1, true);
          w.x = (unsigned)t0; w.y = (unsigned)t1; H8[i] = w; } }
}

template <int FP8, int NKT>
__device__ __forceinline__ void gate4_stream(f32x4 (&ag)[4][4][2], const char* a0, const char* a1, const char* Wb, size_t nstride, int rowstride, int a_rd, int b_rd, char* lds) {
    const int wid = __builtin_amdgcn_readfirstlane(tidx() >> 6);
    LAS char* L = (LAS char*)lds_dyn + ((wid >> 1) * 2 + (wid & 1)) * 1024;
    const int srow = g_srow(), skc = g_skc();
    i32x8 A8[4], B8[2][2];
#pragma unroll
    for (int mt = 0; mt < 4; ++mt) A8[mt] = (i32x8)(0);
    B8[1][0] = (i32x8)(0); B8[1][1] = (i32x8)(0);
    auto issue_h = [&](int s, int h) { const int kt = s >> 2, n = s & 3; LAS char* Bb = L + 32768 + n * 16384 + h * 8192;
        int eo = srow * rowstride + skc * 16; asm volatile("" : "+v"(eo));
        eo += (kt << 7) + h * 64 * rowstride;
        const char* w = Wb + (size_t)n * nstride + (unsigned)eo;
        __builtin_amdgcn_global_load_lds((const unsigned*)(w), (LAS unsigned*)(Bb), 16, 0, 0);
        if (n == 0) { LAS char* Ab = L + (kt & 1) * 16384 + h * 8192; const char* hp = (h ? a1 : a0) + (kt << 7);
            __builtin_amdgcn_global_load_lds((const unsigned*)(hp), (LAS unsigned*)(Ab), 16, 0, 0); } };
    auto issue = [&](int s) { issue_h(s, 0); issue_h(s, 1); };
    auto ld8 = [&](const char* base) { const u32x4 lo = *(const u32x4*)(base), hi = *(const u32x4*)(base + 1024);
        return (i32x8){(int)lo.x, (int)lo.y, (int)lo.z, (int)lo.w, (int)hi.x, (int)hi.y, (int)hi.z, (int)hi.w}; };
    constexpr int SC1 = 0x7f7f7f7f, SCW = 0x79797979;
    auto mm = [&](f32x4 c, const i32x8& b, const i32x8& a) {
        if (FP8) return __builtin_amdgcn_mfma_scale_f32_16x16x128_f8f6f4(b, a, c, 0, 0, 0, SCW, 0, SC1);
        typedef int i32x4_ __attribute__((ext_vector_type(4)));
        const i32x4_ bl = __builtin_shufflevector(b, b, 0, 1, 2, 3), bh = __builtin_shufflevector(b, b, 4, 5, 6, 7), al = __builtin_shufflevector(a, a, 0, 1, 2, 3), ah = __builtin_shufflevector(a, a, 4, 5, 6, 7);
        c = __builtin_amdgcn_mfma_f32_16x16x32_bf16(__builtin_bit_cast(bf16x8, bl), __builtin_bit_cast(bf16x8, al), c, 0, 0, 0);
        return __builtin_amdgcn_mfma_f32_16x16x32_bf16(__builtin_bit_cast(bf16x8, bh), __builtin_bit_cast(bf16x8, ah), c, 0, 0, 0); };
    issue(0); issue(1); issue(2);
#define MG8_SUB(N, PV, COND, SN) do { const char* Bs_ = lds + 32768 + (N) * 16384 + b_rd;                                       \
        B8[(N) & 1][0] = ld8(Bs_); B8[(N) & 1][1] = ld8(Bs_ + 2048); if (COND) issue_h((SN), 0); SB();                          \
        _Pragma("unroll") for (int mt = 0; mt < 4; ++mt) {                                                                     \
            _Pragma("unroll") for (int nt = 0; nt < 2; ++nt) ag[PV][mt][nt] = mm(ag[PV][mt][nt], B8[((N) & 1) ^ 1][nt], A8[mt]);  \
            if ((N) == 0) A8[mt] = ld8(As + a_rd + mt * 2048); }                                                               \
        if (COND) issue_h((SN), 1); SB(); } while (0)
#define MG8_KT(LASTK) do { const char* As = lds + (kt & 1) * 16384;                                                            \
        G_WAITV(4); __builtin_amdgcn_s_barrier(); asm volatile("" ::: "memory");                                               \
        MG8_SUB(0, 3, true, 4 * kt + 3);                                                                                       \
        G_WAITV(4); __builtin_amdgcn_s_barrier(); asm volatile("" ::: "memory");                                               \
        MG8_SUB(1, 0, !(LASTK), 4 * kt + 4);                                                                                   \
        if (!(LASTK)) G_WAITV(6); else G_WAITV(2);                                                                             \
        __builtin_amdgcn_s_barrier(); asm volatile("" ::: "memory");                                                           \
        MG8_SUB(2, 1, !(LASTK), 4 * kt + 5);                                                                                   \
        if (!(LASTK)) G_WAITV(6); else G_WAITV(0);                                                                             \
        __builtin_amdgcn_s_barrier(); asm volatile("" ::: "memory");                                                           \
        MG8_SUB(3, 2, !(LASTK), 4 * kt + 6); } while (0)
    int kt = 0;
#pragma unroll 1
    for (; kt < NKT - 1; ++kt) MG8_KT(false);
    MG8_KT(true);
#undef MG8_KT
#undef MG8_SUB
#pragma unroll
    for (int mt = 0; mt < 4; ++mt)
#pragma unroll
        for (int nt = 0; nt < 2; ++nt) ag[3][mt][nt] = mm(ag[3][mt][nt], B8[1][nt], A8[mt]);
    __syncthreads();
}

__device__ __forceinline__ void merge_unit(const Params& p, int l, int rt, int ct, char* lds) {
    const int tid = tidx(), lane = tid & 63, wid = __builtin_amdgcn_readfirstlane(tid >> 6), wm = wid >> 2, wn = wid & 3, fr = lane & 15, fq = lane >> 4;
    const int a_rd = g_lds_byte(wm * 64 + fr, fq * 8), b_rd = g_lds_byte(wn * 32 + fr, fq * 8);
    const int r0 = rt * 128, n0 = ct * 128;
    LAS char* L = (LAS char*)lds_dyn + ((wid >> 1) * 2 + (wid & 1)) * 1024;
    const int srow = g_srow(), skc = g_skc();
    GFrag f0, f1;
    unsigned gp[4][4][2][2];
    {
        const char* Hb = WSP(const char, OFF_HYS) + (size_t)(r0 + srow) * 1024 + skc * 16;
        const char* Wb = (const char*)wts(p, l, WE_WGT) + (size_t)n0 * 1024;
        f32x4 ag[4][4][2];
#pragma unroll
        for (int n = 0; n < 4; ++n) acc_zero(ag[n]);
        gate4_stream<1, 8>(ag, Hb, Hb + (size_t)64 * 1024, Wb, (size_t)1024 * 1024, 1024, a_rd, b_rd, lds);
#pragma unroll
        for (int n = 0; n < 4; ++n) {
#pragma unroll
            for (int mt = 0; mt < 4; ++mt) {
#pragma unroll
                for (int nt = 0; nt < 2; ++nt) { gp[n][mt][nt][0] = cvt_pk_bf16(sigmoid_f(ag[n][mt][nt][0]), sigmoid_f(ag[n][mt][nt][1])); gp[n][mt][nt][1] = cvt_pk_bf16(sigmoid_f(ag[n][mt][nt][2]), sigmoid_f(ag[n][mt][nt][3]));
                    asm volatile("" : "+v"(gp[n][mt][nt][0]), "+v"(gp[n][mt][nt][1])); }
            }
        }
    }
    SB();
    f32x4 am[4][2], ap[4][2]; acc_zero(am); acc_zero(ap);
    {
        const bf16_t* OAD = WSP(const bf16_t, OFF_OAD); const bf16_t* OBC = WSP(const bf16_t, OFF_P);
        auto issue = [&](int s) { const bf16_t* a; const bf16_t* b; unsigned as, bs; int k0;
            int so = srow, sk = skc * 8; asm volatile("" : "+v"(so), "+v"(sk));
            if (s < 4)       { k0 = (s << 6) + sk;        a = OAD + (unsigned)((r0 + so) * 512 + k0);       as = 64 * 512; b = wts(p, l, WE_WBA) + (unsigned)((n0 + so) * 256 + k0); bs = 64 * 256; }
            else if (s < 8)  { k0 = ((s - 4) << 6) + sk;  a = OBC + (unsigned)((r0 + so) * 768 + k0);       as = 64 * 768; b = wts(p, l, WE_WBB) + (unsigned)((n0 + so) * 256 + k0); bs = 64 * 256; }
            else if (s < 16) { k0 = ((s - 8) << 6) + sk;  a = OBC + (unsigned)((r0 + so) * 768 + 256 + k0); as = 64 * 768; b = wts(p, l, WE_WBC) + (unsigned)((n0 + so) * 512 + k0); bs = 64 * 512; }
            else             { k0 = ((s - 16) << 6) + sk; a = OAD + (unsigned)((r0 + so) * 512 + 256 + k0); as = 64 * 512; b = wts(p, l, WE_WBD) + (unsigned)((n0 + so) * 256 + k0); bs = 64 * 256; }
            LAS char* Lb = L + (s & 3) * G_STAGE;
            __builtin_amdgcn_global_load_lds((const unsigned*)(a), (LAS unsigned*)(Lb), 16, 0, 0);
            __builtin_amdgcn_global_load_lds((const unsigned*)(a + as), (LAS unsigned*)(Lb + 8192), 16, 0, 0);
            __builtin_amdgcn_global_load_lds((const unsigned*)(b), (LAS unsigned*)(Lb + G_TILE), 16, 0, 0);
            __builtin_amdgcn_global_load_lds((const unsigned*)(b + bs), (LAS unsigned*)(Lb + G_TILE + 8192), 16, 0, 0); };
        auto combine = [&](const unsigned (&g)[4][2][2]) {
#pragma unroll
            for (int mt = 0; mt < 4; ++mt)
#pragma unroll
                for (int nt = 0; nt < 2; ++nt) {
                    const unsigned g0 = g[mt][nt][0], g1 = g[mt][nt][1];
                    am[mt][nt][0] += __uint_as_float(g0 << 16) * ap[mt][nt][0]; am[mt][nt][1] += __uint_as_float(g0 & 0xffff0000u) * ap[mt][nt][1];
                    am[mt][nt][2] += __uint_as_float(g1 << 16) * ap[mt][nt][2]; am[mt][nt][3] += __uint_as_float(g1 & 0xffff0000u) * ap[mt][nt][3];
                    ap[mt][nt] = (f32x4){0.f, 0.f, 0.f, 0.f};
                    asm volatile("" : "+v"(am[mt][nt])); } };
        gf_zero(f1);
        issue(0); issue(1); issue(2);
        int s = 0;
#pragma unroll
        for (int n = 0; n < 4; ++n) {
            const int send = n == 0 ? 4 : n == 1 ? 8 : n == 2 ? 16 : 20;
#pragma unroll 1
            for (; s < send; ++s) {
                if (s + 2 < 20) G_WAITV(8); else if (s + 1 < 20) G_WAITV(4); else G_WAITV(0);
                __builtin_amdgcn_s_barrier(); asm volatile("" ::: "memory");
                if (s + 3 < 20) issue(s + 3);
                const char* As = lds + (s & 3) * G_STAGE;
                GF_STAGE(ap, ap, As, As + G_TILE);
            }
            gf_mma(ap, f1); SB();
            combine(gp[n]); gf_zero(f1); SB();
        }
        __syncthreads();
    }
    bf16_t* M = WSP(bf16_t, OFF_HYFN);
    const int t2 = tidx(), w2 = t2 >> 6, l2 = t2 & 63;
    int so = (r0 + (w2 >> 2) * 64 + (l2 & 15)) * 1024 + n0 + (w2 & 3) * 32 + (l2 >> 4) * 4;
#pragma unroll
    for (int mt = 0; mt < 4; ++mt)
#pragma unroll
        for (int nt = 0; nt < 2; ++nt) {
            u32x2 w; w.x = cvt_pk_bf16(am[mt][nt][0], am[mt][nt][1]); w.y = cvt_pk_bf16(am[mt][nt][2], am[mt][nt][3]);
            *(u32x2*)(M + (unsigned)(so + mt * 16 * 1024 + nt * 16)) = w; }
    SB();
}
PHASE_FN void ph_merge(const Params& p, int l, char* lds_unused) {
    char* lds = lds_dyn; (void)lds_unused;
    for (int u = bidx(); u < NTILE * 8; u += gdim()) {
        const int rt = u >> 3, ct = u & 7; if (skip_tile(l, rt)) continue;
        merge_unit(p, l, rt, ct, lds);
    }
}

PHASE_FN void ph_wout(const Params& p, int l, char* lds_unused) {
    char* lds = lds_dyn; (void)lds_unused;
    const int tid = tidx(), lane = tid & 63, wid = tid >> 6, wm = wid >> 2, wn = wid & 3, fr = lane & 15, fq = lane >> 4;
    const int a_rd = g_lds_byte(wm * 64 + fr, fq * 8), b_rd = g_lds_byte(wn * 32 + fr, fq * 8);
    const bf16_t* M = WSP(const bf16_t, OFF_HYFN);
    auto epi = [&](const f32x4 (&acc)[4][2], int r0, int n0) {
        const float* gt = modvec(p, l, r0) + 2048;
#pragma unroll
        for (int mt = 0; mt < 4; ++mt) { const int row = r0 + wm * 64 + mt * 16 + fr; const float* xs = (l == 0) ? xrow_in(p, row) : xrow_st(p, row); float* xd = xrow_st(p, row);
#pragma unroll
            for (int nt = 0; nt < 2; ++nt) { const int col = n0 + wn * 32 + nt * 16 + fq * 4; const f32x4 x = *(const f32x4*)(xs + col), g = *(const f32x4*)(gt + col);
                f32x4 o; o[0] = x[0] + g[0] * acc[mt][nt][0]; o[1] = x[1] + g[1] * acc[mt][nt][1]; o[2] = x[2] + g[2] * acc[mt][nt][2]; o[3] = x[3] + g[3] * acc[mt][nt][3];
                if (DBG_NO_MIX) o = x;
                *(f32x4*)(xd + col) = o; } } };
    for (int u = bidx(); u < 512; u += gdim()) {
        const int lt = u >> 1, half = u & 1, rt = lt + (lt >> 7) * 2, r0 = rt * 128;
        const char* a0 = (const char*)(M + (size_t)(r0 + g_srow()) * 1024 + g_skc() * 8);
        const char* Wb = (const char*)(wts(p, l, WE_WOUT) + (size_t)half * 512 * 1024);
        f32x4 ag[4][4][2];
#pragma unroll
        for (int n = 0; n < 4; ++n) acc_zero(ag[n]);
        gate4_stream<0, 16>(ag, a0, a0 + (size_t)64 * 2048, Wb, (size_t)128 * 2048, 2048, a_rd, b_rd, lds);
#pragma unroll
        for (int n = 0; n < 4; ++n) epi(ag[n], r0, half * 512 + n * 128);
    }
    if (l != NLAYER - 1) for (int u = bidx(); u < 32; u += gdim()) {
        const int rt = 128 + (u >> 4) * 130 + ((u >> 3) & 1), ct = u & 7, r0 = rt * 128, n0 = ct * 128;
        const bf16_t* a0 = M + (size_t)(r0 + g_srow()) * 1024 + g_skc() * 8; const bf16_t* b0 = wts(p, l, WE_WOUT) + (size_t)(n0 + g_srow()) * 1024 + g_skc() * 8;
        f32x4 acc[4][2]; acc_zero(acc);
        mma_seg<1, 0>(acc, a0, a0 + (size_t)64 * 1024, 0, b0, b0 + (size_t)64 * 1024, 1024, lds);
        epi(acc, r0, n0);
    }
}

__device__ __forceinline__ int* moe_sched(const Params& p, int l, char* lds) {
    int* s = (int*)(lds + G_LDS);
    __syncthreads();
    if (tidx() == 0) { int acc = 0; for (int i = 0; i < 24; ++i) { const int c = WSP(const int, OFF_CNT)[l * 32 + i]; s[32 + i] = c; s[i] = acc; acc += (c + 127) >> 7; } s[24] = acc; }
    __syncthreads();
    return s;
}
__device__ __forceinline__ void moe_decode(const int* s, int tg, int& pid, int& tl, int& cnt) {
    pid = 0;
    for (int i = 1; i < 24; ++i) if (tg >= s[i]) pid = i;
    tl = tg - s[pid]; cnt = s[32 + pid];
}
__device__ __forceinline__ void pair_experts(int pid, int& elo, int& ehi) { const int g = pid / 6, pi = pid % 6; const int lo = pi < 3 ? 0 : (pi < 5 ? 1 : 2); const int hi = pi < 3 ? pi + 1 : (pi < 5 ? pi - 1 : 3); elo = g * 4 + lo; ehi = g * 4 + hi; }
PHASE_FN void ph_moe1(const Params& p, int l, char* lds_unused) {
    char* lds = lds_dyn; (void)lds_unused;
    const int tid = tidx(), lane = tid & 63, wid = tid >> 6, wm = wid >> 2, wn = wid & 3, fr = lane & 15, fq = lane >> 4;
    const int a_rd = g_lds_byte(wm * 64 + fr, fq * 8), b_rd = g_lds_byte(wn * 32 + fr, fq * 8);
    const int* s = moe_sched(p, l, lds);
    const bf16_t* H = WSP(const bf16_t, OFF_H); bf16_t* ACT = WSP(bf16_t, OFF_P); const int* lists = WSP(const int, OFF_LISTS); const float* tokw = WSP(const float, OFF_TOKW);
    const int ntiles = s[24];
    const int U = ntiles * 2, UF = (U >> 8) << 8;
    for (int u = bidx(); u < UF; u += gdim()) {
        const int tg = u >> 1, half = u & 1; int pid, tl, cnt; moe_decode(s, tg, pid, tl, cnt); int elo, ehi; pair_experts(pid, elo, ehi);
        const int e = half ? ehi : elo;
        const int* lst = lists + (size_t)pid * T;
        auto tok = [&](int rowi) { const int sl = tl * 128 + rowi; return lst[sl < cnt ? sl : 0]; };
        const char* a0 = (const char*)(H + (size_t)tok(g_srow()) * 1024 + g_skc() * 8); const char* a1 = (const char*)(H + (size_t)tok(g_srow() + 64) * 1024 + g_skc() * 8);
        const char* Wb = (const char*)(wts(p, l, WE_WGU) + (size_t)e * 512 * 1024);
        f32x4 ag[4][4][2];
#pragma unroll
        for (int n = 0; n < 4; ++n) acc_zero(ag[n]);
        gate4_stream<0, 16>(ag, a0, a1, Wb, (size_t)128 * 1024 * 2, 2048, a_rd, b_rd, lds);
#pragma unroll
        for (int tt = 0; tt < 4; ++tt)
#pragma unroll
            for (int mt = 0; mt < 4; ++mt) { const int rowi = wm * 64 + mt * 16 + fr; const float w = tokw[(size_t)tok(rowi) * 2 + half];
                float o[4];
#pragma unroll
                for (int j = 0; j < 4; ++j) o[j] = silu_f(ag[tt][mt][0][j]) * ag[tt][mt][1][j] * w;
                u32x2 pk; pk.x = cvt_pk_bf16(o[0], o[1]); pk.y = cvt_pk_bf16(o[2], o[3]);
                *(u32x2*)(ACT + (size_t)(tg * 128 + rowi) * 512 + half * 256 + tt * 64 + wn * 16 + fq * 4) = pk; }
    }
    for (int v = bidx(); v < (U - UF) * 4; v += gdim()) {
        const int tid = tidx(), lane = tid & 63, wid = tid >> 6, wm = wid >> 2, wn = wid & 3, fr = lane & 15, fq = lane >> 4;
        const int u4 = UF + (v >> 2), tt = v & 3, tg = u4 >> 1, half = u4 & 1; int pid, tl, cnt; moe_decode(s, tg, pid, tl, cnt); int elo, ehi; pair_experts(pid, elo, ehi);
        const int e = half ? ehi : elo;
        const int* lst = lists + (size_t)pid * T;
        auto tok = [&](int rowi) { const int sl = tl * 128 + rowi; return lst[sl < cnt ? sl : 0]; };
        const bf16_t* a0 = H + (size_t)tok(g_srow()) * 1024 + g_skc() * 8; const bf16_t* a1 = H + (size_t)tok(g_srow() + 64) * 1024 + g_skc() * 8;
        const bf16_t* b0 = wts(p, l, WE_WGU) + ((size_t)e * 512 + tt * 128 + g_srow()) * 1024 + g_skc() * 8;
        f32x4 acc[4][2]; acc_zero(acc);
        mma_seg<1, 0>(acc, a0, a1, 0, b0, b0 + (size_t)64 * 1024, 1024, lds);
#pragma unroll
        for (int mt = 0; mt < 4; ++mt) { const int rowi = wm * 64 + mt * 16 + fr; const float w = tokw[(size_t)tok(rowi) * 2 + half];
            float o[4];
#pragma unroll
            for (int j = 0; j < 4; ++j) o[j] = silu_f(acc[mt][0][j]) * acc[mt][1][j] * w;
            u32x2 pk; pk.x = cvt_pk_bf16(o[0], o[1]); pk.y = cvt_pk_bf16(o[2], o[3]);
            *(u32x2*)(ACT + (size_t)(tg * 128 + rowi) * 512 + half * 256 + tt * 64 + wn * 16 + fq * 4) = pk; }
    }
}
PHASE_FN void ph_moe2(const Params& p, int l, char* lds_unused) {
    char* lds = lds_dyn; (void)lds_unused;
    const int tid = tidx(), lane = tid & 63, wid = tid >> 6, wm = wid >> 2, wn = wid & 3, fr = lane & 15, fq = lane >> 4;
    const int* s = moe_sched(p, l, lds);
    const bf16_t* ACT = WSP(const bf16_t, OFF_P); const int* lists = WSP(const int, OFF_LISTS);
    const int ntiles = s[24];
    for (int u = bidx(); u < ntiles * 8; u += gdim()) {
        const int tg = u >> 3, ct = u & 7; int pid, tl, cnt; moe_decode(s, tg, pid, tl, cnt); int elo, ehi; pair_experts(pid, elo, ehi);
        const int* lst = lists + (size_t)pid * T;
        f32x4 acc[4][2]; acc_zero(acc);
        { const bf16_t* a0 = ACT + (size_t)(tg * 128 + g_srow()) * 512 + g_skc() * 8; const bf16_t* b0 = wts(p, l, WE_WDN) + ((size_t)elo * 1024 + ct * 128 + g_srow()) * 256 + g_skc() * 8;
          mma_seg<1, 0>(acc, a0, a0 + (size_t)64 * 512, 0, b0, b0 + (size_t)64 * 256, 256, lds); }
        { const bf16_t* a0 = ACT + (size_t)(tg * 128 + g_srow()) * 512 + 256 + g_skc() * 8; const bf16_t* b0 = wts(p, l, WE_WDN) + ((size_t)ehi * 1024 + ct * 128 + g_srow()) * 256 + g_skc() * 8;
          mma_seg<1, 0>(acc, a0, a0 + (size_t)64 * 512, 0, b0, b0 + (size_t)64 * 256, 256, lds); }
#pragma unroll
        for (int mt = 0; mt < 4; ++mt) { const int sl = tl * 128 + wm * 64 + mt * 16 + fr;
            if (sl < cnt) { const int r = lst[sl]; float* xd = xrow_st(p, r); const float* gt = modvec(p, l, r) + 5120;
#pragma unroll
                for (int nt = 0; nt < 2; ++nt) { const int col = ct * 128 + wn * 32 + nt * 16 + fq * 4; const f32x4 x = *(const f32x4*)(xd + col), g = *(const f32x4*)(gt + col);
                    f32x4 o; o[0] = x[0] + g[0] * acc[mt][nt][0]; o[1] = x[1] + g[1] * acc[mt][nt][1]; o[2] = x[2] + g[2] * acc[mt][nt][2]; o[3] = x[3] + g[3] * acc[mt][nt][3];
                    if (DBG_NO_MOE) o = x;
                    *(f32x4*)(xd + col) = o; } } }
    }
}

PHASE_FN void ph_final(const Params& p) {
    const int wid = tidx() >> 6, lane = tidx() & 63; const float* g = p.in[I_FNG];
    for (int r = bidx() * 8 + wid; r < 2 * SEQ; r += gdim() * 8) {
        float* xr = p.out + (size_t)r * D; f32x4 v[4]; float ss = 0.f;
#pragma unroll
        for (int i = 0; i < 4; ++i) { v[i] = *(const f32x4*)(xr + i * 256 + lane * 4); ss += v[i][0] * v[i][0] + v[i][1] * v[i][1] + v[i][2] * v[i][2] + v[i][3] * v[i][3]; }
        ss = wave_sum(ss); const float rinv = rsqrtf(ss * (1.f / 1024.f) + 1e-6f);
#pragma unroll
        for (int i = 0; i < 4; ++i) { const f32x4 gg = *(const f32x4*)(g + i * 256 + lane * 4); f32x4 o; o[0] = v[i][0] * rinv * gg[0]; o[1] = v[i][1] * rinv * gg[1]; o[2] = v[i][2] * rinv * gg[2]; o[3] = v[i][3] * rinv * gg[3];
            *(f32x4*)(xr + i * 256 + lane * 4) = o; }
    }
}

__device__ __forceinline__ void ph_dbgcmp(const Params& p, size_t oa, size_t ob, int slot) {
    const u32x4* a = WSP(const u32x4, oa); const u32x4* b = WSP(const u32x4, ob); int bad = 0;
    const size_t n = (size_t)2 * 1024 * TPB * 2 / 16;
    for (size_t i = (size_t)bidx() * 512 + tidx(); i < n; i += (size_t)gdim() * 512) { const u32x4 x = a[i], y = b[i]; if (x.x != y.x || x.y != y.y || x.z != y.z || x.w != y.w) bad = 1; }
    if (bad) atomicAdd(WSP(int, OFF_CNT) + slot, 1);
}
constexpr int LDS_BYTES = 150 * 1024;
template <int PH>
__global__ void __launch_bounds__(512) k_phase(Params p, int l) {
    char* lds = lds_dyn;
    if (PH == 0) ph_prologue(p, lds);
    if (PH == 1) { ph_wconv(p, l, lds); __syncthreads(); ph_filt(p, l, lds); __syncthreads(); ph_norm<0>(p, l, lds); }
    if (PH == 2) ph_gemm1(p, l, lds);
    if (PH == 3) ph_mixers(p, l, lds);
    if (PH == 4) ph_mla(p, l, lds);
    if (PH == 5) ph_merge(p, l, lds);
    if (PH == 6) ph_wout(p, l, lds);
    if (PH == 7) ph_norm<1>(p, l, lds);
    if (PH == 8) ph_moe1(p, l, lds);
    if (PH == 9) ph_moe2(p, l, lds);
    if (PH == 10) ph_final(p);
}

#if ONE_LAUNCH
__global__ void __launch_bounds__(512) k_fused(Params p0) {
    char* lds = lds_dyn;
    volatile LAS unsigned* xbw = (volatile LAS unsigned*)(lds + LDS_BYTES - 16);
    if (threadIdx.x == 0) { xbw[0] = 0u; xbw[1] = 0u; xbw[2] = 0u; xbw[3] = 0u; }
    __syncthreads();
    (void)xcd_barrier_post((unsigned*)(p0.ws + OFF_BAR), xbw);
#define PQ() ({ Params q_ = p0; asm volatile("" : "+s"(q_.ws)); q_; })
#define GRID_BARRIER() do { XcdBarrier bar_; bar_.bar = (unsigned*)(p0.ws + OFF_BAR); bar_.x = xb_xcc_id(); bar_.st = (volatile LAS unsigned*)(lds_dyn + LDS_BYTES - 16); xcd_barrier(bar_); } while (0)
    asm volatile("; PHASE_MARK 0" ::: "memory"); ph_prologue(PQ(), lds);
    if (REP_PHASE == 100) { GRID_BARRIER(); ph_prologue(PQ(), lds); }
    GRID_BARRIER();
#pragma unroll
    for (int l = 0; l < NLAYER; ++l) {
        asm volatile("; PHASE_MARK 1" ::: "memory"); ph_wconv(PQ(), l, lds); __syncthreads(); ph_filt(PQ(), l, lds); __syncthreads(); ph_norm<0>(PQ(), l, lds);
        GRID_BARRIER();
        if (REP_PHASE == 1) { ph_wconv(PQ(), l, lds); __syncthreads(); ph_norm<0>(PQ(), l, lds); GRID_BARRIER(); }
        asm volatile("; PHASE_MARK 2" ::: "memory"); ph_gemm1(PQ(), l, lds);
        GRID_BARRIER();
        if (REP_PHASE == 2) { ph_gemm1(PQ(), l, lds); GRID_BARRIER(); }

        asm volatile("; PHASE_MARK 3" ::: "memory"); ph_mixers(PQ(), l, lds);
        GRID_BARRIER();
        if (REP_PHASE == 3) { ph_mixers(PQ(), l, lds); GRID_BARRIER(); }
        asm volatile("; PHASE_MARK 4" ::: "memory"); ph_mla(PQ(), l, lds);
        GRID_BARRIER();
        if (REP_PHASE == 4) { ph_mla(PQ(), l, lds); GRID_BARRIER(); }
        asm volatile("; PHASE_MARK 5" ::: "memory"); ph_merge(PQ(), l, lds);
        GRID_BARRIER();
        if (REP_PHASE == 5) { ph_merge(PQ(), l, lds); GRID_BARRIER(); }
        asm volatile("; PHASE_MARK 6" ::: "memory"); ph_wout(PQ(), l, lds);
        GRID_BARRIER();
        if (REP_PHASE == 6 && l == 0) { ph_wout(PQ(), l, lds); GRID_BARRIER(); }
        asm volatile("; PHASE_MARK 7" ::: "memory"); ph_norm<1>(PQ(), l, lds);
        GRID_BARRIER();
        if (REP_PHASE == 7) { ph_norm<2>(PQ(), l, lds); GRID_BARRIER(); }
        asm volatile("; PHASE_MARK 8" ::: "memory"); ph_moe1(PQ(), l, lds);
        GRID_BARRIER();
        if (REP_PHASE == 8) { ph_moe1(PQ(), l, lds); GRID_BARRIER(); }
        asm volatile("; PHASE_MARK 9" ::: "memory"); ph_moe2(PQ(), l, lds);
        GRID_BARRIER();
    }
    asm volatile("; PHASE_MARK 10" ::: "memory"); ph_final(PQ());
}
#endif
template <int PH> static void launch_phase(const Params& p, int l, int grid, hipStream_t stream) {
    static bool attr = false;
    if (!attr) { hipFuncSetAttribute((const void*)k_phase<PH>, hipFuncAttributeMaxDynamicSharedMemorySize, LDS_BYTES); attr = true; }
    hipLaunchKernelGGL(k_phase<PH>, dim3(grid), dim3(512), LDS_BYTES, stream, p, l);
}

extern "C" void kernel_launch(void* const* d_in, const int* in_sizes, int n_in, void* d_out, int out_size, void* d_ws, size_t ws_size, hipStream_t stream) {
    if (n_in != 33 || ws_size < WS_TOTAL || out_size != 2 * SEQ * D) { fprintf(stderr, "kernel_launch: unexpected shapes: n_in %d ws %zu (need %zu) out %d\n", n_in, ws_size, WS_TOTAL, out_size); return; }
    Params p{};
    for (int i = 0; i < 33; ++i) p.in[i] = (const float*)d_in[i];
    p.out = (float*)d_out; p.ws = (unsigned char*)d_ws;
    hipMemsetAsync(d_ws, 0, ZERO_BYTES, stream);
#if ONE_LAUNCH
    static int grid1 = 0;
    if (!grid1) {
        int dev = 0, cus = 0, per_cu = 0;
        hipGetDevice(&dev); hipDeviceGetAttribute(&cus, hipDeviceAttributeMultiprocessorCount, dev);
        hipFuncSetAttribute((const void*)k_fused, hipFuncAttributeMaxDynamicSharedMemorySize, LDS_BYTES);
        hipOccupancyMaxActiveBlocksPerMultiprocessor(&per_cu, k_fused, 512, LDS_BYTES);
        if (per_cu < 1 || cus < 256) { fprintf(stderr, "kernel_launch: cannot make the grid resident (cus %d, blocks/cu %d)\n", cus, per_cu); return; }
        grid1 = 256;
    }
    hipLaunchKernelGGL(k_fused, dim3(grid1), dim3(512), LDS_BYTES, stream, p);
    { const hipError_t le = hipPeekAtLastError(); if (le != hipSuccess) fprintf(stderr, "kernel_launch: launch failed: %s\n", hipGetErrorName(le)); }
    return;
#endif
    const int grid = 256;
    launch_phase<0>(p, 0, grid, stream);
    for (int l = 0; l < NLAYER; ++l) {
        launch_phase<1>(p, l, grid, stream);
        launch_phase<2>(p, l, grid, stream);
        launch_phase<3>(p, l, grid, stream);
        launch_phase<4>(p, l, grid, stream);
        launch_phase<5>(p, l, grid, stream);
        launch_phase<6>(p, l, grid, stream);
        launch_phase<7>(p, l, grid, stream);
        launch_phase<8>(p, l, grid, stream);
        launch_phase<9>(p, l, grid, stream);
    }
    launch_phase<10>(p, 0, grid, stream);
    const hipError_t le = hipPeekAtLastError();
    if (le != hipSuccess) fprintf(stderr, "kernel_launch: launch failed: %s\n", hipGetErrorName(le));
}
```

```cpp
#include <hip/hip_runtime.h>
#include <cstdio>
#include <cstdint>

#ifndef ONE_LAUNCH
#define ONE_LAUNCH 1
#endif
#ifndef REP_PHASE
#define REP_PHASE 0
#endif
#ifndef DBG_NO_MIX
#define DBG_NO_MIX 0
#endif
#ifndef DBG_BR
#define DBG_BR 15
#endif
#ifndef DBG_FN_COPY
#define DBG_FN_COPY 0
#endif
#ifndef DBG_NO_MOE
#define DBG_NO_MOE 0
#endif

constexpr int D = 1024, SEQ = 16384, NCTX = 256, TPB = SEQ + NCTX, T = 2 * TPB, NLAYER = 2;
constexpr int NTILE = T / 128;
constexpr int PLD = 1280;
constexpr int IN_W = 6304;

typedef unsigned short bf16_t;
typedef short bf16x8 __attribute__((ext_vector_type(8)));
typedef short s16x4 __attribute__((ext_vector_type(4)));
typedef float f32x4 __attribute__((ext_vector_type(4)));
typedef float f32x16 __attribute__((ext_vector_type(16)));
typedef unsigned u32x4 __attribute__((ext_vector_type(4)));
typedef unsigned u32x2 __attribute__((ext_vector_type(2)));
typedef _Float16 h16x2 __attribute__((ext_vector_type(2)));

constexpr size_t al256(size_t x) { return (x + 255) & ~(size_t)255; }
constexpr size_t OFF_BAR = 0;
constexpr size_t OFF_CNT = 16384;
constexpr size_t ZERO_BYTES = 32768;
constexpr size_t OFF_MOD = 32768;
constexpr size_t OFF_ROPE = OFF_MOD + al256((size_t)2 * 3 * 6144 * 4);
constexpr size_t OFF_H2L = OFF_ROPE + al256(256 * 8 * 8);
constexpr size_t OFF_W3T = OFF_H2L + (size_t)2 * 16384 * 64 * 2;
constexpr size_t OFF_H2C = OFF_H2L + al256((size_t)2 * 16384 * 64 * 4);
constexpr size_t OFF_CTXS = OFF_H2C + al256((size_t)2 * 256 * 64 * 4);
constexpr size_t OFF_TOKW = OFF_CTXS + al256((size_t)512 * 1024 * 4);
constexpr size_t OFF_LISTS = OFF_TOKW + al256((size_t)T * 2 * 4);
constexpr size_t OFF_WTS_OLD = OFF_LISTS + al256((size_t)24 * T * 4);
constexpr size_t WE_W1T = 0;
constexpr size_t WE_WGT = WE_W1T + (size_t)2304 * 1024;
constexpr size_t WE_WUQ = WE_WGT + (size_t)4096 * 1024;
constexpr size_t WE_WUKV = WE_WUQ + (size_t)384 * 256;
constexpr size_t WE_WBA = WE_WUKV + (size_t)512 * 128;
constexpr size_t WE_WBB = WE_WBA + (size_t)1024 * 256;
constexpr size_t WE_WBD = WE_WBB + (size_t)1024 * 256;
constexpr size_t WE_WBC = WE_WBD + (size_t)1024 * 256;
constexpr size_t WE_WOUT = WE_WBC + (size_t)1024 * 512;
constexpr size_t WE_WGU = WE_WOUT + (size_t)1024 * 1024;
constexpr size_t WE_WDN = WE_WGU + (size_t)16 * 512 * 1024;
constexpr size_t WE_TOTAL = WE_WDN + (size_t)16 * 1024 * 256;
constexpr size_t OFF_H = OFF_WTS_OLD;
constexpr size_t OFF_P = OFF_H + al256((size_t)T * 1024 * 2);
constexpr size_t OFF_HYFN = OFF_P + al256((size_t)T * PLD * 2);
constexpr size_t OFF_Q = OFF_HYFN + al256((size_t)2 * 1024 * TPB * 2);
constexpr size_t OFF_K = OFF_Q + al256((size_t)T * 384 * 2);
constexpr size_t OFF_V = OFF_K + al256((size_t)T * 384 * 2);
constexpr size_t OFF_OAD = OFF_V + al256((size_t)T * 256 * 2);
constexpr size_t OFF_OBT = OFF_OAD + al256((size_t)T * 512 * 2);
constexpr size_t OFF_OCT = OFF_OBT + al256((size_t)2 * 256 * TPB * 2);
constexpr size_t OFF_HYS = OFF_OCT + al256((size_t)2 * 512 * TPB * 2);
constexpr size_t OFF_WTS = OFF_HYS + al256((size_t)256 * 4 * 16384 * 4);
constexpr size_t OFF_FILT = OFF_WTS + al256(WE_TOTAL * 2);
constexpr size_t WS_TOTAL = OFF_FILT + al256((size_t)1024 * 16384 * 2);
constexpr int ACT_ROWS = 36352;
static_assert((size_t)ACT_ROWS * 512 * 2 <= (size_t)T * PLD * 2, "act must fit in P");

struct Params { const float* in[33]; float* out; unsigned char* ws; };
enum { I_X = 0, I_C, I_CTX, I_CCTX, I_ADAW, I_ADAB, I_N1G, I_N2G, I_WIN, I_QNORM, I_WUQ, I_KVNORM, I_WUKV, I_HYSW, I_HYW1, I_HYB1, I_HYF1, I_HYW2, I_HYB2, I_HYF2, I_HYW3, I_HYBIAS,
       I_RPB, I_WBR, I_WOUT, I_MWG, I_MBG, I_MWE, I_MBE, I_MGATE, I_MUP, I_MDOWN, I_FNG };

#define WSP(TYPE, off) ((TYPE*)(p.ws + (off)))
__device__ __forceinline__ bf16_t* wts(const Params& p, int l, size_t we) { (void)l; return (bf16_t*)(p.ws + OFF_WTS) + we; }

typedef float f32x2 __attribute__((ext_vector_type(2))); typedef int i32x8 __attribute__((ext_vector_type(8)));
typedef __bf16 bf16x2_t __attribute__((ext_vector_type(2)));
__device__ __forceinline__ unsigned cvt_pk_bf16(float lo, float hi) { const f32x2 v = {lo, hi}; return __builtin_bit_cast(unsigned, __builtin_convertvector(v, bf16x2_t)); }
__device__ __forceinline__ bf16_t f2bf(float x) { return (bf16_t)(cvt_pk_bf16(x, 0.f) & 0xffffu); }
__device__ __forceinline__ float bf2f(bf16_t v) { return __uint_as_float((unsigned)v << 16); }
__device__ __forceinline__ float wave_sum(float v) {
#pragma unroll
    for (int o = 32; o >= 1; o >>= 1) v += __shfl_xor(v, o);
    return v;
}
__device__ __forceinline__ float silu_f(float x) { return x / (1.f + __expf(-x)); }
__device__ __forceinline__ float sigmoid_f(float x) { return __builtin_amdgcn_rcpf(1.f + __builtin_amdgcn_exp2f(x * -1.4426950408889634f)); }
__device__ __forceinline__ void sincos_turns(float turns, float& s, float& c) { const float f = turns - floorf(turns); sincospif(2.f * f, &s, &c); }
__device__ __forceinline__ void sincos_rad(float x, float& s, float& c) { sincos_turns(x * 0.15915494309189535f, s, c); }

__device__ __forceinline__ const float* xrow_in(const Params& p, int r) {
    const int b = r >= TPB ? 1 : 0, t = r - b * TPB;
    return t < SEQ ? p.in[I_X] + ((size_t)b * SEQ + t) * D : p.in[I_CTX] + ((size_t)b * NCTX + (t - SEQ)) * D;
}
__device__ __forceinline__ float* xrow_st(const Params& p, int r) {
    const int b = r >= TPB ? 1 : 0, t = r - b * TPB;
    return t < SEQ ? p.out + ((size_t)b * SEQ + t) * D : WSP(float, OFF_CTXS) + ((size_t)b * NCTX + (t - SEQ)) * D;
}
__device__ __forceinline__ bool row_is_ctx(int r) { const int b = r >= TPB ? 1 : 0; return (r - b * TPB) >= SEQ; }
__device__ __forceinline__ const float* modvec(const Params& p, int l, int r) {
    const int b = r >= TPB ? 1 : 0, t = r - b * TPB; const int mi = t < SEQ ? b : 2;
    return WSP(float, OFF_MOD) + ((size_t)l * 3 + mi) * 6144;
}

#define XB_TMO      128
#define XB_XCNT(j)  (256  + 64 * (j))
#define XB_XSUB(j)  (1280 + 64 * (j))
#define XB_XGEN(j)  (2304 + 64 * (j))
#define XB_TOP      3328
#define XB_TOPGEN   3392
#define XCD_BAR_WORDS 3456
#define XB_SPIN_CAP (1u << 22)
#define LAS __attribute__((address_space(3)))
__device__ __forceinline__ unsigned xb_ld(unsigned* p)              { return __hip_atomic_load(p, __ATOMIC_RELAXED, __HIP_MEMORY_SCOPE_AGENT); }
__device__ __forceinline__ unsigned xb_add(unsigned* p, unsigned v) { return __hip_atomic_fetch_add(p, v, __ATOMIC_RELAXED, __HIP_MEMORY_SCOPE_AGENT); }
__device__ __forceinline__ unsigned xb_xcc_id() { return (unsigned)__builtin_amdgcn_s_getreg((3 << 11) | 20) & 0xFu; }
#define XB_SPIN(cond, bar) do { unsigned _sp = 0; while (cond) { __builtin_amdgcn_s_sleep(1); \
    if ((++_sp & 255u) == 0u) { if (xb_ld(&(bar)[XB_TMO])) break; if (_sp > XB_SPIN_CAP) { atomicAdd(&(bar)[XB_TMO], 1u); break; } } } } while (0)
struct XcdBarrier { unsigned* bar; unsigned x; volatile LAS unsigned* st; };
__device__ __forceinline__ XcdBarrier xcd_barrier_post(unsigned* bar, volatile LAS unsigned* st) {
    XcdBarrier b; b.bar = bar; b.x = xb_xcc_id(); b.st = st;
    if (threadIdx.x == 0) (void)xb_add(&bar[XB_XCNT(b.x)], 1u);
    return b;
}
__device__ __forceinline__ void xcd_barrier_complete(unsigned* bar, unsigned x, unsigned& nloc, unsigned& nx) {
    const unsigned G = gridDim.x * gridDim.y * gridDim.z;
    unsigned sum, cnt, mine, sp = 0u;
    for (;;) {
        sum = 0u; cnt = 0u; mine = 0u;
#pragma unroll
        for (unsigned j = 0; j < 16; ++j) { const unsigned c = xb_ld(&bar[XB_XCNT(j)]); sum += c; cnt += (c > 0u) ? 1u : 0u; mine = (j == x) ? c : mine; }
        if (sum == G) break;
        __builtin_amdgcn_s_sleep(1);
        if ((++sp & 255u) == 0u) { if (xb_ld(&bar[XB_TMO])) break; if (sp > XB_SPIN_CAP) { atomicAdd(&bar[XB_TMO], 1u); break; } }
    }
    nloc = mine > 0u ? mine : 1u; nx = cnt > 0u ? cnt : 1u;
}
__device__ __forceinline__ void xcd_barrier(const XcdBarrier& b) {
    asm volatile("s_waitcnt vmcnt(0)" ::: "memory");
    __syncthreads();
    if (threadIdx.x == 0) {
        unsigned* bar = b.bar;
        __builtin_amdgcn_s_waitcnt(0);
        unsigned nloc = b.st[0], nx = b.st[1];
        if (nloc == 0u) { xcd_barrier_complete(bar, b.x, nloc, nx); b.st[0] = nloc; b.st[1] = nx; }
        const unsigned old = xb_add(&bar[XB_XSUB(b.x)], 1u);
        const unsigned gen = old / nloc;
        if (old + 1u == (gen + 1u) * nloc) {
            __builtin_amdgcn_fence(__ATOMIC_RELEASE, "agent");
            asm volatile("s_waitcnt vmcnt(0)" ::: "memory");
            const unsigned og = xb_add(&bar[XB_TOP], 1u);
            const unsigned tg = og / nx;
            if (og + 1u == (tg + 1u) * nx) xb_add(&bar[XB_TOPGEN], 1u);
            else XB_SPIN(xb_ld(&bar[XB_TOPGEN]) == tg, bar);
            __builtin_amdgcn_fence(__ATOMIC_ACQUIRE, "agent");
            xb_add(&bar[XB_XGEN(b.x)], 1u);
            asm volatile("s_waitcnt vmcnt(0)" ::: "memory");
        } else {
            XB_SPIN(xb_ld(&bar[XB_XGEN(b.x)]) == gen, bar);
            __builtin_amdgcn_fence(__ATOMIC_ACQUIRE, "agent");
            asm volatile("s_waitcnt vmcnt(0)" ::: "memory");
        }
    }
    __syncthreads();
}

__device__ __forceinline__ int tidx() { int r; asm volatile("v_mov_b32 %0, %1" : "=v"(r) : "v"((int)threadIdx.x)); return r; }
__device__ __forceinline__ int bidx() { int r; asm volatile("s_mov_b32 %0, %1" : "=s"(r) : "s"((int)blockIdx.x)); return r; }
__device__ __forceinline__ int gdim() { int r; asm volatile("s_mov_b32 %0, %1" : "=s"(r) : "s"((int)gridDim.x)); return r; }
extern __shared__ __attribute__((aligned(16))) char lds_dyn[];
constexpr int G_TILE = 128 * 128;
constexpr int G_STAGE = 2 * G_TILE;
constexpr int G_LDS = 4 * G_STAGE;
__device__ __forceinline__ int g_lds_byte(int r, int c) { const int ob = (r & 15) * 64 + (c & 31) * 2; return ((r >> 4) * 2 + (c >> 5)) * 1024 + (ob ^ (((ob >> 9) & 1) << 5)); }
__device__ __forceinline__ int g_srow() { const int t = tidx(), ln = t & 63, p = ln * 16, ob = p ^ (((p >> 9) & 1) << 5); return ((t >> 6) >> 1) * 16 + (ob >> 6); }
__device__ __forceinline__ int g_skc() { const int t = tidx(), ln = t & 63, p = ln * 16, ob = p ^ (((p >> 9) & 1) << 5); return ((t >> 6) & 1) * 4 + ((ob & 63) >> 4); }

template <int SWAP>
__device__ __forceinline__ void mma_tile(f32x4 (&acc)[4][2], const char* As, const char* Bs, int a_rd, int b_rd) {
#pragma unroll
    for (int ks = 0; ks < 2; ++ks) {
        bf16x8 af[4], bfr[2];
#pragma unroll
        for (int mt = 0; mt < 4; ++mt) af[mt] = *(const bf16x8*)(As + a_rd + mt * 2048 + ks * 1024);
#pragma unroll
        for (int nt = 0; nt < 2; ++nt) bfr[nt] = *(const bf16x8*)(Bs + b_rd + nt * 2048 + ks * 1024);
#pragma unroll
        for (int mt = 0; mt < 4; ++mt)
#pragma unroll
            for (int nt = 0; nt < 2; ++nt)
                acc[mt][nt] = SWAP ? __builtin_amdgcn_mfma_f32_16x16x32_bf16(bfr[nt], af[mt], acc[mt][nt], 0, 0, 0)
                                   : __builtin_amdgcn_mfma_f32_16x16x32_bf16(af[mt], bfr[nt], acc[mt][nt], 0, 0, 0);
    }
}
struct GFrag { bf16x8 a[4], b[2]; };
__device__ __forceinline__ void gf_load(GFrag& f, const char* As, const char* Bs, int a_rd, int b_rd, int ks) {
#pragma unroll
    for (int mt = 0; mt < 4; ++mt) f.a[mt] = *(const bf16x8*)(As + a_rd + mt * 2048 + ks * 1024);
#pragma unroll
    for (int nt = 0; nt < 2; ++nt) f.b[nt] = *(const bf16x8*)(Bs + b_rd + nt * 2048 + ks * 1024);
}
template <int SWAP = 1>
__device__ __forceinline__ void gf_mma(f32x4 (&acc)[4][2], const GFrag& f) {
#pragma unroll
    for (int mt = 0; mt < 4; ++mt)
#pragma unroll
        for (int nt = 0; nt < 2; ++nt) acc[mt][nt] = SWAP ? __builtin_amdgcn_mfma_f32_16x16x32_bf16(f.b[nt], f.a[mt], acc[mt][nt], 0, 0, 0)
                                                           : __builtin_amdgcn_mfma_f32_16x16x32_bf16(f.a[mt], f.b[nt], acc[mt][nt], 0, 0, 0);
}
__device__ __forceinline__ void gf_zero(GFrag& f) {
#pragma unroll
    for (int mt = 0; mt < 4; ++mt) f.a[mt] = (bf16x8)(0);
#pragma unroll
    for (int nt = 0; nt < 2; ++nt) f.b[nt] = (bf16x8)(0);
}
#define SB() __builtin_amdgcn_sched_barrier(0)
#define GF_STAGE(ACCP, ACC, AS, BS) do { gf_load(f0, (AS), (BS), a_rd, b_rd, 0); SB(); gf_mma(ACCP, f1); SB(); gf_load(f1, (AS), (BS), a_rd, b_rd, 1); SB(); gf_mma(ACC, f0); SB(); } while (0)

struct GFrag2 { bf16x8 a[4], b[4]; };
__device__ __forceinline__ void gf2_load(GFrag2& f, const char* As, const char* Bs, int a_rd, int b_rd, int ks) {
#pragma unroll
    for (int mt = 0; mt < 4; ++mt) f.a[mt] = *(const bf16x8*)(As + a_rd + mt * 2048 + ks * 1024);
#pragma unroll
    for (int nt = 0; nt < 4; ++nt) f.b[nt] = *(const bf16x8*)(Bs + b_rd + nt * 2048 + ks * 1024);
}
template <int SWAP>
__device__ __forceinline__ void gf2_mma(f32x4 (&acc)[4][4], const GFrag2& f) {
#pragma unroll
    for (int mt = 0; mt < 4; ++mt)
#pragma unroll
        for (int nt = 0; nt < 4; ++nt) acc[mt][nt] = SWAP ? __builtin_amdgcn_mfma_f32_16x16x32_bf16(f.b[nt], f.a[mt], acc[mt][nt], 0, 0, 0)
                                                           : __builtin_amdgcn_mfma_f32_16x16x32_bf16(f.a[mt], f.b[nt], acc[mt][nt], 0, 0, 0);
}
__device__ __forceinline__ void gf2_zero(GFrag2& f) {
#pragma unroll
    for (int mt = 0; mt < 4; ++mt) f.a[mt] = (bf16x8)(0);
#pragma unroll
    for (int nt = 0; nt < 4; ++nt) f.b[nt] = (bf16x8)(0);
}
#define G_WAITV(n) asm volatile("s_waitcnt vmcnt(" #n ")\n\ts_waitcnt lgkmcnt(0)" ::: "memory")
template <int SWAP, int AT>
__device__ __forceinline__ void mma_seg(f32x4 (&acc)[4][2], const bf16_t* __restrict__ a0, const bf16_t* __restrict__ a1, long ldt,
                                        const bf16_t* __restrict__ b0, const bf16_t* __restrict__ b1, int K, char* lds) {
    const int tid = tidx(), lane = tid & 63, wid = __builtin_amdgcn_readfirstlane(tid >> 6), wm = wid >> 2, wn = wid & 3;
    const int fr = lane & 15, fq = lane >> 4;
    const int a_rd = g_lds_byte(wm * 64 + fr, fq * 8), b_rd = g_lds_byte(wn * 32 + fr, fq * 8);
    const int nk = K >> 6;
    if (!AT) {
        LAS char* L = (LAS char*)lds_dyn + ((wid >> 1) * 2 + (wid & 1)) * 1024;
        auto issue = [&](int st) { const int k0 = st << 6; LAS char* Lb = L + (st & 3) * G_STAGE;
            __builtin_amdgcn_global_load_lds((const unsigned*)(a0 + k0), (LAS unsigned*)(Lb), 16, 0, 0);
            __builtin_amdgcn_global_load_lds((const unsigned*)(a1 + k0), (LAS unsigned*)(Lb + 8192), 16, 0, 0);
            __builtin_amdgcn_global_load_lds((const unsigned*)(b0 + k0), (LAS unsigned*)(Lb + G_TILE), 16, 0, 0);
            __builtin_amdgcn_global_load_lds((const unsigned*)(b1 + k0), (LAS unsigned*)(Lb + G_TILE + 8192), 16, 0, 0); };
        GFrag f0, f1; gf_zero(f1);
        issue(0); if (nk > 1) issue(1); if (nk > 2) issue(2);
        for (int kt = 0; kt < nk; ++kt) {
            if (kt + 2 < nk) G_WAITV(8); else if (kt + 1 < nk) G_WAITV(4); else G_WAITV(0);
            __builtin_amdgcn_s_barrier();
            asm volatile("" ::: "memory");
            if (kt + 3 < nk) issue(kt + 3);
            const char* As = lds + (kt & 3) * G_STAGE;
            gf_load(f0, As, As + G_TILE, a_rd, b_rd, 0); SB(); gf_mma<SWAP>(acc, f1); SB(); gf_load(f1, As, As + G_TILE, a_rd, b_rd, 1); SB(); gf_mma<SWAP>(acc, f0); SB();
        }
        gf_mma<SWAP>(acc, f1);
        __syncthreads();
    } else {
        const int w0 = g_lds_byte(g_srow(), g_skc() * 8), w1 = w0 + 4 * 2048;
        const int tk = tid >> 4, tt = tid & 15;
        u32x4 ra0, ra1, rb0, rb1;
        auto gld = [&](int k0) {
            ra0 = *(const u32x4*)(a0 + (long)(k0 + tk) * ldt + tt * 8); ra1 = *(const u32x4*)(a0 + (long)(k0 + tk + 32) * ldt + tt * 8);
            rb0 = *(const u32x4*)(b0 + k0); rb1 = *(const u32x4*)(b1 + k0);
        };
        auto lst = [&](int buf) {
            char* A = lds + buf * G_STAGE; char* B = A + G_TILE;
#pragma unroll
            for (int i = 0; i < 8; ++i) {
                const unsigned wa = ra0[i >> 1], wb = ra1[i >> 1];
                *(bf16_t*)(A + g_lds_byte(tt * 8 + i, tk)) = (bf16_t)((i & 1) ? (wa >> 16) : (wa & 0xffffu));
                *(bf16_t*)(A + g_lds_byte(tt * 8 + i, tk + 32)) = (bf16_t)((i & 1) ? (wb >> 16) : (wb & 0xffffu));
            }
            *(u32x4*)(B + w0) = rb0; *(u32x4*)(B + w1) = rb1;
        };
        gld(0); lst(0); __syncthreads();
        for (int kt = 0; kt < nk; ++kt) {
            if (kt + 1 < nk) gld((kt + 1) << 6);
            __builtin_amdgcn_sched_barrier(0);
            mma_tile<SWAP>(acc, lds + (kt & 1) * G_STAGE, lds + (kt & 1) * G_STAGE + G_TILE, a_rd, b_rd);
            __builtin_amdgcn_sched_barrier(0);
            if (kt + 1 < nk) lst((kt + 1) & 1);
            __syncthreads();
        }
    }
}
__device__ __forceinline__ void mma_pair(f32x4 (&ag)[4][2], f32x4 (&ap)[4][2], const bf16_t* __restrict__ ga0, const bf16_t* __restrict__ ga1, const bf16_t* __restrict__ gb0, const bf16_t* __restrict__ gb1, int nkg,
                                         const bf16_t* __restrict__ pa0, const bf16_t* __restrict__ pa1, const bf16_t* __restrict__ pb0, const bf16_t* __restrict__ pb1, int nkp, char* lds) {
    const int tid = tidx(), lane = tid & 63, wid = __builtin_amdgcn_readfirstlane(tid >> 6), wm = wid >> 2, wn = wid & 3;
    const int fr = lane & 15, fq = lane >> 4;
    const int a_rd = g_lds_byte(wm * 64 + fr, fq * 8), b_rd = g_lds_byte(wn * 32 + fr, fq * 8);
    const int ns = nkg + nkp;
    LAS char* L = (LAS char*)lds_dyn + ((wid >> 1) * 2 + (wid & 1)) * 1024;
    auto issue = [&](int st) { const bool g = st < nkg; const int k0 = (g ? st : st - nkg) << 6; LAS char* Lb = L + (st & 3) * G_STAGE;
        __builtin_amdgcn_global_load_lds((const unsigned*)((g ? ga0 : pa0) + k0), (LAS unsigned*)(Lb), 16, 0, 0);
        __builtin_amdgcn_global_load_lds((const unsigned*)((g ? ga1 : pa1) + k0), (LAS unsigned*)(Lb + 8192), 16, 0, 0);
        __builtin_amdgcn_global_load_lds((const unsigned*)((g ? gb0 : pb0) + k0), (LAS unsigned*)(Lb + G_TILE), 16, 0, 0);
        __builtin_amdgcn_global_load_lds((const unsigned*)((g ? gb1 : pb1) + k0), (LAS unsigned*)(Lb + G_TILE + 8192), 16, 0, 0); };
    issue(0); issue(1); issue(2);
    for (int st = 0; st < nkg; ++st) {
        if (st + 2 < ns) G_WAITV(8); else if (st + 1 < ns) G_WAITV(4); else G_WAITV(0);
        __builtin_amdgcn_s_barrier(); asm volatile("" ::: "memory");
        if (st + 3 < ns) issue(st + 3);
        mma_tile<1>(ag, lds + (st & 3) * G_STAGE, lds + (st & 3) * G_STAGE + G_TILE, a_rd, b_rd);
    }
    for (int st = nkg; st < ns; ++st) {
        if (st + 2 < ns) G_WAITV(8); else if (st + 1 < ns) G_WAITV(4); else G_WAITV(0);
        __builtin_amdgcn_s_barrier(); asm volatile("" ::: "memory");
        if (st + 3 < ns) issue(st + 3);
        mma_tile<1>(ap, lds + (st & 3) * G_STAGE, lds + (st & 3) * G_STAGE + G_TILE, a_rd, b_rd);
    }
    __syncthreads();
}
constexpr int G2_STAGE = 3 * G_TILE;
constexpr int G2_LDS = 3 * G2_STAGE;
template <int SWAP>
__device__ __forceinline__ void mma_tile256(f32x4 (&acc)[4][4], const char* As, const char* Bs, int a_rd, int b_rd) {
#pragma unroll
    for (int ks = 0; ks < 2; ++ks) {
        bf16x8 af[4], bfr[4];
#pragma unroll
        for (int mt = 0; mt < 4; ++mt) af[mt] = *(const bf16x8*)(As + a_rd + mt * 2048 + ks * 1024);
#pragma unroll
        for (int nt = 0; nt < 4; ++nt) bfr[nt] = *(const bf16x8*)(Bs + b_rd + nt * 2048 + ks * 1024);
#pragma unroll
        for (int mt = 0; mt < 4; ++mt)
#pragma unroll
            for (int nt = 0; nt < 4; ++nt)
                acc[mt][nt] = SWAP ? __builtin_amdgcn_mfma_f32_16x16x32_bf16(bfr[nt], af[mt], acc[mt][nt], 0, 0, 0)
                                   : __builtin_amdgcn_mfma_f32_16x16x32_bf16(af[mt], bfr[nt], acc[mt][nt], 0, 0, 0);
    }
}
#define G2_WAITV(n) asm volatile("s_waitcnt vmcnt(" #n ")\n\ts_waitcnt lgkmcnt(0)" ::: "memory")
template <int SWAP>
__device__ __forceinline__ void mma_seg256(f32x4 (&acc)[4][4], const bf16_t* __restrict__ a0, size_t astep, const bf16_t* __restrict__ b0, size_t bstep, int K, char* lds) {
    const int tid = tidx(), lane = tid & 63, wid = __builtin_amdgcn_readfirstlane(tid >> 6), wm = wid >> 1, wn = wid & 1;
    const int fr = lane & 15, fq = lane >> 4;
    const int a_rd = g_lds_byte(wm * 64 + fr, fq * 8), b_rd = g_lds_byte(wn * 64 + fr, fq * 8);
    const int nk = K >> 6;
    LAS char* L = (LAS char*)lds_dyn + ((wid >> 1) * 2 + (wid & 1)) * 1024;
    auto issue = [&](int st) { const int k0 = st << 6; LAS char* Lb = L + (st % 3) * G2_STAGE;
#pragma unroll
        for (int i = 0; i < 4; ++i) __builtin_amdgcn_global_load_lds((const unsigned*)(a0 + i * astep + k0), (LAS unsigned*)(Lb + i * 8192), 16, 0, 0);
#pragma unroll
        for (int i = 0; i < 2; ++i) __builtin_amdgcn_global_load_lds((const unsigned*)(b0 + i * bstep + k0), (LAS unsigned*)(Lb + 2 * G_TILE + i * 8192), 16, 0, 0); };
    GFrag2 f0, f1; gf2_zero(f1);
    issue(0); if (nk > 1) issue(1);
    for (int kt = 0; kt < nk; ++kt) {
        if (kt + 1 < nk) G2_WAITV(6); else G2_WAITV(0);
        __builtin_amdgcn_s_barrier(); asm volatile("" ::: "memory");
        if (kt + 2 < nk) issue(kt + 2);
        const char* As = lds + (kt % 3) * G2_STAGE; const char* Bs = As + 2 * G_TILE;
        gf2_load(f0, As, Bs, a_rd, b_rd, 0); SB(); gf2_mma<SWAP>(acc, f1); SB(); gf2_load(f1, As, Bs, a_rd, b_rd, 1); SB(); gf2_mma<SWAP>(acc, f0); SB();
    }
    gf2_mma<SWAP>(acc, f1);
    __syncthreads();
}
__device__ __forceinline__ void acc_zero256(f32x4 (&acc)[4][4]) {
#pragma unroll
    for (int mt = 0; mt < 4; ++mt)
#pragma unroll
        for (int nt = 0; nt < 4; ++nt) acc[mt][nt] = (f32x4){0.f, 0.f, 0.f, 0.f};
}
__device__ __forceinline__ void acc_zero(f32x4 (&acc)[4][2]) {
#pragma unroll
    for (int mt = 0; mt < 4; ++mt)
#pragma unroll
        for (int nt = 0; nt < 2; ++nt) acc[mt][nt] = (f32x4){0.f, 0.f, 0.f, 0.f};
}

typedef _Float16 f16x8 __attribute__((ext_vector_type(8)));
constexpr int FRS = 130;
#define FBI(n) ((((n) >> 7) * FRS) + ((n) & 127))
constexpr int FFT_BUF_BYTES = 128 * FRS * 8;
struct FFrag { int unused; };
__device__ __forceinline__ float2 cmulf(float2 a, float2 b) { return make_float2(a.x * b.x - a.y * b.y, a.x * b.y + a.y * b.x); }
__device__ __forceinline__ float2 cmulcf(float2 a, float2 b) { return make_float2(a.x * b.x + a.y * b.y, a.y * b.x - a.x * b.y); }
__device__ __forceinline__ float2 tw16k(const float2* thi, const float2* tlo, int idx) { return cmulf(thi[idx >> 7], tlo[idx & 127]); }
__device__ __forceinline__ void mfft_frags(FFrag& F, const float2*) { F.unused = 0; }
template <int CONJ, int TW>
__device__ __forceinline__ void mfft_left(float2* buf, const FFrag& F, const float2* thi, const float2* tlo) {
    const int tid = tidx(), lane = tid & 63, wid = tid >> 6, i = wid >> 1, hi = lane >> 5, l31 = lane & 31, fa = 32 * i + l31;
    f32x16 yr0 = {}, yi0 = {}, yr1 = {}, yi1 = {};
#pragma unroll
    for (int ks = 0; ks < 8; ++ks) {
        f16x8 fr, fi;
#pragma unroll
        for (int j = 0; j < 8; ++j) { const float2 w = thi[(fa * (16 * ks + 8 * hi + j)) & 127]; fr[j] = (_Float16)w.x; fi[j] = (_Float16)(CONJ ? -w.y : w.y); }
        const f16x8 nfi = -fi;
#pragma unroll
        for (int t = 0; t < 2; ++t) {
            const float2* xp = buf + (16 * ks + 8 * hi) * FRS + 32 * (2 * (wid & 1) + t) + l31;
            f16x8 xr, xi;
#pragma unroll
            for (int j = 0; j < 8; ++j) { const float2 v = xp[j * FRS]; xr[j] = (_Float16)v.x; xi[j] = (_Float16)v.y; }
            if (t == 0) { yr0 = __builtin_amdgcn_mfma_f32_32x32x16_f16(fr, xr, yr0, 0, 0, 0); yr0 = __builtin_amdgcn_mfma_f32_32x32x16_f16(nfi, xi, yr0, 0, 0, 0);
                          yi0 = __builtin_amdgcn_mfma_f32_32x32x16_f16(fr, xi, yi0, 0, 0, 0); yi0 = __builtin_amdgcn_mfma_f32_32x32x16_f16(fi, xr, yi0, 0, 0, 0); }
            else        { yr1 = __builtin_amdgcn_mfma_f32_32x32x16_f16(fr, xr, yr1, 0, 0, 0); yr1 = __builtin_amdgcn_mfma_f32_32x32x16_f16(nfi, xi, yr1, 0, 0, 0);
                          yi1 = __builtin_amdgcn_mfma_f32_32x32x16_f16(fr, xi, yi1, 0, 0, 0); yi1 = __builtin_amdgcn_mfma_f32_32x32x16_f16(fi, xr, yi1, 0, 0, 0); }
        }
    }
    __syncthreads();
#pragma unroll
    for (int t = 0; t < 2; ++t)
#pragma unroll
        for (int r = 0; r < 16; ++r) { const int row = 32 * i + (r & 3) + 8 * (r >> 2) + 4 * hi, col = 32 * (2 * (wid & 1) + t) + l31;
            float2 v = t == 0 ? make_float2(yr0[r], yi0[r]) : make_float2(yr1[r], yi1[r]);
            if (TW) { const float2 tv = tw16k(thi, tlo, row * col); v = TW > 0 ? cmulf(v, tv) : cmulcf(v, tv); }
            buf[row * FRS + col] = v; }
    __syncthreads();
}
template <int CONJ, int TW>
__device__ __forceinline__ void mfft_right(float2* buf, const FFrag& F, const float2* thi, const float2* tlo) {
    const int tid = tidx(), lane = tid & 63, wid = tid >> 6, jb = wid >> 1, hi = lane >> 5, l31 = lane & 31, fa = 32 * jb + l31;
    f32x16 yr0 = {}, yi0 = {}, yr1 = {}, yi1 = {};
#pragma unroll
    for (int ks = 0; ks < 8; ++ks) {
        f16x8 fr, fi;
#pragma unroll
        for (int j = 0; j < 8; ++j) { const float2 w = thi[(fa * (16 * ks + 8 * hi + j)) & 127]; fr[j] = (_Float16)w.x; fi[j] = (_Float16)(CONJ ? -w.y : w.y); }
        const f16x8 nfi = -fi;
#pragma unroll
        for (int t = 0; t < 2; ++t) {
            const f32x4* xp = (const f32x4*)(buf + (32 * (2 * (wid & 1) + t) + l31) * FRS + 16 * ks + 8 * hi);
            const f32x4 q0 = xp[0], q1 = xp[1], q2 = xp[2], q3 = xp[3];
            f16x8 xr, xi;
            xr[0] = (_Float16)q0[0]; xi[0] = (_Float16)q0[1]; xr[1] = (_Float16)q0[2]; xi[1] = (_Float16)q0[3]; xr[2] = (_Float16)q1[0]; xi[2] = (_Float16)q1[1]; xr[3] = (_Float16)q1[2]; xi[3] = (_Float16)q1[3];
            xr[4] = (_Float16)q2[0]; xi[4] = (_Float16)q2[1]; xr[5] = (_Float16)q2[2]; xi[5] = (_Float16)q2[3]; xr[6] = (_Float16)q3[0]; xi[6] = (_Float16)q3[1]; xr[7] = (_Float16)q3[2]; xi[7] = (_Float16)q3[3];
            if (t == 0) { yr0 = __builtin_amdgcn_mfma_f32_32x32x16_f16(xr, fr, yr0, 0, 0, 0); yr0 = __builtin_amdgcn_mfma_f32_32x32x16_f16(xi, nfi, yr0, 0, 0, 0);
                          yi0 = __builtin_amdgcn_mfma_f32_32x32x16_f16(xr, fi, yi0, 0, 0, 0); yi0 = __builtin_amdgcn_mfma_f32_32x32x16_f16(xi, fr, yi0, 0, 0, 0); }
            else        { yr1 = __builtin_amdgcn_mfma_f32_32x32x16_f16(xr, fr, yr1, 0, 0, 0); yr1 = __builtin_amdgcn_mfma_f32_32x32x16_f16(xi, nfi, yr1, 0, 0, 0);
                          yi1 = __builtin_amdgcn_mfma_f32_32x32x16_f16(xr, fi, yi1, 0, 0, 0); yi1 = __builtin_amdgcn_mfma_f32_32x32x16_f16(xi, fr, yi1, 0, 0, 0); }
        }
    }
    __syncthreads();
#pragma unroll
    for (int t = 0; t < 2; ++t)
#pragma unroll
        for (int r = 0; r < 16; ++r) { const int row = 32 * (2 * (wid & 1) + t) + (r & 3) + 8 * (r >> 2) + 4 * hi, col = 32 * jb + l31;
            float2 v = t == 0 ? make_float2(yr0[r], yi0[r]) : make_float2(yr1[r], yi1[r]);
            if (TW) { const float2 tv = tw16k(thi, tlo, row * col); v = TW > 0 ? cmulf(v, tv) : cmulcf(v, tv); }
            buf[row * FRS + col] = v; }
    __syncthreads();
}
__device__ __forceinline__ void fft_fwd_blk(float2* buf, const FFrag& F, const float2* thi, const float2* tlo) { mfft_left<0, 1>(buf, F, thi, tlo); mfft_right<0, 0>(buf, F, thi, tlo); }
__device__ __forceinline__ void fft_inv_blk(float2* buf, const FFrag& F, const float2* thi, const float2* tlo) { mfft_right<1, -1>(buf, F, thi, tlo); mfft_left<1, 0>(buf, F, thi, tlo); }
constexpr int FFT_LDS_TAB = FFT_BUF_BYTES;
constexpr int FFT_LDS_EXTRA = FFT_LDS_TAB + 4096;
__device__ __forceinline__ void fft_tables(char* lds) {
    float2* thi = (float2*)(lds + FFT_LDS_TAB); float2* tlo = thi + 128;
    const int t = tidx();
    if (t < 128) { float s, c; sincospif(2.f * (float)t / 128.f, &s, &c); thi[t] = make_float2(c, -s); }
    else if (t < 256) { float s, c; sincospif(2.f * (float)(t - 128) / 16384.f, &s, &c); tlo[t - 128] = make_float2(c, -s); }
    else if (t < 384) { float s, c; sincospif((float)(t - 256) / 128.f, &s, &c); tlo[128 + (t - 256)] = make_float2(c, -s); }
    else { float s, c; sincospif((float)(t - 384) / 16384.f, &s, &c); tlo[256 + (t - 384)] = make_float2(c, -s); }
    __syncthreads();
}
__device__ __forceinline__ float block_sum(float v, float* red) {
    v = wave_sum(v);
    __syncthreads();
    if ((tidx() & 63) == 0) red[tidx() >> 6] = v;
    __syncthreads();
    float s = 0.f;
#pragma unroll
    for (int i = 0; i < 8; ++i) s += red[i];
    return s;
}

#if ONE_LAUNCH
#define PHASE_FN __device__ __forceinline__
#else
#define PHASE_FN __device__
#endif
__device__ __forceinline__ const float* wsrc(const Params& p, int l, int job, int n, int& ld) {
    switch (job) {
    case 0: { ld = IN_W; const float* w = p.in[I_WIN] + (size_t)l * 1024 * IN_W; int c;
        if (n < 768) c = 1440 + n; else if (n < 1024) c = n - 768; else if (n < 1152) c = 256 + (n - 1024); else if (n < 1184) c = 384 + (n - 1152);
        else if (n < 1280) return nullptr; else if (n < 2048) c = 416 + (n - 1280); else c = 1184 + (n - 2048);
        return w + c; }
    case 1: ld = IN_W; return p.in[I_WIN] + (size_t)l * 1024 * IN_W + 2208 + n;
    case 2: ld = 384; return p.in[I_WUQ] + (size_t)l * 256 * 384 + n;
    case 3: ld = 512; return p.in[I_WUKV] + (size_t)l * 128 * 512 + n;
    case 4: ld = 1024; return p.in[I_WBR] + ((size_t)l * 4 + 0) * 256 * 1024 + n;
    case 5: ld = 1024; return p.in[I_WBR] + ((size_t)l * 4 + 1) * 256 * 1024 + n;
    case 6: ld = 1024; return p.in[I_WBR] + ((size_t)l * 4 + 3) * 256 * 1024 + n;
    case 7: ld = 1024; return p.in[I_WOUT] + (size_t)l * 1024 * 1024 + n;
    case 8: { ld = 256; const int e = n >> 9, r = n & 511; const int t = r >> 7, wn = (r & 127) >> 5, nt = (r & 31) >> 4, i = r & 15; const int f = t * 64 + wn * 16 + i;
        return (nt ? p.in[I_MUP] : p.in[I_MGATE]) + ((size_t)l * 16 + e) * 1024 * 256 + f; }
    default: { ld = 1024; const int e = n >> 10, c = n & 1023; return p.in[I_MDOWN] + ((size_t)l * 16 + e) * 256 * 1024 + c; }
    }
}
PHASE_FN void ph_prologue(const Params& p, char* lds_unused) {
    char* lds = lds_dyn; (void)lds_unused;
    const int tid = tidx(), bid = bidx(), G = gdim();
    {
        float* sc = (float*)lds;
        float* red = sc + 3072;
        for (int i = tid; i < 3072; i += 512) { const int v = i >> 10, k = i & 1023; const float x = v < 2 ? p.in[I_C][v * 1024 + k] : p.in[I_CCTX][k]; sc[i] = silu_f(x); }
        __syncthreads();
        for (int u = bid; u < 192; u += G) {
            const int l = u / 96, j0 = (u % 96) * 64, kg = tid >> 6, j = tid & 63;
            const float* w = p.in[I_ADAW] + (size_t)l * 1024 * 6144 + j0 + j;
            float a0 = 0.f, a1 = 0.f, a2 = 0.f;
#pragma unroll 8
            for (int k = kg * 128; k < kg * 128 + 128; ++k) { const float wv = w[(size_t)k * 6144]; a0 += sc[k] * wv; a1 += sc[1024 + k] * wv; a2 += sc[2048 + k] * wv; }
            red[(0 * 8 + kg) * 64 + j] = a0; red[(1 * 8 + kg) * 64 + j] = a1; red[(2 * 8 + kg) * 64 + j] = a2;
            __syncthreads();
            if (tid < 192) { const int v = tid >> 6, jj = tid & 63; float s = p.in[I_ADAB][(size_t)l * 6144 + j0 + jj];
#pragma unroll
                for (int g = 0; g < 8; ++g) s += red[(v * 8 + g) * 64 + jj];
                WSP(float, OFF_MOD)[((size_t)l * 3 + v) * 6144 + j0 + jj] = s; }
            __syncthreads();
        }
    }
    for (int i = bid * 512 + tid; i < 2048; i += G * 512) {
        const int pos = i >> 3, f = i & 7; const float inv = powf(10000.f, -(float)f / 8.f); float s, c; sincos_rad((float)pos * inv, s, c);
        WSP(float2, OFF_ROPE)[i] = make_float2(c, s);
    }
    for (int i = bid * 512 + tidx(); i < NLAYER * 1024 * 64; i += G * 512) { const int l = i >> 16, col = (i >> 6) & 1023, j = i & 63;
        WSP(bf16_t, OFF_W3T)[i] = f2bf(p.in[I_HYW3][(size_t)l * 64 * 1024 + (size_t)j * 1024 + col]); }
    {
        float* w1 = (float*)lds;
        float* w2 = w1 + 33 * 64;
        float* vb = w2 + 64 * 64;
        float* zz = vb + 256;
        float* h1 = zz + 8 * 36;
        for (int l = 0; l < NLAYER; ++l) {
            __syncthreads();
            for (int i = tid; i < 33 * 64; i += 512) w1[i] = p.in[I_HYW1][(size_t)l * 33 * 64 + i];
            for (int i = tid; i < 64 * 64; i += 512) w2[i] = p.in[I_HYW2][(size_t)l * 64 * 64 + i];
            if (tid < 64) { vb[tid] = p.in[I_HYB1][l * 64 + tid]; vb[64 + tid] = p.in[I_HYF1][l * 64 + tid]; vb[128 + tid] = p.in[I_HYB2][l * 64 + tid]; vb[192 + tid] = p.in[I_HYF2][l * 64 + tid]; }
            __syncthreads();
            const int nchunks = (16384 + 256) / 8;
            for (int ch = bid; ch < nchunks; ch += G) {
                const bool isc = ch >= 2048; const int L = isc ? 256 : 16384; const int n = (isc ? ch - 2048 : ch) * 8 + (tid >> 6);
                const int nl = tid >> 6, j = tid & 63;
                if (j < 33) {
                    float v;
                    if (j == 0) v = (float)n / (float)(L - 1);
                    else { const int bi = (j - 1) & 15; const float band = 1e-4f + (float)bi * ((15.f - 1e-4f) / 15.f); float s, c; sincos_turns((float)n * band / (float)L, s, c); v = j <= 16 ? c : -s; }
                    zz[nl * 36 + j] = v;
                }
                __syncthreads();
                { float a = vb[j];
#pragma unroll
                  for (int i = 0; i < 33; ++i) a += zz[nl * 36 + i] * w1[i * 64 + j];
                  h1[nl * 64 + j] = sinf(vb[64 + j] * a); }
                __syncthreads();
                { float a = vb[128 + j];
#pragma unroll 16
                  for (int i = 0; i < 64; ++i) a += h1[nl * 64 + i] * w2[i * 64 + j];
                  const float r = sinf(vb[192 + j] * a);
                  if (isc) WSP(float, OFF_H2C)[((size_t)l * 256 + n) * 64 + j] = r; else WSP(bf16_t, OFF_H2L)[((size_t)l * 16384 + n) * 64 + j] = f2bf(r); }
                __syncthreads();
            }
        }
    }
}
template <int JOB, int N, int K>
__device__ __forceinline__ void wconv_job(const Params& p, int l, size_t we, const float* scale, char* lds) {
    float* tile = (float*)lds;
    const int tid = tidx();
    constexpr int NKT = K / 64, NT = (N / 64) * NKT;
    float xa[8], xb[8];
    auto fetch = [&](int v, float (&x)[8]) { const int n0 = (v / NKT) * 64, k0 = (v % NKT) * 64; const int nn = tid & 63, kk = tid >> 6; int ld; const float* src = wsrc(p, l, JOB, n0 + nn, ld);
#pragma unroll
        for (int i = 0; i < 8; ++i) { const int k = kk + 8 * i; float t = src ? src[(size_t)(k0 + k) * ld] : 0.f; if (scale) t *= scale[k0 + k]; x[i] = t; } };
    if (bidx() < NT) fetch(bidx(), xa);
    for (int v = bidx(); v < NT; v += gdim()) {
        const int n0 = (v / NKT) * 64, k0 = (v % NKT) * 64;
        if (v + gdim() < NT) fetch(v + gdim(), xb);
        __syncthreads();
        { const int nn = tid & 63, kk = tid >> 6;
#pragma unroll
          for (int i = 0; i < 8; ++i) { const int k = kk + 8 * i; tile[k * 65 + nn] = xa[i]; } }
#pragma unroll
        for (int i = 0; i < 8; ++i) xa[i] = xb[i];
        __syncthreads();
        if (JOB == 1) {
          const int nn = tid >> 3, kc = tid & 7; float v[8];
#pragma unroll
          for (int i = 0; i < 8; ++i) v[i] = tile[(kc * 8 + i) * 65 + nn] * 64.f;
          u32x2 w; int t0 = 0, t1 = 0;
          t0 = __builtin_amdgcn_cvt_pk_fp8_f32(v[0], v[1], t0, false); t0 = __builtin_amdgcn_cvt_pk_fp8_f32(v[2], v[3], t0, true);
          t1 = __builtin_amdgcn_cvt_pk_fp8_f32(v[4], v[5], t1, false); t1 = __builtin_amdgcn_cvt_pk_fp8_f32(v[6], v[7], t1, true);
          w.x = (unsigned)t0; w.y = (unsigned)t1;
          *(u32x2*)((char*)wts(p, l, we) + (size_t)(n0 + nn) * K + k0 + kc * 8) = w;
        } else
        { const int nn = tid >> 3, kc = tid & 7; u32x4 w;
          w.x = cvt_pk_bf16(tile[(kc * 8 + 0) * 65 + nn], tile[(kc * 8 + 1) * 65 + nn]); w.y = cvt_pk_bf16(tile[(kc * 8 + 2) * 65 + nn], tile[(kc * 8 + 3) * 65 + nn]);
          w.z = cvt_pk_bf16(tile[(kc * 8 + 4) * 65 + nn], tile[(kc * 8 + 5) * 65 + nn]); w.w = cvt_pk_bf16(tile[(kc * 8 + 6) * 65 + nn], tile[(kc * 8 + 7) * 65 + nn]);
          *(u32x4*)(wts(p, l, we) + (size_t)(n0 + nn) * K + k0 + kc * 8) = w; }
    }
}
PHASE_FN void ph_wconv(const Params& p, int l, char* lds_unused) {
    char* lds = lds_dyn; (void)lds_unused;
    const int tid = tidx(), bid = bidx(), G = gdim();
    wconv_job<0, 2304, 1024>(p, l, WE_W1T, nullptr, lds);
    wconv_job<1, 4096, 1024>(p, l, WE_WGT, nullptr, lds);
    wconv_job<2, 384, 256>(p, l, WE_WUQ, p.in[I_QNORM] + l * 256, lds);
    wconv_job<3, 512, 128>(p, l, WE_WUKV, p.in[I_KVNORM] + l * 128, lds);
    wconv_job<4, 1024, 256>(p, l, WE_WBA, nullptr, lds);
    wconv_job<5, 1024, 256>(p, l, WE_WBB, nullptr, lds);
    wconv_job<6, 1024, 256>(p, l, WE_WBD, nullptr, lds);
    wconv_job<7, 1024, 1024>(p, l, WE_WOUT, nullptr, lds);
    wconv_job<8, 8192, 1024>(p, l, WE_WGU, nullptr, lds);
    wconv_job<9, 16384, 256>(p, l, WE_WDN, nullptr, lds);
    __syncthreads();
    {
        float* cs = (float*)lds;
        __syncthreads();
        if (tid < 64) { float s, c; sincospif(2.f * (float)tid / 64.f, &s, &c); cs[tid] = c; cs[64 + tid] = s; }
        __syncthreads();
        for (int idx = bid * 512 + tid; idx < 512 * 1024; idx += G * 512) {
            const int r = idx; const int n = r & 1023, kp = r >> 10; const int part = kp >> 8, g = (kp & 255) >> 6, c = kp & 63;
            const float* wb = p.in[I_WBR] + ((size_t)l * 4 + 2) * 256 * 1024 + (size_t)(g * 64) * 1024 + n;
            float s = 0.f;
#pragma unroll 8
            for (int k2 = 0; k2 < 64; ++k2) s += cs[part * 64 + ((k2 * c) & 63)] * wb[(size_t)k2 * 1024];
            wts(p, l, WE_WBC)[(size_t)n * 512 + kp] = f2bf(s * (1.f / 1024.f));
        }
    }
}

__device__ __forceinline__ bool skip_tile(int l, int tile) { return (l == NLAYER - 1) && ((tile % 130) >= 128); }
__device__ __forceinline__ float row16_sum(float x) {
    x += __int_as_float(__builtin_amdgcn_update_dpp(0, __float_as_int(x), 0xB1, 0xf, 0xf, true));
    x += __int_as_float(__builtin_amdgcn_update_dpp(0, __float_as_int(x), 0x4E, 0xf, 0xf, true));
    x += __int_as_float(__builtin_amdgcn_update_dpp(0, __float_as_int(x), 0x141, 0xf, 0xf, true));
    x += __int_as_float(__builtin_amdgcn_update_dpp(0, __float_as_int(x), 0x140, 0xf, 0xf, true));
    return x;
}
template <int WHICH>
PHASE_FN void ph_norm(const Params& p, int l, char* lds_unused) {
    char* lds = lds_dyn; (void)lds_unused;
    const int tid = tidx(), wid = tid >> 6, lane = tid & 63, sub = lane >> 4, l16 = lane & 15;
    float* Wr = (float*)lds;
    int* lcount = (int*)(lds + 81920);
    int* lbase = lcount + 32;
    int* pidl = lbase + 32;
    int* rankl = pidl + 128;
    if (WHICH >= 1) {
        for (int i = tid; i < 20 * 1024; i += 512) { const int j = i >> 10, k = i & 1023;
            Wr[i] = j < 4 ? p.in[I_MWG][(size_t)l * 4096 + k * 4 + j] : p.in[I_MWE][(size_t)l * 16384 + k * 16 + (j - 4)]; }
        __syncthreads();
    }
    const float* gain = (WHICH == 0 ? p.in[I_N1G] : p.in[I_N2G]) + l * 1024; float sink = 0.f;
    bf16_t* H = WSP(bf16_t, OFF_H);
    float* At = (float*)(lds + 90112); float* Bt = At + 3072;
    for (int i = tid; i < 3072; i += 512) { const int mi = i >> 10, c = i & 1023; const float* mvb = WSP(float, OFF_MOD) + ((size_t)l * 3 + mi) * 6144 + (WHICH == 0 ? 0 : 3072);
        At[i] = gain[c] * (1.f + mvb[1024 + c]); Bt[i] = mvb[c]; }
    __syncthreads();
    f32x4 vn[16]; bool have = false;
#pragma unroll
    for (int i = 0; i < 16; ++i) vn[i] = (f32x4){0.f, 0.f, 0.f, 0.f};
    for (int tile = bidx(); tile < NTILE * 4; tile += gdim()) {
        if (WHICH >= 1 && skip_tile(l, tile >> 2)) continue;
        if (WHICH == 1) { __syncthreads(); if (tid < 24) lcount[tid] = 0; __syncthreads(); }
        {
            const int rloc = wid * 4 + sub, r = tile * 32 + rloc;
            const float* xr = (WHICH == 0 && l == 0) ? xrow_in(p, r) : xrow_st(p, r);
            const int mi = ((tile * 32) % TPB) < SEQ ? (tile * 32 >= TPB ? 1 : 0) : 2;
            f32x4 v[16]; float ss = 0.f;
            if (have) {
#pragma unroll
                for (int i = 0; i < 16; ++i) { v[i] = vn[i]; ss += v[i][0] * v[i][0] + v[i][1] * v[i][1] + v[i][2] * v[i][2] + v[i][3] * v[i][3]; }
            } else {
#pragma unroll
                for (int i = 0; i < 16; ++i) { v[i] = *(const f32x4*)(xr + 4 * (l16 + 16 * i)); ss += v[i][0] * v[i][0] + v[i][1] * v[i][1] + v[i][2] * v[i][2] + v[i][3] * v[i][3]; }
            }
            { int nt_ = tile + gdim(); while (WHICH >= 1 && nt_ < NTILE * 4 && skip_tile(l, nt_ >> 2)) nt_ += gdim();
              have = nt_ < NTILE * 4;
              if (have) { const int rn = nt_ * 32 + rloc; const float* xn = (WHICH == 0 && l == 0) ? xrow_in(p, rn) : xrow_st(p, rn);
#pragma unroll
                  for (int i = 0; i < 16; ++i) vn[i] = *(const f32x4*)(xn + 4 * (l16 + 16 * i)); }
              else {
#pragma unroll
                  for (int i = 0; i < 16; ++i) vn[i] = (f32x4){0.f, 0.f, 0.f, 0.f}; } }
            __builtin_amdgcn_sched_barrier(0);
            ss = row16_sum(ss);
            const float rinv = rsqrtf(ss * (1.f / 1024.f) + 1e-6f);
#pragma unroll
            for (int i = 0; i < 16; ++i) {
                const int c0 = 4 * (l16 + 16 * i);
                const f32x4 a4 = *(const f32x4*)(At + mi * 1024 + c0), b4 = *(const f32x4*)(Bt + mi * 1024 + c0);
#pragma unroll
                for (int e = 0; e < 4; ++e) v[i][e] = (v[i][e] * rinv) * a4[e] + b4[e];
                u32x2 w; w.x = cvt_pk_bf16(v[i][0], v[i][1]); w.y = cvt_pk_bf16(v[i][2], v[i][3]);
                *(u32x2*)(H + (size_t)r * 1024 + c0) = w;
                if ((i & 3) == 3) __builtin_amdgcn_sched_barrier(0);
            }
            if (WHICH >= 1) {
                float lg[20];
                int wofs = 4 * l16; asm volatile("" : "+v"(wofs));
#pragma unroll
                for (int j = 0; j < 20; ++j) { f32x2 a2 = {0.f, 0.f};
#pragma unroll
                    for (int i = 0; i < 16; ++i) { const f32x4 w = *(const f32x4*)(Wr + j * 1024 + wofs + 64 * i);
                        a2 = __builtin_elementwise_fma(__builtin_shufflevector(v[i], v[i], 0, 1), __builtin_shufflevector(w, w, 0, 1), a2);
                        a2 = __builtin_elementwise_fma(__builtin_shufflevector(v[i], v[i], 2, 3), __builtin_shufflevector(w, w, 2, 3), a2);
                        if ((i & 7) == 7) __builtin_amdgcn_sched_barrier(0); }
                    lg[j] = row16_sum(a2[0] + a2[1]); __builtin_amdgcn_sched_barrier(0); }
#pragma unroll
                for (int j = 0; j < 4; ++j) lg[j] += p.in[I_MBG][l * 4 + j];
#pragma unroll
                for (int j = 0; j < 16; ++j) lg[4 + j] += p.in[I_MBE][l * 16 + j];
                int g = 0; float gm = lg[0];
#pragma unroll
                for (int j = 1; j < 4; ++j) if (lg[j] > gm) { gm = lg[j]; g = j; }
                float gs = 0.f;
#pragma unroll
                for (int j = 0; j < 4; ++j) gs += __expf(lg[j] - gm);
                const float gp = 1.f / gs;
                float e4[4];
#pragma unroll
                for (int j = 0; j < 4; ++j) e4[j] = g == 0 ? lg[4 + j] : g == 1 ? lg[8 + j] : g == 2 ? lg[12 + j] : lg[16 + j];
                int i1 = 0; float m1 = e4[0];
#pragma unroll
                for (int j = 1; j < 4; ++j) if (e4[j] > m1) { m1 = e4[j]; i1 = j; }
                int i2 = -1; float m2 = -3.4e38f;
#pragma unroll
                for (int j = 0; j < 4; ++j) if (j != i1 && e4[j] > m2) { m2 = e4[j]; i2 = j; }
                const float x2 = __expf(m2 - m1); const float pw1 = gp / (1.f + x2), pw2 = gp * x2 / (1.f + x2);
                const int lo = i1 < i2 ? i1 : i2, hi = i1 < i2 ? i2 : i1;
                const float wlo = i1 < i2 ? pw1 : pw2, whi = i1 < i2 ? pw2 : pw1;
                const int pairidx = lo == 0 ? hi - 1 : lo == 1 ? hi + 1 : 5;
                if (WHICH == 2) sink += wlo + whi + (float)pairidx;
                if (l16 == 0 && WHICH == 1) { pidl[rloc] = g * 6 + pairidx; WSP(float, OFF_TOKW)[(size_t)r * 2] = wlo; WSP(float, OFF_TOKW)[(size_t)r * 2 + 1] = whi; }
            }
        }
        if (WHICH == 2) asm volatile("" :: "v"(sink));
        if (WHICH == 1) {
            __syncthreads();
            int mypid = 0;
            if (tid < 32) { mypid = pidl[tid]; rankl[tid] = atomicAdd(&lcount[mypid], 1); }
            __syncthreads();
            if (tid < 24) lbase[tid] = lcount[tid] ? atomicAdd(WSP(int, OFF_CNT) + l * 32 + tid, lcount[tid]) : 0;
            __syncthreads();
            if (tid < 32) WSP(int, OFF_LISTS)[(size_t)mypid * T + lbase[mypid] + rankl[tid]] = tile * 32 + tid;
        }
    }
}

PHASE_FN void ph_filt(const Params& p, int l, char* lds_unused) {
    char* lds = lds_dyn; (void)lds_unused;
    const int tid = tidx(), lane = tid & 63, wid = tid >> 6, wm = wid >> 2, wn = wid & 3, fr = lane & 15, fq = lane >> 4;
    const bf16_t* A = WSP(const bf16_t, OFF_H2L) + (size_t)l * 16384 * 64; const bf16_t* B = WSP(const bf16_t, OFF_W3T) + (size_t)l * 1024 * 64;
    bf16_t* F = WSP(bf16_t, OFF_FILT);
    for (int u = bidx(); u < 128 * 8; u += gdim()) {
        const int n0 = (u >> 3) * 128, c0 = (u & 7) * 128;
        const bf16_t* a0 = A + (size_t)(n0 + g_srow()) * 64 + g_skc() * 8; const bf16_t* b0 = B + (size_t)(c0 + g_srow()) * 64 + g_skc() * 8;
        f32x4 acc[4][2]; acc_zero(acc);
        mma_seg<0, 0>(acc, a0, a0 + (size_t)64 * 64, 0, b0, b0 + (size_t)64 * 64, 64, lds);
#pragma unroll
        for (int mt = 0; mt < 4; ++mt)
#pragma unroll
            for (int nt = 0; nt < 2; ++nt) { const int n = n0 + wm * 64 + mt * 16 + fq * 4, col = c0 + wn * 32 + nt * 16 + fr;
                u32x2 w; w.x = cvt_pk_bf16(acc[mt][nt][0], acc[mt][nt][1]); w.y = cvt_pk_bf16(acc[mt][nt][2], acc[mt][nt][3]);
                *(u32x2*)(F + (size_t)col * 16384 + n) = w; }
    }
}

PHASE_FN void ph_gemm1(const Params& p, int l, char* lds_unused) {
    char* lds = lds_dyn; (void)lds_unused;
    const int tid = tidx(), lane = tid & 63, wid = tid >> 6, wm = wid >> 1, wn = wid & 1, fr = lane & 15, fq = lane >> 4;
    const bf16_t* H = WSP(bf16_t, OFF_H); const bf16_t* W = wts(p, l, WE_W1T);
    const int xcd = bidx() & 7, loc = bidx() >> 3, nl = gdim() >> 3;
    for (int v = loc; ; v += nl) {
        const int rt = (v / 18) * 8 + xcd, ct = v % 18; if (rt >= NTILE / 2) break;
        const int r0 = rt * 256, n0 = ct * 128;
        const bf16_t* a0 = H + (size_t)(r0 + g_srow()) * 1024 + g_skc() * 8; const bf16_t* b0 = W + (size_t)(n0 + g_srow()) * 1024 + g_skc() * 8;
        f32x4 acc[4][4]; acc_zero256(acc);
        if (ct < 10) {
            mma_seg256<1>(acc, a0, (size_t)64 * 1024, b0, (size_t)64 * 1024, 1024, lds);
            bf16_t* P = WSP(bf16_t, OFF_P);
#pragma unroll
            for (int mt = 0; mt < 4; ++mt)
#pragma unroll
                for (int nt = 0; nt < 4; ++nt) { const int row = r0 + wm * 64 + mt * 16 + fr, col = n0 + wn * 64 + nt * 16 + fq * 4;
                    u32x2 w; w.x = cvt_pk_bf16(acc[mt][nt][0], acc[mt][nt][1]); w.y = cvt_pk_bf16(acc[mt][nt][2], acc[mt][nt][3]);
                    *(u32x2*)(P + (size_t)row * PLD + col) = w; }
        } else {
            mma_seg256<0>(acc, a0, (size_t)64 * 1024, b0, (size_t)64 * 1024, 1024, lds);
            const int b = r0 >= TPB ? 1 : 0, t0 = r0 - b * TPB;
            bf16_t* HT = WSP(bf16_t, OFF_HYFN) + (size_t)b * 1024 * TPB;
#pragma unroll
            for (int mt = 0; mt < 4; ++mt)
#pragma unroll
                for (int nt = 0; nt < 4; ++nt) { const int t = t0 + wm * 64 + mt * 16 + fq * 4, ch = (n0 - 1280) + wn * 64 + nt * 16 + fr;
                    u32x2 w; w.x = cvt_pk_bf16(acc[mt][nt][0], acc[mt][nt][1]); w.y = cvt_pk_bf16(acc[mt][nt][2], acc[mt][nt][3]);
                    *(u32x2*)(HT + (size_t)ch * TPB + t) = w; }
        }
    }
}

#define KSWZ(row, colB) ((row) * 256 + ((colB) ^ (((row) & 7) << 4)))
#define SBAR() __builtin_amdgcn_sched_barrier(0)
__device__ __forceinline__ int crow(int r, int hi) { return (r & 3) + 8 * (r >> 2) + 4 * hi; }
__device__ __forceinline__ int v_st(int k, int c) { const int kk = (k & ~0xC) | ((k & 4) << 1) | ((k & 8) >> 1); return ((kk >> 3) * 2 + (c >> 5)) * 512 + ((kk & 7) * 32 + (c & 31)) * 2; }
__device__ __forceinline__ int v_rd_base(int lane) { return ((lane & 3) << 3) | (((lane >> 2) & 3) << 6) | (((lane >> 4) & 1) << 5) | (((lane >> 5) & 1) << 8); }
constexpr int v_rd_off(int d0, int ks, int half) { return d0 * 512 + ks * 2048 + half * 1024; }
template <int OFF> __device__ __forceinline__ s16x4 tr_read(int vb) {
    s16x4 r; asm volatile("ds_read_b64_tr_b16 %0, %1 offset:%2" : "=&v"(r) : "v"(vb), "i"(OFF) : "memory"); return r;
}
template <int D0> __device__ __forceinline__ void pv_one(f32x16& od, int vb, bf16x8 pa0, bf16x8 pa1, bf16x8 pa2, bf16x8 pa3) {
    const s16x4 l0 = tr_read<v_rd_off(D0, 0, 0)>(vb), h0 = tr_read<v_rd_off(D0, 0, 1)>(vb), l1 = tr_read<v_rd_off(D0, 1, 0)>(vb), h1 = tr_read<v_rd_off(D0, 1, 1)>(vb);
    const s16x4 l2 = tr_read<v_rd_off(D0, 2, 0)>(vb), h2 = tr_read<v_rd_off(D0, 2, 1)>(vb), l3 = tr_read<v_rd_off(D0, 3, 0)>(vb), h3 = tr_read<v_rd_off(D0, 3, 1)>(vb);
    asm volatile("s_waitcnt lgkmcnt(0)" ::: "memory"); SBAR();
#define PKV(L, H) (bf16x8){L[0], L[1], L[2], L[3], H[0], H[1], H[2], H[3]}
    od = __builtin_amdgcn_mfma_f32_32x32x16_bf16(pa0, PKV(l0, h0), od, 0, 0, 0);
    od = __builtin_amdgcn_mfma_f32_32x32x16_bf16(pa1, PKV(l1, h1), od, 0, 0, 0);
    od = __builtin_amdgcn_mfma_f32_32x32x16_bf16(pa2, PKV(l2, h2), od, 0, 0, 0);
    od = __builtin_amdgcn_mfma_f32_32x32x16_bf16(pa3, PKV(l3, h3), od, 0, 0, 0);
#undef PKV
}
constexpr int ATT_LDS = 16384 + 32768 + 2048;
constexpr float ATT_THR = 8.f;
template <int DQK, int NA>
__device__ __forceinline__ void attn_unit(const bf16_t* __restrict__ Qb, int ldq, const bf16_t* __restrict__ Kb, int ldk, const bf16_t* __restrict__ Vb, int ldv,
                                          bf16_t* __restrict__ Ob, int ldo, int NT, int nA, int baseA, int baseB, char* lds, const float* biasL, int qrow0, int krow_lo) {
    constexpr float SCALE = DQK == 96 ? 0.10206207261596575f : 0.125f;
    constexpr float C = SCALE * 1.4426950408889634f;
    constexpr int ND = DQK / 16, NKC = DQK / 8;
    const int tid = tidx(), wid = tid >> 6, lane = tid & 63, r32 = lane & 31, hi = lane >> 5;
    char* V_lds = lds; char* K_lds = lds + 16384;
    float* wsf = (float*)(lds + 49152) + wid * 64; float* al_l = wsf; float* li_l = wsf + 32;
    bf16x8 qr[ND];
    { const bf16_t* Qw = Qb + (size_t)(wid * 32 + r32) * ldq + hi * 8;
#pragma unroll
      for (int d0 = 0; d0 < ND; ++d0) qr[d0] = *(const bf16x8*)(Qw + d0 * 16); }
    const int vrow = tid >> 3, vc = (tid & 7) * 8, vst = v_st(vrow, vc);
    const int k0row = tid / NKC, k0c = tid % NKC, kst0 = KSWZ(k0row, k0c * 16);
    const int id1 = tid + 512; const bool has1 = (DQK == 96) && (id1 < 64 * NKC);
    const int k1row = has1 ? id1 / NKC : 0, k1c = has1 ? id1 % NKC : 0, kst1 = KSWZ(k1row, k1c * 16);
    const int vb0 = (int)(uintptr_t)V_lds + v_rd_base(lane);
    bf16x8 sv, sk0, sk1;
    auto SLOAD = [&](int j) { const size_t t0 = (size_t)(j < nA ? baseA + 64 * j : baseB + 64 * (j - nA));
        sv = *(const bf16x8*)(Vb + (t0 + vrow) * ldv + vc); sk0 = *(const bf16x8*)(Kb + (t0 + k0row) * ldk + k0c * 8);
        if (has1) sk1 = *(const bf16x8*)(Kb + (t0 + k1row) * ldk + k1c * 8); };
    auto SWRITE = [&](int b) { *(bf16x8*)(V_lds + b * 8192 + vst) = sv; *(bf16x8*)(K_lds + b * 16384 + kst0) = sk0; if (has1) *(bf16x8*)(K_lds + b * 16384 + kst1) = sk1; };
    float m_reg = -1e30f, l_reg = 0.f; f32x16 o0 = {}, o1 = {};
    __syncthreads();
    SLOAD(0); SWRITE(0); __syncthreads();
    for (int j = 0; j < NT; ++j) {
        const int bsel = j & 1;
        if (j + 1 < NT) SLOAD(j + 1);
        f32x16 p0 = {}, p1 = {};
        { const char* Ks = K_lds + bsel * 16384;
#pragma unroll
          for (int d0 = 0; d0 < ND; ++d0) { const int cb = d0 * 32 + hi * 16;
            const bf16x8 b0 = *(const bf16x8*)(Ks + KSWZ(r32, cb)); const bf16x8 b1 = *(const bf16x8*)(Ks + KSWZ(32 + r32, cb));
            p0 = __builtin_amdgcn_mfma_f32_32x32x16_bf16(b0, qr[d0], p0, 0, 0, 0);
            p1 = __builtin_amdgcn_mfma_f32_32x32x16_bf16(b1, qr[d0], p1, 0, 0, 0); } }
        if (NA) {
            if (j >= nA) {
                const int krow = krow_lo + (j - nA), qrow = qrow0 + (wid >> 1);
                int ws = qrow - 4; ws = ws < 0 ? 0 : (ws > 248 ? 248 : ws);
                const bool rowok = (krow >= ws) && (krow < ws + 8);
                const int qc = 32 * (wid & 1) + r32; int cs = qc - 8; cs = cs < 0 ? 0 : (cs > 48 ? 48 : cs);
                int dri = krow - qrow + 7; dri = dri < 0 ? 0 : (dri > 14 ? 14 : dri);
                const float* brow = biasL + dri * 31 + 15 - qc;
#pragma unroll
                for (int r = 0; r < 16; ++r) { const int kc = crow(r, hi); const bool ok = rowok && kc >= cs && kc < cs + 16; float bv = 0.f; if (ok) bv = brow[kc]; p0[r] = ok ? p0[r] + bv : -1e30f; }
#pragma unroll
                for (int r = 0; r < 16; ++r) { const int kc = 32 + crow(r, hi); const bool ok = rowok && kc >= cs && kc < cs + 16; float bv = 0.f; if (ok) bv = brow[kc]; p1[r] = ok ? p1[r] + bv : -1e30f; }
            }
        }
        float pmax = p0[0];
#pragma unroll
        for (int r = 1; r < 16; ++r) pmax = fmaxf(pmax, p0[r]);
#pragma unroll
        for (int r = 0; r < 16; ++r) pmax = fmaxf(pmax, p1[r]);
        { auto rr = __builtin_amdgcn_permlane32_swap(__float_as_uint(pmax), __float_as_uint(pmax), false, false); pmax = fmaxf(__uint_as_float(rr[0]), __uint_as_float(rr[1])); }
        float mn, alpha;
        if (__all(pmax - m_reg <= ATT_THR / SCALE)) { mn = m_reg; alpha = 1.f; }
        else { mn = fmaxf(m_reg, pmax); alpha = __builtin_amdgcn_exp2f((m_reg - mn) * C); m_reg = mn; }
        const float mnC = -mn * C;
        float ps = 0.f;
#pragma unroll
        for (int r = 0; r < 16; ++r) { p0[r] = __builtin_amdgcn_exp2f(fmaf(p0[r], C, mnC)); ps += p0[r]; }
#pragma unroll
        for (int r = 0; r < 16; ++r) { p1[r] = __builtin_amdgcn_exp2f(fmaf(p1[r], C, mnC)); ps += p1[r]; }
        { auto rr = __builtin_amdgcn_permlane32_swap(__float_as_uint(ps), __float_as_uint(ps), false, false); ps = __uint_as_float(rr[0]) + __uint_as_float(rr[1]); }
        l_reg = l_reg * alpha + ps;
        bf16x8 pa0, pa1, pa2, pa3;
#define PK4(P, BASE, OUT) do { unsigned a0_ = cvt_pk_bf16(P[BASE + 0], P[BASE + 1]), a1_ = cvt_pk_bf16(P[BASE + 2], P[BASE + 3]);   \
        unsigned b0_ = cvt_pk_bf16(P[BASE + 4], P[BASE + 5]), b1_ = cvt_pk_bf16(P[BASE + 6], P[BASE + 7]);                              \
        auto r0_ = __builtin_amdgcn_permlane32_swap(a0_, b0_, false, false); auto r1_ = __builtin_amdgcn_permlane32_swap(a1_, b1_, false, false); \
        u32x4 w_ = {r0_[0], r1_[0], r0_[1], r1_[1]}; OUT = *reinterpret_cast<bf16x8*>(&w_); } while (0)
        PK4(p0, 0, pa0); PK4(p0, 8, pa1); PK4(p1, 0, pa2); PK4(p1, 8, pa3);
#undef PK4
        if (__any(alpha < 1.f)) {
            if (hi == 0) al_l[r32] = alpha;
            asm volatile("s_waitcnt lgkmcnt(0)" ::: "memory");
#pragma unroll
            for (int r = 0; r < 16; ++r) { const float a = al_l[crow(r, hi)]; o0[r] *= a; o1[r] *= a; }
        }
        pv_one<0>(o0, vb0 + bsel * 8192, pa0, pa1, pa2, pa3);
        pv_one<1>(o1, vb0 + bsel * 8192, pa0, pa1, pa2, pa3);
        if (j + 1 < NT) SWRITE(bsel ^ 1);
        __syncthreads();
    }
    if (hi == 0) li_l[r32] = l_reg;
    asm volatile("s_waitcnt lgkmcnt(0)" ::: "memory");
    bf16_t* Ow = Ob + (size_t)(wid * 32) * ldo;
#pragma unroll
    for (int r = 0; r < 16; ++r) { const int orow = crow(r, hi); const float rl = __builtin_amdgcn_rcpf(li_l[orow]);
        Ow[(size_t)orow * ldo + r32] = f2bf(o0[r] * rl); Ow[(size_t)orow * ldo + 32 + r32] = f2bf(o1[r] * rl); }
    __syncthreads();
}

__device__ __forceinline__ void mla_partialSM(f32x16& p0, f32x16& p1, float& m_reg, float& alpha, bool first) {
    constexpr float THR2 = ATT_THR * 1.4426950408889634f;
    float pmax = p0[0];
#pragma unroll
    for (int r = 1; r < 16; ++r) pmax = fmaxf(pmax, p0[r]);
#pragma unroll
    for (int r = 0; r < 16; ++r) pmax = fmaxf(pmax, p1[r]);
    { auto rr = __builtin_amdgcn_permlane32_swap(__float_as_uint(pmax), __float_as_uint(pmax), false, false); pmax = fmaxf(__uint_as_float(rr[0]), __uint_as_float(rr[1])); }
    if (__builtin_expect(!first && __all(pmax <= THR2), 1)) { alpha = 1.f; }
    else { const float d = first ? pmax : fmaxf(pmax, 0.f); alpha = first ? 1.f : __builtin_amdgcn_exp2f(-d); m_reg += d;
#pragma unroll
        for (int r = 0; r < 16; ++r) { p0[r] -= d; p1[r] -= d; } }
#pragma unroll
    for (int r = 0; r < 16; ++r) p0[r] = __builtin_amdgcn_exp2f(p0[r]);
}
__device__ __forceinline__ void mla_finishSM(f32x16& p0, f32x16& p1, float alpha, float& l_reg, bf16x8& pa0, bf16x8& pa1, bf16x8& pa2, bf16x8& pa3) {
#pragma unroll
    for (int r = 0; r < 16; ++r) p1[r] = __builtin_amdgcn_exp2f(p1[r]);
    f32x2 s2 = {p0[0], p0[1]}, t2 = {p1[0], p1[1]};
#pragma unroll
    for (int r = 2; r < 16; r += 2) { s2 += (f32x2){p0[r], p0[r + 1]}; t2 += (f32x2){p1[r], p1[r + 1]}; }
    s2 += t2; float ps = s2[0] + s2[1];
    { auto rr = __builtin_amdgcn_permlane32_swap(__float_as_uint(ps), __float_as_uint(ps), false, false); ps = __uint_as_float(rr[0]) + __uint_as_float(rr[1]); }
    l_reg = l_reg * alpha + ps;
#define PK4(P, BASE, OUT) do { unsigned a0_ = cvt_pk_bf16(P[BASE + 0], P[BASE + 1]), a1_ = cvt_pk_bf16(P[BASE + 2], P[BASE + 3]);   \
    unsigned b0_ = cvt_pk_bf16(P[BASE + 4], P[BASE + 5]), b1_ = cvt_pk_bf16(P[BASE + 6], P[BASE + 7]);                              \
    auto r0_ = __builtin_amdgcn_permlane32_swap(a0_, b0_, false, false); auto r1_ = __builtin_amdgcn_permlane32_swap(a1_, b1_, false, false); \
    u32x4 w_ = {r0_[0], r1_[0], r0_[1], r1_[1]}; OUT = *reinterpret_cast<bf16x8*>(&w_); } while (0)
    PK4(p0, 0, pa0); PK4(p0, 8, pa1); PK4(p1, 0, pa2); PK4(p1, 8, pa3);
#undef PK4
}
__device__ __forceinline__ void mla_qkt(f32x16& p0, f32x16& p1, const char* Ks, const bf16x8* qr, int r32, int hi, float init) {
#pragma unroll
    for (int r = 0; r < 16; ++r) { p0[r] = init; p1[r] = init; }
#pragma unroll
    for (int d0 = 0; d0 < 6; ++d0) { const int cb = d0 * 32 + hi * 16;
        const bf16x8 b0 = *(const bf16x8*)(Ks + KSWZ(r32, cb)); const bf16x8 b1 = *(const bf16x8*)(Ks + KSWZ(32 + r32, cb));
        p0 = __builtin_amdgcn_mfma_f32_32x32x16_bf16(b0, qr[d0], p0, 0, 0, 0);
        p1 = __builtin_amdgcn_mfma_f32_32x32x16_bf16(b1, qr[d0], p1, 0, 0, 0); }
}
__device__ __forceinline__ void mla_unit(const bf16_t* __restrict__ Qb, const bf16_t* __restrict__ Kb, const bf16_t* __restrict__ Vb, bf16_t* __restrict__ Ob,
                                         int NT, int nA, int baseA, int baseB, char* lds) {
    constexpr int ldq = 384, ldk = 384, ldv = 256, ldo = 512;
    const int tid = tidx(), wid = tid >> 6, lane = tid & 63, r32 = lane & 31, hi = lane >> 5;
    char* V_lds = lds; char* K_lds = lds + 16384;
    float* wsf = (float*)(lds + 49152) + wid * 64; float* al_l = wsf; float* li_l = wsf + 32;
    bf16x8 qr[6];
    { const bf16_t* Qw = Qb + (size_t)(wid * 32 + r32) * ldq + hi * 8;
#pragma unroll
      for (int d0 = 0; d0 < 6; ++d0) qr[d0] = *(const bf16x8*)(Qw + d0 * 16); }
    const int vrow = tid >> 3, vc = (tid & 7) * 8, vst = v_st(vrow, vc);
    const int k0row = tid / 12, k0c = tid % 12, kst0 = KSWZ(k0row, k0c * 16);
    const int id1 = tid + 512; const bool has1 = id1 < 768;
    const int k1row = has1 ? id1 / 12 : 0, k1c = has1 ? id1 % 12 : 0, kst1 = KSWZ(k1row, k1c * 16);
    const int vb0 = (int)(uintptr_t)V_lds + v_rd_base(lane);
    bf16x8 sv, sk0, sk1;
    auto SLOAD = [&](int j) { const size_t t0 = (size_t)(j < nA ? baseA + 64 * j : baseB + 64 * (j - nA));
        sv = *(const bf16x8*)(Vb + (t0 + vrow) * ldv + vc); sk0 = *(const bf16x8*)(Kb + (t0 + k0row) * ldk + k0c * 8);
        if (has1) sk1 = *(const bf16x8*)(Kb + (t0 + k1row) * ldk + k1c * 8); };
    auto SWRITE = [&](int b) { *(bf16x8*)(V_lds + b * 8192 + vst) = sv; *(bf16x8*)(K_lds + b * 16384 + kst0) = sk0; if (has1) *(bf16x8*)(K_lds + b * 16384 + kst1) = sk1; };
#define MLA_RESC(a) do { if (__any((a) < 1.f)) { if (hi == 0) al_l[r32] = (a); asm volatile("s_waitcnt lgkmcnt(0)" ::: "memory"); \
    _Pragma("unroll") for (int r = 0; r < 16; ++r) { const float a_ = al_l[crow(r, hi)]; o0[r] *= a_; o1[r] *= a_; } } } while (0)
    float m_reg = 0.f, l_reg = 0.f; f32x16 o0 = {}, o1 = {};
    f32x16 pA0, pA1, pB0, pB1; float alA, alB; bf16x8 pa0, pa1, pa2, pa3;
    __syncthreads();
    SLOAD(0); SWRITE(0); __syncthreads();
    mla_qkt(pA0, pA1, K_lds, qr, r32, hi, 0.f); mla_partialSM(pA0, pA1, m_reg, alA, true);
    SLOAD(1); SWRITE(1); __syncthreads();
    for (int j = 1; j + 1 < NT; j += 2) {
        SBAR(); mla_qkt(pB0, pB1, K_lds + 16384, qr, r32, hi, -m_reg);
        mla_finishSM(pA0, pA1, alA, l_reg, pa0, pa1, pa2, pa3); SBAR();
        SLOAD(j + 1); SBAR();
        pv_one<0>(o0, vb0, pa0, pa1, pa2, pa3); pv_one<1>(o1, vb0, pa0, pa1, pa2, pa3); mla_partialSM(pB0, pB1, m_reg, alB, false);
        __syncthreads(); SWRITE(0);
        MLA_RESC(alB); __syncthreads();
        SBAR(); mla_qkt(pA0, pA1, K_lds, qr, r32, hi, -m_reg);
        mla_finishSM(pB0, pB1, alB, l_reg, pa0, pa1, pa2, pa3); SBAR();
        SLOAD(j + 2); SBAR();
        pv_one<0>(o0, vb0 + 8192, pa0, pa1, pa2, pa3); pv_one<1>(o1, vb0 + 8192, pa0, pa1, pa2, pa3); mla_partialSM(pA0, pA1, m_reg, alA, false);
        __syncthreads(); SWRITE(1);
        MLA_RESC(alA); __syncthreads();
    }
    SBAR(); mla_qkt(pB0, pB1, K_lds + 16384, qr, r32, hi, -m_reg);
    mla_finishSM(pA0, pA1, alA, l_reg, pa0, pa1, pa2, pa3); SBAR();
    pv_one<0>(o0, vb0, pa0, pa1, pa2, pa3); pv_one<1>(o1, vb0, pa0, pa1, pa2, pa3); mla_partialSM(pB0, pB1, m_reg, alB, false);
    __syncthreads(); MLA_RESC(alB);
    mla_finishSM(pB0, pB1, alB, l_reg, pa0, pa1, pa2, pa3); SBAR();
    pv_one<0>(o0, vb0 + 8192, pa0, pa1, pa2, pa3); pv_one<1>(o1, vb0 + 8192, pa0, pa1, pa2, pa3);
#undef MLA_RESC
    if (hi == 0) li_l[r32] = l_reg;
    asm volatile("s_waitcnt lgkmcnt(0)" ::: "memory");
    bf16_t* Ow = Ob + (size_t)(wid * 32) * ldo;
#pragma unroll
    for (int r = 0; r < 16; ++r) { const int orow = crow(r, hi); const float rl = __builtin_amdgcn_rcpf(li_l[orow]);
        Ow[(size_t)orow * ldo + r32] = f2bf(o0[r] * rl); Ow[(size_t)orow * ldo + 32 + r32] = f2bf(o1[r] * rl); }
    __syncthreads();
}

__device__ __forceinline__ void upproj_tile(const Params& p, int l, int tile, int part, char* lds) {
    const int tid = tidx(), lane = tid & 63, wid = tid >> 6, wm = wid >> 2, wn = wid & 3, fr = lane & 15, fq = lane >> 4;
    const int r0 = tile * 128; const bool ctx = row_is_ctx(r0); const int b = r0 >= TPB ? 1 : 0, t0 = r0 - b * TPB;
    float* rq = (float*)(lds + G_LDS); float* rkv = rq + 128;
    const bf16_t* P = WSP(bf16_t, OFF_P); bf16_t* Qo = WSP(bf16_t, OFF_Q); bf16_t* Ko = WSP(bf16_t, OFF_K); bf16_t* Vo = WSP(bf16_t, OFF_V);
    const float2* rope = WSP(float2, OFF_ROPE);
    __syncthreads();
    {
        const int row = tid >> 2, qd = tid & 3; const bf16_t* pr = P + (size_t)(r0 + row) * PLD;
        float sq = 0.f, sk = 0.f;
#pragma unroll
        for (int i = 0; i < 8; ++i) { const bf16x8 v = *(const bf16x8*)(pr + 768 + qd * 64 + i * 8);
#pragma unroll
            for (int e = 0; e < 8; ++e) { const float x = bf2f((bf16_t)v[e]); sq += x * x; } }
#pragma unroll
        for (int i = 0; i < 4; ++i) { const bf16x8 v = *(const bf16x8*)(pr + 1024 + qd * 32 + i * 8);
#pragma unroll
            for (int e = 0; e < 8; ++e) { const float x = bf2f((bf16_t)v[e]); sk += x * x; } }
        sq += __shfl_xor(sq, 1); sq += __shfl_xor(sq, 2); sk += __shfl_xor(sk, 1); sk += __shfl_xor(sk, 2);
        if (qd == 0) { rq[row] = rsqrtf(sq * (1.f / 256.f) + 1e-6f); rkv[row] = rsqrtf(sk * (1.f / 128.f) + 1e-6f); }
    }
    if (part == 0) for (int it = tid; it < 128 * 16; it += 512) {
        const int row = it >> 4, pi = it & 15; const bf16_t* pr = P + (size_t)(r0 + row) * PLD + 1152 + 2 * pi;
        float xe = bf2f(pr[0]), xo = bf2f(pr[1]);
        if (!ctx) { const int t = t0 + row; const int pos = pi < 8 ? (t >> 6) : (t & 63); const float2 cs = rope[pos * 8 + (pi & 7)];
            const float ne = xe * cs.x - xo * cs.y, no = xe * cs.y + xo * cs.x; xe = ne; xo = no; }
        const unsigned w = cvt_pk_bf16(xe, xo);
#pragma unroll
        for (int h = 0; h < 4; ++h) *(unsigned*)(Ko + (size_t)(r0 + row) * 384 + h * 96 + 64 + 2 * pi) = w;
    }
    __syncthreads();
    if (part < 3) { const int ct = part;
        const bf16_t* a0 = P + (size_t)(r0 + g_srow()) * PLD + 768 + g_skc() * 8; const bf16_t* a1 = a0 + (size_t)64 * PLD;
        const bf16_t* b0 = wts(p, l, WE_WUQ) + (size_t)(ct * 128 + g_srow()) * 256 + g_skc() * 8; const bf16_t* b1 = b0 + (size_t)64 * 256;
        f32x4 acc[4][2]; acc_zero(acc);
        mma_seg<1, 0>(acc, a0, a1, 0, b0, b1, 256, lds);
#pragma unroll
        for (int mt = 0; mt < 4; ++mt) { const int row = wm * 64 + mt * 16 + fr; const float rs = rq[row] * 0.14724260355f; const int t = t0 + row;
#pragma unroll
            for (int nt = 0; nt < 2; ++nt) { const int col = ct * 128 + wn * 32 + nt * 16 + fq * 4; const int dd = col % 96;
                float v0 = acc[mt][nt][0] * rs, v1 = acc[mt][nt][1] * rs, v2 = acc[mt][nt][2] * rs, v3 = acc[mt][nt][3] * rs;
                if (dd >= 64 && !ctx) { const int pi = (dd - 64) >> 1;
                    const int posa = pi < 8 ? (t >> 6) : (t & 63), posb = (pi + 1) < 8 ? (t >> 6) : (t & 63);
                    const float2 ca = rope[posa * 8 + (pi & 7)], cb = rope[posb * 8 + ((pi + 1) & 7)];
                    const float n0 = v0 * ca.x - v1 * ca.y, n1 = v0 * ca.y + v1 * ca.x, n2 = v2 * cb.x - v3 * cb.y, n3 = v2 * cb.y + v3 * cb.x; v0 = n0; v1 = n1; v2 = n2; v3 = n3; }
                u32x2 w; w.x = cvt_pk_bf16(v0, v1); w.y = cvt_pk_bf16(v2, v3);
                *(u32x2*)(Qo + (size_t)(r0 + row) * 384 + col) = w; } }
    }
    if (part >= 3) { const int ct = part - 3;
        const bf16_t* a0 = P + (size_t)(r0 + g_srow()) * PLD + 1024 + g_skc() * 8; const bf16_t* a1 = a0 + (size_t)64 * PLD;
        const bf16_t* b0 = wts(p, l, WE_WUKV) + (size_t)(ct * 128 + g_srow()) * 128 + g_skc() * 8; const bf16_t* b1 = b0 + (size_t)64 * 128;
        f32x4 acc[4][2]; acc_zero(acc);
        mma_seg<1, 0>(acc, a0, a1, 0, b0, b1, 128, lds);
#pragma unroll
        for (int mt = 0; mt < 4; ++mt) { const int row = wm * 64 + mt * 16 + fr; const float rs = rkv[row];
#pragma unroll
            for (int nt = 0; nt < 2; ++nt) { const int cc = wn * 32 + nt * 16 + fq * 4;
                u32x2 w; w.x = cvt_pk_bf16(acc[mt][nt][0] * rs, acc[mt][nt][1] * rs); w.y = cvt_pk_bf16(acc[mt][nt][2] * rs, acc[mt][nt][3] * rs);
                if (cc < 64) *(u32x2*)(Ko + (size_t)(r0 + row) * 384 + ct * 96 + cc) = w;
                else *(u32x2*)(Vo + (size_t)(r0 + row) * 256 + ct * 64 + (cc - 64)) = w; } }
    }
}
__device__ __forceinline__ float sconv_lat(const bf16_t* HT, const float* sw, int b, int ch, int n) {
    const bf16_t* r = HT + ((size_t)b * 1024 + ch) * TPB;
    const float um = n > 0 ? bf2f(r[n - 1]) : 0.f, u0 = bf2f(r[n]), up = n < SEQ - 1 ? bf2f(r[n + 1]) : 0.f;
    return sw[ch] * um + sw[768 + ch] * u0 + sw[1536 + ch] * up;
}
__device__ __forceinline__ float2 h2f(unsigned u) { return make_float2((float)__builtin_bit_cast(_Float16, (unsigned short)(u & 0xffffu)), (float)__builtin_bit_cast(_Float16, (unsigned short)(u >> 16))); }
__device__ __forceinline__ unsigned f2h(float2 v) { return __builtin_bit_cast(unsigned, __builtin_amdgcn_cvt_pkrtz(v.x, v.y)); }
__device__ __forceinline__ void hyena_unit(const Params& p, int l, int c, char* lds, const FFrag& FF) {
    float2* buf = (float2*)lds; const float2* thi = (const float2*)(lds + FFT_LDS_TAB); const float2* tlo = thi + 128; const float2* t2hi = thi + 256; const float2* t2lo = thi + 384;
    float* red = (float*)(lds + FFT_LDS_EXTRA);
    const bf16_t* HT = WSP(const bf16_t, OFF_HYFN); const float* sw = p.in[I_HYSW] + (size_t)l * 3 * 768;
    const bf16_t* FL = WSP(const bf16_t, OFF_FILT);
    const float d0 = -3.0701134573253945f, d1 = -15.350567286626973f;
    const float awin = fabsf(d0 + (float)c * ((d1 - d0) / 255.f)) * (1.f / 16383.f);
    unsigned* GS = WSP(unsigned, OFF_HYS) + (size_t)(bidx() & 255) * 65536; unsigned* YS = GS + 16384; unsigned* XS = YS + 16384;
    unsigned Zr[32];
#define HY_W2(n) cmulf(t2hi[(n) >> 7], t2lo[(n) & 127])
#define HY_ST(a, q, v) __hip_atomic_store((a) + (q), (v), __ATOMIC_RELAXED, __HIP_MEMORY_SCOPE_AGENT)
#define HY_LD(a, q) __hip_atomic_load((a) + (q), __ATOMIC_RELAXED, __HIP_MEMORY_SCOPE_AGENT)
    __syncthreads();
#pragma unroll 4
    for (int i = 0; i < 32; ++i) { const int n = tidx() + 512 * i; buf[FBI(n)] = make_float2(sconv_lat(HT, sw, 0, c, n), sconv_lat(HT, sw, 1, c, n)); }
#pragma unroll
    for (int i = 0; i < 32; ++i) Zr[i] = f2h(buf[FBI(tidx() + 512 * i)]);
#pragma unroll 1
    for (int order = 0; order < 2; ++order) {
        const bf16_t* ff = FL + (size_t)(order * 256 + c) * 16384; const bf16_t* fb = FL + (size_t)(512 + order * 256 + c) * 16384;
        float ss = 0.f;
#pragma unroll 4
        for (int i = 0; i < 32; ++i) { const int n = tidx() + 512 * i; const float win = __expf(-(float)n * awin); const float hf = bf2f(ff[n]) * win, hb = bf2f(fb[n]) * win; ss += hf * hf + (n ? hb * hb : 0.f);
            HY_ST(XS, n, f2h(make_float2(sconv_lat(HT, sw, 0, (order + 1) * 256 + c, n), sconv_lat(HT, sw, 1, (order + 1) * 256 + c, n)))); }
        const float tot = block_sum(ss, red);
        const float fac = rsqrtf(tot + 1e-6f) * (16.f / 32768.f);
        const float bias = p.in[I_HYBIAS][(size_t)l * 512 + order * 256 + c];
#pragma unroll 1
        for (int par = 0; par < 2; ++par) {
            __syncthreads();
#pragma unroll 8
            for (int i = 0; i < 32; ++i) { const int n = tidx() + 512 * i; const int nr = 16384 - n;
                const float hf = bf2f(ff[n]) * __expf(-(float)n * awin); const float hbr = n ? bf2f(fb[nr]) * __expf(-(float)nr * awin) : 0.f;
                float2 v; if (par == 0) v = make_float2(hf + hbr, 0.f); else { const float2 w = HY_W2(n); const float d = hf - hbr; v = make_float2(d * w.x, d * w.y); }
                buf[FBI(n)] = v; }
            __syncthreads();
            fft_fwd_blk(buf, FF, thi, tlo);
#pragma unroll 8
            for (int i = 0; i < 32; ++i) { const int q = tidx() + 512 * i; HY_ST(GS, q, f2h(buf[FBI(q)])); }
            __syncthreads();
#pragma unroll
            for (int i = 0; i < 32; ++i) { const int n = tidx() + 512 * i; float2 z = h2f(Zr[i]); z.x *= 0.0625f; z.y *= 0.0625f; if (par) z = cmulf(z, HY_W2(n)); buf[FBI(n)] = z; }
            __syncthreads();
            fft_fwd_blk(buf, FF, thi, tlo);
            asm volatile("s_waitcnt vmcnt(0)" ::: "memory");
#pragma unroll
            for (int hh = 0; hh < 2; ++hh) { unsigned g[16];
#pragma unroll
              for (int i = 0; i < 16; ++i) g[i] = HY_LD(GS, tidx() + 512 * (hh * 16 + i));
#pragma unroll
              for (int i = 0; i < 16; ++i) { const int q = tidx() + 512 * (hh * 16 + i); const float2 pr = cmulf(buf[FBI(q)], h2f(g[i])); buf[FBI(q)] = make_float2(pr.x * fac, pr.y * fac);        }
              __builtin_amdgcn_sched_barrier(0); }
            __syncthreads();
            fft_inv_blk(buf, FF, thi, tlo);
            if (par == 0) {
#pragma unroll 8
                for (int i = 0; i < 32; ++i) { const int q = tidx() + 512 * i; const float2 v = buf[FBI(q)]; HY_ST(YS, q, f2h(v)); }
            } else {
                asm volatile("s_waitcnt vmcnt(0)" ::: "memory");
#pragma unroll
                for (int hh = 0; hh < 2; ++hh) {
                    unsigned y[16], xg[16];
#pragma unroll
                    for (int i = 0; i < 16; ++i) { y[i] = HY_LD(YS, tidx() + 512 * (hh * 16 + i)); xg[i] = HY_LD(XS, tidx() + 512 * (hh * 16 + i)); }
#pragma unroll
                    for (int i = 0; i < 16; ++i) { const int n = tidx() + 512 * (hh * 16 + i); const float2 v = buf[FBI(n)];
                        const float2 t2 = cmulcf(v, HY_W2(n)); const float2 y0 = h2f(y[i]); const float2 z = h2f(Zr[hh * 16 + i]); const float2 g = h2f(xg[i]);
                        Zr[hh * 16 + i] = f2h(make_float2(g.x * (y0.x + t2.x + bias * z.x), g.y * (y0.y + t2.y + bias * z.y))); }
                    __builtin_amdgcn_sched_barrier(0);
                }
            }
        }
    }
#undef HY_W2
#undef HY_ST
#undef HY_LD
    bf16_t* OB = WSP(bf16_t, OFF_OBT);
#pragma unroll
    for (int i = 0; i < 32; ++i) { const int n = tidx() + 512 * i; const float2 z = h2f(Zr[i]); OB[((size_t)0 * 256 + c) * TPB + n] = f2bf(z.x); OB[((size_t)1 * 256 + c) * TPB + n] = f2bf(z.y); }
    __syncthreads();
}
__device__ __forceinline__ void fnet_unit(const Params& p, int c, char* lds, const FFrag& FF) {
    float2* buf = (float2*)lds; const float2* thi = (const float2*)(lds + FFT_LDS_TAB); const float2* tlo = thi + 128;
    const int tid = tidx();
    const bf16_t* HT = WSP(const bf16_t, OFF_HYFN); bf16_t* OC = WSP(bf16_t, OFF_OCT);
    const bf16_t* r0 = HT + ((size_t)0 * 1024 + 768 + c) * TPB; const bf16_t* r1 = HT + ((size_t)1 * 1024 + 768 + c) * TPB;
    if (DBG_FN_COPY) {
        for (int i = 0; i < 32; ++i) { const int n = tid + 512 * i; OC[((size_t)0 * 512 + c) * TPB + n] = r0[n]; OC[((size_t)0 * 512 + 256 + c) * TPB + n] = r1[n]; OC[((size_t)1 * 512 + c) * TPB + n] = r1[n]; OC[((size_t)1 * 512 + 256 + c) * TPB + n] = r0[n]; }
        return;
    }
    __syncthreads();
#pragma unroll 4
    for (int i = 0; i < 32; ++i) { const int n = tid + 512 * i; buf[FBI(n)] = make_float2(bf2f(r0[n]), bf2f(r1[n])); }
    __syncthreads();
    fft_fwd_blk(buf, FF, thi, tlo);
#pragma unroll 4
    for (int i = 0; i < 32; ++i) { const int k = tid + 512 * i; const int km = (16384 - k) & 16383; const float2 X = buf[(k & 127) * FRS + (k >> 7)], Xm = buf[(km & 127) * FRS + (km >> 7)];
        OC[((size_t)0 * 512 + c) * TPB + k] = f2bf(0.5f * (X.x + Xm.x)); OC[((size_t)0 * 512 + 256 + c) * TPB + k] = f2bf(0.5f * (X.y - Xm.y));
        OC[((size_t)1 * 512 + c) * TPB + k] = f2bf(0.5f * (X.y + Xm.y)); OC[((size_t)1 * 512 + 256 + c) * TPB + k] = f2bf(-0.5f * (X.x - Xm.x)); }
    __syncthreads();
}
__device__ __forceinline__ void hyena_ctx_unit(const Params& p, int l, int c, char* lds) {
    float* zs = (float*)lds;
    float* hfs = zs + 512; float* hbs = hfs + 256; float* w3s = hbs + 256; float* red = w3s + 128;
    const int tid = tidx(), b = tid >> 8, t = tid & 255;
    const bf16_t* HT = WSP(const bf16_t, OFF_HYFN); const float* sw = p.in[I_HYSW] + (size_t)l * 3 * 768;
    const float* H2 = WSP(const float, OFF_H2C) + (size_t)l * 256 * 64; const float* w3 = p.in[I_HYW3] + (size_t)l * 64 * 1024;
    const float d0 = -3.0701134573253945f, d1 = -15.350567286626973f;
    const float adelta = fabsf(d0 + (float)c * ((d1 - d0) / 255.f));
    auto sc = [&](int ch) { const bf16_t* r = HT + ((size_t)b * 1024 + ch) * TPB + SEQ;
        const float um = t > 0 ? bf2f(r[t - 1]) : 0.f, u0 = bf2f(r[t]), up = t < 255 ? bf2f(r[t + 1]) : 0.f; return sw[ch] * um + sw[768 + ch] * u0 + sw[1536 + ch] * up; };
    __syncthreads();
    float z = sc(c);
    zs[b * 256 + t] = z;
    for (int order = 0; order < 2; ++order) {
        __syncthreads();
        if (tid < 128) w3s[tid] = w3[(size_t)(tid & 63) * 1024 + (tid >> 6) * 512 + order * 256 + c];
        __syncthreads();
        float ss = 0.f;
        if (tid < 256) { const float* hr = H2 + (size_t)tid * 64; float sf = 0.f, sb = 0.f;
#pragma unroll 16
            for (int j = 0; j < 64; ++j) { sf += hr[j] * w3s[j]; sb += hr[j] * w3s[64 + j]; }
            const float win = __expf(-((float)tid * (1.f / 255.f)) * adelta); const float hf = sf * win, hb = sb * win;
            hfs[tid] = hf; hbs[tid] = hb; ss = hf * hf + (tid ? hb * hb : 0.f); }
        const float tot = block_sum(ss, red);
        const float scale = rsqrtf(tot + 1e-6f);
        __syncthreads();
        float y = 0.f;
        for (int s = 0; s <= t; ++s) y += hfs[t - s] * zs[b * 256 + s];
        for (int s = t + 1; s < 256; ++s) y += hbs[s - t] * zs[b * 256 + s];
        const float bias = p.in[I_HYBIAS][(size_t)l * 512 + order * 256 + c];
        const float g = sc((order + 1) * 256 + c);
        z = g * (y * scale + bias * z);
        __syncthreads();
        zs[b * 256 + t] = z;
    }
    WSP(bf16_t, OFF_OBT)[((size_t)b * 256 + c) * TPB + SEQ + t] = f2bf(z);
    __syncthreads();
}
__device__ __forceinline__ void fnet_ctx_unit(const Params& p, int c, char* lds) {
    float* us = (float*)lds; float* cs = us + 512;
    const int tid = tidx(), b = tid >> 8, k = tid & 255;
    const bf16_t* HT = WSP(const bf16_t, OFF_HYFN);
    __syncthreads();
    us[tid] = bf2f(HT[((size_t)b * 1024 + 768 + c) * TPB + SEQ + k]);
    if (tid < 256) { float s, cc; sincospif(2.f * (float)tid / 256.f, &s, &cc); cs[tid] = cc; cs[256 + tid] = s; }
    __syncthreads();
    float ur = 0.f, ui = 0.f;
    for (int n = 0; n < 256; ++n) { const int m = (k * n) & 255; const float u = us[b * 256 + n]; ur += u * cs[m]; ui -= u * cs[256 + m]; }
    bf16_t* OC = WSP(bf16_t, OFF_OCT);
    OC[((size_t)b * 512 + c) * TPB + SEQ + k] = f2bf(8.f * ur); OC[((size_t)b * 512 + 256 + c) * TPB + SEQ + k] = f2bf(8.f * ui);
    __syncthreads();
}
__device__ __forceinline__ void na_unit(const Params& p, int l, int u, char* lds) {
    const int b = u >> 8, h = (u >> 6) & 3, rb = u & 63, r0 = rb * 4;
    float* biasL = (float*)(lds + ATT_LDS);
    __syncthreads();
    for (int i = tidx(); i < 465; i += 512) biasL[i] = p.in[I_RPB][((size_t)l * 4 + h) * 465 + i] * 8.f;
    const bf16_t* P = WSP(const bf16_t, OFF_P);
    int lo = r0 - 4; lo = lo < 0 ? 0 : (lo > 248 ? 248 : lo);
    int hr = r0 + 3 - 4; hr = hr < 0 ? 0 : (hr > 248 ? 248 : hr); hr += 7;
    const int nloc = hr - lo + 1;
    const size_t tb = (size_t)b * TPB;
    attn_unit<64, 1>(P + (tb + r0 * 64) * PLD + h * 64, PLD, P + tb * PLD + 256 + h * 64, PLD, P + tb * PLD + 512 + h * 64, PLD,
                     WSP(bf16_t, OFF_OAD) + (tb + r0 * 64) * 512 + 256 + h * 64, 512, 4 + nloc, 4, SEQ, lo * 64, lds, biasL, r0, lo);
}
__device__ __forceinline__ void na_ctx_unit(const Params& p, int u, char* lds) {
    const int b = u >> 2, h = u & 3; const bf16_t* P = WSP(const bf16_t, OFF_P); const size_t tb = (size_t)b * TPB;
    attn_unit<64, 0>(P + (tb + SEQ) * PLD + h * 64, PLD, P + tb * PLD + 256 + h * 64, PLD, P + tb * PLD + 512 + h * 64, PLD,
                     WSP(bf16_t, OFF_OAD) + (tb + SEQ) * 512 + 256 + h * 64, 512, 4, 4, SEQ, 0, lds, nullptr, 0, 0);
}
PHASE_FN void ph_mixers(const Params& p, int l, char* lds_unused) {
    char* lds = lds_dyn; (void)lds_unused;
    const int bid = bidx(), G = gdim(); const bool upd_ctx = (l != NLAYER - 1);
    fft_tables(lds);
    { FFrag FF; mfft_frags(FF, (const float2*)(lds + FFT_LDS_TAB));
      for (int rep = 0; rep < (REP_PHASE == 31 ? 2 : 1); ++rep) for (int c = bid; c < 256; c += G) hyena_unit(p, l, c, lds, FF);
      for (int rep = 0; rep < (REP_PHASE == 32 ? 2 : 1); ++rep) for (int c = bid; c < 256; c += G) fnet_unit(p, c, lds, FF); }
    __syncthreads();
    if (upd_ctx) { for (int c = bid; c < 256; c += G) hyena_ctx_unit(p, l, c, lds);
                   for (int c = bid; c < 256; c += G) fnet_ctx_unit(p, c, lds); }
    for (int rep = 0; rep < (REP_PHASE == 33 ? 2 : 1); ++rep) for (int t = bid; t < NTILE * 7; t += G) upproj_tile(p, l, t / 7, t % 7, lds);
    __syncthreads();
    for (int rep = 0; rep < (REP_PHASE == 34 ? 2 : 1); ++rep) for (int u = bid; u < 512; u += G) na_unit(p, l, u, lds);
    if (upd_ctx) for (int u = bid; u < 8; u += G) na_ctx_unit(p, u, lds);
}

__device__ __forceinline__ void transp_unit(const Params& p, int u, char* lds) {
    const int tid = tidx(), rt = u / 12, cg = u % 12, r0 = rt * 128, b = r0 >= TPB ? 1 : 0, t0 = r0 - b * TPB;
    const bf16_t* src = cg < 4 ? WSP(const bf16_t, OFF_OBT) + ((size_t)b * 256 + cg * 64) * TPB + t0 : WSP(const bf16_t, OFF_OCT) + ((size_t)b * 512 + (cg - 4) * 64) * TPB + t0;
    bf16_t* dst = WSP(bf16_t, OFF_P) + (size_t)r0 * 768 + cg * 64;
    char* tl = lds;
    __syncthreads();
    { const int c = tid >> 3, sg = tid & 7; const u32x4 x0 = *(const u32x4*)(src + (size_t)c * TPB + sg * 16), x1 = *(const u32x4*)(src + (size_t)c * TPB + sg * 16 + 8);
      *(u32x4*)(tl + c * 272 + sg * 32) = x0; *(u32x4*)(tl + c * 272 + sg * 32 + 16) = x1; }
    __syncthreads();
    { const int t = tid >> 2, q = tid & 3; unsigned w[8];
#pragma unroll
      for (int i = 0; i < 8; ++i) { const unsigned lo = *(const bf16_t*)(tl + (q * 16 + 2 * i) * 272 + t * 2), hi = *(const bf16_t*)(tl + (q * 16 + 2 * i + 1) * 272 + t * 2); w[i] = lo | (hi << 16); }
      u32x4 y0 = {w[0], w[1], w[2], w[3]}, y1 = {w[4], w[5], w[6], w[7]};
      *(u32x4*)(dst + (size_t)t * 768 + q * 16) = y0; *(u32x4*)(dst + (size_t)t * 768 + q * 16 + 8) = y1; }
}
PHASE_FN void ph_mla(const Params& p, int l, char* lds_unused) {
    char* lds = lds_dyn; (void)lds_unused;
    const bool upd_ctx = (l != NLAYER - 1);
    const bf16_t* Q = WSP(const bf16_t, OFF_Q); const bf16_t* K = WSP(const bf16_t, OFF_K); const bf16_t* V = WSP(const bf16_t, OFF_V); bf16_t* O = WSP(bf16_t, OFF_OAD);
    if (upd_ctx) for (int u = bidx(); u < 8; u += gdim()) { const int b = u >> 2, h = u & 3; const size_t tb = (size_t)b * TPB;
        mla_unit(Q + (tb + SEQ) * 384 + h * 96, K + tb * 384 + h * 96, V + tb * 256 + h * 64, O + (tb + SEQ) * 512 + h * 64, 4, 4, SEQ, 0, lds); }
    for (int v = bidx() >> 3; v < 64; v += (gdim() >> 3)) { const int bh = bidx() & 7, b = bh >> 2, h = bh & 3, qb = v; const size_t tb = (size_t)b * TPB;
        mla_unit(Q + (tb + qb * 256) * 384 + h * 96, K + tb * 384 + h * 96, V + tb * 256 + h * 64, O + (tb + qb * 256) * 512 + h * 64, 260, 260, 0, 0, lds); }
    __syncthreads();
    for (int u = bidx(); u < NTILE * 12; u += gdim()) { if (skip_tile(l, u / 12)) continue; transp_unit(p, u, lds); }
    { const u32x4* Hs = WSP(const u32x4, OFF_H); u32x2* H8 = WSP(u32x2, OFF_HYS);
      for (int i = bidx() * 512 + tidx(); i < T * 128; i += gdim() * 512) { const u32x4 h = Hs[i]; u32x2 w; int t0 = 0, t1 = 0;
          t0 = __builtin_amdgcn_cvt_pk_fp8_f32(__uint_as_float(h.x << 16), __uint_as_float(h.x & 0xffff0000u), t0, false); t0 = __builtin_amdgcn_cvt_pk_fp8_f32(__uint_as_float(h.y << 16), __uint_as_float(h.y & 0xffff0000u), t0, true);
          t1 = __builtin_amdgcn_cvt_pk_fp8_f32(__uint_as_float(h.z << 16), __uint_as_float(h.z & 0xffff0000u), t1, false); t1 = __builtin_amdgcn_cvt_pk_fp8_f32(__uint_as_float(h.w << 16), __uint_as_float(h.w & 0xffff0000u), t1, true);
          w.x = (unsigned)t0; w.y = (unsigned)t1; H8[i] = w; } }
}

template <int FP8, int NKT>
__device__ __forceinline__ void gate4_stream(f32x4 (&ag)[4][4][2], const char* a0, const char* a1, const char* Wb, size_t nstride, int rowstride, int a_rd, int b_rd, char* lds) {
    const int wid = __builtin_amdgcn_readfirstlane(tidx() >> 6);
    LAS char* L = (LAS char*)lds_dyn + ((wid >> 1) * 2 + (wid & 1)) * 1024;
    const int srow = g_srow(), skc = g_skc();
    i32x8 A8[4], B8[2][2];
#pragma unroll
    for (int mt = 0; mt < 4; ++mt) A8[mt] = (i32x8)(0);
    B8[1][0] = (i32x8)(0); B8[1][1] = (i32x8)(0);
    auto issue_h = [&](int s, int h) { const int kt = s >> 2, n = s & 3; LAS char* Bb = L + 32768 + n * 16384 + h * 8192;
        int eo = srow * rowstride + skc * 16; asm volatile("" : "+v"(eo));
        eo += (kt << 7) + h * 64 * rowstride;
        const char* w = Wb + (size_t)n * nstride + (unsigned)eo;
        __builtin_amdgcn_global_load_lds((const unsigned*)(w), (LAS unsigned*)(Bb), 16, 0, 0);
        if (n == 0) { LAS char* Ab = L + (kt & 1) * 16384 + h * 8192; const char* hp = (h ? a1 : a0) + (kt << 7);
            __builtin_amdgcn_global_load_lds((const unsigned*)(hp), (LAS unsigned*)(Ab), 16, 0, 0); } };
    auto issue = [&](int s) { issue_h(s, 0); issue_h(s, 1); };
    auto ld8 = [&](const char* base) { const u32x4 lo = *(const u32x4*)(base), hi = *(const u32x4*)(base + 1024);
        return (i32x8){(int)lo.x, (int)lo.y, (int)lo.z, (int)lo.w, (int)hi.x, (int)hi.y, (int)hi.z, (int)hi.w}; };
    constexpr int SC1 = 0x7f7f7f7f, SCW = 0x79797979;
    auto mm = [&](f32x4 c, const i32x8& b, const i32x8& a) {
        if (FP8) return __builtin_amdgcn_mfma_scale_f32_16x16x128_f8f6f4(b, a, c, 0, 0, 0, SCW, 0, SC1);
        typedef int i32x4_ __attribute__((ext_vector_type(4)));
        const i32x4_ bl = __builtin_shufflevector(b, b, 0, 1, 2, 3), bh = __builtin_shufflevector(b, b, 4, 5, 6, 7), al = __builtin_shufflevector(a, a, 0, 1, 2, 3), ah = __builtin_shufflevector(a, a, 4, 5, 6, 7);
        c = __builtin_amdgcn_mfma_f32_16x16x32_bf16(__builtin_bit_cast(bf16x8, bl), __builtin_bit_cast(bf16x8, al), c, 0, 0, 0);
        return __builtin_amdgcn_mfma_f32_16x16x32_bf16(__builtin_bit_cast(bf16x8, bh), __builtin_bit_cast(bf16x8, ah), c, 0, 0, 0); };
    issue(0); issue(1); issue(2);
#define MG8_SUB(N, PV, COND, SN) do { const char* Bs_ = lds + 32768 + (N) * 16384 + b_rd;                                       \
        B8[(N) & 1][0] = ld8(Bs_); B8[(N) & 1][1] = ld8(Bs_ + 2048); if (COND) issue_h((SN), 0); SB();                          \
        _Pragma("unroll") for (int mt = 0; mt < 4; ++mt) {                                                                     \
            _Pragma("unroll") for (int nt = 0; nt < 2; ++nt) ag[PV][mt][nt] = mm(ag[PV][mt][nt], B8[((N) & 1) ^ 1][nt], A8[mt]);  \
            if ((N) == 0) A8[mt] = ld8(As + a_rd + mt * 2048); }                                                               \
        if (COND) issue_h((SN), 1); SB(); } while (0)
#define MG8_KT(LASTK) do { const char* As = lds + (kt & 1) * 16384;                                                            \
        G_WAITV(4); __builtin_amdgcn_s_barrier(); asm volatile("" ::: "memory");                                               \
        MG8_SUB(0, 3, true, 4 * kt + 3);                                                                                       \
        G_WAITV(4); __builtin_amdgcn_s_barrier(); asm volatile("" ::: "memory");                                               \
        MG8_SUB(1, 0, !(LASTK), 4 * kt + 4);                                                                                   \
        if (!(LASTK)) G_WAITV(6); else G_WAITV(2);                                                                             \
        __builtin_amdgcn_s_barrier(); asm volatile("" ::: "memory");                                                           \
        MG8_SUB(2, 1, !(LASTK), 4 * kt + 5);                                                                                   \
        if (!(LASTK)) G_WAITV(6); else G_WAITV(0);                                                                             \
        __builtin_amdgcn_s_barrier(); asm volatile("" ::: "memory");                                                           \
        MG8_SUB(3, 2, !(LASTK), 4 * kt + 6); } while (0)
    int kt = 0;
#pragma unroll 1
    for (; kt < NKT - 1; ++kt) MG8_KT(false);
    MG8_KT(true);
#undef MG8_KT
#undef MG8_SUB
#pragma unroll
    for (int mt = 0; mt < 4; ++mt)
#pragma unroll
        for (int nt = 0; nt < 2; ++nt) ag[3][mt][nt] = mm(ag[3][mt][nt], B8[1][nt], A8[mt]);
    __syncthreads();
}

__device__ __forceinline__ void merge_unit(const Params& p, int l, int rt, int ct, char* lds) {
    const int tid = tidx(), lane = tid & 63, wid = __builtin_amdgcn_readfirstlane(tid >> 6), wm = wid >> 2, wn = wid & 3, fr = lane & 15, fq = lane >> 4;
    const int a_rd = g_lds_byte(wm * 64 + fr, fq * 8), b_rd = g_lds_byte(wn * 32 + fr, fq * 8);
    const int r0 = rt * 128, n0 = ct * 128;
    LAS char* L = (LAS char*)lds_dyn + ((wid >> 1) * 2 + (wid & 1)) * 1024;
    const int srow = g_srow(), skc = g_skc();
    GFrag f0, f1;
    unsigned gp[4][4][2][2];
    {
        const char* Hb = WSP(const char, OFF_HYS) + (size_t)(r0 + srow) * 1024 + skc * 16;
        const char* Wb = (const char*)wts(p, l, WE_WGT) + (size_t)n0 * 1024;
        f32x4 ag[4][4][2];
#pragma unroll
        for (int n = 0; n < 4; ++n) acc_zero(ag[n]);
        gate4_stream<1, 8>(ag, Hb, Hb + (size_t)64 * 1024, Wb, (size_t)1024 * 1024, 1024, a_rd, b_rd, lds);
#pragma unroll
        for (int n = 0; n < 4; ++n) {
#pragma unroll
            for (int mt = 0; mt < 4; ++mt) {
#pragma unroll
                for (int nt = 0; nt < 2; ++nt) { gp[n][mt][nt][0] = cvt_pk_bf16(sigmoid_f(ag[n][mt][nt][0]), sigmoid_f(ag[n][mt][nt][1])); gp[n][mt][nt][1] = cvt_pk_bf16(sigmoid_f(ag[n][mt][nt][2]), sigmoid_f(ag[n][mt][nt][3]));
                    asm volatile("" : "+v"(gp[n][mt][nt][0]), "+v"(gp[n][mt][nt][1])); }
            }
        }
    }
    SB();
    f32x4 am[4][2], ap[4][2]; acc_zero(am); acc_zero(ap);
    {
        const bf16_t* OAD = WSP(const bf16_t, OFF_OAD); const bf16_t* OBC = WSP(const bf16_t, OFF_P);
        auto issue = [&](int s) { const bf16_t* a; const bf16_t* b; unsigned as, bs; int k0;
            int so = srow, sk = skc * 8; asm volatile("" : "+v"(so), "+v"(sk));
            if (s < 4)       { k0 = (s << 6) + sk;        a = OAD + (unsigned)((r0 + so) * 512 + k0);       as = 64 * 512; b = wts(p, l, WE_WBA) + (unsigned)((n0 + so) * 256 + k0); bs = 64 * 256; }
            else if (s < 8)  { k0 = ((s - 4) << 6) + sk;  a = OBC + (unsigned)((r0 + so) * 768 + k0);       as = 64 * 768; b = wts(p, l, WE_WBB) + (unsigned)((n0 + so) * 256 + k0); bs = 64 * 256; }
            else if (s < 16) { k0 = ((s - 8) << 6) + sk;  a = OBC + (unsigned)((r0 + so) * 768 + 256 + k0); as = 64 * 768; b = wts(p, l, WE_WBC) + (unsigned)((n0 + so) * 512 + k0); bs = 64 * 512; }
            else             { k0 = ((s - 16) << 6) + sk; a = OAD + (unsigned)((r0 + so) * 512 + 256 + k0); as = 64 * 512; b = wts(p, l, WE_WBD) + (unsigned)((n0 + so) * 256 + k0); bs = 64 * 256; }
            LAS char* Lb = L + (s & 3) * G_STAGE;
            __builtin_amdgcn_global_load_lds((const unsigned*)(a), (LAS unsigned*)(Lb), 16, 0, 0);
            __builtin_amdgcn_global_load_lds((const unsigned*)(a + as), (LAS unsigned*)(Lb + 8192), 16, 0, 0);
            __builtin_amdgcn_global_load_lds((const unsigned*)(b), (LAS unsigned*)(Lb + G_TILE), 16, 0, 0);
            __builtin_amdgcn_global_load_lds((const unsigned*)(b + bs), (LAS unsigned*)(Lb + G_TILE + 8192), 16, 0, 0); };
        auto combine = [&](const unsigned (&g)[4][2][2]) {
#pragma unroll
            for (int mt = 0; mt < 4; ++mt)
#pragma unroll
                for (int nt = 0; nt < 2; ++nt) {
                    const unsigned g0 = g[mt][nt][0], g1 = g[mt][nt][1];
                    am[mt][nt][0] += __uint_as_float(g0 << 16) * ap[mt][nt][0]; am[mt][nt][1] += __uint_as_float(g0 & 0xffff0000u) * ap[mt][nt][1];
                    am[mt][nt][2] += __uint_as_float(g1 << 16) * ap[mt][nt][2]; am[mt][nt][3] += __uint_as_float(g1 & 0xffff0000u) * ap[mt][nt][3];
                    ap[mt][nt] = (f32x4){0.f, 0.f, 0.f, 0.f};
                    asm volatile("" : "+v"(am[mt][nt])); } };
        gf_zero(f1);
        issue(0); issue(1); issue(2);
        int s = 0;
#pragma unroll
        for (int n = 0; n < 4; ++n) {
            const int send = n == 0 ? 4 : n == 1 ? 8 : n == 2 ? 16 : 20;
#pragma unroll 1
            for (; s < send; ++s) {
                if (s + 2 < 20) G_WAITV(8); else if (s + 1 < 20) G_WAITV(4); else G_WAITV(0);
                __builtin_amdgcn_s_barrier(); asm volatile("" ::: "memory");
                if (s + 3 < 20) issue(s + 3);
                const char* As = lds + (s & 3) * G_STAGE;
                GF_STAGE(ap, ap, As, As + G_TILE);
            }
            gf_mma(ap, f1); SB();
            combine(gp[n]); gf_zero(f1); SB();
        }
        __syncthreads();
    }
    bf16_t* M = WSP(bf16_t, OFF_HYFN);
    const int t2 = tidx(), w2 = t2 >> 6, l2 = t2 & 63;
    int so = (r0 + (w2 >> 2) * 64 + (l2 & 15)) * 1024 + n0 + (w2 & 3) * 32 + (l2 >> 4) * 4;
#pragma unroll
    for (int mt = 0; mt < 4; ++mt)
#pragma unroll
        for (int nt = 0; nt < 2; ++nt) {
            u32x2 w; w.x = cvt_pk_bf16(am[mt][nt][0], am[mt][nt][1]); w.y = cvt_pk_bf16(am[mt][nt][2], am[mt][nt][3]);
            *(u32x2*)(M + (unsigned)(so + mt * 16 * 1024 + nt * 16)) = w; }
    SB();
}
PHASE_FN void ph_merge(const Params& p, int l, char* lds_unused) {
    char* lds = lds_dyn; (void)lds_unused;
    for (int u = bidx(); u < NTILE * 8; u += gdim()) {
        const int rt = u >> 3, ct = u & 7; if (skip_tile(l, rt)) continue;
        merge_unit(p, l, rt, ct, lds);
    }
}

PHASE_FN void ph_wout(const Params& p, int l, char* lds_unused) {
    char* lds = lds_dyn; (void)lds_unused;
    const int tid = tidx(), lane = tid & 63, wid = tid >> 6, wm = wid >> 2, wn = wid & 3, fr = lane & 15, fq = lane >> 4;
    const int a_rd = g_lds_byte(wm * 64 + fr, fq * 8), b_rd = g_lds_byte(wn * 32 + fr, fq * 8);
    const bf16_t* M = WSP(const bf16_t, OFF_HYFN);
    auto epi = [&](const f32x4 (&acc)[4][2], int r0, int n0) {
        const float* gt = modvec(p, l, r0) + 2048;
#pragma unroll
        for (int mt = 0; mt < 4; ++mt) { const int row = r0 + wm * 64 + mt * 16 + fr; const float* xs = (l == 0) ? xrow_in(p, row) : xrow_st(p, row); float* xd = xrow_st(p, row);
#pragma unroll
            for (int nt = 0; nt < 2; ++nt) { const int col = n0 + wn * 32 + nt * 16 + fq * 4; const f32x4 x = *(const f32x4*)(xs + col), g = *(const f32x4*)(gt + col);
                f32x4 o; o[0] = x[0] + g[0] * acc[mt][nt][0]; o[1] = x[1] + g[1] * acc[mt][nt][1]; o[2] = x[2] + g[2] * acc[mt][nt][2]; o[3] = x[3] + g[3] * acc[mt][nt][3];
                if (DBG_NO_MIX) o = x;
                *(f32x4*)(xd + col) = o; } } };
    for (int u = bidx(); u < 512; u += gdim()) {
        const int lt = u >> 1, half = u & 1, rt = lt + (lt >> 7) * 2, r0 = rt * 128;
        const char* a0 = (const char*)(M + (size_t)(r0 + g_srow()) * 1024 + g_skc() * 8);
        const char* Wb = (const char*)(wts(p, l, WE_WOUT) + (size_t)half * 512 * 1024);
        f32x4 ag[4][4][2];
#pragma unroll
        for (int n = 0; n < 4; ++n) acc_zero(ag[n]);
        gate4_stream<0, 16>(ag, a0, a0 + (size_t)64 * 2048, Wb, (size_t)128 * 2048, 2048, a_rd, b_rd, lds);
#pragma unroll
        for (int n = 0; n < 4; ++n) epi(ag[n], r0, half * 512 + n * 128);
    }
    if (l != NLAYER - 1) for (int u = bidx(); u < 32; u += gdim()) {
        const int rt = 128 + (u >> 4) * 130 + ((u >> 3) & 1), ct = u & 7, r0 = rt * 128, n0 = ct * 128;
        const bf16_t* a0 = M + (size_t)(r0 + g_srow()) * 1024 + g_skc() * 8; const bf16_t* b0 = wts(p, l, WE_WOUT) + (size_t)(n0 + g_srow()) * 1024 + g_skc() * 8;
        f32x4 acc[4][2]; acc_zero(acc);
        mma_seg<1, 0>(acc, a0, a0 + (size_t)64 * 1024, 0, b0, b0 + (size_t)64 * 1024, 1024, lds);
        epi(acc, r0, n0);
    }
}

__device__ __forceinline__ int* moe_sched(const Params& p, int l, char* lds) {
    int* s = (int*)(lds + G_LDS);
    __syncthreads();
    if (tidx() == 0) { int acc = 0; for (int i = 0; i < 24; ++i) { const int c = WSP(const int, OFF_CNT)[l * 32 + i]; s[32 + i] = c; s[i] = acc; acc += (c + 127) >> 7; } s[24] = acc; }
    __syncthreads();
    return s;
}
__device__ __forceinline__ void moe_decode(const int* s, int tg, int& pid, int& tl, int& cnt) {
    pid = 0;
    for (int i = 1; i < 24; ++i) if (tg >= s[i]) pid = i;
    tl = tg - s[pid]; cnt = s[32 + pid];
}
__device__ __forceinline__ void pair_experts(int pid, int& elo, int& ehi) { const int g = pid / 6, pi = pid % 6; const int lo = pi < 3 ? 0 : (pi < 5 ? 1 : 2); const int hi = pi < 3 ? pi + 1 : (pi < 5 ? pi - 1 : 3); elo = g * 4 + lo; ehi = g * 4 + hi; }
PHASE_FN void ph_moe1(const Params& p, int l, char* lds_unused) {
    char* lds = lds_dyn; (void)lds_unused;
    const int tid = tidx(), lane = tid & 63, wid = tid >> 6, wm = wid >> 2, wn = wid & 3, fr = lane & 15, fq = lane >> 4;
    const int a_rd = g_lds_byte(wm * 64 + fr, fq * 8), b_rd = g_lds_byte(wn * 32 + fr, fq * 8);
    const int* s = moe_sched(p, l, lds);
    const bf16_t* H = WSP(const bf16_t, OFF_H); bf16_t* ACT = WSP(bf16_t, OFF_P); const int* lists = WSP(const int, OFF_LISTS); const float* tokw = WSP(const float, OFF_TOKW);
    const int ntiles = s[24];
    const int U = ntiles * 2, UF = (U >> 8) << 8;
    for (int u = bidx(); u < UF; u += gdim()) {
        const int tg = u >> 1, half = u & 1; int pid, tl, cnt; moe_decode(s, tg, pid, tl, cnt); int elo, ehi; pair_experts(pid, elo, ehi);
        const int e = half ? ehi : elo;
        const int* lst = lists + (size_t)pid * T;
        auto tok = [&](int rowi) { const int sl = tl * 128 + rowi; return lst[sl < cnt ? sl : 0]; };
        const char* a0 = (const char*)(H + (size_t)tok(g_srow()) * 1024 + g_skc() * 8); const char* a1 = (const char*)(H + (size_t)tok(g_srow() + 64) * 1024 + g_skc() * 8);
        const char* Wb = (const char*)(wts(p, l, WE_WGU) + (size_t)e * 512 * 1024);
        f32x4 ag[4][4][2];
#pragma unroll
        for (int n = 0; n < 4; ++n) acc_zero(ag[n]);
        gate4_stream<0, 16>(ag, a0, a1, Wb, (size_t)128 * 1024 * 2, 2048, a_rd, b_rd, lds);
#pragma unroll
        for (int tt = 0; tt < 4; ++tt)
#pragma unroll
            for (int mt = 0; mt < 4; ++mt) { const int rowi = wm * 64 + mt * 16 + fr; const float w = tokw[(size_t)tok(rowi) * 2 + half];
                float o[4];
#pragma unroll
                for (int j = 0; j < 4; ++j) o[j] = silu_f(ag[tt][mt][0][j]) * ag[tt][mt][1][j] * w;
                u32x2 pk; pk.x = cvt_pk_bf16(o[0], o[1]); pk.y = cvt_pk_bf16(o[2], o[3]);
                *(u32x2*)(ACT + (size_t)(tg * 128 + rowi) * 512 + half * 256 + tt * 64 + wn * 16 + fq * 4) = pk; }
    }
    for (int v = bidx(); v < (U - UF) * 4; v += gdim()) {
        const int tid = tidx(), lane = tid & 63, wid = tid >> 6, wm = wid >> 2, wn = wid & 3, fr = lane & 15, fq = lane >> 4;
        const int u4 = UF + (v >> 2), tt = v & 3, tg = u4 >> 1, half = u4 & 1; int pid, tl, cnt; moe_decode(s, tg, pid, tl, cnt); int elo, ehi; pair_experts(pid, elo, ehi);
        const int e = half ? ehi : elo;
        const int* lst = lists + (size_t)pid * T;
        auto tok = [&](int rowi) { const int sl = tl * 128 + rowi; return lst[sl < cnt ? sl : 0]; };
        const bf16_t* a0 = H + (size_t)tok(g_srow()) * 1024 + g_skc() * 8; const bf16_t* a1 = H + (size_t)tok(g_srow() + 64) * 1024 + g_skc() * 8;
        const bf16_t* b0 = wts(p, l, WE_WGU) + ((size_t)e * 512 + tt * 128 + g_srow()) * 1024 + g_skc() * 8;
        f32x4 acc[4][2]; acc_zero(acc);
        mma_seg<1, 0>(acc, a0, a1, 0, b0, b0 + (size_t)64 * 1024, 1024, lds);
#pragma unroll
        for (int mt = 0; mt < 4; ++mt) { const int rowi = wm * 64 + mt * 16 + fr; const float w = tokw[(size_t)tok(rowi) * 2 + half];
            float o[4];
#pragma unroll
            for (int j = 0; j < 4; ++j) o[j] = silu_f(acc[mt][0][j]) * acc[mt][1][j] * w;
            u32x2 pk; pk.x = cvt_pk_bf16(o[0], o[1]); pk.y = cvt_pk_bf16(o[2], o[3]);
            *(u32x2*)(ACT + (size_t)(tg * 128 + rowi) * 512 + half * 256 + tt * 64 + wn * 16 + fq * 4) = pk; }
    }
}
PHASE_FN void ph_moe2(const Params& p, int l, char* lds_unused) {
    char* lds = lds_dyn; (void)lds_unused;
    const int tid = tidx(), lane = tid & 63, wid = tid >> 6, wm = wid >> 2, wn = wid & 3, fr = lane & 15, fq = lane >> 4;
    const int* s = moe_sched(p, l, lds);
    const bf16_t* ACT = WSP(const bf16_t, OFF_P); const int* lists = WSP(const int, OFF_LISTS);
    const int ntiles = s[24];
    for (int u = bidx(); u < ntiles * 8; u += gdim()) {
        const int tg = u >> 3, ct = u & 7; int pid, tl, cnt; moe_decode(s, tg, pid, tl, cnt); int elo, ehi; pair_experts(pid, elo, ehi);
        const int* lst = lists + (size_t)pid * T;
        f32x4 acc[4][2]; acc_zero(acc);
        { const bf16_t* a0 = ACT + (size_t)(tg * 128 + g_srow()) * 512 + g_skc() * 8; const bf16_t* b0 = wts(p, l, WE_WDN) + ((size_t)elo * 1024 + ct * 128 + g_srow()) * 256 + g_skc() * 8;
          mma_seg<1, 0>(acc, a0, a0 + (size_t)64 * 512, 0, b0, b0 + (size_t)64 * 256, 256, lds); }
        { const bf16_t* a0 = ACT + (size_t)(tg * 128 + g_srow()) * 512 + 256 + g_skc() * 8; const bf16_t* b0 = wts(p, l, WE_WDN) + ((size_t)ehi * 1024 + ct * 128 + g_srow()) * 256 + g_skc() * 8;
          mma_seg<1, 0>(acc, a0, a0 + (size_t)64 * 512, 0, b0, b0 + (size_t)64 * 256, 256, lds); }
#pragma unroll
        for (int mt = 0; mt < 4; ++mt) { const int sl = tl * 128 + wm * 64 + mt * 16 + fr;
            if (sl < cnt) { const int r = lst[sl]; float* xd = xrow_st(p, r); const float* gt = modvec(p, l, r) + 5120;
#pragma unroll
                for (int nt = 0; nt < 2; ++nt) { const int col = ct * 128 + wn * 32 + nt * 16 + fq * 4; const f32x4 x = *(const f32x4*)(xd + col), g = *(const f32x4*)(gt + col);
                    f32x4 o; o[0] = x[0] + g[0] * acc[mt][nt][0]; o[1] = x[1] + g[1] * acc[mt][nt][1]; o[2] = x[2] + g[2] * acc[mt][nt][2]; o[3] = x[3] + g[3] * acc[mt][nt][3];
                    if (DBG_NO_MOE) o = x;
                    *(f32x4*)(xd + col) = o; } } }
    }
}

PHASE_FN void ph_final(const Params& p) {
    const int wid = tidx() >> 6, lane = tidx() & 63; const float* g = p.in[I_FNG];
    for (int r = bidx() * 8 + wid; r < 2 * SEQ; r += gdim() * 8) {
        float* xr = p.out + (size_t)r * D; f32x4 v[4]; float ss = 0.f;
#pragma unroll
        for (int i = 0; i < 4; ++i) { v[i] = *(const f32x4*)(xr + i * 256 + lane * 4); ss += v[i][0] * v[i][0] + v[i][1] * v[i][1] + v[i][2] * v[i][2] + v[i][3] * v[i][3]; }
        ss = wave_sum(ss); const float rinv = rsqrtf(ss * (1.f / 1024.f) + 1e-6f);
#pragma unroll
        for (int i = 0; i < 4; ++i) { const f32x4 gg = *(const f32x4*)(g + i * 256 + lane * 4); f32x4 o; o[0] = v[i][0] * rinv * gg[0]; o[1] = v[i][1] * rinv * gg[1]; o[2] = v[i][2] * rinv * gg[2]; o[3] = v[i][3] * rinv * gg[3];
            *(f32x4*)(xr + i * 256 + lane * 4) = o; }
    }
}

__device__ __forceinline__ void ph_dbgcmp(const Params& p, size_t oa, size_t ob, int slot) {
    const u32x4* a = WSP(const u32x4, oa); const u32x4* b = WSP(const u32x4, ob); int bad = 0;
    const size_t n = (size_t)2 * 1024 * TPB * 2 / 16;
    for (size_t i = (size_t)bidx() * 512 + tidx(); i < n; i += (size_t)gdim() * 512) { const u32x4 x = a[i], y = b[i]; if (x.x != y.x || x.y != y.y || x.z != y.z || x.w != y.w) bad = 1; }
    if (bad) atomicAdd(WSP(int, OFF_CNT) + slot, 1);
}
constexpr int LDS_BYTES = 150 * 1024;
template <int PH>
__global__ void __launch_bounds__(512) k_phase(Params p, int l) {
    char* lds = lds_dyn;
    if (PH == 0) ph_prologue(p, lds);
    if (PH == 1) { ph_wconv(p, l, lds); __syncthreads(); ph_filt(p, l, lds); __syncthreads(); ph_norm<0>(p, l, lds); }
    if (PH == 2) ph_gemm1(p, l, lds);
    if (PH == 3) ph_mixers(p, l, lds);
    if (PH == 4) ph_mla(p, l, lds);
    if (PH == 5) ph_merge(p, l, lds);
    if (PH == 6) ph_wout(p, l, lds);
    if (PH == 7) ph_norm<1>(p, l, lds);
    if (PH == 8) ph_moe1(p, l, lds);
    if (PH == 9) ph_moe2(p, l, lds);
    if (PH == 10) ph_final(p);
}

#if ONE_LAUNCH
__global__ void __launch_bounds__(512) k_fused(Params p0) {
    char* lds = lds_dyn;
    volatile LAS unsigned* xbw = (volatile LAS unsigned*)(lds + LDS_BYTES - 16);
    if (threadIdx.x == 0) { xbw[0] = 0u; xbw[1] = 0u; xbw[2] = 0u; xbw[3] = 0u; }
    __syncthreads();
    (void)xcd_barrier_post((unsigned*)(p0.ws + OFF_BAR), xbw);
#define PQ() ({ Params q_ = p0; asm volatile("" : "+s"(q_.ws)); q_; })
#define GRID_BARRIER() do { XcdBarrier bar_; bar_.bar = (unsigned*)(p0.ws + OFF_BAR); bar_.x = xb_xcc_id(); bar_.st = (volatile LAS unsigned*)(lds_dyn + LDS_BYTES - 16); xcd_barrier(bar_); } while (0)
    asm volatile("; PHASE_MARK 0" ::: "memory"); ph_prologue(PQ(), lds);
    if (REP_PHASE == 100) { GRID_BARRIER(); ph_prologue(PQ(), lds); }
    GRID_BARRIER();
#pragma unroll
    for (int l = 0; l < NLAYER; ++l) {
        asm volatile("; PHASE_MARK 1" ::: "memory"); ph_wconv(PQ(), l, lds); __syncthreads(); ph_filt(PQ(), l, lds); __syncthreads(); ph_norm<0>(PQ(), l, lds);
        GRID_BARRIER();
        if (REP_PHASE == 1) { ph_wconv(PQ(), l, lds); __syncthreads(); ph_norm<0>(PQ(), l, lds); GRID_BARRIER(); }
        asm volatile("; PHASE_MARK 2" ::: "memory"); ph_gemm1(PQ(), l, lds);
        GRID_BARRIER();
        if (REP_PHASE == 2) { ph_gemm1(PQ(), l, lds); GRID_BARRIER(); }

        asm volatile("; PHASE_MARK 3" ::: "memory"); ph_mixers(PQ(), l, lds);
        GRID_BARRIER();
        if (REP_PHASE == 3) { ph_mixers(PQ(), l, lds); GRID_BARRIER(); }
        asm volatile("; PHASE_MARK 4" ::: "memory"); ph_mla(PQ(), l, lds);
        GRID_BARRIER();
        if (REP_PHASE == 4) { ph_mla(PQ(), l, lds); GRID_BARRIER(); }
        asm volatile("; PHASE_MARK 5" ::: "memory"); ph_merge(PQ(), l, lds);
        GRID_BARRIER();
        if (REP_PHASE == 5) { ph_merge(PQ(), l, lds); GRID_BARRIER(); }
        asm volatile("; PHASE_MARK 6" ::: "memory"); ph_wout(PQ(), l, lds);
        GRID_BARRIER();
        if (REP_PHASE == 6 && l == 0) { ph_wout(PQ(), l, lds); GRID_BARRIER(); }
        asm volatile("; PHASE_MARK 7" ::: "memory"); ph_norm<1>(PQ(), l, lds);
        GRID_BARRIER();
        if (REP_PHASE == 7) { ph_norm<2>(PQ(), l, lds); GRID_BARRIER(); }
        asm volatile("; PHASE_MARK 8" ::: "memory"); ph_moe1(PQ(), l, lds);
        GRID_BARRIER();
        if (REP_PHASE == 8) { ph_moe1(PQ(), l, lds); GRID_BARRIER(); }
        asm volatile("; PHASE_MARK 9" ::: "memory"); ph_moe2(PQ(), l, lds);
        GRID_BARRIER();
    }
    asm volatile("; PHASE_MARK 10" ::: "memory"); ph_final(PQ());
}
#endif
template <int PH> static void launch_phase(const Params& p, int l, int grid, hipStream_t stream) {
    static bool attr = false;
    if (!attr) { hipFuncSetAttribute((const void*)k_phase<PH>, hipFuncAttributeMaxDynamicSharedMemorySize, LDS_BYTES); attr = true; }
    hipLaunchKernelGGL(k_phase<PH>, dim3(grid), dim3(512), LDS_BYTES, stream, p, l);
}

extern "C" void kernel_launch(void* const* d_in, const int* in_sizes, int n_in, void* d_out, int out_size, void* d_ws, size_t ws_size, hipStream_t stream) {
    if (n_in != 33 || ws_size < WS_TOTAL || out_size != 2 * SEQ * D) { fprintf(stderr, "kernel_launch: unexpected shapes: n_in %d ws %zu (need %zu) out %d\n", n_in, ws_size, WS_TOTAL, out_size); return; }
    Params p{};
    for (int i = 0; i < 33; ++i) p.in[i] = (const float*)d_in[i];
    p.out = (float*)d_out; p.ws = (unsigned char*)d_ws;
    hipMemsetAsync(d_ws, 0, ZERO_BYTES, stream);
#if ONE_LAUNCH
    static int grid1 = 0;
    if (!grid1) {
        int dev = 0, cus = 0, per_cu = 0;
        hipGetDevice(&dev); hipDeviceGetAttribute(&cus, hipDeviceAttributeMultiprocessorCount, dev);
        hipFuncSetAttribute((const void*)k_fused, hipFuncAttributeMaxDynamicSharedMemorySize, LDS_BYTES);
        hipOccupancyMaxActiveBlocksPerMultiprocessor(&per_cu, k_fused, 512, LDS_BYTES);
        if (per_cu < 1 || cus < 256) { fprintf(stderr, "kernel_launch: cannot make the grid resident (cus %d, blocks/cu %d)\n", cus, per_cu); return; }
        grid1 = 256;
    }
    hipLaunchKernelGGL(k_fused, dim3(grid1), dim3(512), LDS_BYTES, stream, p);
    { const hipError_t le = hipPeekAtLastError(); if (le != hipSuccess) fprintf(stderr, "kernel_launch: launch failed: %s\n", hipGetErrorName(le)); }
    return;
#endif
    const int grid = 256;
    launch_phase<0>(p, 0, grid, stream);
    for (int l = 0; l < NLAYER; ++l) {
        launch_phase<1>(p, l, grid, stream);
        launch_phase<2>(p, l, grid, stream);
        launch_phase<3>(p, l, grid, stream);
        launch_phase<4>(p, l, grid, stream);
        launch_phase<5>(p, l, grid, stream);
        launch_phase<6>(p, l, grid, stream);
        launch_phase<7>(p, l, grid, stream);
        launch_phase<8>(p, l, grid, stream);
        launch_phase<9>(p, l, grid, stream);
    }
    launch_phase<10>(p, 0, grid, stream);
    const hipError_t le = hipPeekAtLastError();
    if (le != hipSuccess) fprintf(stderr, "kernel_launch: launch failed: %s\n", hipGetErrorName(le));
}
```

```cpp
#include <hip/hip_runtime.h>
#include <cstdio>
#include <cstdint>

#ifndef ONE_LAUNCH
#define ONE_LAUNCH 1
#endif
#ifndef REP_PHASE
#define REP_PHASE 0
#endif
#ifndef DBG_NO_MIX
#define DBG_NO_MIX 0
#endif
#ifndef DBG_BR
#define DBG_BR 15
#endif
#ifndef DBG_FN_COPY
#define DBG_FN_COPY 0
#endif
#ifndef DBG_NO_MOE
#define DBG_NO_MOE 0
#endif

constexpr int D = 1024, SEQ = 16384, NCTX = 256, TPB = SEQ + NCTX, T = 2 * TPB, NLAYER = 2;
constexpr int NTILE = T / 128;
constexpr int PLD = 1280;
constexpr int IN_W = 6304;

typedef unsigned short bf16_t;
typedef short bf16x8 __attribute__((ext_vector_type(8)));
typedef short s16x4 __attribute__((ext_vector_type(4)));
typedef float f32x4 __attribute__((ext_vector_type(4)));
typedef float f32x16 __attribute__((ext_vector_type(16)));
typedef unsigned u32x4 __attribute__((ext_vector_type(4)));
typedef unsigned u32x2 __attribute__((ext_vector_type(2)));
typedef _Float16 h16x2 __attribute__((ext_vector_type(2)));

constexpr size_t al256(size_t x) { return (x + 255) & ~(size_t)255; }
constexpr size_t OFF_BAR = 0;
constexpr size_t OFF_CNT = 16384;
constexpr size_t ZERO_BYTES = 32768;
constexpr size_t OFF_MOD = 32768;
constexpr size_t OFF_ROPE = OFF_MOD + al256((size_t)2 * 3 * 6144 * 4);
constexpr size_t OFF_H2L = OFF_ROPE + al256(256 * 8 * 8);
constexpr size_t OFF_W3T = OFF_H2L + (size_t)2 * 16384 * 64 * 2;
constexpr size_t OFF_H2C = OFF_H2L + al256((size_t)2 * 16384 * 64 * 4);
constexpr size_t OFF_CTXS = OFF_H2C + al256((size_t)2 * 256 * 64 * 4);
constexpr size_t OFF_TOKW = OFF_CTXS + al256((size_t)512 * 1024 * 4);
constexpr size_t OFF_LISTS = OFF_TOKW + al256((size_t)T * 2 * 4);
constexpr size_t OFF_WTS_OLD = OFF_LISTS + al256((size_t)24 * T * 4);
constexpr size_t WE_W1T = 0;
constexpr size_t WE_WGT = WE_W1T + (size_t)2304 * 1024;
constexpr size_t WE_WUQ = WE_WGT + (size_t)4096 * 1024;
constexpr size_t WE_WUKV = WE_WUQ + (size_t)384 * 256;
constexpr size_t WE_WBA = WE_WUKV + (size_t)512 * 128;
constexpr size_t WE_WBB = WE_WBA + (size_t)1024 * 256;
constexpr size_t WE_WBD = WE_WBB + (size_t)1024 * 256;
constexpr size_t WE_WBC = WE_WBD + (size_t)1024 * 256;
constexpr size_t WE_WOUT = WE_WBC + (size_t)1024 * 512;
constexpr size_t WE_WGU = WE_WOUT + (size_t)1024 * 1024;
constexpr size_t WE_WDN = WE_WGU + (size_t)16 * 512 * 1024;
constexpr size_t WE_TOTAL = WE_WDN + (size_t)16 * 1024 * 256;
constexpr size_t OFF_H = OFF_WTS_OLD;
constexpr size_t OFF_P = OFF_H + al256((size_t)T * 1024 * 2);
constexpr size_t OFF_HYFN = OFF_P + al256((size_t)T * PLD * 2);
constexpr size_t OFF_Q = OFF_HYFN + al256((size_t)2 * 1024 * TPB * 2);
constexpr size_t OFF_K = OFF_Q + al256((size_t)T * 384 * 2);
constexpr size_t OFF_V = OFF_K + al256((size_t)T * 384 * 2);
constexpr size_t OFF_OAD = OFF_V + al256((size_t)T * 256 * 2);
constexpr size_t OFF_OBT = OFF_OAD + al256((size_t)T * 512 * 2);
constexpr size_t OFF_OCT = OFF_OBT + al256((size_t)2 * 256 * TPB * 2);
constexpr size_t OFF_HYS = OFF_OCT + al256((size_t)2 * 512 * TPB * 2);
constexpr size_t OFF_WTS = OFF_HYS + al256((size_t)256 * 4 * 16384 * 4);
constexpr size_t OFF_FILT = OFF_WTS + al256(WE_TOTAL * 2);
constexpr size_t WS_TOTAL = OFF_FILT + al256((size_t)1024 * 16384 * 2);
constexpr int ACT_ROWS = 36352;
static_assert((size_t)ACT_ROWS * 512 * 2 <= (size_t)T * PLD * 2, "act must fit in P");

struct Params { const float* in[33]; float* out; unsigned char* ws; };
enum { I_X = 0, I_C, I_CTX, I_CCTX, I_ADAW, I_ADAB, I_N1G, I_N2G, I_WIN, I_QNORM, I_WUQ, I_KVNORM, I_WUKV, I_HYSW, I_HYW1, I_HYB1, I_HYF1, I_HYW2, I_HYB2, I_HYF2, I_HYW3, I_HYBIAS,
       I_RPB, I_WBR, I_WOUT, I_MWG, I_MBG, I_MWE, I_MBE, I_MGATE, I_MUP, I_MDOWN, I_FNG };

#define WSP(TYPE, off) ((TYPE*)(p.ws + (off)))
__device__ __forceinline__ bf16_t* wts(const Params& p, int l, size_t we) { (void)l; return (bf16_t*)(p.ws + OFF_WTS) + we; }

typedef float f32x2 __attribute__((ext_vector_type(2))); typedef int i32x8 __attribute__((ext_vector_type(8)));
typedef __bf16 bf16x2_t __attribute__((ext_vector_type(2)));
__device__ __forceinline__ unsigned cvt_pk_bf16(float lo, float hi) { const f32x2 v = {lo, hi}; return __builtin_bit_cast(unsigned, __builtin_convertvector(v, bf16x2_t)); }
__device__ __forceinline__ bf16_t f2bf(float x) { return (bf16_t)(cvt_pk_bf16(x, 0.f) & 0xffffu); }
__device__ __forceinline__ float bf2f(bf16_t v) { return __uint_as_float((unsigned)v << 16); }
__device__ __forceinline__ float wave_sum(float v) {
#pragma unroll
    for (int o = 32; o >= 1; o >>= 1) v += __shfl_xor(v, o);
    return v;
}
__device__ __forceinline__ float silu_f(float x) { return x / (1.f + __expf(-x)); }
__device__ __forceinline__ float sigmoid_f(float x) { return __builtin_amdgcn_rcpf(1.f + __builtin_amdgcn_exp2f(x * -1.4426950408889634f)); }
__device__ __forceinline__ void sincos_turns(float turns, float& s, float& c) { const float f = turns - floorf(turns); sincospif(2.f * f, &s, &c); }
__device__ __forceinline__ void sincos_rad(float x, float& s, float& c) { sincos_turns(x * 0.15915494309189535f, s, c); }

__device__ __forceinline__ const float* xrow_in(const Params& p, int r) {
    const int b = r >= TPB ? 1 : 0, t = r - b * TPB;
    return t < SEQ ? p.in[I_X] + ((size_t)b * SEQ + t) * D : p.in[I_CTX] + ((size_t)b * NCTX + (t - SEQ)) * D;
}
__device__ __forceinline__ float* xrow_st(const Params& p, int r) {
    const int b = r >= TPB ? 1 : 0, t = r - b * TPB;
    return t < SEQ ? p.out + ((size_t)b * SEQ + t) * D : WSP(float, OFF_CTXS) + ((size_t)b * NCTX + (t - SEQ)) * D;
}
__device__ __forceinline__ bool row_is_ctx(int r) { const int b = r >= TPB ? 1 : 0; return (r - b * TPB) >= SEQ; }
__device__ __forceinline__ const float* modvec(const Params& p, int l, int r) {
    const int b = r >= TPB ? 1 : 0, t = r - b * TPB; const int mi = t < SEQ ? b : 2;
    return WSP(float, OFF_MOD) + ((size_t)l * 3 + mi) * 6144;
}

#define XB_TMO      128
#define XB_XCNT(j)  (256  + 64 * (j))
#define XB_XSUB(j)  (1280 + 64 * (j))
#define XB_XGEN(j)  (2304 + 64 * (j))
#define XB_TOP      3328
#define XB_TOPGEN   3392
#define XCD_BAR_WORDS 3456
#define XB_SPIN_CAP (1u << 22)
#define LAS __attribute__((address_space(3)))
__device__ __forceinline__ unsigned xb_ld(unsigned* p)              { return __hip_atomic_load(p, __ATOMIC_RELAXED, __HIP_MEMORY_SCOPE_AGENT); }
__device__ __forceinline__ unsigned xb_add(unsigned* p, unsigned v) { return __hip_atomic_fetch_add(p, v, __ATOMIC_RELAXED, __HIP_MEMORY_SCOPE_AGENT); }
__device__ __forceinline__ unsigned xb_xcc_id() { return (unsigned)__builtin_amdgcn_s_getreg((3 << 11) | 20) & 0xFu; }
#define XB_SPIN(cond, bar) do { unsigned _sp = 0; while (cond) { __builtin_amdgcn_s_sleep(1); \
    if ((++_sp & 255u) == 0u) { if (xb_ld(&(bar)[XB_TMO])) break; if (_sp > XB_SPIN_CAP) { atomicAdd(&(bar)[XB_TMO], 1u); break; } } } } while (0)
struct XcdBarrier { unsigned* bar; unsigned x; volatile LAS unsigned* st; };
__device__ __forceinline__ XcdBarrier xcd_barrier_post(unsigned* bar, volatile LAS unsigned* st) {
    XcdBarrier b; b.bar = bar; b.x = xb_xcc_id(); b.st = st;
    if (threadIdx.x == 0) (void)xb_add(&bar[XB_XCNT(b.x)], 1u);
    return b;
}
__device__ __forceinline__ void xcd_barrier_complete(unsigned* bar, unsigned x, unsigned& nloc, unsigned& nx) {
    const unsigned G = gridDim.x * gridDim.y * gridDim.z;
    unsigned sum, cnt, mine, sp = 0u;
    for (;;) {
        sum = 0u; cnt = 0u; mine = 0u;
#pragma unroll
        for (unsigned j = 0; j < 16; ++j) { const unsigned c = xb_ld(&bar[XB_XCNT(j)]); sum += c; cnt += (c > 0u) ? 1u : 0u; mine = (j == x) ? c : mine; }
        if (sum == G) break;
        __builtin_amdgcn_s_sleep(1);
        if ((++sp & 255u) == 0u) { if (xb_ld(&bar[XB_TMO])) break; if (sp > XB_SPIN_CAP) { atomicAdd(&bar[XB_TMO], 1u); break; } }
    }
    nloc = mine > 0u ? mine : 1u; nx = cnt > 0u ? cnt : 1u;
}
__device__ __forceinline__ void xcd_barrier(const XcdBarrier& b) {
    asm volatile("s_waitcnt vmcnt(0)" ::: "memory");
    __syncthreads();
    if (threadIdx.x == 0) {
        unsigned* bar = b.bar;
        __builtin_amdgcn_s_waitcnt(0);
        unsigned nloc = b.st[0], nx = b.st[1];
        if (nloc == 0u) { xcd_barrier_complete(bar, b.x, nloc, nx); b.st[0] = nloc; b.st[1] = nx; }
        const unsigned old = xb_add(&bar[XB_XSUB(b.x)], 1u);
        const unsigned gen = old / nloc;
        if (old + 1u == (gen + 1u) * nloc) {
            __builtin_amdgcn_fence(__ATOMIC_RELEASE, "agent");
            asm volatile("s_waitcnt vmcnt(0)" ::: "memory");
            const unsigned og = xb_add(&bar[XB_TOP], 1u);
            const unsigned tg = og / nx;
            if (og + 1u == (tg + 1u) * nx) xb_add(&bar[XB_TOPGEN], 1u);
            else XB_SPIN(xb_ld(&bar[XB_TOPGEN]) == tg, bar);
            __builtin_amdgcn_fence(__ATOMIC_ACQUIRE, "agent");
            xb_add(&bar[XB_XGEN(b.x)], 1u);
            asm volatile("s_waitcnt vmcnt(0)" ::: "memory");
        } else {
            XB_SPIN(xb_ld(&bar[XB_XGEN(b.x)]) == gen, bar);
            __builtin_amdgcn_fence(__ATOMIC_ACQUIRE, "agent");
            asm volatile("s_waitcnt vmcnt(0)" ::: "memory");
        }
    }
    __syncthreads();
}

__device__ __forceinline__ int tidx() { int r; asm volatile("v_mov_b32 %0, %1" : "=v"(r) : "v"((int)threadIdx.x)); return r; }
__device__ __forceinline__ int bidx() { int r; asm volatile("s_mov_b32 %0, %1" : "=s"(r) : "s"((int)blockIdx.x)); return r; }
__device__ __forceinline__ int gdim() { int r; asm volatile("s_mov_b32 %0, %1" : "=s"(r) : "s"((int)gridDim.x)); return r; }
extern __shared__ __attribute__((aligned(16))) char lds_dyn[];
constexpr int G_TILE = 128 * 128;
constexpr int G_STAGE = 2 * G_TILE;
constexpr int G_LDS = 4 * G_STAGE;
__device__ __forceinline__ int g_lds_byte(int r, int c) { const int ob = (r & 15) * 64 + (c & 31) * 2; return ((r >> 4) * 2 + (c >> 5)) * 1024 + (ob ^ (((ob >> 9) & 1) << 5)); }
__device__ __forceinline__ int g_srow() { const int t = tidx(), ln = t & 63, p = ln * 16, ob = p ^ (((p >> 9) & 1) << 5); return ((t >> 6) >> 1) * 16 + (ob >> 6); }
__device__ __forceinline__ int g_skc() { const int t = tidx(), ln = t & 63, p = ln * 16, ob = p ^ (((p >> 9) & 1) << 5); return ((t >> 6) & 1) * 4 + ((ob & 63) >> 4); }

template <int SWAP>
__device__ __forceinline__ void mma_tile(f32x4 (&acc)[4][2], const char* As, const char* Bs, int a_rd, int b_rd) {
#pragma unroll
    for (int ks = 0; ks < 2; ++ks) {
        bf16x8 af[4], bfr[2];
#pragma unroll
        for (int mt = 0; mt < 4; ++mt) af[mt] = *(const bf16x8*)(As + a_rd + mt * 2048 + ks * 1024);
#pragma unroll
        for (int nt = 0; nt < 2; ++nt) bfr[nt] = *(const bf16x8*)(Bs + b_rd + nt * 2048 + ks * 1024);
#pragma unroll
        for (int mt = 0; mt < 4; ++mt)
#pragma unroll
            for (int nt = 0; nt < 2; ++nt)
                acc[mt][nt] = SWAP ? __builtin_amdgcn_mfma_f32_16x16x32_bf16(bfr[nt], af[mt], acc[mt][nt], 0, 0, 0)
                                   : __builtin_amdgcn_mfma_f32_16x16x32_bf16(af[mt], bfr[nt], acc[mt][nt], 0, 0, 0);
    }
}
struct GFrag { bf16x8 a[4], b[2]; };
__device__ __forceinline__ void gf_load(GFrag& f, const char* As, const char* Bs, int a_rd, int b_rd, int ks) {
#pragma unroll
    for (int mt = 0; mt < 4; ++mt) f.a[mt] = *(const bf16x8*)(As + a_rd + mt * 2048 + ks * 1024);
#pragma unroll
    for (int nt = 0; nt < 2; ++nt) f.b[nt] = *(const bf16x8*)(Bs + b_rd + nt * 2048 + ks * 1024);
}
template <int SWAP = 1>
__device__ __forceinline__ void gf_mma(f32x4 (&acc)[4][2], const GFrag& f) {
#pragma unroll
    for (int mt = 0; mt < 4; ++mt)
#pragma unroll
        for (int nt = 0; nt < 2; ++nt) acc[mt][nt] = SWAP ? __builtin_amdgcn_mfma_f32_16x16x32_bf16(f.b[nt], f.a[mt], acc[mt][nt], 0, 0, 0)
                                                           : __builtin_amdgcn_mfma_f32_16x16x32_bf16(f.a[mt], f.b[nt], acc[mt][nt], 0, 0, 0);
}
__device__ __forceinline__ void gf_zero(GFrag& f) {
#pragma unroll
    for (int mt = 0; mt < 4; ++mt) f.a[mt] = (bf16x8)(0);
#pragma unroll
    for (int nt = 0; nt < 2; ++nt) f.b[nt] = (bf16x8)(0);
}
#define SB() __builtin_amdgcn_sched_barrier(0)
#define GF_STAGE(ACCP, ACC, AS, BS) do { gf_load(f0, (AS), (BS), a_rd, b_rd, 0); SB(); gf_mma(ACCP, f1); SB(); gf_load(f1, (AS), (BS), a_rd, b_rd, 1); SB(); gf_mma(ACC, f0); SB(); } while (0)

struct GFrag2 { bf16x8 a[4], b[4]; };
__device__ __forceinline__ void gf2_load(GFrag2& f, const char* As, const char* Bs, int a_rd, int b_rd, int ks) {
#pragma unroll
    for (int mt = 0; mt < 4; ++mt) f.a[mt] = *(const bf16x8*)(As + a_rd + mt * 2048 + ks * 1024);
#pragma unroll
    for (int nt = 0; nt < 4; ++nt) f.b[nt] = *(const bf16x8*)(Bs + b_rd + nt * 2048 + ks * 1024);
}
template <int SWAP>
__device__ __forceinline__ void gf2_mma(f32x4 (&acc)[4][4], const GFrag2& f) {
#pragma unroll
    for (int mt = 0; mt < 4; ++mt)
#pragma unroll
        for (int nt = 0; nt < 4; ++nt) acc[mt][nt] = SWAP ? __builtin_amdgcn_mfma_f32_16x16x32_bf16(f.b[nt], f.a[mt], acc[mt][nt], 0, 0, 0)
                                                           : __builtin_amdgcn_mfma_f32_16x16x32_bf16(f.a[mt], f.b[nt], acc[mt][nt], 0, 0, 0);
}
__device__ __forceinline__ void gf2_zero(GFrag2& f) {
#pragma unroll
    for (int mt = 0; mt < 4; ++mt) f.a[mt] = (bf16x8)(0);
#pragma unroll
    for (int nt = 0; nt < 4; ++nt) f.b[nt] = (bf16x8)(0);
}
#define G_WAITV(n) asm volatile("s_waitcnt vmcnt(" #n ")\n\ts_waitcnt lgkmcnt(0)" ::: "memory")
template <int SWAP, int AT>
__device__ __forceinline__ void mma_seg(f32x4 (&acc)[4][2], const bf16_t* __restrict__ a0, const bf16_t* __restrict__ a1, long ldt,
                                        const bf16_t* __restrict__ b0, const bf16_t* __restrict__ b1, int K, char* lds) {
    const int tid = tidx(), lane = tid & 63, wid = __builtin_amdgcn_readfirstlane(tid >> 6), wm = wid >> 2, wn = wid & 3;
    const int fr = lane & 15, fq = lane >> 4;
    const int a_rd = g_lds_byte(wm * 64 + fr, fq * 8), b_rd = g_lds_byte(wn * 32 + fr, fq * 8);
    const int nk = K >> 6;
    if (!AT) {
        LAS char* L = (LAS char*)lds_dyn + ((wid >> 1) * 2 + (wid & 1)) * 1024;
        auto issue = [&](int st) { const int k0 = st << 6; LAS char* Lb = L + (st & 3) * G_STAGE;
            __builtin_amdgcn_global_load_lds((const unsigned*)(a0 + k0), (LAS unsigned*)(Lb), 16, 0, 0);
            __builtin_amdgcn_global_load_lds((const unsigned*)(a1 + k0), (LAS unsigned*)(Lb + 8192), 16, 0, 0);
            __builtin_amdgcn_global_load_lds((const unsigned*)(b0 + k0), (LAS unsigned*)(Lb + G_TILE), 16, 0, 0);
            __builtin_amdgcn_global_load_lds((const unsigned*)(b1 + k0), (LAS unsigned*)(Lb + G_TILE + 8192), 16, 0, 0); };
        GFrag f0, f1; gf_zero(f1);
        issue(0); if (nk > 1) issue(1); if (nk > 2) issue(2);
        for (int kt = 0; kt < nk; ++kt) {
            if (kt + 2 < nk) G_WAITV(8); else if (kt + 1 < nk) G_WAITV(4); else G_WAITV(0);
            __builtin_amdgcn_s_barrier();
            asm volatile("" ::: "memory");
            if (kt + 3 < nk) issue(kt + 3);
            const char* As = lds + (kt & 3) * G_STAGE;
            gf_load(f0, As, As + G_TILE, a_rd, b_rd, 0); SB(); gf_mma<SWAP>(acc, f1); SB(); gf_load(f1, As, As + G_TILE, a_rd, b_rd, 1); SB(); gf_mma<SWAP>(acc, f0); SB();
        }
        gf_mma<SWAP>(acc, f1);
        __syncthreads();
    } else {
        const int w0 = g_lds_byte(g_srow(), g_skc() * 8), w1 = w0 + 4 * 2048;
        const int tk = tid >> 4, tt = tid & 15;
        u32x4 ra0, ra1, rb0, rb1;
        auto gld = [&](int k0) {
            ra0 = *(const u32x4*)(a0 + (long)(k0 + tk) * ldt + tt * 8); ra1 = *(const u32x4*)(a0 + (long)(k0 + tk + 32) * ldt + tt * 8);
            rb0 = *(const u32x4*)(b0 + k0); rb1 = *(const u32x4*)(b1 + k0);
        };
        auto lst = [&](int buf) {
            char* A = lds + buf * G_STAGE; char* B = A + G_TILE;
#pragma unroll
            for (int i = 0; i < 8; ++i) {
                const unsigned wa = ra0[i >> 1], wb = ra1[i >> 1];
                *(bf16_t*)(A + g_lds_byte(tt * 8 + i, tk)) = (bf16_t)((i & 1) ? (wa >> 16) : (wa & 0xffffu));
                *(bf16_t*)(A + g_lds_byte(tt * 8 + i, tk + 32)) = (bf16_t)((i & 1) ? (wb >> 16) : (wb & 0xffffu));
            }
            *(u32x4*)(B + w0) = rb0; *(u32x4*)(B + w1) = rb1;
        };
        gld(0); lst(0); __syncthreads();
        for (int kt = 0; kt < nk; ++kt) {
            if (kt + 1 < nk) gld((kt + 1) << 6);
            __builtin_amdgcn_sched_barrier(0);
            mma_tile<SWAP>(acc, lds + (kt & 1) * G_STAGE, lds + (kt & 1) * G_STAGE + G_TILE, a_rd, b_rd);
            __builtin_amdgcn_sched_barrier(0);
            if (kt + 1 < nk) lst((kt + 1) & 1);
            __syncthreads();
        }
    }
}
__device__ __forceinline__ void mma_pair(f32x4 (&ag)[4][2], f32x4 (&ap)[4][2], const bf16_t* __restrict__ ga0, const bf16_t* __restrict__ ga1, const bf16_t* __restrict__ gb0, const bf16_t* __restrict__ gb1, int nkg,
                                         const bf16_t* __restrict__ pa0, const bf16_t* __restrict__ pa1, const bf16_t* __restrict__ pb0, const bf16_t* __restrict__ pb1, int nkp, char* lds) {
    const int tid = tidx(), lane = tid & 63, wid = __builtin_amdgcn_readfirstlane(tid >> 6), wm = wid >> 2, wn = wid & 3;
    const int fr = lane & 15, fq = lane >> 4;
    const int a_rd = g_lds_byte(wm * 64 + fr, fq * 8), b_rd = g_lds_byte(wn * 32 + fr, fq * 8);
    const int ns = nkg + nkp;
    LAS char* L = (LAS char*)lds_dyn + ((wid >> 1) * 2 + (wid & 1)) * 1024;
    auto issue = [&](int st) { const bool g = st < nkg; const int k0 = (g ? st : st - nkg) << 6; LAS char* Lb = L + (st & 3) * G_STAGE;
        __builtin_amdgcn_global_load_lds((const unsigned*)((g ? ga0 : pa0) + k0), (LAS unsigned*)(Lb), 16, 0, 0);
        __builtin_amdgcn_global_load_lds((const unsigned*)((g ? ga1 : pa1) + k0), (LAS unsigned*)(Lb + 8192), 16, 0, 0);
        __builtin_amdgcn_global_load_lds((const unsigned*)((g ? gb0 : pb0) + k0), (LAS unsigned*)(Lb + G_TILE), 16, 0, 0);
        __builtin_amdgcn_global_load_lds((const unsigned*)((g ? gb1 : pb1) + k0), (LAS unsigned*)(Lb + G_TILE + 8192), 16, 0, 0); };
    issue(0); issue(1); issue(2);
    for (int st = 0; st < nkg; ++st) {
        if (st + 2 < ns) G_WAITV(8); else if (st + 1 < ns) G_WAITV(4); else G_WAITV(0);
        __builtin_amdgcn_s_barrier(); asm volatile("" ::: "memory");
        if (st + 3 < ns) issue(st + 3);
        mma_tile<1>(ag, lds + (st & 3) * G_STAGE, lds + (st & 3) * G_STAGE + G_TILE, a_rd, b_rd);
    }
    for (int st = nkg; st < ns; ++st) {
        if (st + 2 < ns) G_WAITV(8); else if (st + 1 < ns) G_WAITV(4); else G_WAITV(0);
        __builtin_amdgcn_s_barrier(); asm volatile("" ::: "memory");
        if (st + 3 < ns) issue(st + 3);
        mma_tile<1>(ap, lds + (st & 3) * G_STAGE, lds + (st & 3) * G_STAGE + G_TILE, a_rd, b_rd);
    }
    __syncthreads();
}
constexpr int G2_STAGE = 3 * G_TILE;
constexpr int G2_LDS = 3 * G2_STAGE;
template <int SWAP>
__device__ __forceinline__ void mma_tile256(f32x4 (&acc)[4][4], const char* As, const char* Bs, int a_rd, int b_rd) {
#pragma unroll
    for (int ks = 0; ks < 2; ++ks) {
        bf16x8 af[4], bfr[4];
#pragma unroll
        for (int mt = 0; mt < 4; ++mt) af[mt] = *(const bf16x8*)(As + a_rd + mt * 2048 + ks * 1024);
#pragma unroll
        for (int nt = 0; nt < 4; ++nt) bfr[nt] = *(const bf16x8*)(Bs + b_rd + nt * 2048 + ks * 1024);
#pragma unroll
        for (int mt = 0; mt < 4; ++mt)
#pragma unroll
            for (int nt = 0; nt < 4; ++nt)
                acc[mt][nt] = SWAP ? __builtin_amdgcn_mfma_f32_16x16x32_bf16(bfr[nt], af[mt], acc[mt][nt], 0, 0, 0)
                                   : __builtin_amdgcn_mfma_f32_16x16x32_bf16(af[mt], bfr[nt], acc[mt][nt], 0, 0, 0);
    }
}
#define G2_WAITV(n) asm volatile("s_waitcnt vmcnt(" #n ")\n\ts_waitcnt lgkmcnt(0)" ::: "memory")
template <int SWAP>
__device__ __forceinline__ void mma_seg256(f32x4 (&acc)[4][4], const bf16_t* __restrict__ a0, size_t astep, const bf16_t* __restrict__ b0, size_t bstep, int K, char* lds) {
    const int tid = tidx(), lane = tid & 63, wid = __builtin_amdgcn_readfirstlane(tid >> 6), wm = wid >> 1, wn = wid & 1;
    const int fr = lane & 15, fq = lane >> 4;
    const int a_rd = g_lds_byte(wm * 64 + fr, fq * 8), b_rd = g_lds_byte(wn * 64 + fr, fq * 8);
    const int nk = K >> 6;
    LAS char* L = (LAS char*)lds_dyn + ((wid >> 1) * 2 + (wid & 1)) * 1024;
    auto issue = [&](int st) { const int k0 = st << 6; LAS char* Lb = L + (st % 3) * G2_STAGE;
#pragma unroll
        for (int i = 0; i < 4; ++i) __builtin_amdgcn_global_load_lds((const unsigned*)(a0 + i * astep + k0), (LAS unsigned*)(Lb + i * 8192), 16, 0, 0);
#pragma unroll
        for (int i = 0; i < 2; ++i) __builtin_amdgcn_global_load_lds((const unsigned*)(b0 + i * bstep + k0), (LAS unsigned*)(Lb + 2 * G_TILE + i * 8192), 16, 0, 0); };
    GFrag2 f0, f1; gf2_zero(f1);
    issue(0); if (nk > 1) issue(1);
    for (int kt = 0; kt < nk; ++kt) {
        if (kt + 1 < nk) G2_WAITV(6); else G2_WAITV(0);
        __builtin_amdgcn_s_barrier(); asm volatile("" ::: "memory");
        if (kt + 2 < nk) issue(kt + 2);
        const char* As = lds + (kt % 3) * G2_STAGE; const char* Bs = As + 2 * G_TILE;
        gf2_load(f0, As, Bs, a_rd, b_rd, 0); SB(); gf2_mma<SWAP>(acc, f1); SB(); gf2_load(f1, As, Bs, a_rd, b_rd, 1); SB(); gf2_mma<SWAP>(acc, f0); SB();
    }
    gf2_mma<SWAP>(acc, f1);
    __syncthreads();
}
__device__ __forceinline__ void acc_zero256(f32x4 (&acc)[4][4]) {
#pragma unroll
    for (int mt = 0; mt < 4; ++mt)
#pragma unroll
        for (int nt = 0; nt < 4; ++nt) acc[mt][nt] = (f32x4){0.f, 0.f, 0.f, 0.f};
}
__device__ __forceinline__ void acc_zero(f32x4 (&acc)[4][2]) {
#pragma unroll
    for (int mt = 0; mt < 4; ++mt)
#pragma unroll
        for (int nt = 0; nt < 2; ++nt) acc[mt][nt] = (f32x4){0.f, 0.f, 0.f, 0.f};
}

typedef _Float16 f16x8 __attribute__((ext_vector_type(8)));
constexpr int FRS = 130;
#define FBI(n) ((((n) >> 7) * FRS) + ((n) & 127))
constexpr int FFT_BUF_BYTES = 128 * FRS * 8;
struct FFrag { int unused; };
__device__ __forceinline__ float2 cmulf(float2 a, float2 b) { return make_float2(a.x * b.x - a.y * b.y, a.x * b.y + a.y * b.x); }
__device__ __forceinline__ float2 cmulcf(float2 a, float2 b) { return make_float2(a.x * b.x + a.y * b.y, a.y * b.x - a.x * b.y); }
__device__ __forceinline__ float2 tw16k(const float2* thi, const float2* tlo, int idx) { return cmulf(thi[idx >> 7], tlo[idx & 127]); }
__device__ __forceinline__ void mfft_frags(FFrag& F, const float2*) { F.unused = 0; }
template <int CONJ, int TW>
__device__ __forceinline__ void mfft_left(float2* buf, const FFrag& F, const float2* thi, const float2* tlo) {
    const int tid = tidx(), lane = tid & 63, wid = tid >> 6, i = wid >> 1, hi = lane >> 5, l31 = lane & 31, fa = 32 * i + l31;
    f32x16 yr0 = {}, yi0 = {}, yr1 = {}, yi1 = {};
#pragma unroll
    for (int ks = 0; ks < 8; ++ks) {
        f16x8 fr, fi;
#pragma unroll
        for (int j = 0; j < 8; ++j) { const float2 w = thi[(fa * (16 * ks + 8 * hi + j)) & 127]; fr[j] = (_Float16)w.x; fi[j] = (_Float16)(CONJ ? -w.y : w.y); }
        const f16x8 nfi = -fi;
#pragma unroll
        for (int t = 0; t < 2; ++t) {
            const float2* xp = buf + (16 * ks + 8 * hi) * FRS + 32 * (2 * (wid & 1) + t) + l31;
            f16x8 xr, xi;
#pragma unroll
            for (int j = 0; j < 8; ++j) { const float2 v = xp[j * FRS]; xr[j] = (_Float16)v.x; xi[j] = (_Float16)v.y; }
            if (t == 0) { yr0 = __builtin_amdgcn_mfma_f32_32x32x16_f16(fr, xr, yr0, 0, 0, 0); yr0 = __builtin_amdgcn_mfma_f32_32x32x16_f16(nfi, xi, yr0, 0, 0, 0);
                          yi0 = __builtin_amdgcn_mfma_f32_32x32x16_f16(fr, xi, yi0, 0, 0, 0); yi0 = __builtin_amdgcn_mfma_f32_32x32x16_f16(fi, xr, yi0, 0, 0, 0); }
            else        { yr1 = __builtin_amdgcn_mfma_f32_32x32x16_f16(fr, xr, yr1, 0, 0, 0); yr1 = __builtin_amdgcn_mfma_f32_32x32x16_f16(nfi, xi, yr1, 0, 0, 0);
                          yi1 = __builtin_amdgcn_mfma_f32_32x32x16_f16(fr, xi, yi1, 0, 0, 0); yi1 = __builtin_amdgcn_mfma_f32_32x32x16_f16(fi, xr, yi1, 0, 0, 0); }
        }
    }
    __syncthreads();
#pragma unroll
    for (int t = 0; t < 2; ++t)
#pragma unroll
        for (int r = 0; r < 16; ++r) { const int row = 32 * i + (r & 3) + 8 * (r >> 2) + 4 * hi, col = 32 * (2 * (wid & 1) + t) + l31;
            float2 v = t == 0 ? make_float2(yr0[r], yi0[r]) : make_float2(yr1[r], yi1[r]);
            if (TW) { const float2 tv = tw16k(thi, tlo, row * col); v = TW > 0 ? cmulf(v, tv) : cmulcf(v, tv); }
            buf[row * FRS + col] = v; }
    __syncthreads();
}
template <int CONJ, int TW>
__device__ __forceinline__ void mfft_right(float2* buf, const FFrag& F, const float2* thi, const float2* tlo) {
    const int tid = tidx(), lane = tid & 63, wid = tid >> 6, jb = wid >> 1, hi = lane >> 5, l31 = lane & 31, fa = 32 * jb + l31;
    f32x16 yr0 = {}, yi0 = {}, yr1 = {}, yi1 = {};
#pragma unroll
    for (int ks = 0; ks < 8; ++ks) {
        f16x8 fr, fi;
#pragma unroll
        for (int j = 0; j < 8; ++j) { const float2 w = thi[(fa * (16 * ks + 8 * hi + j)) & 127]; fr[j] = (_Float16)w.x; fi[j] = (_Float16)(CONJ ? -w.y : w.y); }
        const f16x8 nfi = -fi;
#pragma unroll
        for (int t = 0; t < 2; ++t) {
            const f32x4* xp = (const f32x4*)(buf + (32 * (2 * (wid & 1) + t) + l31) * FRS + 16 * ks + 8 * hi);
            const f32x4 q0 = xp[0], q1 = xp[1], q2 = xp[2], q3 = xp[3];
            f16x8 xr, xi;
            xr[0] = (_Float16)q0[0]; xi[0] = (_Float16)q0[1]; xr[1] = (_Float16)q0[2]; xi[1] = (_Float16)q0[3]; xr[2] = (_Float16)q1[0]; xi[2] = (_Float16)q1[1]; xr[3] = (_Float16)q1[2]; xi[3] = (_Float16)q1[3];
            xr[4] = (_Float16)q2[0]; xi[4] = (_Float16)q2[1]; xr[5] = (_Float16)q2[2]; xi[5] = (_Float16)q2[3]; xr[6] = (_Float16)q3[0]; xi[6] = (_Float16)q3[1]; xr[7] = (_Float16)q3[2]; xi[7] = (_Float16)q3[3];
            if (t == 0) { yr0 = __builtin_amdgcn_mfma_f32_32x32x16_f16(xr, fr, yr0, 0, 0, 0); yr0 = __builtin_amdgcn_mfma_f32_32x32x16_f16(xi, nfi, yr0, 0, 0, 0);
                          yi0 = __builtin_amdgcn_mfma_f32_32x32x16_f16(xr, fi, yi0, 0, 0, 0); yi0 = __builtin_amdgcn_mfma_f32_32x32x16_f16(xi, fr, yi0, 0, 0, 0); }
            else        { yr1 = __builtin_amdgcn_mfma_f32_32x32x16_f16(xr, fr, yr1, 0, 0, 0); yr1 = __builtin_amdgcn_mfma_f32_32x32x16_f16(xi, nfi, yr1, 0, 0, 0);
                          yi1 = __builtin_amdgcn_mfma_f32_32x32x16_f16(xr, fi, yi1, 0, 0, 0); yi1 = __builtin_amdgcn_mfma_f32_32x32x16_f16(xi, fr, yi1, 0, 0, 0); }
        }
    }
    __syncthreads();
#pragma unroll
    for (int t = 0; t < 2; ++t)
#pragma unroll
        for (int r = 0; r < 16; ++r) { const int row = 32 * (2 * (wid & 1) + t) + (r & 3) + 8 * (r >> 2) + 4 * hi, col = 32 * jb + l31;
            float2 v = t == 0 ? make_float2(yr0[r], yi0[r]) : make_float2(yr1[r], yi1[r]);
            if (TW) { const float2 tv = tw16k(thi, tlo, row * col); v = TW > 0 ? cmulf(v, tv) : cmulcf(v, tv); }
            buf[row * FRS + col] = v; }
    __syncthreads();
}
__device__ __forceinline__ void fft_fwd_blk(float2* buf, const FFrag& F, const float2* thi, const float2* tlo) { mfft_left<0, 1>(buf, F, thi, tlo); mfft_right<0, 0>(buf, F, thi, tlo); }
__device__ __forceinline__ void fft_inv_blk(float2* buf, const FFrag& F, const float2* thi, const float2* tlo) { mfft_right<1, -1>(buf, F, thi, tlo); mfft_left<1, 0>(buf, F, thi, tlo); }
constexpr int FFT_LDS_TAB = FFT_BUF_BYTES;
constexpr int FFT_LDS_EXTRA = FFT_LDS_TAB + 4096;
__device__ __forceinline__ void fft_tables(char* lds) {
    float2* thi = (float2*)(lds + FFT_LDS_TAB); float2* tlo = thi + 128;
    const int t = tidx();
    if (t < 128) { float s, c; sincospif(2.f * (float)t / 128.f, &s, &c); thi[t] = make_float2(c, -s); }
    else if (t < 256) { float s, c; sincospif(2.f * (float)(t - 128) / 16384.f, &s, &c); tlo[t - 128] = make_float2(c, -s); }
    else if (t < 384) { float s, c; sincospif((float)(t - 256) / 128.f, &s, &c); tlo[128 + (t - 256)] = make_float2(c, -s); }
    else { float s, c; sincospif((float)(t - 384) / 16384.f, &s, &c); tlo[256 + (t - 384)] = make_float2(c, -s); }
    __syncthreads();
}
__device__ __forceinline__ float block_sum(float v, float* red) {
    v = wave_sum(v);
    __syncthreads();
    if ((tidx() & 63) == 0) red[tidx() >> 6] = v;
    __syncthreads();
    float s = 0.f;
#pragma unroll
    for (int i = 0; i < 8; ++i) s += red[i];
    return s;
}

#if ONE_LAUNCH
#define PHASE_FN __device__ __forceinline__
#else
#define PHASE_FN __device__
#endif
__device__ __forceinline__ const float* wsrc(const Params& p, int l, int job, int n, int& ld) {
    switch (job) {
    case 0: { ld = IN_W; const float* w = p.in[I_WIN] + (size_t)l * 1024 * IN_W; int c;
        if (n < 768) c = 1440 + n; else if (n < 1024) c = n - 768; else if (n < 1152) c = 256 + (n - 1024); else if (n < 1184) c = 384 + (n - 1152);
        else if (n < 1280) return nullptr; else if (n < 2048) c = 416 + (n - 1280); else c = 1184 + (n - 2048);
        return w + c; }
    case 1: ld = IN_W; return p.in[I_WIN] + (size_t)l * 1024 * IN_W + 2208 + n;
    case 2: ld = 384; return p.in[I_WUQ] + (size_t)l * 256 * 384 + n;
    case 3: ld = 512; return p.in[I_WUKV] + (size_t)l * 128 * 512 + n;
    case 4: ld = 1024; return p.in[I_WBR] + ((size_t)l * 4 + 0) * 256 * 1024 + n;
    case 5: ld = 1024; return p.in[I_WBR] + ((size_t)l * 4 + 1) * 256 * 1024 + n;
    case 6: ld = 1024; return p.in[I_WBR] + ((size_t)l * 4 + 3) * 256 * 1024 + n;
    case 7: ld = 1024; return p.in[I_WOUT] + (size_t)l * 1024 * 1024 + n;
    case 8: { ld = 256; const int e = n >> 9, r = n & 511; const int t = r >> 7, wn = (r & 127) >> 5, nt = (r & 31) >> 4, i = r & 15; const int f = t * 64 + wn * 16 + i;
        return (nt ? p.in[I_MUP] : p.in[I_MGATE]) + ((size_t)l * 16 + e) * 1024 * 256 + f; }
    default: { ld = 1024; const int e = n >> 10, c = n & 1023; return p.in[I_MDOWN] + ((size_t)l * 16 + e) * 256 * 1024 + c; }
    }
}
PHASE_FN void ph_prologue(const Params& p, char* lds_unused) {
    char* lds = lds_dyn; (void)lds_unused;
    const int tid = tidx(), bid = bidx(), G = gdim();
    {
        float* sc = (float*)lds;
        float* red = sc + 3072;
        for (int i = tid; i < 3072; i += 512) { const int v = i >> 10, k = i & 1023; const float x = v < 2 ? p.in[I_C][v * 1024 + k] : p.in[I_CCTX][k]; sc[i] = silu_f(x); }
        __syncthreads();
        for (int u = bid; u < 192; u += G) {
            const int l = u / 96, j0 = (u % 96) * 64, kg = tid >> 6, j = tid & 63;
            const float* w = p.in[I_ADAW] + (size_t)l * 1024 * 6144 + j0 + j;
            float a0 = 0.f, a1 = 0.f, a2 = 0.f;
#pragma unroll 8
            for (int k = kg * 128; k < kg * 128 + 128; ++k) { const float wv = w[(size_t)k * 6144]; a0 += sc[k] * wv; a1 += sc[1024 + k] * wv; a2 += sc[2048 + k] * wv; }
            red[(0 * 8 + kg) * 64 + j] = a0; red[(1 * 8 + kg) * 64 + j] = a1; red[(2 * 8 + kg) * 64 + j] = a2;
            __syncthreads();
            if (tid < 192) { const int v = tid >> 6, jj = tid & 63; float s = p.in[I_ADAB][(size_t)l * 6144 + j0 + jj];
#pragma unroll
                for (int g = 0; g < 8; ++g) s += red[(v * 8 + g) * 64 + jj];
                WSP(float, OFF_MOD)[((size_t)l * 3 + v) * 6144 + j0 + jj] = s; }
            __syncthreads();
        }
    }
    for (int i = bid * 512 + tid; i < 2048; i += G * 512) {
        const int pos = i >> 3, f = i & 7; const float inv = powf(10000.f, -(float)f / 8.f); float s, c; sincos_rad((float)pos * inv, s, c);
        WSP(float2, OFF_ROPE)[i] = make_float2(c, s);
    }
    for (int i = bid * 512 + tidx(); i < NLAYER * 1024 * 64; i += G * 512) { const int l = i >> 16, col = (i >> 6) & 1023, j = i & 63;
        WSP(bf16_t, OFF_W3T)[i] = f2bf(p.in[I_HYW3][(size_t)l * 64 * 1024 + (size_t)j * 1024 + col]); }
    {
        float* w1 = (float*)lds;
        float* w2 = w1 + 33 * 64;
        float* vb = w2 + 64 * 64;
        float* zz = vb + 256;
        float* h1 = zz + 8 * 36;
        for (int l = 0; l < NLAYER; ++l) {
            __syncthreads();
            for (int i = tid; i < 33 * 64; i += 512) w1[i] = p.in[I_HYW1][(size_t)l * 33 * 64 + i];
            for (int i = tid; i < 64 * 64; i += 512) w2[i] = p.in[I_HYW2][(size_t)l * 64 * 64 + i];
            if (tid < 64) { vb[tid] = p.in[I_HYB1][l * 64 + tid]; vb[64 + tid] = p.in[I_HYF1][l * 64 + tid]; vb[128 + tid] = p.in[I_HYB2][l * 64 + tid]; vb[192 + tid] = p.in[I_HYF2][l * 64 + tid]; }
            __syncthreads();
            const int nchunks = (16384 + 256) / 8;
            for (int ch = bid; ch < nchunks; ch += G) {
                const bool isc = ch >= 2048; const int L = isc ? 256 : 16384; const int n = (isc ? ch - 2048 : ch) * 8 + (tid >> 6);
                const int nl = tid >> 6, j = tid & 63;
                if (j < 33) {
                    float v;
                    if (j == 0) v = (float)n / (float)(L - 1);
                    else { const int bi = (j - 1) & 15; const float band = 1e-4f + (float)bi * ((15.f - 1e-4f) / 15.f); float s, c; sincos_turns((float)n * band / (float)L, s, c); v = j <= 16 ? c : -s; }
                    zz[nl * 36 + j] = v;
                }
                __syncthreads();
                { float a = vb[j];
#pragma unroll
                  for (int i = 0; i < 33; ++i) a += zz[nl * 36 + i] * w1[i * 64 + j];
                  h1[nl * 64 + j] = sinf(vb[64 + j] * a); }
                __syncthreads();
                { float a = vb[128 + j];
#pragma unroll 16
                  for (int i = 0; i < 64; ++i) a += h1[nl * 64 + i] * w2[i * 64 + j];
                  const float r = sinf(vb[192 + j] * a);
                  if (isc) WSP(float, OFF_H2C)[((size_t)l * 256 + n) * 64 + j] = r; else WSP(bf16_t, OFF_H2L)[((size_t)l * 16384 + n) * 64 + j] = f2bf(r); }
                __syncthreads();
            }
        }
    }
}
template <int JOB, int N, int K>
__device__ __forceinline__ void wconv_job(const Params& p, int l, size_t we, const float* scale, char* lds) {
    float* tile = (float*)lds;
    const int tid = tidx();
    constexpr int NKT = K / 64, NT = (N / 64) * NKT;
    float xa[8], xb[8];
    auto fetch = [&](int v, float (&x)[8]) { const int n0 = (v / NKT) * 64, k0 = (v % NKT) * 64; const int nn = tid & 63, kk = tid >> 6; int ld; const float* src = wsrc(p, l, JOB, n0 + nn, ld);
#pragma unroll
        for (int i = 0; i < 8; ++i) { const int k = kk + 8 * i; float t = src ? src[(size_t)(k0 + k) * ld] : 0.f; if (scale) t *= scale[k0 + k]; x[i] = t; } };
    if (bidx() < NT) fetch(bidx(), xa);
    for (int v = bidx(); v < NT; v += gdim()) {
        const int n0 = (v / NKT) * 64, k0 = (v % NKT) * 64;
        if (v + gdim() < NT) fetch(v + gdim(), xb);
        __syncthreads();
        { const int nn = tid & 63, kk = tid >> 6;
#pragma unroll
          for (int i = 0; i < 8; ++i) { const int k = kk + 8 * i; tile[k * 65 + nn] = xa[i]; } }
#pragma unroll
        for (int i = 0; i < 8; ++i) xa[i] = xb[i];
        __syncthreads();
        if (JOB == 1) {
          const int nn = tid >> 3, kc = tid & 7; float v[8];
#pragma unroll
          for (int i = 0; i < 8; ++i) v[i] = tile[(kc * 8 + i) * 65 + nn] * 64.f;
          u32x2 w; int t0 = 0, t1 = 0;
          t0 = __builtin_amdgcn_cvt_pk_fp8_f32(v[0], v[1], t0, false); t0 = __builtin_amdgcn_cvt_pk_fp8_f32(v[2], v[3], t0, true);
          t1 = __builtin_amdgcn_cvt_pk_fp8_f32(v[4], v[5], t1, false); t1 = __builtin_amdgcn_cvt_pk_fp8_f32(v[6], v[7], t1, true);
          w.x = (unsigned)t0; w.y = (unsigned)t1;
          *(u32x2*)((char*)wts(p, l, we) + (size_t)(n0 + nn) * K + k0 + kc * 8) = w;
        } else
        { const int nn = tid >> 3, kc = tid & 7; u32x4 w;
          w.x = cvt_pk_bf16(tile[(kc * 8 + 0) * 65 + nn], tile[(kc * 8 + 1) * 65 + nn]); w.y = cvt_pk_bf16(tile[(kc * 8 + 2) * 65 + nn], tile[(kc * 8 + 3) * 65 + nn]);
          w.z = cvt_pk_bf16(tile[(kc * 8 + 4) * 65 + nn], tile[(kc * 8 + 5) * 65 + nn]); w.w = cvt_pk_bf16(tile[(kc * 8 + 6) * 65 + nn], tile[(kc * 8 + 7) * 65 + nn]);
          *(u32x4*)(wts(p, l, we) + (size_t)(n0 + nn) * K + k0 + kc * 8) = w; }
    }
}
PHASE_FN void ph_wconv(const Params& p, int l, char* lds_unused) {
    char* lds = lds_dyn; (void)lds_unused;
    const int tid = tidx(), bid = bidx(), G = gdim();
    wconv_job<0, 2304, 1024>(p, l, WE_W1T, nullptr, lds);
    wconv_job<1, 4096, 1024>(p, l, WE_WGT, nullptr, lds);
    wconv_job<2, 384, 256>(p, l, WE_WUQ, p.in[I_QNORM] + l * 256, lds);
    wconv_job<3, 512, 128>(p, l, WE_WUKV, p.in[I_KVNORM] + l * 128, lds);
    wconv_job<4, 1024, 256>(p, l, WE_WBA, nullptr, lds);
    wconv_job<5, 1024, 256>(p, l, WE_WBB, nullptr, lds);
    wconv_job<6, 1024, 256>(p, l, WE_WBD, nullptr, lds);
    wconv_job<7, 1024, 1024>(p, l, WE_WOUT, nullptr, lds);
    wconv_job<8, 8192, 1024>(p, l, WE_WGU, nullptr, lds);
    wconv_job<9, 16384, 256>(p, l, WE_WDN, nullptr, lds);
    __syncthreads();
    {
        float* cs = (float*)lds;
        __syncthreads();
        if (tid < 64) { float s, c; sincospif(2.f * (float)tid / 64.f, &s, &c); cs[tid] = c; cs[64 + tid] = s; }
        __syncthreads();
        for (int idx = bid * 512 + tid; idx < 512 * 1024; idx += G * 512) {
            const int r = idx; const int n = r & 1023, kp = r >> 10; const int part = kp >> 8, g = (kp & 255) >> 6, c = kp & 63;
            const float* wb = p.in[I_WBR] + ((size_t)l * 4 + 2) * 256 * 1024 + (size_t)(g * 64) * 1024 + n;
            float s = 0.f;
#pragma unroll 8
            for (int k2 = 0; k2 < 64; ++k2) s += cs[part * 64 + ((k2 * c) & 63)] * wb[(size_t)k2 * 1024];
            wts(p, l, WE_WBC)[(size_t)n * 512 + kp] = f2bf(s * (1.f / 1024.f));
        }
    }
}

__device__ __forceinline__ bool skip_tile(int l, int tile) { return (l == NLAYER - 1) && ((tile % 130) >= 128); }
__device__ __forceinline__ float row16_sum(float x) {
    x += __int_as_float(__builtin_amdgcn_update_dpp(0, __float_as_int(x), 0xB1, 0xf, 0xf, true));
    x += __int_as_float(__builtin_amdgcn_update_dpp(0, __float_as_int(x), 0x4E, 0xf, 0xf, true));
    x += __int_as_float(__builtin_amdgcn_update_dpp(0, __float_as_int(x), 0x141, 0xf, 0xf, true));
    x += __int_as_float(__builtin_amdgcn_update_dpp(0, __float_as_int(x), 0x140, 0xf, 0xf, true));
    return x;
}
template <int WHICH>
PHASE_FN void ph_norm(const Params& p, int l, char* lds_unused) {
    char* lds = lds_dyn; (void)lds_unused;
    const int tid = tidx(), wid = tid >> 6, lane = tid & 63, sub = lane >> 4, l16 = lane & 15;
    float* Wr = (float*)lds;
    int* lcount = (int*)(lds + 81920);
    int* lbase = lcount + 32;
    int* pidl = lbase + 32;
    int* rankl = pidl + 128;
    if (WHICH >= 1) {
        for (int i = tid; i < 20 * 1024; i += 512) { const int j = i >> 10, k = i & 1023;
            Wr[i] = j < 4 ? p.in[I_MWG][(size_t)l * 4096 + k * 4 + j] : p.in[I_MWE][(size_t)l * 16384 + k * 16 + (j - 4)]; }
        __syncthreads();
    }
    const float* gain = (WHICH == 0 ? p.in[I_N1G] : p.in[I_N2G]) + l * 1024; float sink = 0.f;
    bf16_t* H = WSP(bf16_t, OFF_H);
    float* At = (float*)(lds + 90112); float* Bt = At + 3072;
    for (int i = tid; i < 3072; i += 512) { const int mi = i >> 10, c = i & 1023; const float* mvb = WSP(float, OFF_MOD) + ((size_t)l * 3 + mi) * 6144 + (WHICH == 0 ? 0 : 3072);
        At[i] = gain[c] * (1.f + mvb[1024 + c]); Bt[i] = mvb[c]; }
    __syncthreads();
    f32x4 vn[16]; bool have = false;
#pragma unroll
    for (int i = 0; i < 16; ++i) vn[i] = (f32x4){0.f, 0.f, 0.f, 0.f};
    for (int tile = bidx(); tile < NTILE * 4; tile += gdim()) {
        if (WHICH >= 1 && skip_tile(l, tile >> 2)) continue;
        if (WHICH == 1) { __syncthreads(); if (tid < 24) lcount[tid] = 0; __syncthreads(); }
        {
            const int rloc = wid * 4 + sub, r = tile * 32 + rloc;
            const float* xr = (WHICH == 0 && l == 0) ? xrow_in(p, r) : xrow_st(p, r);
            const int mi = ((tile * 32) % TPB) < SEQ ? (tile * 32 >= TPB ? 1 : 0) : 2;
            f32x4 v[16]; float ss = 0.f;
            if (have) {
#pragma unroll
                for (int i = 0; i < 16; ++i) { v[i] = vn[i]; ss += v[i][0] * v[i][0] + v[i][1] * v[i][1] + v[i][2] * v[i][2] + v[i][3] * v[i][3]; }
            } else {
#pragma unroll
                for (int i = 0; i < 16; ++i) { v[i] = *(const f32x4*)(xr + 4 * (l16 + 16 * i)); ss += v[i][0] * v[i][0] + v[i][1] * v[i][1] + v[i][2] * v[i][2] + v[i][3] * v[i][3]; }
            }
            { int nt_ = tile + gdim(); while (WHICH >= 1 && nt_ < NTILE * 4 && skip_tile(l, nt_ >> 2)) nt_ += gdim();
              have = nt_ < NTILE * 4;
              if (have) { const int rn = nt_ * 32 + rloc; const float* xn = (WHICH == 0 && l == 0) ? xrow_in(p, rn) : xrow_st(p, rn);
#pragma unroll
                  for (int i = 0; i < 16; ++i) vn[i] = *(const f32x4*)(xn + 4 * (l16 + 16 * i)); }
              else {
#pragma unroll
                  for (int i = 0; i < 16; ++i) vn[i] = (f32x4){0.f, 0.f, 0.f, 0.f}; } }
            __builtin_amdgcn_sched_barrier(0);
            ss = row16_sum(ss);
            const float rinv = rsqrtf(ss * (1.f / 1024.f) + 1e-6f);
#pragma unroll
            for (int i = 0; i < 16; ++i) {
                const int c0 = 4 * (l16 + 16 * i);
                const f32x4 a4 = *(const f32x4*)(At + mi * 1024 + c0), b4 = *(const f32x4*)(Bt + mi * 1024 + c0);
#pragma unroll
                for (int e = 0; e < 4; ++e) v[i][e] = (v[i][e] * rinv) * a4[e] + b4[e];
                u32x2 w; w.x = cvt_pk_bf16(v[i][0], v[i][1]); w.y = cvt_pk_bf16(v[i][2], v[i][3]);
                *(u32x2*)(H + (size_t)r * 1024 + c0) = w;
                if ((i & 3) == 3) __builtin_amdgcn_sched_barrier(0);
            }
            if (WHICH >= 1) {
                float lg[20];
                int wofs = 4 * l16; asm volatile("" : "+v"(wofs));
#pragma unroll
                for (int j = 0; j < 20; ++j) { f32x2 a2 = {0.f, 0.f};
#pragma unroll
                    for (int i = 0; i < 16; ++i) { const f32x4 w = *(const f32x4*)(Wr + j * 1024 + wofs + 64 * i);
                        a2 = __builtin_elementwise_fma(__builtin_shufflevector(v[i], v[i], 0, 1), __builtin_shufflevector(w, w, 0, 1), a2);
                        a2 = __builtin_elementwise_fma(__builtin_shufflevector(v[i], v[i], 2, 3), __builtin_shufflevector(w, w, 2, 3), a2);
                        if ((i & 7) == 7) __builtin_amdgcn_sched_barrier(0); }
                    lg[j] = row16_sum(a2[0] + a2[1]); __builtin_amdgcn_sched_barrier(0); }
#pragma unroll
                for (int j = 0; j < 4; ++j) lg[j] += p.in[I_MBG][l * 4 + j];
#pragma unroll
                for (int j = 0; j < 16; ++j) lg[4 + j] += p.in[I_MBE][l * 16 + j];
                int g = 0; float gm = lg[0];
#pragma unroll
                for (int j = 1; j < 4; ++j) if (lg[j] > gm) { gm = lg[j]; g = j; }
                float gs = 0.f;
#pragma unroll
                for (int j = 0; j < 4; ++j) gs += __expf(lg[j] - gm);
                const float gp = 1.f / gs;
                float e4[4];
#pragma unroll
                for (int j = 0; j < 4; ++j) e4[j] = g == 0 ? lg[4 + j] : g == 1 ? lg[8 + j] : g == 2 ? lg[12 + j] : lg[16 + j];
                int i1 = 0; float m1 = e4[0];
#pragma unroll
                for (int j = 1; j < 4; ++j) if (e4[j] > m1) { m1 = e4[j]; i1 = j; }
                int i2 = -1; float m2 = -3.4e38f;
#pragma unroll
                for (int j = 0; j < 4; ++j) if (j != i1 && e4[j] > m2) { m2 = e4[j]; i2 = j; }
                const float x2 = __expf(m2 - m1); const float pw1 = gp / (1.f + x2), pw2 = gp * x2 / (1.f + x2);
                const int lo = i1 < i2 ? i1 : i2, hi = i1 < i2 ? i2 : i1;
                const float wlo = i1 < i2 ? pw1 : pw2, whi = i1 < i2 ? pw2 : pw1;
                const int pairidx = lo == 0 ? hi - 1 : lo == 1 ? hi + 1 : 5;
                if (WHICH == 2) sink += wlo + whi + (float)pairidx;
                if (l16 == 0 && WHICH == 1) { pidl[rloc] = g * 6 + pairidx; WSP(float, OFF_TOKW)[(size_t)r * 2] = wlo; WSP(float, OFF_TOKW)[(size_t)r * 2 + 1] = whi; }
            }
        }
        if (WHICH == 2) asm volatile("" :: "v"(sink));
        if (WHICH == 1) {
            __syncthreads();
            int mypid = 0;
            if (tid < 32) { mypid = pidl[tid]; rankl[tid] = atomicAdd(&lcount[mypid], 1); }
            __syncthreads();
            if (tid < 24) lbase[tid] = lcount[tid] ? atomicAdd(WSP(int, OFF_CNT) + l * 32 + tid, lcount[tid]) : 0;
            __syncthreads();
            if (tid < 32) WSP(int, OFF_LISTS)[(size_t)mypid * T + lbase[mypid] + rankl[tid]] = tile * 32 + tid;
        }
    }
}

PHASE_FN void ph_filt(const Params& p, int l, char* lds_unused) {
    char* lds = lds_dyn; (void)lds_unused;
    const int tid = tidx(), lane = tid & 63, wid = tid >> 6, wm = wid >> 2, wn = wid & 3, fr = lane & 15, fq = lane >> 4;
    const bf16_t* A = WSP(const bf16_t, OFF_H2L) + (size_t)l * 16384 * 64; const bf16_t* B = WSP(const bf16_t, OFF_W3T) + (size_t)l * 1024 * 64;
    bf16_t* F = WSP(bf16_t, OFF_FILT);
    for (int u = bidx(); u < 128 * 8; u += gdim()) {
        const int n0 = (u >> 3) * 128, c0 = (u & 7) * 128;
        const bf16_t* a0 = A + (size_t)(n0 + g_srow()) * 64 + g_skc() * 8; const bf16_t* b0 = B + (size_t)(c0 + g_srow()) * 64 + g_skc() * 8;
        f32x4 acc[4][2]; acc_zero(acc);
        mma_seg<0, 0>(acc, a0, a0 + (size_t)64 * 64, 0, b0, b0 + (size_t)64 * 64, 64, lds);
#pragma unroll
        for (int mt = 0; mt < 4; ++mt)
#pragma unroll
            for (int nt = 0; nt < 2; ++nt) { const int n = n0 + wm * 64 + mt * 16 + fq * 4, col = c0 + wn * 32 + nt * 16 + fr;
                u32x2 w; w.x = cvt_pk_bf16(acc[mt][nt][0], acc[mt][nt][1]); w.y = cvt_pk_bf16(acc[mt][nt][2], acc[mt][nt][3]);
                *(u32x2*)(F + (size_t)col * 16384 + n) = w; }
    }
}

PHASE_FN void ph_gemm1(const Params& p, int l, char* lds_unused) {
    char* lds = lds_dyn; (void)lds_unused;
    const int tid = tidx(), lane = tid & 63, wid = tid >> 6, wm = wid >> 1, wn = wid & 1, fr = lane & 15, fq = lane >> 4;
    const bf16_t* H = WSP(bf16_t, OFF_H); const bf16_t* W = wts(p, l, WE_W1T);
    const int xcd = bidx() & 7, loc = bidx() >> 3, nl = gdim() >> 3;
    for (int v = loc; ; v += nl) {
        const int rt = (v / 18) * 8 + xcd, ct = v % 18; if (rt >= NTILE / 2) break;
        const int r0 = rt * 256, n0 = ct * 128;
        const bf16_t* a0 = H + (size_t)(r0 + g_srow()) * 1024 + g_skc() * 8; const bf16_t* b0 = W + (size_t)(n0 + g_srow()) * 1024 + g_skc() * 8;
        f32x4 acc[4][4]; acc_zero256(acc);
        if (ct < 10) {
            mma_seg256<1>(acc, a0, (size_t)64 * 1024, b0, (size_t)64 * 1024, 1024, lds);
            bf16_t* P = WSP(bf16_t, OFF_P);
#pragma unroll
            for (int mt = 0; mt < 4; ++mt)
#pragma unroll
                for (int nt = 0; nt < 4; ++nt) { const int row = r0 + wm * 64 + mt * 16 + fr, col = n0 + wn * 64 + nt * 16 + fq * 4;
                    u32x2 w; w.x = cvt_pk_bf16(acc[mt][nt][0], acc[mt][nt][1]); w.y = cvt_pk_bf16(acc[mt][nt][2], acc[mt][nt][3]);
                    *(u32x2*)(P + (size_t)row * PLD + col) = w; }
        } else {
            mma_seg256<0>(acc, a0, (size_t)64 * 1024, b0, (size_t)64 * 1024, 1024, lds);
            const int b = r0 >= TPB ? 1 : 0, t0 = r0 - b * TPB;
            bf16_t* HT = WSP(bf16_t, OFF_HYFN) + (size_t)b * 1024 * TPB;
#pragma unroll
            for (int mt = 0; mt < 4; ++mt)
#pragma unroll
                for (int nt = 0; nt < 4; ++nt) { const int t = t0 + wm * 64 + mt * 16 + fq * 4, ch = (n0 - 1280) + wn * 64 + nt * 16 + fr;
                    u32x2 w; w.x = cvt_pk_bf16(acc[mt][nt][0], acc[mt][nt][1]); w.y = cvt_pk_bf16(acc[mt][nt][2], acc[mt][nt][3]);
                    *(u32x2*)(HT + (size_t)ch * TPB + t) = w; }
        }
    }
}

#define KSWZ(row, colB) ((row) * 256 + ((colB) ^ (((row) & 7) << 4)))
#define SBAR() __builtin_amdgcn_sched_barrier(0)
__device__ __forceinline__ int crow(int r, int hi) { return (r & 3) + 8 * (r >> 2) + 4 * hi; }
__device__ __forceinline__ int v_st(int k, int c) { const int kk = (k & ~0xC) | ((k & 4) << 1) | ((k & 8) >> 1); return ((kk >> 3) * 2 + (c >> 5)) * 512 + ((kk & 7) * 32 + (c & 31)) * 2; }
__device__ __forceinline__ int v_rd_base(int lane) { return ((lane & 3) << 3) | (((lane >> 2) & 3) << 6) | (((lane >> 4) & 1) << 5) | (((lane >> 5) & 1) << 8); }
constexpr int v_rd_off(int d0, int ks, int half) { return d0 * 512 + ks * 2048 + half * 1024; }
template <int OFF> __device__ __forceinline__ s16x4 tr_read(int vb) {
    s16x4 r; asm volatile("ds_read_b64_tr_b16 %0, %1 offset:%2" : "=&v"(r) : "v"(vb), "i"(OFF) : "memory"); return r;
}
template <int D0> __device__ __forceinline__ void pv_one(f32x16& od, int vb, bf16x8 pa0, bf16x8 pa1, bf16x8 pa2, bf16x8 pa3) {
    const s16x4 l0 = tr_read<v_rd_off(D0, 0, 0)>(vb), h0 = tr_read<v_rd_off(D0, 0, 1)>(vb), l1 = tr_read<v_rd_off(D0, 1, 0)>(vb), h1 = tr_read<v_rd_off(D0, 1, 1)>(vb);
    const s16x4 l2 = tr_read<v_rd_off(D0, 2, 0)>(vb), h2 = tr_read<v_rd_off(D0, 2, 1)>(vb), l3 = tr_read<v_rd_off(D0, 3, 0)>(vb), h3 = tr_read<v_rd_off(D0, 3, 1)>(vb);
    asm volatile("s_waitcnt lgkmcnt(0)" ::: "memory"); SBAR();
#define PKV(L, H) (bf16x8){L[0], L[1], L[2], L[3], H[0], H[1], H[2], H[3]}
    od = __builtin_amdgcn_mfma_f32_32x32x16_bf16(pa0, PKV(l0, h0), od, 0, 0, 0);
    od = __builtin_amdgcn_mfma_f32_32x32x16_bf16(pa1, PKV(l1, h1), od, 0, 0, 0);
    od = __builtin_amdgcn_mfma_f32_32x32x16_bf16(pa2, PKV(l2, h2), od, 0, 0, 0);
    od = __builtin_amdgcn_mfma_f32_32x32x16_bf16(pa3, PKV(l3, h3), od, 0, 0, 0);
#undef PKV
}
constexpr int ATT_LDS = 16384 + 32768 + 2048;
constexpr float ATT_THR = 8.f;
template <int DQK, int NA>
__device__ __forceinline__ void attn_unit(const bf16_t* __restrict__ Qb, int ldq, const bf16_t* __restrict__ Kb, int ldk, const bf16_t* __restrict__ Vb, int ldv,
                                          bf16_t* __restrict__ Ob, int ldo, int NT, int nA, int baseA, int baseB, char* lds, const float* biasL, int qrow0, int krow_lo) {
    constexpr float SCALE = DQK == 96 ? 0.10206207261596575f : 0.125f;
    constexpr float C = SCALE * 1.4426950408889634f;
    constexpr int ND = DQK / 16, NKC = DQK / 8;
    const int tid = tidx(), wid = tid >> 6, lane = tid & 63, r32 = lane & 31, hi = lane >> 5;
    char* V_lds = lds; char* K_lds = lds + 16384;
    float* wsf = (float*)(lds + 49152) + wid * 64; float* al_l = wsf; float* li_l = wsf + 32;
    bf16x8 qr[ND];
    { const bf16_t* Qw = Qb + (size_t)(wid * 32 + r32) * ldq + hi * 8;
#pragma unroll
      for (int d0 = 0; d0 < ND; ++d0) qr[d0] = *(const bf16x8*)(Qw + d0 * 16); }
    const int vrow = tid >> 3, vc = (tid & 7) * 8, vst = v_st(vrow, vc);
    const int k0row = tid / NKC, k0c = tid % NKC, kst0 = KSWZ(k0row, k0c * 16);
    const int id1 = tid + 512; const bool has1 = (DQK == 96) && (id1 < 64 * NKC);
    const int k1row = has1 ? id1 / NKC : 0, k1c = has1 ? id1 % NKC : 0, kst1 = KSWZ(k1row, k1c * 16);
    const int vb0 = (int)(uintptr_t)V_lds + v_rd_base(lane);
    bf16x8 sv, sk0, sk1;
    auto SLOAD = [&](int j) { const size_t t0 = (size_t)(j < nA ? baseA + 64 * j : baseB + 64 * (j - nA));
        sv = *(const bf16x8*)(Vb + (t0 + vrow) * ldv + vc); sk0 = *(const bf16x8*)(Kb + (t0 + k0row) * ldk + k0c * 8);
        if (has1) sk1 = *(const bf16x8*)(Kb + (t0 + k1row) * ldk + k1c * 8); };
    auto SWRITE = [&](int b) { *(bf16x8*)(V_lds + b * 8192 + vst) = sv; *(bf16x8*)(K_lds + b * 16384 + kst0) = sk0; if (has1) *(bf16x8*)(K_lds + b * 16384 + kst1) = sk1; };
    float m_reg = -1e30f, l_reg = 0.f; f32x16 o0 = {}, o1 = {};
    __syncthreads();
    SLOAD(0); SWRITE(0); __syncthreads();
    for (int j = 0; j < NT; ++j) {
        const int bsel = j & 1;
        if (j + 1 < NT) SLOAD(j + 1);
        f32x16 p0 = {}, p1 = {};
        { const char* Ks = K_lds + bsel * 16384;
#pragma unroll
          for (int d0 = 0; d0 < ND; ++d0) { const int cb = d0 * 32 + hi * 16;
            const bf16x8 b0 = *(const bf16x8*)(Ks + KSWZ(r32, cb)); const bf16x8 b1 = *(const bf16x8*)(Ks + KSWZ(32 + r32, cb));
            p0 = __builtin_amdgcn_mfma_f32_32x32x16_bf16(b0, qr[d0], p0, 0, 0, 0);
            p1 = __builtin_amdgcn_mfma_f32_32x32x16_bf16(b1, qr[d0], p1, 0, 0, 0); } }
        if (NA) {
            if (j >= nA) {
                const int krow = krow_lo + (j - nA), qrow = qrow0 + (wid >> 1);
                int ws = qrow - 4; ws = ws < 0 ? 0 : (ws > 248 ? 248 : ws);
                const bool rowok = (krow >= ws) && (krow < ws + 8);
                const int qc = 32 * (wid & 1) + r32; int cs = qc - 8; cs = cs < 0 ? 0 : (cs > 48 ? 48 : cs);
                int dri = krow - qrow + 7; dri = dri < 0 ? 0 : (dri > 14 ? 14 : dri);
                const float* brow = biasL + dri * 31 + 15 - qc;
#pragma unroll
                for (int r = 0; r < 16; ++r) { const int kc = crow(r, hi); const bool ok = rowok && kc >= cs && kc < cs + 16; float bv = 0.f; if (ok) bv = brow[kc]; p0[r] = ok ? p0[r] + bv : -1e30f; }
#pragma unroll
                for (int r = 0; r < 16; ++r) { const int kc = 32 + crow(r, hi); const bool ok = rowok && kc >= cs && kc < cs + 16; float bv = 0.f; if (ok) bv = brow[kc]; p1[r] = ok ? p1[r] + bv : -1e30f; }
            }
        }
        float pmax = p0[0];
#pragma unroll
        for (int r = 1; r < 16; ++r) pmax = fmaxf(pmax, p0[r]);
#pragma unroll
        for (int r = 0; r < 16; ++r) pmax = fmaxf(pmax, p1[r]);
        { auto rr = __builtin_amdgcn_permlane32_swap(__float_as_uint(pmax), __float_as_uint(pmax), false, false); pmax = fmaxf(__uint_as_float(rr[0]), __uint_as_float(rr[1])); }
        float mn, alpha;
        if (__all(pmax - m_reg <= ATT_THR / SCALE)) { mn = m_reg; alpha = 1.f; }
        else { mn = fmaxf(m_reg, pmax); alpha = __builtin_amdgcn_exp2f((m_reg - mn) * C); m_reg = mn; }
        const float mnC = -mn * C;
        float ps = 0.f;
#pragma unroll
        for (int r = 0; r < 16; ++r) { p0[r] = __builtin_amdgcn_exp2f(fmaf(p0[r], C, mnC)); ps += p0[r]; }
#pragma unroll
        for (int r = 0; r < 16; ++r) { p1[r] = __builtin_amdgcn_exp2f(fmaf(p1[r], C, mnC)); ps += p1[r]; }
        { auto rr = __builtin_amdgcn_permlane32_swap(__float_as_uint(ps), __float_as_uint(ps), false, false); ps = __uint_as_float(rr[0]) + __uint_as_float(rr[1]); }
        l_reg = l_reg * alpha + ps;
        bf16x8 pa0, pa1, pa2, pa3;
#define PK4(P, BASE, OUT) do { unsigned a0_ = cvt_pk_bf16(P[BASE + 0], P[BASE + 1]), a1_ = cvt_pk_bf16(P[BASE + 2], P[BASE + 3]);   \
        unsigned b0_ = cvt_pk_bf16(P[BASE + 4], P[BASE + 5]), b1_ = cvt_pk_bf16(P[BASE + 6], P[BASE + 7]);                              \
        auto r0_ = __builtin_amdgcn_permlane32_swap(a0_, b0_, false, false); auto r1_ = __builtin_amdgcn_permlane32_swap(a1_, b1_, false, false); \
        u32x4 w_ = {r0_[0], r1_[0], r0_[1], r1_[1]}; OUT = *reinterpret_cast<bf16x8*>(&w_); } while (0)
        PK4(p0, 0, pa0); PK4(p0, 8, pa1); PK4(p1, 0, pa2); PK4(p1, 8, pa3);
#undef PK4
        if (__any(alpha < 1.f)) {
            if (hi == 0) al_l[r32] = alpha;
            asm volatile("s_waitcnt lgkmcnt(0)" ::: "memory");
#pragma unroll
            for (int r = 0; r < 16; ++r) { const float a = al_l[crow(r, hi)]; o0[r] *= a; o1[r] *= a; }
        }
        pv_one<0>(o0, vb0 + bsel * 8192, pa0, pa1, pa2, pa3);
        pv_one<1>(o1, vb0 + bsel * 8192, pa0, pa1, pa2, pa3);
        if (j + 1 < NT) SWRITE(bsel ^ 1);
        __syncthreads();
    }
    if (hi == 0) li_l[r32] = l_reg;
    asm volatile("s_waitcnt lgkmcnt(0)" ::: "memory");
    bf16_t* Ow = Ob + (size_t)(wid * 32) * ldo;
#pragma unroll
    for (int r = 0; r < 16; ++r) { const int orow = crow(r, hi); const float rl = __builtin_amdgcn_rcpf(li_l[orow]);
        Ow[(size_t)orow * ldo + r32] = f2bf(o0[r] * rl); Ow[(size_t)orow * ldo + 32 + r32] = f2bf(o1[r] * rl); }
    __syncthreads();
}

__device__ __forceinline__ void mla_partialSM(f32x16& p0, f32x16& p1, float& m_reg, float& alpha, bool first) {
    constexpr float THR2 = ATT_THR * 1.4426950408889634f;
    float pmax = p0[0];
#pragma unroll
    for (int r = 1; r < 16; ++r) pmax = fmaxf(pmax, p0[r]);
#pragma unroll
    for (int r = 0; r < 16; ++r) pmax = fmaxf(pmax, p1[r]);
    { auto rr = __builtin_amdgcn_permlane32_swap(__float_as_uint(pmax), __float_as_uint(pmax), false, false); pmax = fmaxf(__uint_as_float(rr[0]), __uint_as_float(rr[1])); }
    if (__builtin_expect(!first && __all(pmax <= THR2), 1)) { alpha = 1.f; }
    else { const float d = first ? pmax : fmaxf(pmax, 0.f); alpha = first ? 1.f : __builtin_amdgcn_exp2f(-d); m_reg += d;
#pragma unroll
        for (int r = 0; r < 16; ++r) { p0[r] -= d; p1[r] -= d; } }
#pragma unroll
    for (int r = 0; r < 16; ++r) p0[r] = __builtin_amdgcn_exp2f(p0[r]);
}
__device__ __forceinline__ void mla_finishSM(f32x16& p0, f32x16& p1, float alpha, float& l_reg, bf16x8& pa0, bf16x8& pa1, bf16x8& pa2, bf16x8& pa3) {
#pragma unroll
    for (int r = 0; r < 16; ++r) p1[r] = __builtin_amdgcn_exp2f(p1[r]);
    f32x2 s2 = {p0[0], p0[1]}, t2 = {p1[0], p1[1]};
#pragma unroll
    for (int r = 2; r < 16; r += 2) { s2 += (f32x2){p0[r], p0[r + 1]}; t2 += (f32x2){p1[r], p1[r + 1]}; }
    s2 += t2; float ps = s2[0] + s2[1];
    { auto rr = __builtin_amdgcn_permlane32_swap(__float_as_uint(ps), __float_as_uint(ps), false, false); ps = __uint_as_float(rr[0]) + __uint_as_float(rr[1]); }
    l_reg = l_reg * alpha + ps;
#define PK4(P, BASE, OUT) do { unsigned a0_ = cvt_pk_bf16(P[BASE + 0], P[BASE + 1]), a1_ = cvt_pk_bf16(P[BASE + 2], P[BASE + 3]);   \
    unsigned b0_ = cvt_pk_bf16(P[BASE + 4], P[BASE + 5]), b1_ = cvt_pk_bf16(P[BASE + 6], P[BASE + 7]);                              \
    auto r0_ = __builtin_amdgcn_permlane32_swap(a0_, b0_, false, false); auto r1_ = __builtin_amdgcn_permlane32_swap(a1_, b1_, false, false); \
    u32x4 w_ = {r0_[0], r1_[0], r0_[1], r1_[1]}; OUT = *reinterpret_cast<bf16x8*>(&w_); } while (0)
    PK4(p0, 0, pa0); PK4(p0, 8, pa1); PK4(p1, 0, pa2); PK4(p1, 8, pa3);
#undef PK4
}
__device__ __forceinline__ void mla_qkt(f32x16& p0, f32x16& p1, const char* Ks, const bf16x8* qr, int r32, int hi, float init) {
#pragma unroll
    for (int r = 0; r < 16; ++r) { p0[r] = init; p1[r] = init; }
#pragma unroll
    for (int d0 = 0; d0 < 6; ++d0) { const int cb = d0 * 32 + hi * 16;
        const bf16x8 b0 = *(const bf16x8*)(Ks + KSWZ(r32, cb)); const bf16x8 b1 = *(const bf16x8*)(Ks + KSWZ(32 + r32, cb));
        p0 = __builtin_amdgcn_mfma_f32_32x32x16_bf16(b0, qr[d0], p0, 0, 0, 0);
        p1 = __builtin_amdgcn_mfma_f32_32x32x16_bf16(b1, qr[d0], p1, 0, 0, 0); }
}
__device__ __forceinline__ void mla_unit(const bf16_t* __restrict__ Qb, const bf16_t* __restrict__ Kb, const bf16_t* __restrict__ Vb, bf16_t* __restrict__ Ob,
                                         int NT, int nA, int baseA, int baseB, char* lds) {
    constexpr int ldq = 384, ldk = 384, ldv = 256, ldo = 512;
    const int tid = tidx(), wid = tid >> 6, lane = tid & 63, r32 = lane & 31, hi = lane >> 5;
    char* V_lds = lds; char* K_lds = lds + 16384;
    float* wsf = (float*)(lds + 49152) + wid * 64; float* al_l = wsf; float* li_l = wsf + 32;
    bf16x8 qr[6];
    { const bf16_t* Qw = Qb + (size_t)(wid * 32 + r32) * ldq + hi * 8;
#pragma unroll
      for (int d0 = 0; d0 < 6; ++d0) qr[d0] = *(const bf16x8*)(Qw + d0 * 16); }
    const int vrow = tid >> 3, vc = (tid & 7) * 8, vst = v_st(vrow, vc);
    const int k0row = tid / 12, k0c = tid % 12, kst0 = KSWZ(k0row, k0c * 16);
    const int id1 = tid + 512; const bool has1 = id1 < 768;
    const int k1row = has1 ? id1 / 12 : 0, k1c = has1 ? id1 % 12 : 0, kst1 = KSWZ(k1row, k1c * 16);
    const int vb0 = (int)(uintptr_t)V_lds + v_rd_base(lane);
    bf16x8 sv, sk0, sk1;
    auto SLOAD = [&](int j) { const size_t t0 = (size_t)(j < nA ? baseA + 64 * j : baseB + 64 * (j - nA));
        sv = *(const bf16x8*)(Vb + (t0 + vrow) * ldv + vc); sk0 = *(const bf16x8*)(Kb + (t0 + k0row) * ldk + k0c * 8);
        if (has1) sk1 = *(const bf16x8*)(Kb + (t0 + k1row) * ldk + k1c * 8); };
    auto SWRITE = [&](int b) { *(bf16x8*)(V_lds + b * 8192 + vst) = sv; *(bf16x8*)(K_lds + b * 16384 + kst0) = sk0; if (has1) *(bf16x8*)(K_lds + b * 16384 + kst1) = sk1; };
#define MLA_RESC(a) do { if (__any((a) < 1.f)) { if (hi == 0) al_l[r32] = (a); asm volatile("s_waitcnt lgkmcnt(0)" ::: "memory"); \
    _Pragma("unroll") for (int r = 0; r < 16; ++r) { const float a_ = al_l[crow(r, hi)]; o0[r] *= a_; o1[r] *= a_; } } } while (0)
    float m_reg = 0.f, l_reg = 0.f; f32x16 o0 = {}, o1 = {};
    f32x16 pA0, pA1, pB0, pB1; float alA, alB; bf16x8 pa0, pa1, pa2, pa3;
    __syncthreads();
    SLOAD(0); SWRITE(0); __syncthreads();
    mla_qkt(pA0, pA1, K_lds, qr, r32, hi, 0.f); mla_partialSM(pA0, pA1, m_reg, alA, true);
    SLOAD(1); SWRITE(1); __syncthreads();
    for (int j = 1; j + 1 < NT; j += 2) {
        SBAR(); mla_qkt(pB0, pB1, K_lds + 16384, qr, r32, hi, -m_reg);
        mla_finishSM(pA0, pA1, alA, l_reg, pa0, pa1, pa2, pa3); SBAR();
        SLOAD(j + 1); SBAR();
        pv_one<0>(o0, vb0, pa0, pa1, pa2, pa3); pv_one<1>(o1, vb0, pa0, pa1, pa2, pa3); mla_partialSM(pB0, pB1, m_reg, alB, false);
        __syncthreads(); SWRITE(0);
        MLA_RESC(alB); __syncthreads();
        SBAR(); mla_qkt(pA0, pA1, K_lds, qr, r32, hi, -m_reg);
        mla_finishSM(pB0, pB1, alB, l_reg, pa0, pa1, pa2, pa3); SBAR();
        SLOAD(j + 2); SBAR();
        pv_one<0>(o0, vb0 + 8192, pa0, pa1, pa2, pa3); pv_one<1>(o1, vb0 + 8192, pa0, pa1, pa2, pa3); mla_partialSM(pA0, pA1, m_reg, alA, false);
        __syncthreads(); SWRITE(1);
        MLA_RESC(alA); __syncthreads();
    }
    SBAR(); mla_qkt(pB0, pB1, K_lds + 16384, qr, r32, hi, -m_reg);
    mla_finishSM(pA0, pA1, alA, l_reg, pa0, pa1, pa2, pa3); SBAR();
    pv_one<0>(o0, vb0, pa0, pa1, pa2, pa3); pv_one<1>(o1, vb0, pa0, pa1, pa2, pa3); mla_partialSM(pB0, pB1, m_reg, alB, false);
    __syncthreads(); MLA_RESC(alB);
    mla_finishSM(pB0, pB1, alB, l_reg, pa0, pa1, pa2, pa3); SBAR();
    pv_one<0>(o0, vb0 + 8192, pa0, pa1, pa2, pa3); pv_one<1>(o1, vb0 + 8192, pa0, pa1, pa2, pa3);
#undef MLA_RESC
    if (hi == 0) li_l[r32] = l_reg;
    asm volatile("s_waitcnt lgkmcnt(0)" ::: "memory");
    bf16_t* Ow = Ob + (size_t)(wid * 32) * ldo;
#pragma unroll
    for (int r = 0; r < 16; ++r) { const int orow = crow(r, hi); const float rl = __builtin_amdgcn_rcpf(li_l[orow]);
        Ow[(size_t)orow * ldo + r32] = f2bf(o0[r] * rl); Ow[(size_t)orow * ldo + 32 + r32] = f2bf(o1[r] * rl); }
    __syncthreads();
}

__device__ __forceinline__ void upproj_tile(const Params& p, int l, int tile, int part, char* lds) {
    const int tid = tidx(), lane = tid & 63, wid = tid >> 6, wm = wid >> 2, wn = wid & 3, fr = lane & 15, fq = lane >> 4;
    const int r0 = tile * 128; const bool ctx = row_is_ctx(r0); const int b = r0 >= TPB ? 1 : 0, t0 = r0 - b * TPB;
    float* rq = (float*)(lds + G_LDS); float* rkv = rq + 128;
    const bf16_t* P = WSP(bf16_t, OFF_P); bf16_t* Qo = WSP(bf16_t, OFF_Q); bf16_t* Ko = WSP(bf16_t, OFF_K); bf16_t* Vo = WSP(bf16_t, OFF_V);
    const float2* rope = WSP(float2, OFF_ROPE);
    __syncthreads();
    {
        const int row = tid >> 2, qd = tid & 3; const bf16_t* pr = P + (size_t)(r0 + row) * PLD;
        float sq = 0.f, sk = 0.f;
#pragma unroll
        for (int i = 0; i < 8; ++i) { const bf16x8 v = *(const bf16x8*)(pr + 768 + qd * 64 + i * 8);
#pragma unroll
            for (int e = 0; e < 8; ++e) { const float x = bf2f((bf16_t)v[e]); sq += x * x; } }
#pragma unroll
        for (int i = 0; i < 4; ++i) { const bf16x8 v = *(const bf16x8*)(pr + 1024 + qd * 32 + i * 8);
#pragma unroll
            for (int e = 0; e < 8; ++e) { const float x = bf2f((bf16_t)v[e]); sk += x * x; } }
        sq += __shfl_xor(sq, 1); sq += __shfl_xor(sq, 2); sk += __shfl_xor(sk, 1); sk += __shfl_xor(sk, 2);
        if (qd == 0) { rq[row] = rsqrtf(sq * (1.f / 256.f) + 1e-6f); rkv[row] = rsqrtf(sk * (1.f / 128.f) + 1e-6f); }
    }
    if (part == 0) for (int it = tid; it < 128 * 16; it += 512) {
        const int row = it >> 4, pi = it & 15; const bf16_t* pr = P + (size_t)(r0 + row) * PLD + 1152 + 2 * pi;
        float xe = bf2f(pr[0]), xo = bf2f(pr[1]);
        if (!ctx) { const int t = t0 + row; const int pos = pi < 8 ? (t >> 6) : (t & 63); const float2 cs = rope[pos * 8 + (pi & 7)];
            const float ne = xe * cs.x - xo * cs.y, no = xe * cs.y + xo * cs.x; xe = ne; xo = no; }
        const unsigned w = cvt_pk_bf16(xe, xo);
#pragma unroll
        for (int h = 0; h < 4; ++h) *(unsigned*)(Ko + (size_t)(r0 + row) * 384 + h * 96 + 64 + 2 * pi) = w;
    }
    __syncthreads();
    if (part < 3) { const int ct = part;
        const bf16_t* a0 = P + (size_t)(r0 + g_srow()) * PLD + 768 + g_skc() * 8; const bf16_t* a1 = a0 + (size_t)64 * PLD;
        const bf16_t* b0 = wts(p, l, WE_WUQ) + (size_t)(ct * 128 + g_srow()) * 256 + g_skc() * 8; const bf16_t* b1 = b0 + (size_t)64 * 256;
        f32x4 acc[4][2]; acc_zero(acc);
        mma_seg<1, 0>(acc, a0, a1, 0, b0, b1, 256, lds);
#pragma unroll
        for (int mt = 0; mt < 4; ++mt) { const int row = wm * 64 + mt * 16 + fr; const float rs = rq[row] * 0.14724260355f; const int t = t0 + row;
#pragma unroll
            for (int nt = 0; nt < 2; ++nt) { const int col = ct * 128 + wn * 32 + nt * 16 + fq * 4; const int dd = col % 96;
                float v0 = acc[mt][nt][0] * rs, v1 = acc[mt][nt][1] * rs, v2 = acc[mt][nt][2] * rs, v3 = acc[mt][nt][3] * rs;
                if (dd >= 64 && !ctx) { const int pi = (dd - 64) >> 1;
                    const int posa = pi < 8 ? (t >> 6) : (t & 63), posb = (pi + 1) < 8 ? (t >> 6) : (t & 63);
                    const float2 ca = rope[posa * 8 + (pi & 7)], cb = rope[posb * 8 + ((pi + 1) & 7)];
                    const float n0 = v0 * ca.x - v1 * ca.y, n1 = v0 * ca.y + v1 * ca.x, n2 = v2 * cb.x - v3 * cb.y, n3 = v2 * cb.y + v3 * cb.x; v0 = n0; v1 = n1; v2 = n2; v3 = n3; }
                u32x2 w; w.x = cvt_pk_bf16(v0, v1); w.y = cvt_pk_bf16(v2, v3);
                *(u32x2*)(Qo + (size_t)(r0 + row) * 384 + col) = w; } }
    }
    if (part >= 3) { const int ct = part - 3;
        const bf16_t* a0 = P + (size_t)(r0 + g_srow()) * PLD + 1024 + g_skc() * 8; const bf16_t* a1 = a0 + (size_t)64 * PLD;
        const bf16_t* b0 = wts(p, l, WE_WUKV) + (size_t)(ct * 128 + g_srow()) * 128 + g_skc() * 8; const bf16_t* b1 = b0 + (size_t)64 * 128;
        f32x4 acc[4][2]; acc_zero(acc);
        mma_seg<1, 0>(acc, a0, a1, 0, b0, b1, 128, lds);
#pragma unroll
        for (int mt = 0; mt < 4; ++mt) { const int row = wm * 64 + mt * 16 + fr; const float rs = rkv[row];
#pragma unroll
            for (int nt = 0; nt < 2; ++nt) { const int cc = wn * 32 + nt * 16 + fq * 4;
                u32x2 w; w.x = cvt_pk_bf16(acc[mt][nt][0] * rs, acc[mt][nt][1] * rs); w.y = cvt_pk_bf16(acc[mt][nt][2] * rs, acc[mt][nt][3] * rs);
                if (cc < 64) *(u32x2*)(Ko + (size_t)(r0 + row) * 384 + ct * 96 + cc) = w;
                else *(u32x2*)(Vo + (size_t)(r0 + row) * 256 + ct * 64 + (cc - 64)) = w; } }
    }
}
__device__ __forceinline__ float sconv_lat(const bf16_t* HT, const float* sw, int b, int ch, int n) {
    const bf16_t* r = HT + ((size_t)b * 1024 + ch) * TPB;
    const float um = n > 0 ? bf2f(r[n - 1]) : 0.f, u0 = bf2f(r[n]), up = n < SEQ - 1 ? bf2f(r[n + 1]) : 0.f;
    return sw[ch] * um + sw[768 + ch] * u0 + sw[1536 + ch] * up;
}
__device__ __forceinline__ float2 h2f(unsigned u) { return make_float2((float)__builtin_bit_cast(_Float16, (unsigned short)(u & 0xffffu)), (float)__builtin_bit_cast(_Float16, (unsigned short)(u >> 16))); }
__device__ __forceinline__ unsigned f2h(float2 v) { return __builtin_bit_cast(unsigned, __builtin_amdgcn_cvt_pkrtz(v.x, v.y)); }
__device__ __forceinline__ void hyena_unit(const Params& p, int l, int c, char* lds, const FFrag& FF) {
    float2* buf = (float2*)lds; const float2* thi = (const float2*)(lds + FFT_LDS_TAB); const float2* tlo = thi + 128; const float2* t2hi = thi + 256; const float2* t2lo = thi + 384;
    float* red = (float*)(lds + FFT_LDS_EXTRA);
    const bf16_t* HT = WSP(const bf16_t, OFF_HYFN); const float* sw = p.in[I_HYSW] + (size_t)l * 3 * 768;
    const bf16_t* FL = WSP(const bf16_t, OFF_FILT);
    const float d0 = -3.0701134573253945f, d1 = -15.350567286626973f;
    const float awin = fabsf(d0 + (float)c * ((d1 - d0) / 255.f)) * (1.f / 16383.f);
    unsigned* GS = WSP(unsigned, OFF_HYS) + (size_t)(bidx() & 255) * 65536; unsigned* YS = GS + 16384; unsigned* XS = YS + 16384;
    unsigned Zr[32];
#define HY_W2(n) cmulf(t2hi[(n) >> 7], t2lo[(n) & 127])
#define HY_ST(a, q, v) __hip_atomic_store((a) + (q), (v), __ATOMIC_RELAXED, __HIP_MEMORY_SCOPE_AGENT)
#define HY_LD(a, q) __hip_atomic_load((a) + (q), __ATOMIC_RELAXED, __HIP_MEMORY_SCOPE_AGENT)
    __syncthreads();
#pragma unroll 4
    for (int i = 0; i < 32; ++i) { const int n = tidx() + 512 * i; buf[FBI(n)] = make_float2(sconv_lat(HT, sw, 0, c, n), sconv_lat(HT, sw, 1, c, n)); }
#pragma unroll
    for (int i = 0; i < 32; ++i) Zr[i] = f2h(buf[FBI(tidx() + 512 * i)]);
#pragma unroll 1
    for (int order = 0; order < 2; ++order) {
        const bf16_t* ff = FL + (size_t)(order * 256 + c) * 16384; const bf16_t* fb = FL + (size_t)(512 + order * 256 + c) * 16384;
        float ss = 0.f;
#pragma unroll 4
        for (int i = 0; i < 32; ++i) { const int n = tidx() + 512 * i; const float win = __expf(-(float)n * awin); const float hf = bf2f(ff[n]) * win, hb = bf2f(fb[n]) * win; ss += hf * hf + (n ? hb * hb : 0.f);
            HY_ST(XS, n, f2h(make_float2(sconv_lat(HT, sw, 0, (order + 1) * 256 + c, n), sconv_lat(HT, sw, 1, (order + 1) * 256 + c, n)))); }
        const float tot = block_sum(ss, red);
        const float fac = rsqrtf(tot + 1e-6f) * (16.f / 32768.f);
        const float bias = p.in[I_HYBIAS][(size_t)l * 512 + order * 256 + c];
#pragma unroll 1
        for (int par = 0; par < 2; ++par) {
            __syncthreads();
#pragma unroll 8
            for (int i = 0; i < 32; ++i) { const int n = tidx() + 512 * i; const int nr = 16384 - n;
                const float hf = bf2f(ff[n]) * __expf(-(float)n * awin); const float hbr = n ? bf2f(fb[nr]) * __expf(-(float)nr * awin) : 0.f;
                float2 v; if (par == 0) v = make_float2(hf + hbr, 0.f); else { const float2 w = HY_W2(n); const float d = hf - hbr; v = make_float2(d * w.x, d * w.y); }
                buf[FBI(n)] = v; }
            __syncthreads();
            fft_fwd_blk(buf, FF, thi, tlo);
#pragma unroll 8
            for (int i = 0; i < 32; ++i) { const int q = tidx() + 512 * i; HY_ST(GS, q, f2h(buf[FBI(q)])); }
            __syncthreads();
#pragma unroll
            for (int i = 0; i < 32; ++i) { const int n = tidx() + 512 * i; float2 z = h2f(Zr[i]); z.x *= 0.0625f; z.y *= 0.0625f; if (par) z = cmulf(z, HY_W2(n)); buf[FBI(n)] = z; }
            __syncthreads();
            fft_fwd_blk(buf, FF, thi, tlo);
            asm volatile("s_waitcnt vmcnt(0)" ::: "memory");
#pragma unroll
            for (int hh = 0; hh < 2; ++hh) { unsigned g[16];
#pragma unroll
              for (int i = 0; i < 16; ++i) g[i] = HY_LD(GS, tidx() + 512 * (hh * 16 + i));
#pragma unroll
              for (int i = 0; i < 16; ++i) { const int q = tidx() + 512 * (hh * 16 + i); const float2 pr = cmulf(buf[FBI(q)], h2f(g[i])); buf[FBI(q)] = make_float2(pr.x * fac, pr.y * fac);        }
              __builtin_amdgcn_sched_barrier(0); }
            __syncthreads();
            fft_inv_blk(buf, FF, thi, tlo);
            if (par == 0) {
#pragma unroll 8
                for (int i = 0; i < 32; ++i) { const int q = tidx() + 512 * i; const float2 v = buf[FBI(q)]; HY_ST(YS, q, f2h(v)); }
            } else {
                asm volatile("s_waitcnt vmcnt(0)" ::: "memory");
#pragma unroll
                for (int hh = 0; hh < 2; ++hh) {
                    unsigned y[16], xg[16];
#pragma unroll
                    for (int i = 0; i < 16; ++i) { y[i] = HY_LD(YS, tidx() + 512 * (hh * 16 + i)); xg[i] = HY_LD(XS, tidx() + 512 * (hh * 16 + i)); }
#pragma unroll
                    for (int i = 0; i < 16; ++i) { const int n = tidx() + 512 * (hh * 16 + i); const float2 v = buf[FBI(n)];
                        const float2 t2 = cmulcf(v, HY_W2(n)); const float2 y0 = h2f(y[i]); const float2 z = h2f(Zr[hh * 16 + i]); const float2 g = h2f(xg[i]);
                        Zr[hh * 16 + i] = f2h(make_float2(g.x * (y0.x + t2.x + bias * z.x), g.y * (y0.y + t2.y + bias * z.y))); }
                    __builtin_amdgcn_sched_barrier(0);
                }
            }
        }
    }
#undef HY_W2
#undef HY_ST
#undef HY_LD
    bf16_t* OB = WSP(bf16_t, OFF_OBT);
#pragma unroll
    for (int i = 0; i < 32; ++i) { const int n = tidx() + 512 * i; const float2 z = h2f(Zr[i]); OB[((size_t)0 * 256 + c) * TPB + n] = f2bf(z.x); OB[((size_t)1 * 256 + c) * TPB + n] = f2bf(z.y); }
    __syncthreads();
}
__device__ __forceinline__ void fnet_unit(const Params& p, int c, char* lds, const FFrag& FF) {
    float2* buf = (float2*)lds; const float2* thi = (const float2*)(lds + FFT_LDS_TAB); const float2* tlo = thi + 128;
    const int tid = tidx();
    const bf16_t* HT = WSP(const bf16_t, OFF_HYFN); bf16_t* OC = WSP(bf16_t, OFF_OCT);
    const bf16_t* r0 = HT + ((size_t)0 * 1024 + 768 + c) * TPB; const bf16_t* r1 = HT + ((size_t)1 * 1024 + 768 + c) * TPB;
    if (DBG_FN_COPY) {
        for (int i = 0; i < 32; ++i) { const int n = tid + 512 * i; OC[((size_t)0 * 512 + c) * TPB + n] = r0[n]; OC[((size_t)0 * 512 + 256 + c) * TPB + n] = r1[n]; OC[((size_t)1 * 512 + c) * TPB + n] = r1[n]; OC[((size_t)1 * 512 + 256 + c) * TPB + n] = r0[n]; }
        return;
    }
    __syncthreads();
#pragma unroll 4
    for (int i = 0; i < 32; ++i) { const int n = tid + 512 * i; buf[FBI(n)] = make_float2(bf2f(r0[n]), bf2f(r1[n])); }
    __syncthreads();
    fft_fwd_blk(buf, FF, thi, tlo);
#pragma unroll 4
    for (int i = 0; i < 32; ++i) { const int k = tid + 512 * i; const int km = (16384 - k) & 16383; const float2 X = buf[(k & 127) * FRS + (k >> 7)], Xm = buf[(km & 127) * FRS + (km >> 7)];
        OC[((size_t)0 * 512 + c) * TPB + k] = f2bf(0.5f * (X.x + Xm.x)); OC[((size_t)0 * 512 + 256 + c) * TPB + k] = f2bf(0.5f * (X.y - Xm.y));
        OC[((size_t)1 * 512 + c) * TPB + k] = f2bf(0.5f * (X.y + Xm.y)); OC[((size_t)1 * 512 + 256 + c) * TPB + k] = f2bf(-0.5f * (X.x - Xm.x)); }
    __syncthreads();
}
__device__ __forceinline__ void hyena_ctx_unit(const Params& p, int l, int c, char* lds) {
    float* zs = (float*)lds;
    float* hfs = zs + 512; float* hbs = hfs + 256; float* w3s = hbs + 256; float* red = w3s + 128;
    const int tid = tidx(), b = tid >> 8, t = tid & 255;
    const bf16_t* HT = WSP(const bf16_t, OFF_HYFN); const float* sw = p.in[I_HYSW] + (size_t)l * 3 * 768;
    const float* H2 = WSP(const float, OFF_H2C) + (size_t)l * 256 * 64; const float* w3 = p.in[I_HYW3] + (size_t)l * 64 * 1024;
    const float d0 = -3.0701134573253945f, d1 = -15.350567286626973f;
    const float adelta = fabsf(d0 + (float)c * ((d1 - d0) / 255.f));
    auto sc = [&](int ch) { const bf16_t* r = HT + ((size_t)b * 1024 + ch) * TPB + SEQ;
        const float um = t > 0 ? bf2f(r[t - 1]) : 0.f, u0 = bf2f(r[t]), up = t < 255 ? bf2f(r[t + 1]) : 0.f; return sw[ch] * um + sw[768 + ch] * u0 + sw[1536 + ch] * up; };
    __syncthreads();
    float z = sc(c);
    zs[b * 256 + t] = z;
    for (int order = 0; order < 2; ++order) {
        __syncthreads();
        if (tid < 128) w3s[tid] = w3[(size_t)(tid & 63) * 1024 + (tid >> 6) * 512 + order * 256 + c];
        __syncthreads();
        float ss = 0.f;
        if (tid < 256) { const float* hr = H2 + (size_t)tid * 64; float sf = 0.f, sb = 0.f;
#pragma unroll 16
            for (int j = 0; j < 64; ++j) { sf += hr[j] * w3s[j]; sb += hr[j] * w3s[64 + j]; }
            const float win = __expf(-((float)tid * (1.f / 255.f)) * adelta); const float hf = sf * win, hb = sb * win;
            hfs[tid] = hf; hbs[tid] = hb; ss = hf * hf + (tid ? hb * hb : 0.f); }
        const float tot = block_sum(ss, red);
        const float scale = rsqrtf(tot + 1e-6f);
        __syncthreads();
        float y = 0.f;
        for (int s = 0; s <= t; ++s) y += hfs[t - s] * zs[b * 256 + s];
        for (int s = t + 1; s < 256; ++s) y += hbs[s - t] * zs[b * 256 + s];
        const float bias = p.in[I_HYBIAS][(size_t)l * 512 + order * 256 + c];
        const float g = sc((order + 1) * 256 + c);
        z = g * (y * scale + bias * z);
        __syncthreads();
        zs[b * 256 + t] = z;
    }
    WSP(bf16_t, OFF_OBT)[((size_t)b * 256 + c) * TPB + SEQ + t] = f2bf(z);
    __syncthreads();
}
__device__ __forceinline__ void fnet_ctx_unit(const Params& p, int c, char* lds) {
    float* us = (float*)lds; float* cs = us + 512;
    const int tid = tidx(), b = tid >> 8, k = tid & 255;
    const bf16_t* HT = WSP(const bf16_t, OFF_HYFN);
    __syncthreads();
    us[tid] = bf2f(HT[((size_t)b * 1024 + 768 + c) * TPB + SEQ + k]);
    if (tid < 256) { float s, cc; sincospif(2.f * (float)tid / 256.f, &s, &cc); cs[tid] = cc; cs[256 + tid] = s; }
    __syncthreads();
    float ur = 0.f, ui = 0.f;
    for (int n = 0; n < 256; ++n) { const int m = (k * n) & 255; const float u = us[b * 256 + n]; ur += u * cs[m]; ui -= u * cs[256 + m]; }
    bf16_t* OC = WSP(bf16_t, OFF_OCT);
    OC[((size_t)b * 512 + c) * TPB + SEQ + k] = f2bf(8.f * ur); OC[((size_t)b * 512 + 256 + c) * TPB + SEQ + k] = f2bf(8.f * ui);
    __syncthreads();
}
__device__ __forceinline__ void na_unit(const Params& p, int l, int u, char* lds) {
    const int b = u >> 8, h = (u >> 6) & 3, rb = u & 63, r0 = rb * 4;
    float* biasL = (float*)(lds + ATT_LDS);
    __syncthreads();
    for (int i = tidx(); i < 465; i += 512) biasL[i] = p.in[I_RPB][((size_t)l * 4 + h) * 465 + i] * 8.f;
    const bf16_t* P = WSP(const bf16_t, OFF_P);
    int lo = r0 - 4; lo = lo < 0 ? 0 : (lo > 248 ? 248 : lo);
    int hr = r0 + 3 - 4; hr = hr < 0 ? 0 : (hr > 248 ? 248 : hr); hr += 7;
    const int nloc = hr - lo + 1;
    const size_t tb = (size_t)b * TPB;
    attn_unit<64, 1>(P + (tb + r0 * 64) * PLD + h * 64, PLD, P + tb * PLD + 256 + h * 64, PLD, P + tb * PLD + 512 + h * 64, PLD,
                     WSP(bf16_t, OFF_OAD) + (tb + r0 * 64) * 512 + 256 + h * 64, 512, 4 + nloc, 4, SEQ, lo * 64, lds, biasL, r0, lo);
}
__device__ __forceinline__ void na_ctx_unit(const Params& p, int u, char* lds) {
    const int b = u >> 2, h = u & 3; const bf16_t* P = WSP(const bf16_t, OFF_P); const size_t tb = (size_t)b * TPB;
    attn_unit<64, 0>(P + (tb + SEQ) * PLD + h * 64, PLD, P + tb * PLD + 256 + h * 64, PLD, P + tb * PLD + 512 + h * 64, PLD,
                     WSP(bf16_t, OFF_OAD) + (tb + SEQ) * 512 + 256 + h * 64, 512, 4, 4, SEQ, 0, lds, nullptr, 0, 0);
}
PHASE_FN void ph_mixers(const Params& p, int l, char* lds_unused) {
    char* lds = lds_dyn; (void)lds_unused;
    const int bid = bidx(), G = gdim(); const bool upd_ctx = (l != NLAYER - 1);
    fft_tables(lds);
    { FFrag FF; mfft_frags(FF, (const float2*)(lds + FFT_LDS_TAB));
      for (int rep = 0; rep < (REP_PHASE == 31 ? 2 : 1); ++rep) for (int c = bid; c < 256; c += G) hyena_unit(p, l, c, lds, FF);
      for (int rep = 0; rep < (REP_PHASE == 32 ? 2 : 1); ++rep) for (int c = bid; c < 256; c += G) fnet_unit(p, c, lds, FF); }
    __syncthreads();
    if (upd_ctx) { for (int c = bid; c < 256; c += G) hyena_ctx_unit(p, l, c, lds);
                   for (int c = bid; c < 256; c += G) fnet_ctx_unit(p, c, lds); }
    for (int rep = 0; rep < (REP_PHASE == 33 ? 2 : 1); ++rep) for (int t = bid; t < NTILE * 7; t += G) upproj_tile(p, l, t / 7, t % 7, lds);
    __syncthreads();
    for (int rep = 0; rep < (REP_PHASE == 34 ? 2 : 1); ++rep) for (int u = bid; u < 512; u += G) na_unit(p, l, u, lds);
    if (upd_ctx) for (int u = bid; u < 8; u += G) na_ctx_unit(p, u, lds);
}

__device__ __forceinline__ void transp_unit(const Params& p, int u, char* lds) {
    const int tid = tidx(), rt = u / 12, cg = u % 12, r0 = rt * 128, b = r0 >= TPB ? 1 : 0, t0 = r0 - b * TPB;
    const bf16_t* src = cg < 4 ? WSP(const bf16_t, OFF_OBT) + ((size_t)b * 256 + cg * 64) * TPB + t0 : WSP(const bf16_t, OFF_OCT) + ((size_t)b * 512 + (cg - 4) * 64) * TPB + t0;
    bf16_t* dst = WSP(bf16_t, OFF_P) + (size_t)r0 * 768 + cg * 64;
    char* tl = lds;
    __syncthreads();
    { const int c = tid >> 3, sg = tid & 7; const u32x4 x0 = *(const u32x4*)(src + (size_t)c * TPB + sg * 16), x1 = *(const u32x4*)(src + (size_t)c * TPB + sg * 16 + 8);
      *(u32x4*)(tl + c * 272 + sg * 32) = x0; *(u32x4*)(tl + c * 272 + sg * 32 + 16) = x1; }
    __syncthreads();
    { const int t = tid >> 2, q = tid & 3; unsigned w[8];
#pragma unroll
      for (int i = 0; i < 8; ++i) { const unsigned lo = *(const bf16_t*)(tl + (q * 16 + 2 * i) * 272 + t * 2), hi = *(const bf16_t*)(tl + (q * 16 + 2 * i + 1) * 272 + t * 2); w[i] = lo | (hi << 16); }
      u32x4 y0 = {w[0], w[1], w[2], w[3]}, y1 = {w[4], w[5], w[6], w[7]};
      *(u32x4*)(dst + (size_t)t * 768 + q * 16) = y0; *(u32x4*)(dst + (size_t)t * 768 + q * 16 + 8) = y1; }
}
PHASE_FN void ph_mla(const Params& p, int l, char* lds_unused) {
    char* lds = lds_dyn; (void)lds_unused;
    const bool upd_ctx = (l != NLAYER - 1);
    const bf16_t* Q = WSP(const bf16_t, OFF_Q); const bf16_t* K = WSP(const bf16_t, OFF_K); const bf16_t* V = WSP(const bf16_t, OFF_V); bf16_t* O = WSP(bf16_t, OFF_OAD);
    if (upd_ctx) for (int u = bidx(); u < 8; u += gdim()) { const int b = u >> 2, h = u & 3; const size_t tb = (size_t)b * TPB;
        mla_unit(Q + (tb + SEQ) * 384 + h * 96, K + tb * 384 + h * 96, V + tb * 256 + h * 64, O + (tb + SEQ) * 512 + h * 64, 4, 4, SEQ, 0, lds); }
    for (int v = bidx() >> 3; v < 64; v += (gdim() >> 3)) { const int bh = bidx() & 7, b = bh >> 2, h = bh & 3, qb = v; const size_t tb = (size_t)b * TPB;
        mla_unit(Q + (tb + qb * 256) * 384 + h * 96, K + tb * 384 + h * 96, V + tb * 256 + h * 64, O + (tb + qb * 256) * 512 + h * 64, 260, 260, 0, 0, lds); }
    __syncthreads();
    for (int u = bidx(); u < NTILE * 12; u += gdim()) { if (skip_tile(l, u / 12)) continue; transp_unit(p, u, lds); }
    { const u32x4* Hs = WSP(const u32x4, OFF_H); u32x2* H8 = WSP(u32x2, OFF_HYS);
      for (int i = bidx() * 512 + tidx(); i < T * 128; i += gdim() * 512) { const u32x4 h = Hs[i]; u32x2 w; int t0 = 0, t1 = 0;
          t0 = __builtin_amdgcn_cvt_pk_fp8_f32(__uint_as_float(h.x << 16), __uint_as_float(h.x & 0xffff0000u), t0, false); t0 = __builtin_amdgcn_cvt_pk_fp8_f32(__uint_as_float(h.y << 16), __uint_as_float(h.y & 0xffff0000u), t0, true);
          t1 = __builtin_amdgcn_cvt_pk_fp8_f32(__uint_as_float(h.z << 16), __uint_as_float(h.z & 0xffff0000u), t1, false); t1 = __builtin_amdgcn_cvt_pk_fp8_f32(__uint_as_float(h.w << 16), __uint_as_float(h.w & 0xffff0000u), t1, true);
          w.x = (unsigned)t0; w.y = (unsigned)t1; H8[i] = w; } }
}

template <int FP8, int NKT>
__device__ __forceinline__ void gate4_stream(f32x4 (&ag)[4][4][2], const char* a0, const char* a1, const char* Wb, size_t nstride, int rowstride, int a_rd, int b_rd, char* lds) {
    const int wid = __builtin_amdgcn_readfirstlane(tidx() >> 6);
    LAS char* L = (LAS char*)lds_dyn + ((wid >> 1) * 2 + (wid & 1)) * 1024;
    const int srow = g_srow(), skc = g_skc();
    i32x8 A8[4], B8[2][2];
#pragma unroll
    for (int mt = 0; mt < 4; ++mt) A8[mt] = (i32x8)(0);
    B8[1][0] = (i32x8)(0); B8[1][1] = (i32x8)(0);
    auto issue_h = [&](int s, int h) { const int kt = s >> 2, n = s & 3; LAS char* Bb = L + 32768 + n * 16384 + h * 8192;
        int eo = srow * rowstride + skc * 16; asm volatile("" : "+v"(eo));
        eo += (kt << 7) + h * 64 * rowstride;
        const char* w = Wb + (size_t)n * nstride + (unsigned)eo;
        __builtin_amdgcn_global_load_lds((const unsigned*)(w), (LAS unsigned*)(Bb), 16, 0, 0);
        if (n == 0) { LAS char* Ab = L + (kt & 1) * 16384 + h * 8192; const char* hp = (h ? a1 : a0) + (kt << 7);
            __builtin_amdgcn_global_load_lds((const unsigned*)(hp), (LAS unsigned*)(Ab), 16, 0, 0); } };
    auto issue = [&](int s) { issue_h(s, 0); issue_h(s, 1); };
    auto ld8 = [&](const char* base) { const u32x4 lo = *(const u32x4*)(base), hi = *(const u32x4*)(base + 1024);
        return (i32x8){(int)lo.x, (int)lo.y, (int)lo.z, (int)lo.w, (int)hi.x, (int)hi.y, (int)hi.z, (int)hi.w}; };
    constexpr int SC1 = 0x7f7f7f7f, SCW = 0x79797979;
    auto mm = [&](f32x4 c, const i32x8& b, const i32x8& a) {
        if (FP8) return __builtin_amdgcn_mfma_scale_f32_16x16x128_f8f6f4(b, a, c, 0, 0, 0, SCW, 0, SC1);
        typedef int i32x4_ __attribute__((ext_vector_type(4)));
        const i32x4_ bl = __builtin_shufflevector(b, b, 0, 1, 2, 3), bh = __builtin_shufflevector(b, b, 4, 5, 6, 7), al = __builtin_shufflevector(a, a, 0, 1, 2, 3), ah = __builtin_shufflevector(a, a, 4, 5, 6, 7);
        c = __builtin_amdgcn_mfma_f32_16x16x32_bf16(__builtin_bit_cast(bf16x8, bl), __builtin_bit_cast(bf16x8, al), c, 0, 0, 0);
        return __builtin_amdgcn_mfma_f32_16x16x32_bf16(__builtin_bit_cast(bf16x8, bh), __builtin_bit_cast(bf16x8, ah), c, 0, 0, 0); };
    issue(0); issue(1); issue(2);
#define MG8_SUB(N, PV, COND, SN) do { const char* Bs_ = lds + 32768 + (N) * 16384 + b_rd;                                       \
        B8[(N) & 1][0] = ld8(Bs_); B8[(N) & 1][1] = ld8(Bs_ + 2048); if (COND) issue_h((SN), 0); SB();                          \
        _Pragma("unroll") for (int mt = 0; mt < 4; ++mt) {                                                                     \
            _Pragma("unroll") for (int nt = 0; nt < 2; ++nt) ag[PV][mt][nt] = mm(ag[PV][mt][nt], B8[((N) & 1) ^ 1][nt], A8[mt]);  \
            if ((N) == 0) A8[mt] = ld8(As + a_rd + mt * 2048); }                                                               \
        if (COND) issue_h((SN), 1); SB(); } while (0)
#define MG8_KT(LASTK) do { const char* As = lds + (kt & 1) * 16384;                                                            \
        G_WAITV(4); __builtin_amdgcn_s_barrier(); asm volatile("" ::: "memory");                                               \
        MG8_SUB(0, 3, true, 4 * kt + 3);                                                                                       \
        G_WAITV(4); __builtin_amdgcn_s_barrier(); asm volatile("" ::: "memory");                                               \
        MG8_SUB(1, 0, !(LASTK), 4 * kt + 4);                                                                                   \
        if (!(LASTK)) G_WAITV(6); else G_WAITV(2);                                                                             \
        __builtin_amdgcn_s_barrier(); asm volatile("" ::: "memory");                                                           \
        MG8_SUB(2, 1, !(LASTK), 4 * kt + 5);                                                                                   \
        if (!(LASTK)) G_WAITV(6); else G_WAITV(0);                                                                             \
        __builtin_amdgcn_s_barrier(); asm volatile("" ::: "memory");                                                           \
        MG8_SUB(3, 2, !(LASTK), 4 * kt + 6); } while (0)
    int kt = 0;
#pragma unroll 1
    for (; kt < NKT - 1; ++kt) MG8_KT(false);
    MG8_KT(true);
#undef MG8_KT
#undef MG8_SUB
#pragma unroll
    for (int mt = 0; mt < 4; ++mt)
#pragma unroll
        for (int nt = 0; nt < 2; ++nt) ag[3][mt][nt] = mm(ag[3][mt][nt], B8[1][nt], A8[mt]);
    __syncthreads();
}

__device__ __forceinline__ void merge_unit(const Params& p, int l, int rt, int ct, char* lds) {
    const int tid = tidx(), lane = tid & 63, wid = __builtin_amdgcn_readfirstlane(tid >> 6), wm = wid >> 2, wn = wid & 3, fr = lane & 15, fq = lane >> 4;
    const int a_rd = g_lds_byte(wm * 64 + fr, fq * 8), b_rd = g_lds_byte(wn * 32 + fr, fq * 8);
    const int r0 = rt * 128, n0 = ct * 128;
    LAS char* L = (LAS char*)lds_dyn + ((wid >> 1) * 2 + (wid & 1)) * 1024;
    const int srow = g_srow(), skc = g_skc();
    GFrag f0, f1;
    unsigned gp[4][4][2][2];
    {
        const char* Hb = WSP(const char, OFF_HYS) + (size_t)(r0 + srow) * 1024 + skc * 16;
        const char* Wb = (const char*)wts(p, l, WE_WGT) + (size_t)n0 * 1024;
        f32x4 ag[4][4][2];
#pragma unroll
        for (int n = 0; n < 4; ++n) acc_zero(ag[n]);
        gate4_stream<1, 8>(ag, Hb, Hb + (size_t)64 * 1024, Wb, (size_t)1024 * 1024, 1024, a_rd, b_rd, lds);
#pragma unroll
        for (int n = 0; n < 4; ++n) {
#pragma unroll
            for (int mt = 0; mt < 4; ++mt) {
#pragma unroll
                for (int nt = 0; nt < 2; ++nt) { gp[n][mt][nt][0] = cvt_pk_bf16(sigmoid_f(ag[n][mt][nt][0]), sigmoid_f(ag[n][mt][nt][1])); gp[n][mt][nt][1] = cvt_pk_bf16(sigmoid_f(ag[n][mt][nt][2]), sigmoid_f(ag[n][mt][nt][3]));
                    asm volatile("" : "+v"(gp[n][mt][nt][0]), "+v"(gp[n][mt][nt][1])); }
            }
        }
    }
    SB();
    f32x4 am[4][2], ap[4][2]; acc_zero(am); acc_zero(ap);
    {
        const bf16_t* OAD = WSP(const bf16_t, OFF_OAD); const bf16_t* OBC = WSP(const bf16_t, OFF_P);
        auto issue = [&](int s) { const bf16_t* a; const bf16_t* b; unsigned as, bs; int k0;
            int so = srow, sk = skc * 8; asm volatile("" : "+v"(so), "+v"(sk));
            if (s < 4)       { k0 = (s << 6) + sk;        a = OAD + (unsigned)((r0 + so) * 512 + k0);       as = 64 * 512; b = wts(p, l, WE_WBA) + (unsigned)((n0 + so) * 256 + k0); bs = 64 * 256; }
            else if (s < 8)  { k0 = ((s - 4) << 6) + sk;  a = OBC + (unsigned)((r0 + so) * 768 + k0);       as = 64 * 768; b = wts(p, l, WE_WBB) + (unsigned)((n0 + so) * 256 + k0); bs = 64 * 256; }
            else if (s < 16) { k0 = ((s - 8) << 6) + sk;  a = OBC + (unsigned)((r0 + so) * 768 + 256 + k0); as = 64 * 768; b = wts(p, l, WE_WBC) + (unsigned)((n0 + so) * 512 + k0); bs = 64 * 512; }
            else             { k0 = ((s - 16) << 6) + sk; a = OAD + (unsigned)((r0 + so) * 512 + 256 + k0); as = 64 * 512; b = wts(p, l, WE_WBD) + (unsigned)((n0 + so) * 256 + k0); bs = 64 * 256; }
            LAS char* Lb = L + (s & 3) * G_STAGE;
            __builtin_amdgcn_global_load_lds((const unsigned*)(a), (LAS unsigned*)(Lb), 16, 0, 0);
            __builtin_amdgcn_global_load_lds((const unsigned*)(a + as), (LAS unsigned*)(Lb + 8192), 16, 0, 0);
            __builtin_amdgcn_global_load_lds((const unsigned*)(b), (LAS unsigned*)(Lb + G_TILE), 16, 0, 0);
            __builtin_amdgcn_global_load_lds((const unsigned*)(b + bs), (LAS unsigned*)(Lb + G_TILE + 8192), 16, 0, 0); };
        auto combine = [&](const unsigned (&g)[4][2][2]) {
#pragma unroll
            for (int mt = 0; mt < 4; ++mt)
#pragma unroll
                for (int nt = 0; nt < 2; ++nt) {
                    const unsigned g0 = g[mt][nt][0], g1 = g[mt][nt][1];
                    am[mt][nt][0] += __uint_as_float(g0 << 16) * ap[mt][nt][0]; am[mt][nt][1] += __uint_as_float(g0 & 0xffff0000u) * ap[mt][nt][1];
                    am[mt][nt][2] += __uint_as_float(g1 << 16) * ap[mt][nt][2]; am[mt][nt][3] += __uint_as_float(g1 & 0xffff0000u) * ap[mt][nt][3];
                    ap[mt][nt] = (f32x4){0.f, 0.f, 0.f, 0.f};
                    asm volatile("" : "+v"(am[mt][nt])); } };
        gf_zero(f1);
        issue(0); issue(1); issue(2);
        int s = 0;
#pragma unroll
        for (int n = 0; n < 4; ++n) {
            const int send = n == 0 ? 4 : n == 1 ? 8 : n == 2 ? 16 : 20;
#pragma unroll 1
            for (; s < send; ++s) {
                if (s + 2 < 20) G_WAITV(8); else if (s + 1 < 20) G_WAITV(4); else G_WAITV(0);
                __builtin_amdgcn_s_barrier(); asm volatile("" ::: "memory");
                if (s + 3 < 20) issue(s + 3);
                const char* As = lds + (s & 3) * G_STAGE;
                GF_STAGE(ap, ap, As, As + G_TILE);
            }
            gf_mma(ap, f1); SB();
            combine(gp[n]); gf_zero(f1); SB();
        }
        __syncthreads();
    }
    bf16_t* M = WSP(bf16_t, OFF_HYFN);
    const int t2 = tidx(), w2 = t2 >> 6, l2 = t2 & 63;
    int so = (r0 + (w2 >> 2) * 64 + (l2 & 15)) * 1024 + n0 + (w2 & 3) * 32 + (l2 >> 4) * 4;
#pragma unroll
    for (int mt = 0; mt < 4; ++mt)
#pragma unroll
        for (int nt = 0; nt < 2; ++nt) {
            u32x2 w; w.x = cvt_pk_bf16(am[mt][nt][0], am[mt][nt][1]); w.y = cvt_pk_bf16(am[mt][nt][2], am[mt][nt][3]);
            *(u32x2*)(M + (unsigned)(so + mt * 16 * 1024 + nt * 16)) = w; }
    SB();
}
PHASE_FN void ph_merge(const Params& p, int l, char* lds_unused) {
    char* lds = lds_dyn; (void)lds_unused;
    { const int xcd = bidx() & 7, ctp = xcd & 3, par = xcd >> 2;
      for (int v = bidx() >> 3; v < NTILE; v += (gdim() >> 3)) {
          const int rt = (v >> 1) * 2 + par, ct = ctp * 2 + (v & 1); if (skip_tile(l, rt)) continue;
          merge_unit(p, l, rt, ct, lds);
      } }
}

PHASE_FN void ph_wout(const Params& p, int l, char* lds_unused) {
    char* lds = lds_dyn; (void)lds_unused;
    const int tid = tidx(), lane = tid & 63, wid = tid >> 6, wm = wid >> 2, wn = wid & 3, fr = lane & 15, fq = lane >> 4;
    const int a_rd = g_lds_byte(wm * 64 + fr, fq * 8), b_rd = g_lds_byte(wn * 32 + fr, fq * 8);
    const bf16_t* M = WSP(const bf16_t, OFF_HYFN);
    auto epi = [&](const f32x4 (&acc)[4][2], int r0, int n0) {
        const float* gt = modvec(p, l, r0) + 2048;
#pragma unroll
        for (int mt = 0; mt < 4; ++mt) { const int row = r0 + wm * 64 + mt * 16 + fr; const float* xs = (l == 0) ? xrow_in(p, row) : xrow_st(p, row); float* xd = xrow_st(p, row);
#pragma unroll
            for (int nt = 0; nt < 2; ++nt) { const int col = n0 + wn * 32 + nt * 16 + fq * 4; const f32x4 x = *(const f32x4*)(xs + col), g = *(const f32x4*)(gt + col);
                f32x4 o; o[0] = x[0] + g[0] * acc[mt][nt][0]; o[1] = x[1] + g[1] * acc[mt][nt][1]; o[2] = x[2] + g[2] * acc[mt][nt][2]; o[3] = x[3] + g[3] * acc[mt][nt][3];
                if (DBG_NO_MIX) o = x;
                *(f32x4*)(xd + col) = o; } } };
    for (int u = bidx(); u < 512; u += gdim()) {
        const int lt = u >> 1, half = u & 1, rt = lt + (lt >> 7) * 2, r0 = rt * 128;
        const char* a0 = (const char*)(M + (size_t)(r0 + g_srow()) * 1024 + g_skc() * 8);
        const char* Wb = (const char*)(wts(p, l, WE_WOUT) + (size_t)half * 512 * 1024);
        f32x4 ag[4][4][2];
#pragma unroll
        for (int n = 0; n < 4; ++n) acc_zero(ag[n]);
        gate4_stream<0, 16>(ag, a0, a0 + (size_t)64 * 2048, Wb, (size_t)128 * 2048, 2048, a_rd, b_rd, lds);
#pragma unroll
        for (int n = 0; n < 4; ++n) epi(ag[n], r0, half * 512 + n * 128);
    }
    if (l != NLAYER - 1) for (int u = bidx(); u < 32; u += gdim()) {
        const int rt = 128 + (u >> 4) * 130 + ((u >> 3) & 1), ct = u & 7, r0 = rt * 128, n0 = ct * 128;
        const bf16_t* a0 = M + (size_t)(r0 + g_srow()) * 1024 + g_skc() * 8; const bf16_t* b0 = wts(p, l, WE_WOUT) + (size_t)(n0 + g_srow()) * 1024 + g_skc() * 8;
        f32x4 acc[4][2]; acc_zero(acc);
        mma_seg<1, 0>(acc, a0, a0 + (size_t)64 * 1024, 0, b0, b0 + (size_t)64 * 1024, 1024, lds);
        epi(acc, r0, n0);
    }
}

__device__ __forceinline__ int* moe_sched(const Params& p, int l, char* lds) {
    int* s = (int*)(lds + G_LDS);
    __syncthreads();
    if (tidx() == 0) { int acc = 0; for (int i = 0; i < 24; ++i) { const int c = WSP(const int, OFF_CNT)[l * 32 + i]; s[32 + i] = c; s[i] = acc; acc += (c + 127) >> 7; } s[24] = acc; }
    __syncthreads();
    return s;
}
__device__ __forceinline__ void moe_decode(const int* s, int tg, int& pid, int& tl, int& cnt) {
    pid = 0;
    for (int i = 1; i < 24; ++i) if (tg >= s[i]) pid = i;
    tl = tg - s[pid]; cnt = s[32 + pid];
}
__device__ __forceinline__ void pair_experts(int pid, int& elo, int& ehi) { const int g = pid / 6, pi = pid % 6; const int lo = pi < 3 ? 0 : (pi < 5 ? 1 : 2); const int hi = pi < 3 ? pi + 1 : (pi < 5 ? pi - 1 : 3); elo = g * 4 + lo; ehi = g * 4 + hi; }
PHASE_FN void ph_moe1(const Params& p, int l, char* lds_unused) {
    char* lds = lds_dyn; (void)lds_unused;
    const int tid = tidx(), lane = tid & 63, wid = tid >> 6, wm = wid >> 2, wn = wid & 3, fr = lane & 15, fq = lane >> 4;
    const int a_rd = g_lds_byte(wm * 64 + fr, fq * 8), b_rd = g_lds_byte(wn * 32 + fr, fq * 8);
    const int* s = moe_sched(p, l, lds);
    const bf16_t* H = WSP(const bf16_t, OFF_H); bf16_t* ACT = WSP(bf16_t, OFF_P); const int* lists = WSP(const int, OFF_LISTS); const float* tokw = WSP(const float, OFF_TOKW);
    const int ntiles = s[24];
    const int U = ntiles * 2, UF = (U >> 8) << 8;
    for (int u = bidx(); u < UF; u += gdim()) {
        const int tg = u >> 1, half = u & 1; int pid, tl, cnt; moe_decode(s, tg, pid, tl, cnt); int elo, ehi; pair_experts(pid, elo, ehi);
        const int e = half ? ehi : elo;
        const int* lst = lists + (size_t)pid * T;
        auto tok = [&](int rowi) { const int sl = tl * 128 + rowi; return lst[sl < cnt ? sl : 0]; };
        const char* a0 = (const char*)(H + (size_t)tok(g_srow()) * 1024 + g_skc() * 8); const char* a1 = (const char*)(H + (size_t)tok(g_srow() + 64) * 1024 + g_skc() * 8);
        const char* Wb = (const char*)(wts(p, l, WE_WGU) + (size_t)e * 512 * 1024);
        f32x4 ag[4][4][2];
#pragma unroll
        for (int n = 0; n < 4; ++n) acc_zero(ag[n]);
        gate4_stream<0, 16>(ag, a0, a1, Wb, (size_t)128 * 1024 * 2, 2048, a_rd, b_rd, lds);
#pragma unroll
        for (int tt = 0; tt < 4; ++tt)
#pragma unroll
            for (int mt = 0; mt < 4; ++mt) { const int rowi = wm * 64 + mt * 16 + fr; const float w = tokw[(size_t)tok(rowi) * 2 + half];
                float o[4];
#pragma unroll
                for (int j = 0; j < 4; ++j) o[j] = silu_f(ag[tt][mt][0][j]) * ag[tt][mt][1][j] * w;
                u32x2 pk; pk.x = cvt_pk_bf16(o[0], o[1]); pk.y = cvt_pk_bf16(o[2], o[3]);
                *(u32x2*)(ACT + (size_t)(tg * 128 + rowi) * 512 + half * 256 + tt * 64 + wn * 16 + fq * 4) = pk; }
    }
    for (int v = bidx(); v < (U - UF) * 4; v += gdim()) {
        const int tid = tidx(), lane = tid & 63, wid = tid >> 6, wm = wid >> 2, wn = wid & 3, fr = lane & 15, fq = lane >> 4;
        const int u4 = UF + (v >> 2), tt = v & 3, tg = u4 >> 1, half = u4 & 1; int pid, tl, cnt; moe_decode(s, tg, pid, tl, cnt); int elo, ehi; pair_experts(pid, elo, ehi);
        const int e = half ? ehi : elo;
        const int* lst = lists + (size_t)pid * T;
        auto tok = [&](int rowi) { const int sl = tl * 128 + rowi; return lst[sl < cnt ? sl : 0]; };
        const bf16_t* a0 = H + (size_t)tok(g_srow()) * 1024 + g_skc() * 8; const bf16_t* a1 = H + (size_t)tok(g_srow() + 64) * 1024 + g_skc() * 8;
        const bf16_t* b0 = wts(p, l, WE_WGU) + ((size_t)e * 512 + tt * 128 + g_srow()) * 1024 + g_skc() * 8;
        f32x4 acc[4][2]; acc_zero(acc);
        mma_seg<1, 0>(acc, a0, a1, 0, b0, b0 + (size_t)64 * 1024, 1024, lds);
#pragma unroll
        for (int mt = 0; mt < 4; ++mt) { const int rowi = wm * 64 + mt * 16 + fr; const float w = tokw[(size_t)tok(rowi) * 2 + half];
            float o[4];
#pragma unroll
            for (int j = 0; j < 4; ++j) o[j] = silu_f(acc[mt][0][j]) * acc[mt][1][j] * w;
            u32x2 pk; pk.x = cvt_pk_bf16(o[0], o[1]); pk.y = cvt_pk_bf16(o[2], o[3]);
            *(u32x2*)(ACT + (size_t)(tg * 128 + rowi) * 512 + half * 256 + tt * 64 + wn * 16 + fq * 4) = pk; }
    }
}
PHASE_FN void ph_moe2(const Params& p, int l, char* lds_unused) {
    char* lds = lds_dyn; (void)lds_unused;
    const int tid = tidx(), lane = tid & 63, wid = tid >> 6, wm = wid >> 2, wn = wid & 3, fr = lane & 15, fq = lane >> 4;
    const int* s = moe_sched(p, l, lds);
    const bf16_t* ACT = WSP(const bf16_t, OFF_P); const int* lists = WSP(const int, OFF_LISTS);
    const int ntiles = s[24];
    for (int u = bidx(); u < ntiles * 8; u += gdim()) {
        const int tg = u >> 3, ct = u & 7; int pid, tl, cnt; moe_decode(s, tg, pid, tl, cnt); int elo, ehi; pair_experts(pid, elo, ehi);
        const int* lst = lists + (size_t)pid * T;
        f32x4 acc[4][2]; acc_zero(acc);
        { const bf16_t* a0 = ACT + (size_t)(tg * 128 + g_srow()) * 512 + g_skc() * 8; const bf16_t* b0 = wts(p, l, WE_WDN) + ((size_t)elo * 1024 + ct * 128 + g_srow()) * 256 + g_skc() * 8;
          mma_seg<1, 0>(acc, a0, a0 + (size_t)64 * 512, 0, b0, b0 + (size_t)64 * 256, 256, lds); }
        { const bf16_t* a0 = ACT + (size_t)(tg * 128 + g_srow()) * 512 + 256 + g_skc() * 8; const bf16_t* b0 = wts(p, l, WE_WDN) + ((size_t)ehi * 1024 + ct * 128 + g_srow()) * 256 + g_skc() * 8;
          mma_seg<1, 0>(acc, a0, a0 + (size_t)64 * 512, 0, b0, b0 + (size_t)64 * 256, 256, lds); }
#pragma unroll
        for (int mt = 0; mt < 4; ++mt) { const int sl = tl * 128 + wm * 64 + mt * 16 + fr;
            if (sl < cnt) { const int r = lst[sl]; float* xd = xrow_st(p, r); const float* gt = modvec(p, l, r) + 5120;
#pragma unroll
                for (int nt = 0; nt < 2; ++nt) { const int col = ct * 128 + wn * 32 + nt * 16 + fq * 4; const f32x4 x = *(const f32x4*)(xd + col), g = *(const f32x4*)(gt + col);
                    f32x4 o; o[0] = x[0] + g[0] * acc[mt][nt][0]; o[1] = x[1] + g[1] * acc[mt][nt][1]; o[2] = x[2] + g[2] * acc[mt][nt][2]; o[3] = x[3] + g[3] * acc[mt][nt][3];
                    if (DBG_NO_MOE) o = x;
                    *(f32x4*)(xd + col) = o; } } }
    }
}

PHASE_FN void ph_final(const Params& p) {
    const int wid = tidx() >> 6, lane = tidx() & 63; const float* g = p.in[I_FNG];
    for (int r = bidx() * 8 + wid; r < 2 * SEQ; r += gdim() * 8) {
        float* xr = p.out + (size_t)r * D; f32x4 v[4]; float ss = 0.f;
#pragma unroll
        for (int i = 0; i < 4; ++i) { v[i] = *(const f32x4*)(xr + i * 256 + lane * 4); ss += v[i][0] * v[i][0] + v[i][1] * v[i][1] + v[i][2] * v[i][2] + v[i][3] * v[i][3]; }
        ss = wave_sum(ss); const float rinv = rsqrtf(ss * (1.f / 1024.f) + 1e-6f);
#pragma unroll
        for (int i = 0; i < 4; ++i) { const f32x4 gg = *(const f32x4*)(g + i * 256 + lane * 4); f32x4 o; o[0] = v[i][0] * rinv * gg[0]; o[1] = v[i][1] * rinv * gg[1]; o[2] = v[i][2] * rinv * gg[2]; o[3] = v[i][3] * rinv * gg[3];
            *(f32x4*)(xr + i * 256 + lane * 4) = o; }
    }
}

__device__ __forceinline__ void ph_dbgcmp(const Params& p, size_t oa, size_t ob, int slot) {
    const u32x4* a = WSP(const u32x4, oa); const u32x4* b = WSP(const u32x4, ob); int bad = 0;
    const size_t n = (size_t)2 * 1024 * TPB * 2 / 16;
    for (size_t i = (size_t)bidx() * 512 + tidx(); i < n; i += (size_t)gdim() * 512) { const u32x4 x = a[i], y = b[i]; if (x.x != y.x || x.y != y.y || x.z != y.z || x.w != y.w) bad = 1; }
    if (bad) atomicAdd(WSP(int, OFF_CNT) + slot, 1);
}
constexpr int LDS_BYTES = 150 * 1024;
template <int PH>
__global__ void __launch_bounds__(512) k_phase(Params p, int l) {
    char* lds = lds_dyn;
    if (PH == 0) ph_prologue(p, lds);
    if (PH == 1) { ph_wconv(p, l, lds); __syncthreads(); ph_filt(p, l, lds); __syncthreads(); ph_norm<0>(p, l, lds); }
    if (PH == 2) ph_gemm1(p, l, lds);
    if (PH == 3) ph_mixers(p, l, lds);
    if (PH == 4) ph_mla(p, l, lds);
    if (PH == 5) ph_merge(p, l, lds);
    if (PH == 6) ph_wout(p, l, lds);
    if (PH == 7) ph_norm<1>(p, l, lds);
    if (PH == 8) ph_moe1(p, l, lds);
    if (PH == 9) ph_moe2(p, l, lds);
    if (PH == 10) ph_final(p);
}

#if ONE_LAUNCH
__global__ void __launch_bounds__(512) k_fused(Params p0) {
    char* lds = lds_dyn;
    volatile LAS unsigned* xbw = (volatile LAS unsigned*)(lds + LDS_BYTES - 16);
    if (threadIdx.x == 0) { xbw[0] = 0u; xbw[1] = 0u; xbw[2] = 0u; xbw[3] = 0u; }
    __syncthreads();
    (void)xcd_barrier_post((unsigned*)(p0.ws + OFF_BAR), xbw);
#define PQ() ({ Params q_ = p0; asm volatile("" : "+s"(q_.ws)); q_; })
#define GRID_BARRIER() do { XcdBarrier bar_; bar_.bar = (unsigned*)(p0.ws + OFF_BAR); bar_.x = xb_xcc_id(); bar_.st = (volatile LAS unsigned*)(lds_dyn + LDS_BYTES - 16); xcd_barrier(bar_); } while (0)
    asm volatile("; PHASE_MARK 0" ::: "memory"); ph_prologue(PQ(), lds);
    if (REP_PHASE == 100) { GRID_BARRIER(); ph_prologue(PQ(), lds); }
    GRID_BARRIER();
#pragma unroll
    for (int l = 0; l < NLAYER; ++l) {
        asm volatile("; PHASE_MARK 1" ::: "memory"); ph_wconv(PQ(), l, lds); __syncthreads(); ph_filt(PQ(), l, lds); __syncthreads(); ph_norm<0>(PQ(), l, lds);
        GRID_BARRIER();
        if (REP_PHASE == 1) { ph_wconv(PQ(), l, lds); __syncthreads(); ph_norm<0>(PQ(), l, lds); GRID_BARRIER(); }
        asm volatile("; PHASE_MARK 2" ::: "memory"); ph_gemm1(PQ(), l, lds);
        GRID_BARRIER();
        if (REP_PHASE == 2) { ph_gemm1(PQ(), l, lds); GRID_BARRIER(); }

        asm volatile("; PHASE_MARK 3" ::: "memory"); ph_mixers(PQ(), l, lds);
        GRID_BARRIER();
        if (REP_PHASE == 3) { ph_mixers(PQ(), l, lds); GRID_BARRIER(); }
        asm volatile("; PHASE_MARK 4" ::: "memory"); ph_mla(PQ(), l, lds);
        GRID_BARRIER();
        if (REP_PHASE == 4) { ph_mla(PQ(), l, lds); GRID_BARRIER(); }
        asm volatile("; PHASE_MARK 5" ::: "memory"); ph_merge(PQ(), l, lds);
        GRID_BARRIER();
        if (REP_PHASE == 5) { ph_merge(PQ(), l, lds); GRID_BARRIER(); }
        asm volatile("; PHASE_MARK 6" ::: "memory"); ph_wout(PQ(), l, lds);
        GRID_BARRIER();
        if (REP_PHASE == 6 && l == 0) { ph_wout(PQ(), l, lds); GRID_BARRIER(); }
        asm volatile("; PHASE_MARK 7" ::: "memory"); ph_norm<1>(PQ(), l, lds);
        GRID_BARRIER();
        if (REP_PHASE == 7) { ph_norm<2>(PQ(), l, lds); GRID_BARRIER(); }
        asm volatile("; PHASE_MARK 8" ::: "memory"); ph_moe1(PQ(), l, lds);
        GRID_BARRIER();
        if (REP_PHASE == 8) { ph_moe1(PQ(), l, lds); GRID_BARRIER(); }
        asm volatile("; PHASE_MARK 9" ::: "memory"); ph_moe2(PQ(), l, lds);
        GRID_BARRIER();
    }
    asm volatile("; PHASE_MARK 10" ::: "memory"); ph_final(PQ());
}
#endif
template <int PH> static void launch_phase(const Params& p, int l, int grid, hipStream_t stream) {
    static bool attr = false;
    if (!attr) { hipFuncSetAttribute((const void*)k_phase<PH>, hipFuncAttributeMaxDynamicSharedMemorySize, LDS_BYTES); attr = true; }
    hipLaunchKernelGGL(k_phase<PH>, dim3(grid), dim3(512), LDS_BYTES, stream, p, l);
}

extern "C" void kernel_launch(void* const* d_in, const int* in_sizes, int n_in, void* d_out, int out_size, void* d_ws, size_t ws_size, hipStream_t stream) {
    if (n_in != 33 || ws_size < WS_TOTAL || out_size != 2 * SEQ * D) { fprintf(stderr, "kernel_launch: unexpected shapes: n_in %d ws %zu (need %zu) out %d\n", n_in, ws_size, WS_TOTAL, out_size); return; }
    Params p{};
    for (int i = 0; i < 33; ++i) p.in[i] = (const float*)d_in[i];
    p.out = (float*)d_out; p.ws = (unsigned char*)d_ws;
    hipMemsetAsync(d_ws, 0, ZERO_BYTES, stream);
#if ONE_LAUNCH
    static int grid1 = 0;
    if (!grid1) {
        int dev = 0, cus = 0, per_cu = 0;
        hipGetDevice(&dev); hipDeviceGetAttribute(&cus, hipDeviceAttributeMultiprocessorCount, dev);
        hipFuncSetAttribute((const void*)k_fused, hipFuncAttributeMaxDynamicSharedMemorySize, LDS_BYTES);
        hipOccupancyMaxActiveBlocksPerMultiprocessor(&per_cu, k_fused, 512, LDS_BYTES);
        if (per_cu < 1 || cus < 256) { fprintf(stderr, "kernel_launch: cannot make the grid resident (cus %d, blocks/cu %d)\n", cus, per_cu); return; }
        grid1 = 256;
    }
    hipLaunchKernelGGL(k_fused, dim3(grid1), dim3(512), LDS_BYTES, stream, p);
    { const hipError_t le = hipPeekAtLastError(); if (le != hipSuccess) fprintf(stderr, "kernel_launch: launch failed: %s\n", hipGetErrorName(le)); }
    return;
#endif
    const int grid = 256;
    launch_phase<0>(p, 0, grid, stream);
    for (int l = 0; l < NLAYER; ++l) {
        launch_phase<1>(p, l, grid, stream);
        launch_phase<2>(p, l, grid, stream);
        launch_phase<3>(p, l, grid, stream);
        launch_phase<4>(p, l, grid, stream);
        launch_phase<5>(p, l, grid, stream);
        launch_phase<6>(p, l, grid, stream);
        launch_phase<7>(p, l, grid, stream);
        launch_phase<8>(p, l, grid, stream);
        launch_phase<9>(p, l, grid, stream);
    }
    launch_phase<10>(p, 0, grid, stream);
    const hipError_t le = hipPeekAtLastError();
    if (le != hipSuccess) fprintf(stderr, "kernel_launch: launch failed: %s\n", hipGetErrorName(le));
}
```

```cpp
#include <hip/hip_runtime.h>
#include <cstdio>
#include <cstdint>

#ifndef ONE_LAUNCH
#define ONE_LAUNCH 1
#endif
#ifndef REP_PHASE
#define REP_PHASE 0
#endif
#ifndef DBG_NO_MIX
#define DBG_NO_MIX 0
#endif
#ifndef DBG_BR
#define DBG_BR 15
#endif
#ifndef DBG_FN_COPY
#define DBG_FN_COPY 0
#endif
#ifndef DBG_NO_MOE
#define DBG_NO_MOE 0
#endif

constexpr int D = 1024, SEQ = 16384, NCTX = 256, TPB = SEQ + NCTX, T = 2 * TPB, NLAYER = 2;
constexpr int NTILE = T / 128;
constexpr int PLD = 1280;
constexpr int IN_W = 6304;

typedef unsigned short bf16_t;
typedef short bf16x8 __attribute__((ext_vector_type(8)));
typedef short s16x4 __attribute__((ext_vector_type(4)));
typedef float f32x4 __attribute__((ext_vector_type(4)));
typedef float f32x16 __attribute__((ext_vector_type(16)));
typedef unsigned u32x4 __attribute__((ext_vector_type(4)));
typedef unsigned u32x2 __attribute__((ext_vector_type(2)));
typedef _Float16 h16x2 __attribute__((ext_vector_type(2)));

constexpr size_t al256(size_t x) { return (x + 255) & ~(size_t)255; }
constexpr size_t OFF_BAR = 0;
constexpr size_t OFF_CNT = 16384;
constexpr size_t ZERO_BYTES = 32768;
constexpr size_t OFF_MOD = 32768;
constexpr size_t OFF_ROPE = OFF_MOD + al256((size_t)2 * 3 * 6144 * 4);
constexpr size_t OFF_H2L = OFF_ROPE + al256(256 * 8 * 8);
constexpr size_t OFF_W3T = OFF_H2L + (size_t)2 * 16384 * 64 * 2;
constexpr size_t OFF_H2C = OFF_H2L + al256((size_t)2 * 16384 * 64 * 4);
constexpr size_t OFF_CTXS = OFF_H2C + al256((size_t)2 * 256 * 64 * 4);
constexpr size_t OFF_TOKW = OFF_CTXS + al256((size_t)512 * 1024 * 4);
constexpr size_t OFF_LISTS = OFF_TOKW + al256((size_t)T * 2 * 4);
constexpr size_t OFF_WTS_OLD = OFF_LISTS + al256((size_t)24 * T * 4);
constexpr size_t WE_W1T = 0;
constexpr size_t WE_WGT = WE_W1T + (size_t)2304 * 1024;
constexpr size_t WE_WUQ = WE_WGT + (size_t)4096 * 1024;
constexpr size_t WE_WUKV = WE_WUQ + (size_t)384 * 256;
constexpr size_t WE_WBA = WE_WUKV + (size_t)512 * 128;
constexpr size_t WE_WBB = WE_WBA + (size_t)1024 * 256;
constexpr size_t WE_WBD = WE_WBB + (size_t)1024 * 256;
constexpr size_t WE_WBC = WE_WBD + (size_t)1024 * 256;
constexpr size_t WE_WOUT = WE_WBC + (size_t)1024 * 512;
constexpr size_t WE_WGU = WE_WOUT + (size_t)1024 * 1024;
constexpr size_t WE_WDN = WE_WGU + (size_t)16 * 512 * 1024;
constexpr size_t WE_TOTAL = WE_WDN + (size_t)16 * 1024 * 256;
constexpr size_t OFF_H = OFF_WTS_OLD;
constexpr size_t OFF_P = OFF_H + al256((size_t)T * 1024 * 2);
constexpr size_t OFF_HYFN = OFF_P + al256((size_t)T * PLD * 2);
constexpr size_t OFF_Q = OFF_HYFN + al256((size_t)2 * 1024 * TPB * 2);
constexpr size_t OFF_K = OFF_Q + al256((size_t)T * 384 * 2);
constexpr size_t OFF_V = OFF_K + al256((size_t)T * 384 * 2);
constexpr size_t OFF_OAD = OFF_V + al256((size_t)T * 256 * 2);
constexpr size_t OFF_OBT = OFF_OAD + al256((size_t)T * 512 * 2);
constexpr size_t OFF_OCT = OFF_OBT + al256((size_t)2 * 256 * TPB * 2);
constexpr size_t OFF_HYS = OFF_OCT + al256((size_t)2 * 512 * TPB * 2);
constexpr size_t OFF_WTS = OFF_HYS + al256((size_t)256 * 4 * 16384 * 4);
constexpr size_t OFF_FILT = OFF_WTS + al256(WE_TOTAL * 2);
constexpr size_t WS_TOTAL = OFF_FILT + al256((size_t)1024 * 16384 * 2);
constexpr int ACT_ROWS = 36352;
static_assert((size_t)ACT_ROWS * 512 * 2 <= (size_t)T * PLD * 2, "act must fit in P");

struct Params { const float* in[33]; float* out; unsigned char* ws; };
enum { I_X = 0, I_C, I_CTX, I_CCTX, I_ADAW, I_ADAB, I_N1G, I_N2G, I_WIN, I_QNORM, I_WUQ, I_KVNORM, I_WUKV, I_HYSW, I_HYW1, I_HYB1, I_HYF1, I_HYW2, I_HYB2, I_HYF2, I_HYW3, I_HYBIAS,
       I_RPB, I_WBR, I_WOUT, I_MWG, I_MBG, I_MWE, I_MBE, I_MGATE, I_MUP, I_MDOWN, I_FNG };

#define WSP(TYPE, off) ((TYPE*)(p.ws + (off)))
__device__ __forceinline__ bf16_t* wts(const Params& p, int l, size_t we) { (void)l; return (bf16_t*)(p.ws + OFF_WTS) + we; }

typedef float f32x2 __attribute__((ext_vector_type(2))); typedef int i32x8 __attribute__((ext_vector_type(8)));
typedef __bf16 bf16x2_t __attribute__((ext_vector_type(2)));
__device__ __forceinline__ unsigned cvt_pk_bf16(float lo, float hi) { const f32x2 v = {lo, hi}; return __builtin_bit_cast(unsigned, __builtin_convertvector(v, bf16x2_t)); }
__device__ __forceinline__ bf16_t f2bf(float x) { return (bf16_t)(cvt_pk_bf16(x, 0.f) & 0xffffu); }
__device__ __forceinline__ float bf2f(bf16_t v) { return __uint_as_float((unsigned)v << 16); }
__device__ __forceinline__ float wave_sum(float v) {
#pragma unroll
    for (int o = 32; o >= 1; o >>= 1) v += __shfl_xor(v, o);
    return v;
}
__device__ __forceinline__ float silu_f(float x) { return x / (1.f + __expf(-x)); }
__device__ __forceinline__ float sigmoid_f(float x) { return __builtin_amdgcn_rcpf(1.f + __builtin_amdgcn_exp2f(x * -1.4426950408889634f)); }
__device__ __forceinline__ void sincos_turns(float turns, float& s, float& c) { const float f = turns - floorf(turns); sincospif(2.f * f, &s, &c); }
__device__ __forceinline__ void sincos_rad(float x, float& s, float& c) { sincos_turns(x * 0.15915494309189535f, s, c); }

__device__ __forceinline__ const float* xrow_in(const Params& p, int r) {
    const int b = r >= TPB ? 1 : 0, t = r - b * TPB;
    return t < SEQ ? p.in[I_X] + ((size_t)b * SEQ + t) * D : p.in[I_CTX] + ((size_t)b * NCTX + (t - SEQ)) * D;
}
__device__ __forceinline__ float* xrow_st(const Params& p, int r) {
    const int b = r >= TPB ? 1 : 0, t = r - b * TPB;
    return t < SEQ ? p.out + ((size_t)b * SEQ + t) * D : WSP(float, OFF_CTXS) + ((size_t)b * NCTX + (t - SEQ)) * D;
}
__device__ __forceinline__ bool row_is_ctx(int r) { const int b = r >= TPB ? 1 : 0; return (r - b * TPB) >= SEQ; }
__device__ __forceinline__ const float* modvec(const Params& p, int l, int r) {
    const int b = r >= TPB ? 1 : 0, t = r - b * TPB; const int mi = t < SEQ ? b : 2;
    return WSP(float, OFF_MOD) + ((size_t)l * 3 + mi) * 6144;
}

#define XB_TMO      128
#define XB_XCNT(j)  (256  + 64 * (j))
#define XB_XSUB(j)  (1280 + 64 * (j))
#define XB_XGEN(j)  (2304 + 64 * (j))
#define XB_TOP      3328
#define XB_TOPGEN   3392
#define XCD_BAR_WORDS 3456
#define XB_SPIN_CAP (1u << 22)
#define LAS __attribute__((address_space(3)))
__device__ __forceinline__ unsigned xb_ld(unsigned* p)              { return __hip_atomic_load(p, __ATOMIC_RELAXED, __HIP_MEMORY_SCOPE_AGENT); }
__device__ __forceinline__ unsigned xb_add(unsigned* p, unsigned v) { return __hip_atomic_fetch_add(p, v, __ATOMIC_RELAXED, __HIP_MEMORY_SCOPE_AGENT); }
__device__ __forceinline__ unsigned xb_xcc_id() { return (unsigned)__builtin_amdgcn_s_getreg((3 << 11) | 20) & 0xFu; }
#define XB_SPIN(cond, bar) do { unsigned _sp = 0; while (cond) { __builtin_amdgcn_s_sleep(1); \
    if ((++_sp & 255u) == 0u) { if (xb_ld(&(bar)[XB_TMO])) break; if (_sp > XB_SPIN_CAP) { atomicAdd(&(bar)[XB_TMO], 1u); break; } } } } while (0)
struct XcdBarrier { unsigned* bar; unsigned x; volatile LAS unsigned* st; };
__device__ __forceinline__ XcdBarrier xcd_barrier_post(unsigned* bar, volatile LAS unsigned* st) {
    XcdBarrier b; b.bar = bar; b.x = xb_xcc_id(); b.st = st;
    if (threadIdx.x == 0) (void)xb_add(&bar[XB_XCNT(b.x)], 1u);
    return b;
}
__device__ __forceinline__ void xcd_barrier_complete(unsigned* bar, unsigned x, unsigned& nloc, unsigned& nx) {
    const unsigned G = gridDim.x * gridDim.y * gridDim.z;
    unsigned sum, cnt, mine, sp = 0u;
    for (;;) {
        sum = 0u; cnt = 0u; mine = 0u;
#pragma unroll
        for (unsigned j = 0; j < 16; ++j) { const unsigned c = xb_ld(&bar[XB_XCNT(j)]); sum += c; cnt += (c > 0u) ? 1u : 0u; mine = (j == x) ? c : mine; }
        if (sum == G) break;
        __builtin_amdgcn_s_sleep(1);
        if ((++sp & 255u) == 0u) { if (xb_ld(&bar[XB_TMO])) break; if (sp > XB_SPIN_CAP) { atomicAdd(&bar[XB_TMO], 1u); break; } }
    }
    nloc = mine > 0u ? mine : 1u; nx = cnt > 0u ? cnt : 1u;
}
__device__ __forceinline__ void xcd_barrier(const XcdBarrier& b) {
    asm volatile("s_waitcnt vmcnt(0)" ::: "memory");
    __syncthreads();
    if (threadIdx.x == 0) {
        unsigned* bar = b.bar;
        __builtin_amdgcn_s_waitcnt(0);
        unsigned nloc = b.st[0], nx = b.st[1];
        if (nloc == 0u) { xcd_barrier_complete(bar, b.x, nloc, nx); b.st[0] = nloc; b.st[1] = nx; }
        const unsigned old = xb_add(&bar[XB_XSUB(b.x)], 1u);
        const unsigned gen = old / nloc;
        if (old + 1u == (gen + 1u) * nloc) {
            __builtin_amdgcn_fence(__ATOMIC_RELEASE, "agent");
            asm volatile("s_waitcnt vmcnt(0)" ::: "memory");
            const unsigned og = xb_add(&bar[XB_TOP], 1u);
            const unsigned tg = og / nx;
            if (og + 1u == (tg + 1u) * nx) xb_add(&bar[XB_TOPGEN], 1u);
            else XB_SPIN(xb_ld(&bar[XB_TOPGEN]) == tg, bar);
            __builtin_amdgcn_fence(__ATOMIC_ACQUIRE, "agent");
            xb_add(&bar[XB_XGEN(b.x)], 1u);
            asm volatile("s_waitcnt vmcnt(0)" ::: "memory");
        } else {
            XB_SPIN(xb_ld(&bar[XB_XGEN(b.x)]) == gen, bar);
            __builtin_amdgcn_fence(__ATOMIC_ACQUIRE, "agent");
            asm volatile("s_waitcnt vmcnt(0)" ::: "memory");
        }
    }
    __syncthreads();
}

__device__ __forceinline__ int tidx() { int r; asm volatile("v_mov_b32 %0, %1" : "=v"(r) : "v"((int)threadIdx.x)); return r; }
__device__ __forceinline__ int bidx() { int r; asm volatile("s_mov_b32 %0, %1" : "=s"(r) : "s"((int)blockIdx.x)); return r; }
__device__ __forceinline__ int gdim() { int r; asm volatile("s_mov_b32 %0, %1" : "=s"(r) : "s"((int)gridDim.x)); return r; }
extern __shared__ __attribute__((aligned(16))) char lds_dyn[];
constexpr int G_TILE = 128 * 128;
constexpr int G_STAGE = 2 * G_TILE;
constexpr int G_LDS = 4 * G_STAGE;
__device__ __forceinline__ int g_lds_byte(int r, int c) { const int ob = (r & 15) * 64 + (c & 31) * 2; return ((r >> 4) * 2 + (c >> 5)) * 1024 + (ob ^ (((ob >> 9) & 1) << 5)); }
__device__ __forceinline__ int g_srow() { const int t = tidx(), ln = t & 63, p = ln * 16, ob = p ^ (((p >> 9) & 1) << 5); return ((t >> 6) >> 1) * 16 + (ob >> 6); }
__device__ __forceinline__ int g_skc() { const int t = tidx(), ln = t & 63, p = ln * 16, ob = p ^ (((p >> 9) & 1) << 5); return ((t >> 6) & 1) * 4 + ((ob & 63) >> 4); }

template <int SWAP>
__device__ __forceinline__ void mma_tile(f32x4 (&acc)[4][2], const char* As, const char* Bs, int a_rd, int b_rd) {
#pragma unroll
    for (int ks = 0; ks < 2; ++ks) {
        bf16x8 af[4], bfr[2];
#pragma unroll
        for (int mt = 0; mt < 4; ++mt) af[mt] = *(const bf16x8*)(As + a_rd + mt * 2048 + ks * 1024);
#pragma unroll
        for (int nt = 0; nt < 2; ++nt) bfr[nt] = *(const bf16x8*)(Bs + b_rd + nt * 2048 + ks * 1024);
#pragma unroll
        for (int mt = 0; mt < 4; ++mt)
#pragma unroll
            for (int nt = 0; nt < 2; ++nt)
                acc[mt][nt] = SWAP ? __builtin_amdgcn_mfma_f32_16x16x32_bf16(bfr[nt], af[mt], acc[mt][nt], 0, 0, 0)
                                   : __builtin_amdgcn_mfma_f32_16x16x32_bf16(af[mt], bfr[nt], acc[mt][nt], 0, 0, 0);
    }
}
struct GFrag { bf16x8 a[4], b[2]; };
__device__ __forceinline__ void gf_load(GFrag& f, const char* As, const char* Bs, int a_rd, int b_rd, int ks) {
#pragma unroll
    for (int mt = 0; mt < 4; ++mt) f.a[mt] = *(const bf16x8*)(As + a_rd + mt * 2048 + ks * 1024);
#pragma unroll
    for (int nt = 0; nt < 2; ++nt) f.b[nt] = *(const bf16x8*)(Bs + b_rd + nt * 2048 + ks * 1024);
}
template <int SWAP = 1>
__device__ __forceinline__ void gf_mma(f32x4 (&acc)[4][2], const GFrag& f) {
#pragma unroll
    for (int mt = 0; mt < 4; ++mt)
#pragma unroll
        for (int nt = 0; nt < 2; ++nt) acc[mt][nt] = SWAP ? __builtin_amdgcn_mfma_f32_16x16x32_bf16(f.b[nt], f.a[mt], acc[mt][nt], 0, 0, 0)
                                                           : __builtin_amdgcn_mfma_f32_16x16x32_bf16(f.a[mt], f.b[nt], acc[mt][nt], 0, 0, 0);
}
__device__ __forceinline__ void gf_zero(GFrag& f) {
#pragma unroll
    for (int mt = 0; mt < 4; ++mt) f.a[mt] = (bf16x8)(0);
#pragma unroll
    for (int nt = 0; nt < 2; ++nt) f.b[nt] = (bf16x8)(0);
}
#define SB() __builtin_amdgcn_sched_barrier(0)
#define GF_STAGE(ACCP, ACC, AS, BS) do { gf_load(f0, (AS), (BS), a_rd, b_rd, 0); SB(); gf_mma(ACCP, f1); SB(); gf_load(f1, (AS), (BS), a_rd, b_rd, 1); SB(); gf_mma(ACC, f0); SB(); } while (0)

struct GFrag2 { bf16x8 a[4], b[4]; };
__device__ __forceinline__ void gf2_load(GFrag2& f, const char* As, const char* Bs, int a_rd, int b_rd, int ks) {
#pragma unroll
    for (int mt = 0; mt < 4; ++mt) f.a[mt] = *(const bf16x8*)(As + a_rd + mt * 2048 + ks * 1024);
#pragma unroll
    for (int nt = 0; nt < 4; ++nt) f.b[nt] = *(const bf16x8*)(Bs + b_rd + nt * 2048 + ks * 1024);
}
template <int SWAP>
__device__ __forceinline__ void gf2_mma(f32x4 (&acc)[4][4], const GFrag2& f) {
#pragma unroll
    for (int mt = 0; mt < 4; ++mt)
#pragma unroll
        for (int nt = 0; nt < 4; ++nt) acc[mt][nt] = SWAP ? __builtin_amdgcn_mfma_f32_16x16x32_bf16(f.b[nt], f.a[mt], acc[mt][nt], 0, 0, 0)
                                                           : __builtin_amdgcn_mfma_f32_16x16x32_bf16(f.a[mt], f.b[nt], acc[mt][nt], 0, 0, 0);
}
__device__ __forceinline__ void gf2_zero(GFrag2& f) {
#pragma unroll
    for (int mt = 0; mt < 4; ++mt) f.a[mt] = (bf16x8)(0);
#pragma unroll
    for (int nt = 0; nt < 4; ++nt) f.b[nt] = (bf16x8)(0);
}
#define G_WAITV(n) asm volatile("s_waitcnt vmcnt(" #n ")\n\ts_waitcnt lgkmcnt(0)" ::: "memory")
template <int SWAP, int AT>
__device__ __forceinline__ void mma_seg(f32x4 (&acc)[4][2], const bf16_t* __restrict__ a0, const bf16_t* __restrict__ a1, long ldt,
                                        const bf16_t* __restrict__ b0, const bf16_t* __restrict__ b1, int K, char* lds) {
    const int tid = tidx(), lane = tid & 63, wid = __builtin_amdgcn_readfirstlane(tid >> 6), wm = wid >> 2, wn = wid & 3;
    const int fr = lane & 15, fq = lane >> 4;
    const int a_rd = g_lds_byte(wm * 64 + fr, fq * 8), b_rd = g_lds_byte(wn * 32 + fr, fq * 8);
    const int nk = K >> 6;
    if (!AT) {
        LAS char* L = (LAS char*)lds_dyn + ((wid >> 1) * 2 + (wid & 1)) * 1024;
        auto issue = [&](int st) { const int k0 = st << 6; LAS char* Lb = L + (st & 3) * G_STAGE;
            __builtin_amdgcn_global_load_lds((const unsigned*)(a0 + k0), (LAS unsigned*)(Lb), 16, 0, 0);
            __builtin_amdgcn_global_load_lds((const unsigned*)(a1 + k0), (LAS unsigned*)(Lb + 8192), 16, 0, 0);
            __builtin_amdgcn_global_load_lds((const unsigned*)(b0 + k0), (LAS unsigned*)(Lb + G_TILE), 16, 0, 0);
            __builtin_amdgcn_global_load_lds((const unsigned*)(b1 + k0), (LAS unsigned*)(Lb + G_TILE + 8192), 16, 0, 0); };
        GFrag f0, f1; gf_zero(f1);
        issue(0); if (nk > 1) issue(1); if (nk > 2) issue(2);
        for (int kt = 0; kt < nk; ++kt) {
            if (kt + 2 < nk) G_WAITV(8); else if (kt + 1 < nk) G_WAITV(4); else G_WAITV(0);
            __builtin_amdgcn_s_barrier();
            asm volatile("" ::: "memory");
            if (kt + 3 < nk) issue(kt + 3);
            const char* As = lds + (kt & 3) * G_STAGE;
            gf_load(f0, As, As + G_TILE, a_rd, b_rd, 0); SB(); gf_mma<SWAP>(acc, f1); SB(); gf_load(f1, As, As + G_TILE, a_rd, b_rd, 1); SB(); gf_mma<SWAP>(acc, f0); SB();
        }
        gf_mma<SWAP>(acc, f1);
        __syncthreads();
    } else {
        const int w0 = g_lds_byte(g_srow(), g_skc() * 8), w1 = w0 + 4 * 2048;
        const int tk = tid >> 4, tt = tid & 15;
        u32x4 ra0, ra1, rb0, rb1;
        auto gld = [&](int k0) {
            ra0 = *(const u32x4*)(a0 + (long)(k0 + tk) * ldt + tt * 8); ra1 = *(const u32x4*)(a0 + (long)(k0 + tk + 32) * ldt + tt * 8);
            rb0 = *(const u32x4*)(b0 + k0); rb1 = *(const u32x4*)(b1 + k0);
        };
        auto lst = [&](int buf) {
            char* A = lds + buf * G_STAGE; char* B = A + G_TILE;
#pragma unroll
            for (int i = 0; i < 8; ++i) {
                const unsigned wa = ra0[i >> 1], wb = ra1[i >> 1];
                *(bf16_t*)(A + g_lds_byte(tt * 8 + i, tk)) = (bf16_t)((i & 1) ? (wa >> 16) : (wa & 0xffffu));
                *(bf16_t*)(A + g_lds_byte(tt * 8 + i, tk + 32)) = (bf16_t)((i & 1) ? (wb >> 16) : (wb & 0xffffu));
            }
            *(u32x4*)(B + w0) = rb0; *(u32x4*)(B + w1) = rb1;
        };
        gld(0); lst(0); __syncthreads();
        for (int kt = 0; kt < nk; ++kt) {
            if (kt + 1 < nk) gld((kt + 1) << 6);
            __builtin_amdgcn_sched_barrier(0);
            mma_tile<SWAP>(acc, lds + (kt & 1) * G_STAGE, lds + (kt & 1) * G_STAGE + G_TILE, a_rd, b_rd);
            __builtin_amdgcn_sched_barrier(0);
            if (kt + 1 < nk) lst((kt + 1) & 1);
            __syncthreads();
        }
    }
}
__device__ __forceinline__ void mma_pair(f32x4 (&ag)[4][2], f32x4 (&ap)[4][2], const bf16_t* __restrict__ ga0, const bf16_t* __restrict__ ga1, const bf16_t* __restrict__ gb0, const bf16_t* __restrict__ gb1, int nkg,
                                         const bf16_t* __restrict__ pa0, const bf16_t* __restrict__ pa1, const bf16_t* __restrict__ pb0, const bf16_t* __restrict__ pb1, int nkp, char* lds) {
    const int tid = tidx(), lane = tid & 63, wid = __builtin_amdgcn_readfirstlane(tid >> 6), wm = wid >> 2, wn = wid & 3;
    const int fr = lane & 15, fq = lane >> 4;
    const int a_rd = g_lds_byte(wm * 64 + fr, fq * 8), b_rd = g_lds_byte(wn * 32 + fr, fq * 8);
    const int ns = nkg + nkp;
    LAS char* L = (LAS char*)lds_dyn + ((wid >> 1) * 2 + (wid & 1)) * 1024;
    auto issue = [&](int st) { const bool g = st < nkg; const int k0 = (g ? st : st - nkg) << 6; LAS char* Lb = L + (st & 3) * G_STAGE;
        __builtin_amdgcn_global_load_lds((const unsigned*)((g ? ga0 : pa0) + k0), (LAS unsigned*)(Lb), 16, 0, 0);
        __builtin_amdgcn_global_load_lds((const unsigned*)((g ? ga1 : pa1) + k0), (LAS unsigned*)(Lb + 8192), 16, 0, 0);
        __builtin_amdgcn_global_load_lds((const unsigned*)((g ? gb0 : pb0) + k0), (LAS unsigned*)(Lb + G_TILE), 16, 0, 0);
        __builtin_amdgcn_global_load_lds((const unsigned*)((g ? gb1 : pb1) + k0), (LAS unsigned*)(Lb + G_TILE + 8192), 16, 0, 0); };
    issue(0); issue(1); issue(2);
    for (int st = 0; st < nkg; ++st) {
        if (st + 2 < ns) G_WAITV(8); else if (st + 1 < ns) G_WAITV(4); else G_WAITV(0);
        __builtin_amdgcn_s_barrier(); asm volatile("" ::: "memory");
        if (st + 3 < ns) issue(st + 3);
        mma_tile<1>(ag, lds + (st & 3) * G_STAGE, lds + (st & 3) * G_STAGE + G_TILE, a_rd, b_rd);
    }
    for (int st = nkg; st < ns; ++st) {
        if (st + 2 < ns) G_WAITV(8); else if (st + 1 < ns) G_WAITV(4); else G_WAITV(0);
        __builtin_amdgcn_s_barrier(); asm volatile("" ::: "memory");
        if (st + 3 < ns) issue(st + 3);
        mma_tile<1>(ap, lds + (st & 3) * G_STAGE, lds + (st & 3) * G_STAGE + G_TILE, a_rd, b_rd);
    }
    __syncthreads();
}
constexpr int G2_STAGE = 3 * G_TILE;
constexpr int G2_LDS = 3 * G2_STAGE;
template <int SWAP>
__device__ __forceinline__ void mma_tile256(f32x4 (&acc)[4][4], const char* As, const char* Bs, int a_rd, int b_rd) {
#pragma unroll
    for (int ks = 0; ks < 2; ++ks) {
        bf16x8 af[4], bfr[4];
#pragma unroll
        for (int mt = 0; mt < 4; ++mt) af[mt] = *(const bf16x8*)(As + a_rd + mt * 2048 + ks * 1024);
#pragma unroll
        for (int nt = 0; nt < 4; ++nt) bfr[nt] = *(const bf16x8*)(Bs + b_rd + nt * 2048 + ks * 1024);
#pragma unroll
        for (int mt = 0; mt < 4; ++mt)
#pragma unroll
            for (int nt = 0; nt < 4; ++nt)
                acc[mt][nt] = SWAP ? __builtin_amdgcn_mfma_f32_16x16x32_bf16(bfr[nt], af[mt], acc[mt][nt], 0, 0, 0)
                                   : __builtin_amdgcn_mfma_f32_16x16x32_bf16(af[mt], bfr[nt], acc[mt][nt], 0, 0, 0);
    }
}
#define G2_WAITV(n) asm volatile("s_waitcnt vmcnt(" #n ")\n\ts_waitcnt lgkmcnt(0)" ::: "memory")
template <int SWAP>
__device__ __forceinline__ void mma_seg256(f32x4 (&acc)[4][4], const bf16_t* __restrict__ a0, size_t astep, const bf16_t* __restrict__ b0, size_t bstep, int K, char* lds) {
    const int tid = tidx(), lane = tid & 63, wid = __builtin_amdgcn_readfirstlane(tid >> 6), wm = wid >> 1, wn = wid & 1;
    const int fr = lane & 15, fq = lane >> 4;
    const int a_rd = g_lds_byte(wm * 64 + fr, fq * 8), b_rd = g_lds_byte(wn * 64 + fr, fq * 8);
    const int nk = K >> 6;
    LAS char* L = (LAS char*)lds_dyn + ((wid >> 1) * 2 + (wid & 1)) * 1024;
    auto issue = [&](int st) { const int k0 = st << 6; LAS char* Lb = L + (st % 3) * G2_STAGE;
#pragma unroll
        for (int i = 0; i < 4; ++i) __builtin_amdgcn_global_load_lds((const unsigned*)(a0 + i * astep + k0), (LAS unsigned*)(Lb + i * 8192), 16, 0, 0);
#pragma unroll
        for (int i = 0; i < 2; ++i) __builtin_amdgcn_global_load_lds((const unsigned*)(b0 + i * bstep + k0), (LAS unsigned*)(Lb + 2 * G_TILE + i * 8192), 16, 0, 0); };
    GFrag2 f0, f1; gf2_zero(f1);
    issue(0); if (nk > 1) issue(1);
    for (int kt = 0; kt < nk; ++kt) {
        if (kt + 1 < nk) G2_WAITV(6); else G2_WAITV(0);
        __builtin_amdgcn_s_barrier(); asm volatile("" ::: "memory");
        if (kt + 2 < nk) issue(kt + 2);
        const char* As = lds + (kt % 3) * G2_STAGE; const char* Bs = As + 2 * G_TILE;
        gf2_load(f0, As, Bs, a_rd, b_rd, 0); SB(); gf2_mma<SWAP>(acc, f1); SB(); gf2_load(f1, As, Bs, a_rd, b_rd, 1); SB(); gf2_mma<SWAP>(acc, f0); SB();
    }
    gf2_mma<SWAP>(acc, f1);
    __syncthreads();
}
__device__ __forceinline__ void acc_zero256(f32x4 (&acc)[4][4]) {
#pragma unroll
    for (int mt = 0; mt < 4; ++mt)
#pragma unroll
        for (int nt = 0; nt < 4; ++nt) acc[mt][nt] = (f32x4){0.f, 0.f, 0.f, 0.f};
}
__device__ __forceinline__ void acc_zero(f32x4 (&acc)[4][2]) {
#pragma unroll
    for (int mt = 0; mt < 4; ++mt)
#pragma unroll
        for (int nt = 0; nt < 2; ++nt) acc[mt][nt] = (f32x4){0.f, 0.f, 0.f, 0.f};
}

typedef _Float16 f16x8 __attribute__((ext_vector_type(8)));
constexpr int FRS = 130;
#define FBI(n) ((((n) >> 7) * FRS) + ((n) & 127))
constexpr int FFT_BUF_BYTES = 128 * FRS * 8;
struct FFrag { int unused; };
__device__ __forceinline__ float2 cmulf(float2 a, float2 b) { return make_float2(a.x * b.x - a.y * b.y, a.x * b.y + a.y * b.x); }
__device__ __forceinline__ float2 cmulcf(float2 a, float2 b) { return make_float2(a.x * b.x + a.y * b.y, a.y * b.x - a.x * b.y); }
__device__ __forceinline__ float2 tw16k(const float2* thi, const float2* tlo, int idx) { return cmulf(thi[idx >> 7], tlo[idx & 127]); }
__device__ __forceinline__ void mfft_frags(FFrag& F, const float2*) { F.unused = 0; }
template <int CONJ, int TW>
__device__ __forceinline__ void mfft_left(float2* buf, const FFrag& F, const float2* thi, const float2* tlo) {
    const int tid = tidx(), lane = tid & 63, wid = tid >> 6, i = wid >> 1, hi = lane >> 5, l31 = lane & 31, fa = 32 * i + l31;
    f32x16 yr0 = {}, yi0 = {}, yr1 = {}, yi1 = {};
#pragma unroll
    for (int ks = 0; ks < 8; ++ks) {
        f16x8 fr, fi;
#pragma unroll
        for (int j = 0; j < 8; ++j) { const float2 w = thi[(fa * (16 * ks + 8 * hi + j)) & 127]; fr[j] = (_Float16)w.x; fi[j] = (_Float16)(CONJ ? -w.y : w.y); }
        const f16x8 nfi = -fi;
#pragma unroll
        for (int t = 0; t < 2; ++t) {
            const float2* xp = buf + (16 * ks + 8 * hi) * FRS + 32 * (2 * (wid & 1) + t) + l31;
            f16x8 xr, xi;
#pragma unroll
            for (int j = 0; j < 8; ++j) { const float2 v = xp[j * FRS]; xr[j] = (_Float16)v.x; xi[j] = (_Float16)v.y; }
            if (t == 0) { yr0 = __builtin_amdgcn_mfma_f32_32x32x16_f16(fr, xr, yr0, 0, 0, 0); yr0 = __builtin_amdgcn_mfma_f32_32x32x16_f16(nfi, xi, yr0, 0, 0, 0);
                          yi0 = __builtin_amdgcn_mfma_f32_32x32x16_f16(fr, xi, yi0, 0, 0, 0); yi0 = __builtin_amdgcn_mfma_f32_32x32x16_f16(fi, xr, yi0, 0, 0, 0); }
            else        { yr1 = __builtin_amdgcn_mfma_f32_32x32x16_f16(fr, xr, yr1, 0, 0, 0); yr1 = __builtin_amdgcn_mfma_f32_32x32x16_f16(nfi, xi, yr1, 0, 0, 0);
                          yi1 = __builtin_amdgcn_mfma_f32_32x32x16_f16(fr, xi, yi1, 0, 0, 0); yi1 = __builtin_amdgcn_mfma_f32_32x32x16_f16(fi, xr, yi1, 0, 0, 0); }
        }
    }
    __syncthreads();
#pragma unroll
    for (int t = 0; t < 2; ++t)
#pragma unroll
        for (int r = 0; r < 16; ++r) { const int row = 32 * i + (r & 3) + 8 * (r >> 2) + 4 * hi, col = 32 * (2 * (wid & 1) + t) + l31;
            float2 v = t == 0 ? make_float2(yr0[r], yi0[r]) : make_float2(yr1[r], yi1[r]);
            if (TW) { const float2 tv = tw16k(thi, tlo, row * col); v = TW > 0 ? cmulf(v, tv) : cmulcf(v, tv); }
            buf[row * FRS + col] = v; }
    __syncthreads();
}
template <int CONJ, int TW>
__device__ __forceinline__ void mfft_right(float2* buf, const FFrag& F, const float2* thi, const float2* tlo) {
    const int tid = tidx(), lane = tid & 63, wid = tid >> 6, jb = wid >> 1, hi = lane >> 5, l31 = lane & 31, fa = 32 * jb + l31;
    f32x16 yr0 = {}, yi0 = {}, yr1 = {}, yi1 = {};
#pragma unroll
    for (int ks = 0; ks < 8; ++ks) {
        f16x8 fr, fi;
#pragma unroll
        for (int j = 0; j < 8; ++j) { const float2 w = thi[(fa * (16 * ks + 8 * hi + j)) & 127]; fr[j] = (_Float16)w.x; fi[j] = (_Float16)(CONJ ? -w.y : w.y); }
        const f16x8 nfi = -fi;
#pragma unroll
        for (int t = 0; t < 2; ++t) {
            const f32x4* xp = (const f32x4*)(buf + (32 * (2 * (wid & 1) + t) + l31) * FRS + 16 * ks + 8 * hi);
            const f32x4 q0 = xp[0], q1 = xp[1], q2 = xp[2], q3 = xp[3];
            f16x8 xr, xi;
            xr[0] = (_Float16)q0[0]; xi[0] = (_Float16)q0[1]; xr[1] = (_Float16)q0[2]; xi[1] = (_Float16)q0[3]; xr[2] = (_Float16)q1[0]; xi[2] = (_Float16)q1[1]; xr[3] = (_Float16)q1[2]; xi[3] = (_Float16)q1[3];
            xr[4] = (_Float16)q2[0]; xi[4] = (_Float16)q2[1]; xr[5] = (_Float16)q2[2]; xi[5] = (_Float16)q2[3]; xr[6] = (_Float16)q3[0]; xi[6] = (_Float16)q3[1]; xr[7] = (_Float16)q3[2]; xi[7] = (_Float16)q3[3];
            if (t == 0) { yr0 = __builtin_amdgcn_mfma_f32_32x32x16_f16(xr, fr, yr0, 0, 0, 0); yr0 = __builtin_amdgcn_mfma_f32_32x32x16_f16(xi, nfi, yr0, 0, 0, 0);
                          yi0 = __builtin_amdgcn_mfma_f32_32x32x16_f16(xr, fi, yi0, 0, 0, 0); yi0 = __builtin_amdgcn_mfma_f32_32x32x16_f16(xi, fr, yi0, 0, 0, 0); }
            else        { yr1 = __builtin_amdgcn_mfma_f32_32x32x16_f16(xr, fr, yr1, 0, 0, 0); yr1 = __builtin_amdgcn_mfma_f32_32x32x16_f16(xi, nfi, yr1, 0, 0, 0);
                          yi1 = __builtin_amdgcn_mfma_f32_32x32x16_f16(xr, fi, yi1, 0, 0, 0); yi1 = __builtin_amdgcn_mfma_f32_32x32x16_f16(xi, fr, yi1, 0, 0, 0); }
        }
    }
    __syncthreads();
#pragma unroll
    for (int t = 0; t < 2; ++t)
#pragma unroll
        for (int r = 0; r < 16; ++r) { const int row = 32 * (2 * (wid & 1) + t) + (r & 3) + 8 * (r >> 2) + 4 * hi, col = 32 * jb + l31;
            float2 v = t == 0 ? make_float2(yr0[r], yi0[r]) : make_float2(yr1[r], yi1[r]);
            if (TW) { const float2 tv = tw16k(thi, tlo, row * col); v = TW > 0 ? cmulf(v, tv) : cmulcf(v, tv); }
            buf[row * FRS + col] = v; }
    __syncthreads();
}
__device__ __forceinline__ void fft_fwd_blk(float2* buf, const FFrag& F, const float2* thi, const float2* tlo) { mfft_left<0, 1>(buf, F, thi, tlo); mfft_right<0, 0>(buf, F, thi, tlo); }
__device__ __forceinline__ void fft_inv_blk(float2* buf, const FFrag& F, const float2* thi, const float2* tlo) { mfft_right<1, -1>(buf, F, thi, tlo); mfft_left<1, 0>(buf, F, thi, tlo); }
constexpr int FFT_LDS_TAB = FFT_BUF_BYTES;
constexpr int FFT_LDS_EXTRA = FFT_LDS_TAB + 4096;
__device__ __forceinline__ void fft_tables(char* lds) {
    float2* thi = (float2*)(lds + FFT_LDS_TAB); float2* tlo = thi + 128;
    const int t = tidx();
    if (t < 128) { float s, c; sincospif(2.f * (float)t / 128.f, &s, &c); thi[t] = make_float2(c, -s); }
    else if (t < 256) { float s, c; sincospif(2.f * (float)(t - 128) / 16384.f, &s, &c); tlo[t - 128] = make_float2(c, -s); }
    else if (t < 384) { float s, c; sincospif((float)(t - 256) / 128.f, &s, &c); tlo[128 + (t - 256)] = make_float2(c, -s); }
    else { float s, c; sincospif((float)(t - 384) / 16384.f, &s, &c); tlo[256 + (t - 384)] = make_float2(c, -s); }
    __syncthreads();
}
__device__ __forceinline__ float block_sum(float v, float* red) {
    v = wave_sum(v);
    __syncthreads();
    if ((tidx() & 63) == 0) red[tidx() >> 6] = v;
    __syncthreads();
    float s = 0.f;
#pragma unroll
    for (int i = 0; i < 8; ++i) s += red[i];
    return s;
}

#if ONE_LAUNCH
#define PHASE_FN __device__ __forceinline__
#else
#define PHASE_FN __device__
#endif
__device__ __forceinline__ const float* wsrc(const Params& p, int l, int job, int n, int& ld) {
    switch (job) {
    case 0: { ld = IN_W; const float* w = p.in[I_WIN] + (size_t)l * 1024 * IN_W; int c;
        if (n < 768) c = 1440 + n; else if (n < 1024) c = n - 768; else if (n < 1152) c = 256 + (n - 1024); else if (n < 1184) c = 384 + (n - 1152);
        else if (n < 1280) return nullptr; else if (n < 2048) c = 416 + (n - 1280); else c = 1184 + (n - 2048);
        return w + c; }
    case 1: ld = IN_W; return p.in[I_WIN] + (size_t)l * 1024 * IN_W + 2208 + n;
    case 2: ld = 384; return p.in[I_WUQ] + (size_t)l * 256 * 384 + n;
    case 3: ld = 512; return p.in[I_WUKV] + (size_t)l * 128 * 512 + n;
    case 4: ld = 1024; return p.in[I_WBR] + ((size_t)l * 4 + 0) * 256 * 1024 + n;
    case 5: ld = 1024; return p.in[I_WBR] + ((size_t)l * 4 + 1) * 256 * 1024 + n;
    case 6: ld = 1024; return p.in[I_WBR] + ((size_t)l * 4 + 3) * 256 * 1024 + n;
    case 7: ld = 1024; return p.in[I_WOUT] + (size_t)l * 1024 * 1024 + n;
    case 8: { ld = 256; const int e = n >> 9, r = n & 511; const int t = r >> 7, wn = (r & 127) >> 5, nt = (r & 31) >> 4, i = r & 15; const int f = t * 64 + wn * 16 + i;
        return (nt ? p.in[I_MUP] : p.in[I_MGATE]) + ((size_t)l * 16 + e) * 1024 * 256 + f; }
    default: { ld = 1024; const int e = n >> 10, c = n & 1023; return p.in[I_MDOWN] + ((size_t)l * 16 + e) * 256 * 1024 + c; }
    }
}
PHASE_FN void ph_prologue(const Params& p, char* lds_unused) {
    char* lds = lds_dyn; (void)lds_unused;
    const int tid = tidx(), bid = bidx(), G = gdim();
    {
        float* sc = (float*)lds;
        float* red = sc + 3072;
        for (int i = tid; i < 3072; i += 512) { const int v = i >> 10, k = i & 1023; const float x = v < 2 ? p.in[I_C][v * 1024 + k] : p.in[I_CCTX][k]; sc[i] = silu_f(x); }
        __syncthreads();
        for (int u = bid; u < 192; u += G) {
            const int l = u / 96, j0 = (u % 96) * 64, kg = tid >> 6, j = tid & 63;
            const float* w = p.in[I_ADAW] + (size_t)l * 1024 * 6144 + j0 + j;
            float a0 = 0.f, a1 = 0.f, a2 = 0.f;
#pragma unroll 8
            for (int k = kg * 128; k < kg * 128 + 128; ++k) { const float wv = w[(size_t)k * 6144]; a0 += sc[k] * wv; a1 += sc[1024 + k] * wv; a2 += sc[2048 + k] * wv; }
            red[(0 * 8 + kg) * 64 + j] = a0; red[(1 * 8 + kg) * 64 + j] = a1; red[(2 * 8 + kg) * 64 + j] = a2;
            __syncthreads();
            if (tid < 192) { const int v = tid >> 6, jj = tid & 63; float s = p.in[I_ADAB][(size_t)l * 6144 + j0 + jj];
#pragma unroll
                for (int g = 0; g < 8; ++g) s += red[(v * 8 + g) * 64 + jj];
                WSP(float, OFF_MOD)[((size_t)l * 3 + v) * 6144 + j0 + jj] = s; }
            __syncthreads();
        }
    }
    for (int i = bid * 512 + tid; i < 2048; i += G * 512) {
        const int pos = i >> 3, f = i & 7; const float inv = powf(10000.f, -(float)f / 8.f); float s, c; sincos_rad((float)pos * inv, s, c);
        WSP(float2, OFF_ROPE)[i] = make_float2(c, s);
    }
    for (int i = bid * 512 + tidx(); i < NLAYER * 1024 * 64; i += G * 512) { const int l = i >> 16, col = (i >> 6) & 1023, j = i & 63;
        WSP(bf16_t, OFF_W3T)[i] = f2bf(p.in[I_HYW3][(size_t)l * 64 * 1024 + (size_t)j * 1024 + col]); }
    {
        float* w1 = (float*)lds;
        float* w2 = w1 + 33 * 64;
        float* vb = w2 + 64 * 64;
        float* zz = vb + 256;
        float* h1 = zz + 8 * 36;
        for (int l = 0; l < NLAYER; ++l) {
            __syncthreads();
            for (int i = tid; i < 33 * 64; i += 512) w1[i] = p.in[I_HYW1][(size_t)l * 33 * 64 + i];
            for (int i = tid; i < 64 * 64; i += 512) w2[i] = p.in[I_HYW2][(size_t)l * 64 * 64 + i];
            if (tid < 64) { vb[tid] = p.in[I_HYB1][l * 64 + tid]; vb[64 + tid] = p.in[I_HYF1][l * 64 + tid]; vb[128 + tid] = p.in[I_HYB2][l * 64 + tid]; vb[192 + tid] = p.in[I_HYF2][l * 64 + tid]; }
            __syncthreads();
            const int nchunks = (16384 + 256) / 8;
            for (int ch = bid; ch < nchunks; ch += G) {
                const bool isc = ch >= 2048; const int L = isc ? 256 : 16384; const int n = (isc ? ch - 2048 : ch) * 8 + (tid >> 6);
                const int nl = tid >> 6, j = tid & 63;
                if (j < 33) {
                    float v;
                    if (j == 0) v = (float)n / (float)(L - 1);
                    else { const int bi = (j - 1) & 15; const float band = 1e-4f + (float)bi * ((15.f - 1e-4f) / 15.f); float s, c; sincos_turns((float)n * band / (float)L, s, c); v = j <= 16 ? c : -s; }
                    zz[nl * 36 + j] = v;
                }
                __syncthreads();
                { float a = vb[j];
#pragma unroll
                  for (int i = 0; i < 33; ++i) a += zz[nl * 36 + i] * w1[i * 64 + j];
                  h1[nl * 64 + j] = sinf(vb[64 + j] * a); }
                __syncthreads();
                { float a = vb[128 + j];
#pragma unroll 16
                  for (int i = 0; i < 64; ++i) a += h1[nl * 64 + i] * w2[i * 64 + j];
                  const float r = sinf(vb[192 + j] * a);
                  if (isc) WSP(float, OFF_H2C)[((size_t)l * 256 + n) * 64 + j] = r; else WSP(bf16_t, OFF_H2L)[((size_t)l * 16384 + n) * 64 + j] = f2bf(r); }
                __syncthreads();
            }
        }
    }
}
template <int JOB, int N, int K>
__device__ __forceinline__ void wconv_job(const Params& p, int l, size_t we, const float* scale, char* lds) {
    float* tile = (float*)lds;
    const int tid = tidx();
    constexpr int NKT = K / 64, NT = (N / 64) * NKT;
    float xa[8], xb[8];
    auto fetch = [&](int v, float (&x)[8]) { const int n0 = (v / NKT) * 64, k0 = (v % NKT) * 64; const int nn = tid & 63, kk = tid >> 6; int ld; const float* src = wsrc(p, l, JOB, n0 + nn, ld);
#pragma unroll
        for (int i = 0; i < 8; ++i) { const int k = kk + 8 * i; float t = src ? src[(size_t)(k0 + k) * ld] : 0.f; if (scale) t *= scale[k0 + k]; x[i] = t; } };
    if (bidx() < NT) fetch(bidx(), xa);
    for (int v = bidx(); v < NT; v += gdim()) {
        const int n0 = (v / NKT) * 64, k0 = (v % NKT) * 64;
        if (v + gdim() < NT) fetch(v + gdim(), xb);
        __syncthreads();
        { const int nn = tid & 63, kk = tid >> 6;
#pragma unroll
          for (int i = 0; i < 8; ++i) { const int k = kk + 8 * i; tile[k * 65 + nn] = xa[i]; } }
#pragma unroll
        for (int i = 0; i < 8; ++i) xa[i] = xb[i];
        __syncthreads();
        if (JOB == 1) {
          const int nn = tid >> 3, kc = tid & 7; float v[8];
#pragma unroll
          for (int i = 0; i < 8; ++i) v[i] = tile[(kc * 8 + i) * 65 + nn] * 64.f;
          u32x2 w; int t0 = 0, t1 = 0;
          t0 = __builtin_amdgcn_cvt_pk_fp8_f32(v[0], v[1], t0, false); t0 = __builtin_amdgcn_cvt_pk_fp8_f32(v[2], v[3], t0, true);
          t1 = __builtin_amdgcn_cvt_pk_fp8_f32(v[4], v[5], t1, false); t1 = __builtin_amdgcn_cvt_pk_fp8_f32(v[6], v[7], t1, true);
          w.x = (unsigned)t0; w.y = (unsigned)t1;
          *(u32x2*)((char*)wts(p, l, we) + (size_t)(n0 + nn) * K + k0 + kc * 8) = w;
        } else
        { const int nn = tid >> 3, kc = tid & 7; u32x4 w;
          w.x = cvt_pk_bf16(tile[(kc * 8 + 0) * 65 + nn], tile[(kc * 8 + 1) * 65 + nn]); w.y = cvt_pk_bf16(tile[(kc * 8 + 2) * 65 + nn], tile[(kc * 8 + 3) * 65 + nn]);
          w.z = cvt_pk_bf16(tile[(kc * 8 + 4) * 65 + nn], tile[(kc * 8 + 5) * 65 + nn]); w.w = cvt_pk_bf16(tile[(kc * 8 + 6) * 65 + nn], tile[(kc * 8 + 7) * 65 + nn]);
          *(u32x4*)(wts(p, l, we) + (size_t)(n0 + nn) * K + k0 + kc * 8) = w; }
    }
}
PHASE_FN void ph_wconv(const Params& p, int l, char* lds_unused) {
    char* lds = lds_dyn; (void)lds_unused;
    const int tid = tidx(), bid = bidx(), G = gdim();
    wconv_job<0, 2304, 1024>(p, l, WE_W1T, nullptr, lds);
    wconv_job<1, 4096, 1024>(p, l, WE_WGT, nullptr, lds);
    wconv_job<2, 384, 256>(p, l, WE_WUQ, p.in[I_QNORM] + l * 256, lds);
    wconv_job<3, 512, 128>(p, l, WE_WUKV, p.in[I_KVNORM] + l * 128, lds);
    wconv_job<4, 1024, 256>(p, l, WE_WBA, nullptr, lds);
    wconv_job<5, 1024, 256>(p, l, WE_WBB, nullptr, lds);
    wconv_job<6, 1024, 256>(p, l, WE_WBD, nullptr, lds);
    wconv_job<7, 1024, 1024>(p, l, WE_WOUT, nullptr, lds);
    wconv_job<8, 8192, 1024>(p, l, WE_WGU, nullptr, lds);
    wconv_job<9, 16384, 256>(p, l, WE_WDN, nullptr, lds);
    __syncthreads();
    {
        float* cs = (float*)lds;
        __syncthreads();
        if (tid < 64) { float s, c; sincospif(2.f * (float)tid / 64.f, &s, &c); cs[tid] = c; cs[64 + tid] = s; }
        __syncthreads();
        for (int idx = bid * 512 + tid; idx < 512 * 1024; idx += G * 512) {
            const int r = idx; const int n = r & 1023, kp = r >> 10; const int part = kp >> 8, g = (kp & 255) >> 6, c = kp & 63;
            const float* wb = p.in[I_WBR] + ((size_t)l * 4 + 2) * 256 * 1024 + (size_t)(g * 64) * 1024 + n;
            float s = 0.f;
#pragma unroll 8
            for (int k2 = 0; k2 < 64; ++k2) s += cs[part * 64 + ((k2 * c) & 63)] * wb[(size_t)k2 * 1024];
            wts(p, l, WE_WBC)[(size_t)n * 512 + kp] = f2bf(s * (1.f / 1024.f));
        }
    }
}

__device__ __forceinline__ bool skip_tile(int l, int tile) { return (l == NLAYER - 1) && ((tile % 130) >= 128); }
__device__ __forceinline__ float row16_sum(float x) {
    x += __int_as_float(__builtin_amdgcn_update_dpp(0, __float_as_int(x), 0xB1, 0xf, 0xf, true));
    x += __int_as_float(__builtin_amdgcn_update_dpp(0, __float_as_int(x), 0x4E, 0xf, 0xf, true));
    x += __int_as_float(__builtin_amdgcn_update_dpp(0, __float_as_int(x), 0x141, 0xf, 0xf, true));
    x += __int_as_float(__builtin_amdgcn_update_dpp(0, __float_as_int(x), 0x140, 0xf, 0xf, true));
    return x;
}
template <int WHICH>
PHASE_FN void ph_norm(const Params& p, int l, char* lds_unused) {
    char* lds = lds_dyn; (void)lds_unused;
    const int tid = tidx(), wid = tid >> 6, lane = tid & 63, sub = lane >> 4, l16 = lane & 15;
    float* Wr = (float*)lds;
    int* lcount = (int*)(lds + 81920);
    int* lbase = lcount + 32;
    int* pidl = lbase + 32;
    int* rankl = pidl + 128;
    if (WHICH >= 1) {
        for (int i = tid; i < 20 * 1024; i += 512) { const int j = i >> 10, k = i & 1023;
            Wr[i] = j < 4 ? p.in[I_MWG][(size_t)l * 4096 + k * 4 + j] : p.in[I_MWE][(size_t)l * 16384 + k * 16 + (j - 4)]; }
        __syncthreads();
    }
    const float* gain = (WHICH == 0 ? p.in[I_N1G] : p.in[I_N2G]) + l * 1024; float sink = 0.f;
    bf16_t* H = WSP(bf16_t, OFF_H);
    float* At = (float*)(lds + 90112); float* Bt = At + 3072;
    for (int i = tid; i < 3072; i += 512) { const int mi = i >> 10, c = i & 1023; const float* mvb = WSP(float, OFF_MOD) + ((size_t)l * 3 + mi) * 6144 + (WHICH == 0 ? 0 : 3072);
        At[i] = gain[c] * (1.f + mvb[1024 + c]); Bt[i] = mvb[c]; }
    __syncthreads();
    f32x4 vn[16]; bool have = false;
#pragma unroll
    for (int i = 0; i < 16; ++i) vn[i] = (f32x4){0.f, 0.f, 0.f, 0.f};
    for (int tile = bidx(); tile < NTILE * 4; tile += gdim()) {
        if (WHICH >= 1 && skip_tile(l, tile >> 2)) continue;
        if (WHICH == 1) { __syncthreads(); if (tid < 24) lcount[tid] = 0; __syncthreads(); }
        {
            const int rloc = wid * 4 + sub, r = tile * 32 + rloc;
            const float* xr = (WHICH == 0 && l == 0) ? xrow_in(p, r) : xrow_st(p, r);
            const int mi = ((tile * 32) % TPB) < SEQ ? (tile * 32 >= TPB ? 1 : 0) : 2;
            f32x4 v[16]; float ss = 0.f;
            if (have) {
#pragma unroll
                for (int i = 0; i < 16; ++i) { v[i] = vn[i]; ss += v[i][0] * v[i][0] + v[i][1] * v[i][1] + v[i][2] * v[i][2] + v[i][3] * v[i][3]; }
            } else {
#pragma unroll
                for (int i = 0; i < 16; ++i) { v[i] = *(const f32x4*)(xr + 4 * (l16 + 16 * i)); ss += v[i][0] * v[i][0] + v[i][1] * v[i][1] + v[i][2] * v[i][2] + v[i][3] * v[i][3]; }
            }
            { int nt_ = tile + gdim(); while (WHICH >= 1 && nt_ < NTILE * 4 && skip_tile(l, nt_ >> 2)) nt_ += gdim();
              have = nt_ < NTILE * 4;
              if (have) { const int rn = nt_ * 32 + rloc; const float* xn = (WHICH == 0 && l == 0) ? xrow_in(p, rn) : xrow_st(p, rn);
#pragma unroll
                  for (int i = 0; i < 16; ++i) vn[i] = *(const f32x4*)(xn + 4 * (l16 + 16 * i)); }
              else {
#pragma unroll
                  for (int i = 0; i < 16; ++i) vn[i] = (f32x4){0.f, 0.f, 0.f, 0.f}; } }
            __builtin_amdgcn_sched_barrier(0);
            ss = row16_sum(ss);
            const float rinv = rsqrtf(ss * (1.f / 1024.f) + 1e-6f);
#pragma unroll
            for (int i = 0; i < 16; ++i) {
                const int c0 = 4 * (l16 + 16 * i);
                const f32x4 a4 = *(const f32x4*)(At + mi * 1024 + c0), b4 = *(const f32x4*)(Bt + mi * 1024 + c0);
#pragma unroll
                for (int e = 0; e < 4; ++e) v[i][e] = (v[i][e] * rinv) * a4[e] + b4[e];
                u32x2 w; w.x = cvt_pk_bf16(v[i][0], v[i][1]); w.y = cvt_pk_bf16(v[i][2], v[i][3]);
                *(u32x2*)(H + (size_t)r * 1024 + c0) = w;
                if ((i & 3) == 3) __builtin_amdgcn_sched_barrier(0);
            }
            if (WHICH >= 1) {
                float lg[20];
                int wofs = 4 * l16; asm volatile("" : "+v"(wofs));
#pragma unroll
                for (int j = 0; j < 20; ++j) { f32x2 a2 = {0.f, 0.f};
#pragma unroll
                    for (int i = 0; i < 16; ++i) { const f32x4 w = *(const f32x4*)(Wr + j * 1024 + wofs + 64 * i);
                        a2 = __builtin_elementwise_fma(__builtin_shufflevector(v[i], v[i], 0, 1), __builtin_shufflevector(w, w, 0, 1), a2);
                        a2 = __builtin_elementwise_fma(__builtin_shufflevector(v[i], v[i], 2, 3), __builtin_shufflevector(w, w, 2, 3), a2);
                        if ((i & 7) == 7) __builtin_amdgcn_sched_barrier(0); }
                    lg[j] = row16_sum(a2[0] + a2[1]); __builtin_amdgcn_sched_barrier(0); }
#pragma unroll
                for (int j = 0; j < 4; ++j) lg[j] += p.in[I_MBG][l * 4 + j];
#pragma unroll
                for (int j = 0; j < 16; ++j) lg[4 + j] += p.in[I_MBE][l * 16 + j];
                int g = 0; float gm = lg[0];
#pragma unroll
                for (int j = 1; j < 4; ++j) if (lg[j] > gm) { gm = lg[j]; g = j; }
                float gs = 0.f;
#pragma unroll
                for (int j = 0; j < 4; ++j) gs += __expf(lg[j] - gm);
                const float gp = 1.f / gs;
                float e4[4];
#pragma unroll
                for (int j = 0; j < 4; ++j) e4[j] = g == 0 ? lg[4 + j] : g == 1 ? lg[8 + j] : g == 2 ? lg[12 + j] : lg[16 + j];
                int i1 = 0; float m1 = e4[0];
#pragma unroll
                for (int j = 1; j < 4; ++j) if (e4[j] > m1) { m1 = e4[j]; i1 = j; }
                int i2 = -1; float m2 = -3.4e38f;
#pragma unroll
                for (int j = 0; j < 4; ++j) if (j != i1 && e4[j] > m2) { m2 = e4[j]; i2 = j; }
                const float x2 = __expf(m2 - m1); const float pw1 = gp / (1.f + x2), pw2 = gp * x2 / (1.f + x2);
                const int lo = i1 < i2 ? i1 : i2, hi = i1 < i2 ? i2 : i1;
                const float wlo = i1 < i2 ? pw1 : pw2, whi = i1 < i2 ? pw2 : pw1;
                const int pairidx = lo == 0 ? hi - 1 : lo == 1 ? hi + 1 : 5;
                if (WHICH == 2) sink += wlo + whi + (float)pairidx;
                if (l16 == 0 && WHICH == 1) { pidl[rloc] = g * 6 + pairidx; WSP(float, OFF_TOKW)[(size_t)r * 2] = wlo; WSP(float, OFF_TOKW)[(size_t)r * 2 + 1] = whi; }
            }
        }
        if (WHICH == 2) asm volatile("" :: "v"(sink));
        if (WHICH == 1) {
            __syncthreads();
            int mypid = 0;
            if (tid < 32) { mypid = pidl[tid]; rankl[tid] = atomicAdd(&lcount[mypid], 1); }
            __syncthreads();
            if (tid < 24) lbase[tid] = lcount[tid] ? atomicAdd(WSP(int, OFF_CNT) + l * 32 + tid, lcount[tid]) : 0;
            __syncthreads();
            if (tid < 32) WSP(int, OFF_LISTS)[(size_t)mypid * T + lbase[mypid] + rankl[tid]] = tile * 32 + tid;
        }
    }
}

PHASE_FN void ph_filt(const Params& p, int l, char* lds_unused) {
    char* lds = lds_dyn; (void)lds_unused;
    const int tid = tidx(), lane = tid & 63, wid = tid >> 6, wm = wid >> 2, wn = wid & 3, fr = lane & 15, fq = lane >> 4;
    const bf16_t* A = WSP(const bf16_t, OFF_H2L) + (size_t)l * 16384 * 64; const bf16_t* B = WSP(const bf16_t, OFF_W3T) + (size_t)l * 1024 * 64;
    bf16_t* F = WSP(bf16_t, OFF_FILT);
    for (int u = bidx(); u < 128 * 8; u += gdim()) {
        const int n0 = (u >> 3) * 128, c0 = (u & 7) * 128;
        const bf16_t* a0 = A + (size_t)(n0 + g_srow()) * 64 + g_skc() * 8; const bf16_t* b0 = B + (size_t)(c0 + g_srow()) * 64 + g_skc() * 8;
        f32x4 acc[4][2]; acc_zero(acc);
        mma_seg<0, 0>(acc, a0, a0 + (size_t)64 * 64, 0, b0, b0 + (size_t)64 * 64, 64, lds);
#pragma unroll
        for (int mt = 0; mt < 4; ++mt)
#pragma unroll
            for (int nt = 0; nt < 2; ++nt) { const int n = n0 + wm * 64 + mt * 16 + fq * 4, col = c0 + wn * 32 + nt * 16 + fr;
                u32x2 w; w.x = cvt_pk_bf16(acc[mt][nt][0], acc[mt][nt][1]); w.y = cvt_pk_bf16(acc[mt][nt][2], acc[mt][nt][3]);
                *(u32x2*)(F + (size_t)col * 16384 + n) = w; }
    }
}

PHASE_FN void ph_gemm1(const Params& p, int l, char* lds_unused);

#define KSWZ(row, colB) ((row) * 256 + ((colB) ^ (((row) & 7) << 4)))
#define SBAR() __builtin_amdgcn_sched_barrier(0)
__device__ __forceinline__ int crow(int r, int hi) { return (r & 3) + 8 * (r >> 2) + 4 * hi; }
__device__ __forceinline__ int v_st(int k, int c) { const int kk = (k & ~0xC) | ((k & 4) << 1) | ((k & 8) >> 1); return ((kk >> 3) * 2 + (c >> 5)) * 512 + ((kk & 7) * 32 + (c & 31)) * 2; }
__device__ __forceinline__ int v_rd_base(int lane) { return ((lane & 3) << 3) | (((lane >> 2) & 3) << 6) | (((lane >> 4) & 1) << 5) | (((lane >> 5) & 1) << 8); }
constexpr int v_rd_off(int d0, int ks, int half) { return d0 * 512 + ks * 2048 + half * 1024; }
template <int OFF> __device__ __forceinline__ s16x4 tr_read(int vb) {
    s16x4 r; asm volatile("ds_read_b64_tr_b16 %0, %1 offset:%2" : "=&v"(r) : "v"(vb), "i"(OFF) : "memory"); return r;
}
template <int D0> __device__ __forceinline__ void pv_one(f32x16& od, int vb, bf16x8 pa0, bf16x8 pa1, bf16x8 pa2, bf16x8 pa3) {
    const s16x4 l0 = tr_read<v_rd_off(D0, 0, 0)>(vb), h0 = tr_read<v_rd_off(D0, 0, 1)>(vb), l1 = tr_read<v_rd_off(D0, 1, 0)>(vb), h1 = tr_read<v_rd_off(D0, 1, 1)>(vb);
    const s16x4 l2 = tr_read<v_rd_off(D0, 2, 0)>(vb), h2 = tr_read<v_rd_off(D0, 2, 1)>(vb), l3 = tr_read<v_rd_off(D0, 3, 0)>(vb), h3 = tr_read<v_rd_off(D0, 3, 1)>(vb);
    asm volatile("s_waitcnt lgkmcnt(0)" ::: "memory"); SBAR();
#define PKV(L, H) (bf16x8){L[0], L[1], L[2], L[3], H[0], H[1], H[2], H[3]}
    od = __builtin_amdgcn_mfma_f32_32x32x16_bf16(pa0, PKV(l0, h0), od, 0, 0, 0);
    od = __builtin_amdgcn_mfma_f32_32x32x16_bf16(pa1, PKV(l1, h1), od, 0, 0, 0);
    od = __builtin_amdgcn_mfma_f32_32x32x16_bf16(pa2, PKV(l2, h2), od, 0, 0, 0);
    od = __builtin_amdgcn_mfma_f32_32x32x16_bf16(pa3, PKV(l3, h3), od, 0, 0, 0);
#undef PKV
}
constexpr int ATT_LDS = 16384 + 32768 + 2048;
constexpr float ATT_THR = 8.f;
template <int DQK, int NA>
__device__ __forceinline__ void attn_unit(const bf16_t* __restrict__ Qb, int ldq, const bf16_t* __restrict__ Kb, int ldk, const bf16_t* __restrict__ Vb, int ldv,
                                          bf16_t* __restrict__ Ob, int ldo, int NT, int nA, int baseA, int baseB, char* lds, const float* biasL, int qrow0, int krow_lo) {
    constexpr float SCALE = DQK == 96 ? 0.10206207261596575f : 0.125f;
    constexpr float C = SCALE * 1.4426950408889634f;
    constexpr int ND = DQK / 16, NKC = DQK / 8;
    const int tid = tidx(), wid = tid >> 6, lane = tid & 63, r32 = lane & 31, hi = lane >> 5;
    char* V_lds = lds; char* K_lds = lds + 16384;
    float* wsf = (float*)(lds + 49152) + wid * 64; float* al_l = wsf; float* li_l = wsf + 32;
    bf16x8 qr[ND];
    { const bf16_t* Qw = Qb + (size_t)(wid * 32 + r32) * ldq + hi * 8;
#pragma unroll
      for (int d0 = 0; d0 < ND; ++d0) qr[d0] = *(const bf16x8*)(Qw + d0 * 16); }
    const int vrow = tid >> 3, vc = (tid & 7) * 8, vst = v_st(vrow, vc);
    const int k0row = tid / NKC, k0c = tid % NKC, kst0 = KSWZ(k0row, k0c * 16);
    const int id1 = tid + 512; const bool has1 = (DQK == 96) && (id1 < 64 * NKC);
    const int k1row = has1 ? id1 / NKC : 0, k1c = has1 ? id1 % NKC : 0, kst1 = KSWZ(k1row, k1c * 16);
    const int vb0 = (int)(uintptr_t)V_lds + v_rd_base(lane);
    bf16x8 sv, sk0, sk1;
    auto SLOAD = [&](int j) { const size_t t0 = (size_t)(j < nA ? baseA + 64 * j : baseB + 64 * (j - nA));
        sv = *(const bf16x8*)(Vb + (t0 + vrow) * ldv + vc); sk0 = *(const bf16x8*)(Kb + (t0 + k0row) * ldk + k0c * 8);
        if (has1) sk1 = *(const bf16x8*)(Kb + (t0 + k1row) * ldk + k1c * 8); };
    auto SWRITE = [&](int b) { *(bf16x8*)(V_lds + b * 8192 + vst) = sv; *(bf16x8*)(K_lds + b * 16384 + kst0) = sk0; if (has1) *(bf16x8*)(K_lds + b * 16384 + kst1) = sk1; };
    float m_reg = -1e30f, l_reg = 0.f; f32x16 o0 = {}, o1 = {};
    __syncthreads();
    SLOAD(0); SWRITE(0); __syncthreads();
    for (int j = 0; j < NT; ++j) {
        const int bsel = j & 1;
        if (j + 1 < NT) SLOAD(j + 1);
        f32x16 p0 = {}, p1 = {};
        { const char* Ks = K_lds + bsel * 16384;
#pragma unroll
          for (int d0 = 0; d0 < ND; ++d0) { const int cb = d0 * 32 + hi * 16;
            const bf16x8 b0 = *(const bf16x8*)(Ks + KSWZ(r32, cb)); const bf16x8 b1 = *(const bf16x8*)(Ks + KSWZ(32 + r32, cb));
            p0 = __builtin_amdgcn_mfma_f32_32x32x16_bf16(b0, qr[d0], p0, 0, 0, 0);
            p1 = __builtin_amdgcn_mfma_f32_32x32x16_bf16(b1, qr[d0], p1, 0, 0, 0); } }
        if (NA) {
            if (j >= nA) {
                const int krow = krow_lo + (j - nA), qrow = qrow0 + (wid >> 1);
                int ws = qrow - 4; ws = ws < 0 ? 0 : (ws > 248 ? 248 : ws);
                const bool rowok = (krow >= ws) && (krow < ws + 8);
                const int qc = 32 * (wid & 1) + r32; int cs = qc - 8; cs = cs < 0 ? 0 : (cs > 48 ? 48 : cs);
                int dri = krow - qrow + 7; dri = dri < 0 ? 0 : (dri > 14 ? 14 : dri);
                const float* brow = biasL + dri * 31 + 15 - qc;
#pragma unroll
                for (int r = 0; r < 16; ++r) { const int kc = crow(r, hi); const bool ok = rowok && kc >= cs && kc < cs + 16; float bv = 0.f; if (ok) bv = brow[kc]; p0[r] = ok ? p0[r] + bv : -1e30f; }
#pragma unroll
                for (int r = 0; r < 16; ++r) { const int kc = 32 + crow(r, hi); const bool ok = rowok && kc >= cs && kc < cs + 16; float bv = 0.f; if (ok) bv = brow[kc]; p1[r] = ok ? p1[r] + bv : -1e30f; }
            }
        }
        float pmax = p0[0];
#pragma unroll
        for (int r = 1; r < 16; ++r) pmax = fmaxf(pmax, p0[r]);
#pragma unroll
        for (int r = 0; r < 16; ++r) pmax = fmaxf(pmax, p1[r]);
        { auto rr = __builtin_amdgcn_permlane32_swap(__float_as_uint(pmax), __float_as_uint(pmax), false, false); pmax = fmaxf(__uint_as_float(rr[0]), __uint_as_float(rr[1])); }
        float mn, alpha;
        if (__all(pmax - m_reg <= ATT_THR / SCALE)) { mn = m_reg; alpha = 1.f; }
        else { mn = fmaxf(m_reg, pmax); alpha = __builtin_amdgcn_exp2f((m_reg - mn) * C); m_reg = mn; }
        const float mnC = -mn * C;
        float ps = 0.f;
#pragma unroll
        for (int r = 0; r < 16; ++r) { p0[r] = __builtin_amdgcn_exp2f(fmaf(p0[r], C, mnC)); ps += p0[r]; }
#pragma unroll
        for (int r = 0; r < 16; ++r) { p1[r] = __builtin_amdgcn_exp2f(fmaf(p1[r], C, mnC)); ps += p1[r]; }
        { auto rr = __builtin_amdgcn_permlane32_swap(__float_as_uint(ps), __float_as_uint(ps), false, false); ps = __uint_as_float(rr[0]) + __uint_as_float(rr[1]); }
        l_reg = l_reg * alpha + ps;
        bf16x8 pa0, pa1, pa2, pa3;
#define PK4(P, BASE, OUT) do { unsigned a0_ = cvt_pk_bf16(P[BASE + 0], P[BASE + 1]), a1_ = cvt_pk_bf16(P[BASE + 2], P[BASE + 3]);   \
        unsigned b0_ = cvt_pk_bf16(P[BASE + 4], P[BASE + 5]), b1_ = cvt_pk_bf16(P[BASE + 6], P[BASE + 7]);                              \
        auto r0_ = __builtin_amdgcn_permlane32_swap(a0_, b0_, false, false); auto r1_ = __builtin_amdgcn_permlane32_swap(a1_, b1_, false, false); \
        u32x4 w_ = {r0_[0], r1_[0], r0_[1], r1_[1]}; OUT = *reinterpret_cast<bf16x8*>(&w_); } while (0)
        PK4(p0, 0, pa0); PK4(p0, 8, pa1); PK4(p1, 0, pa2); PK4(p1, 8, pa3);
#undef PK4
        if (__any(alpha < 1.f)) {
            if (hi == 0) al_l[r32] = alpha;
            asm volatile("s_waitcnt lgkmcnt(0)" ::: "memory");
#pragma unroll
            for (int r = 0; r < 16; ++r) { const float a = al_l[crow(r, hi)]; o0[r] *= a; o1[r] *= a; }
        }
        pv_one<0>(o0, vb0 + bsel * 8192, pa0, pa1, pa2, pa3);
        pv_one<1>(o1, vb0 + bsel * 8192, pa0, pa1, pa2, pa3);
        if (j + 1 < NT) SWRITE(bsel ^ 1);
        __syncthreads();
    }
    if (hi == 0) li_l[r32] = l_reg;
    asm volatile("s_waitcnt lgkmcnt(0)" ::: "memory");
    bf16_t* Ow = Ob + (size_t)(wid * 32) * ldo;
#pragma unroll
    for (int r = 0; r < 16; ++r) { const int orow = crow(r, hi); const float rl = __builtin_amdgcn_rcpf(li_l[orow]);
        Ow[(size_t)orow * ldo + r32] = f2bf(o0[r] * rl); Ow[(size_t)orow * ldo + 32 + r32] = f2bf(o1[r] * rl); }
    __syncthreads();
}

__device__ __forceinline__ void mla_partialSM(f32x16& p0, f32x16& p1, float& m_reg, float& alpha, bool first) {
    constexpr float THR2 = ATT_THR * 1.4426950408889634f;
    float pmax = p0[0];
#pragma unroll
    for (int r = 1; r < 16; ++r) pmax = fmaxf(pmax, p0[r]);
#pragma unroll
    for (int r = 0; r < 16; ++r) pmax = fmaxf(pmax, p1[r]);
    { auto rr = __builtin_amdgcn_permlane32_swap(__float_as_uint(pmax), __float_as_uint(pmax), false, false); pmax = fmaxf(__uint_as_float(rr[0]), __uint_as_float(rr[1])); }
    if (__builtin_expect(!first && __all(pmax <= THR2), 1)) { alpha = 1.f; }
    else { const float d = first ? pmax : fmaxf(pmax, 0.f); alpha = first ? 1.f : __builtin_amdgcn_exp2f(-d); m_reg += d;
#pragma unroll
        for (int r = 0; r < 16; ++r) { p0[r] -= d; p1[r] -= d; } }
#pragma unroll
    for (int r = 0; r < 16; ++r) p0[r] = __builtin_amdgcn_exp2f(p0[r]);
}
__device__ __forceinline__ void mla_finishSM(f32x16& p0, f32x16& p1, float alpha, float& l_reg, bf16x8& pa0, bf16x8& pa1, bf16x8& pa2, bf16x8& pa3) {
#pragma unroll
    for (int r = 0; r < 16; ++r) p1[r] = __builtin_amdgcn_exp2f(p1[r]);
    f32x2 s2 = {p0[0], p0[1]}, t2 = {p1[0], p1[1]};
#pragma unroll
    for (int r = 2; r < 16; r += 2) { s2 += (f32x2){p0[r], p0[r + 1]}; t2 += (f32x2){p1[r], p1[r + 1]}; }
    s2 += t2; float ps = s2[0] + s2[1];
    { auto rr = __builtin_amdgcn_permlane32_swap(__float_as_uint(ps), __float_as_uint(ps), false, false); ps = __uint_as_float(rr[0]) + __uint_as_float(rr[1]); }
    l_reg = l_reg * alpha + ps;
#define PK4(P, BASE, OUT) do { unsigned a0_ = cvt_pk_bf16(P[BASE + 0], P[BASE + 1]), a1_ = cvt_pk_bf16(P[BASE + 2], P[BASE + 3]);   \
    unsigned b0_ = cvt_pk_bf16(P[BASE + 4], P[BASE + 5]), b1_ = cvt_pk_bf16(P[BASE + 6], P[BASE + 7]);                              \
    auto r0_ = __builtin_amdgcn_permlane32_swap(a0_, b0_, false, false); auto r1_ = __builtin_amdgcn_permlane32_swap(a1_, b1_, false, false); \
    u32x4 w_ = {r0_[0], r1_[0], r0_[1], r1_[1]}; OUT = *reinterpret_cast<bf16x8*>(&w_); } while (0)
    PK4(p0, 0, pa0); PK4(p0, 8, pa1); PK4(p1, 0, pa2); PK4(p1, 8, pa3);
#undef PK4
}
__device__ __forceinline__ void mla_qkt(f32x16& p0, f32x16& p1, const char* Ks, const bf16x8* qr, int r32, int hi, float init) {
#pragma unroll
    for (int r = 0; r < 16; ++r) { p0[r] = init; p1[r] = init; }
#pragma unroll
    for (int d0 = 0; d0 < 6; ++d0) { const int cb = d0 * 32 + hi * 16;
        const bf16x8 b0 = *(const bf16x8*)(Ks + KSWZ(r32, cb)); const bf16x8 b1 = *(const bf16x8*)(Ks + KSWZ(32 + r32, cb));
        p0 = __builtin_amdgcn_mfma_f32_32x32x16_bf16(b0, qr[d0], p0, 0, 0, 0);
        p1 = __builtin_amdgcn_mfma_f32_32x32x16_bf16(b1, qr[d0], p1, 0, 0, 0); }
}
__device__ __forceinline__ void mla_unit(const bf16_t* __restrict__ Qb, const bf16_t* __restrict__ Kb, const bf16_t* __restrict__ Vb, bf16_t* __restrict__ Ob,
                                         int NT, int nA, int baseA, int baseB, char* lds) {
    constexpr int ldq = 384, ldk = 384, ldv = 256, ldo = 512;
    const int tid = tidx(), wid = tid >> 6, lane = tid & 63, r32 = lane & 31, hi = lane >> 5;
    char* V_lds = lds; char* K_lds = lds + 16384;
    float* wsf = (float*)(lds + 49152) + wid * 64; float* al_l = wsf; float* li_l = wsf + 32;
    bf16x8 qr[6];
    { const bf16_t* Qw = Qb + (size_t)(wid * 32 + r32) * ldq + hi * 8;
#pragma unroll
      for (int d0 = 0; d0 < 6; ++d0) qr[d0] = *(const bf16x8*)(Qw + d0 * 16); }
    const int vrow = tid >> 3, vc = (tid & 7) * 8, vst = v_st(vrow, vc);
    const int k0row = tid / 12, k0c = tid % 12, kst0 = KSWZ(k0row, k0c * 16);
    const int id1 = tid + 512; const bool has1 = id1 < 768;
    const int k1row = has1 ? id1 / 12 : 0, k1c = has1 ? id1 % 12 : 0, kst1 = KSWZ(k1row, k1c * 16);
    const int vb0 = (int)(uintptr_t)V_lds + v_rd_base(lane);
    bf16x8 sv, sk0, sk1;
    auto SLOAD = [&](int j) { const size_t t0 = (size_t)(j < nA ? baseA + 64 * j : baseB + 64 * (j - nA));
        sv = *(const bf16x8*)(Vb + (t0 + vrow) * ldv + vc); sk0 = *(const bf16x8*)(Kb + (t0 + k0row) * ldk + k0c * 8);
        if (has1) sk1 = *(const bf16x8*)(Kb + (t0 + k1row) * ldk + k1c * 8); };
    auto SWRITE = [&](int b) { *(bf16x8*)(V_lds + b * 8192 + vst) = sv; *(bf16x8*)(K_lds + b * 16384 + kst0) = sk0; if (has1) *(bf16x8*)(K_lds + b * 16384 + kst1) = sk1; };
#define MLA_RESC(a) do { if (__any((a) < 1.f)) { if (hi == 0) al_l[r32] = (a); asm volatile("s_waitcnt lgkmcnt(0)" ::: "memory"); \
    _Pragma("unroll") for (int r = 0; r < 16; ++r) { const float a_ = al_l[crow(r, hi)]; o0[r] *= a_; o1[r] *= a_; } } } while (0)
    float m_reg = 0.f, l_reg = 0.f; f32x16 o0 = {}, o1 = {};
    f32x16 pA0, pA1, pB0, pB1; float alA, alB; bf16x8 pa0, pa1, pa2, pa3;
    __syncthreads();
    SLOAD(0); SWRITE(0); __syncthreads();
    mla_qkt(pA0, pA1, K_lds, qr, r32, hi, 0.f); mla_partialSM(pA0, pA1, m_reg, alA, true);
    SLOAD(1); SWRITE(1); __syncthreads();
    for (int j = 1; j + 1 < NT; j += 2) {
        SBAR(); mla_qkt(pB0, pB1, K_lds + 16384, qr, r32, hi, -m_reg);
        mla_finishSM(pA0, pA1, alA, l_reg, pa0, pa1, pa2, pa3); SBAR();
        SLOAD(j + 1); SBAR();
        pv_one<0>(o0, vb0, pa0, pa1, pa2, pa3); pv_one<1>(o1, vb0, pa0, pa1, pa2, pa3); mla_partialSM(pB0, pB1, m_reg, alB, false);
        __syncthreads(); SWRITE(0);
        MLA_RESC(alB); __syncthreads();
        SBAR(); mla_qkt(pA0, pA1, K_lds, qr, r32, hi, -m_reg);
        mla_finishSM(pB0, pB1, alB, l_reg, pa0, pa1, pa2, pa3); SBAR();
        SLOAD(j + 2); SBAR();
        pv_one<0>(o0, vb0 + 8192, pa0, pa1, pa2, pa3); pv_one<1>(o1, vb0 + 8192, pa0, pa1, pa2, pa3); mla_partialSM(pA0, pA1, m_reg, alA, false);
        __syncthreads(); SWRITE(1);
        MLA_RESC(alA); __syncthreads();
    }
    SBAR(); mla_qkt(pB0, pB1, K_lds + 16384, qr, r32, hi, -m_reg);
    mla_finishSM(pA0, pA1, alA, l_reg, pa0, pa1, pa2, pa3); SBAR();
    pv_one<0>(o0, vb0, pa0, pa1, pa2, pa3); pv_one<1>(o1, vb0, pa0, pa1, pa2, pa3); mla_partialSM(pB0, pB1, m_reg, alB, false);
    __syncthreads(); MLA_RESC(alB);
    mla_finishSM(pB0, pB1, alB, l_reg, pa0, pa1, pa2, pa3); SBAR();
    pv_one<0>(o0, vb0 + 8192, pa0, pa1, pa2, pa3); pv_one<1>(o1, vb0 + 8192, pa0, pa1, pa2, pa3);
#undef MLA_RESC
    if (hi == 0) li_l[r32] = l_reg;
    asm volatile("s_waitcnt lgkmcnt(0)" ::: "memory");
    bf16_t* Ow = Ob + (size_t)(wid * 32) * ldo;
#pragma unroll
    for (int r = 0; r < 16; ++r) { const int orow = crow(r, hi); const float rl = __builtin_amdgcn_rcpf(li_l[orow]);
        Ow[(size_t)orow * ldo + r32] = f2bf(o0[r] * rl); Ow[(size_t)orow * ldo + 32 + r32] = f2bf(o1[r] * rl); }
    __syncthreads();
}

__device__ __forceinline__ void upproj_tile(const Params& p, int l, int tile, int part, char* lds) {
    const int tid = tidx(), lane = tid & 63, wid = tid >> 6, wm = wid >> 2, wn = wid & 3, fr = lane & 15, fq = lane >> 4;
    const int r0 = tile * 128; const bool ctx = row_is_ctx(r0); const int b = r0 >= TPB ? 1 : 0, t0 = r0 - b * TPB;
    float* rq = (float*)(lds + G_LDS); float* rkv = rq + 128;
    const bf16_t* P = WSP(bf16_t, OFF_P); bf16_t* Qo = WSP(bf16_t, OFF_Q); bf16_t* Ko = WSP(bf16_t, OFF_K); bf16_t* Vo = WSP(bf16_t, OFF_V);
    const float2* rope = WSP(float2, OFF_ROPE);
    __syncthreads();
    {
        const int row = tid >> 2, qd = tid & 3; const bf16_t* pr = P + (size_t)(r0 + row) * PLD;
        float sq = 0.f, sk = 0.f;
#pragma unroll
        for (int i = 0; i < 8; ++i) { const bf16x8 v = *(const bf16x8*)(pr + 768 + qd * 64 + i * 8);
#pragma unroll
            for (int e = 0; e < 8; ++e) { const float x = bf2f((bf16_t)v[e]); sq += x * x; } }
#pragma unroll
        for (int i = 0; i < 4; ++i) { const bf16x8 v = *(const bf16x8*)(pr + 1024 + qd * 32 + i * 8);
#pragma unroll
            for (int e = 0; e < 8; ++e) { const float x = bf2f((bf16_t)v[e]); sk += x * x; } }
        sq += __shfl_xor(sq, 1); sq += __shfl_xor(sq, 2); sk += __shfl_xor(sk, 1); sk += __shfl_xor(sk, 2);
        if (qd == 0) { rq[row] = rsqrtf(sq * (1.f / 256.f) + 1e-6f); rkv[row] = rsqrtf(sk * (1.f / 128.f) + 1e-6f); }
    }
    if (part == 0) for (int it = tid; it < 128 * 16; it += 512) {
        const int row = it >> 4, pi = it & 15; const bf16_t* pr = P + (size_t)(r0 + row) * PLD + 1152 + 2 * pi;
        float xe = bf2f(pr[0]), xo = bf2f(pr[1]);
        if (!ctx) { const int t = t0 + row; const int pos = pi < 8 ? (t >> 6) : (t & 63); const float2 cs = rope[pos * 8 + (pi & 7)];
            const float ne = xe * cs.x - xo * cs.y, no = xe * cs.y + xo * cs.x; xe = ne; xo = no; }
        const unsigned w = cvt_pk_bf16(xe, xo);
#pragma unroll
        for (int h = 0; h < 4; ++h) *(unsigned*)(Ko + (size_t)(r0 + row) * 384 + h * 96 + 64 + 2 * pi) = w;
    }
    __syncthreads();
    if (part < 3) { const int ct = part;
        const bf16_t* a0 = P + (size_t)(r0 + g_srow()) * PLD + 768 + g_skc() * 8; const bf16_t* a1 = a0 + (size_t)64 * PLD;
        const bf16_t* b0 = wts(p, l, WE_WUQ) + (size_t)(ct * 128 + g_srow()) * 256 + g_skc() * 8; const bf16_t* b1 = b0 + (size_t)64 * 256;
        f32x4 acc[4][2]; acc_zero(acc);
        mma_seg<1, 0>(acc, a0, a1, 0, b0, b1, 256, lds);
#pragma unroll
        for (int mt = 0; mt < 4; ++mt) { const int row = wm * 64 + mt * 16 + fr; const float rs = rq[row] * 0.14724260355f; const int t = t0 + row;
#pragma unroll
            for (int nt = 0; nt < 2; ++nt) { const int col = ct * 128 + wn * 32 + nt * 16 + fq * 4; const int dd = col % 96;
                float v0 = acc[mt][nt][0] * rs, v1 = acc[mt][nt][1] * rs, v2 = acc[mt][nt][2] * rs, v3 = acc[mt][nt][3] * rs;
                if (dd >= 64 && !ctx) { const int pi = (dd - 64) >> 1;
                    const int posa = pi < 8 ? (t >> 6) : (t & 63), posb = (pi + 1) < 8 ? (t >> 6) : (t & 63);
                    const float2 ca = rope[posa * 8 + (pi & 7)], cb = rope[posb * 8 + ((pi + 1) & 7)];
                    const float n0 = v0 * ca.x - v1 * ca.y, n1 = v0 * ca.y + v1 * ca.x, n2 = v2 * cb.x - v3 * cb.y, n3 = v2 * cb.y + v3 * cb.x; v0 = n0; v1 = n1; v2 = n2; v3 = n3; }
                u32x2 w; w.x = cvt_pk_bf16(v0, v1); w.y = cvt_pk_bf16(v2, v3);
                *(u32x2*)(Qo + (size_t)(r0 + row) * 384 + col) = w; } }
    }
    if (part >= 3) { const int ct = part - 3;
        const bf16_t* a0 = P + (size_t)(r0 + g_srow()) * PLD + 1024 + g_skc() * 8; const bf16_t* a1 = a0 + (size_t)64 * PLD;
        const bf16_t* b0 = wts(p, l, WE_WUKV) + (size_t)(ct * 128 + g_srow()) * 128 + g_skc() * 8; const bf16_t* b1 = b0 + (size_t)64 * 128;
        f32x4 acc[4][2]; acc_zero(acc);
        mma_seg<1, 0>(acc, a0, a1, 0, b0, b1, 128, lds);
#pragma unroll
        for (int mt = 0; mt < 4; ++mt) { const int row = wm * 64 + mt * 16 + fr; const float rs = rkv[row];
#pragma unroll
            for (int nt = 0; nt < 2; ++nt) { const int cc = wn * 32 + nt * 16 + fq * 4;
                u32x2 w; w.x = cvt_pk_bf16(acc[mt][nt][0] * rs, acc[mt][nt][1] * rs); w.y = cvt_pk_bf16(acc[mt][nt][2] * rs, acc[mt][nt][3] * rs);
                if (cc < 64) *(u32x2*)(Ko + (size_t)(r0 + row) * 384 + ct * 96 + cc) = w;
                else *(u32x2*)(Vo + (size_t)(r0 + row) * 256 + ct * 64 + (cc - 64)) = w; } }
    }
}
__device__ __forceinline__ float sconv_lat(const bf16_t* HT, const float* sw, int b, int ch, int n) {
    const bf16_t* r = HT + ((size_t)b * 1024 + ch) * TPB;
    const float um = n > 0 ? bf2f(r[n - 1]) : 0.f, u0 = bf2f(r[n]), up = n < SEQ - 1 ? bf2f(r[n + 1]) : 0.f;
    return sw[ch] * um + sw[768 + ch] * u0 + sw[1536 + ch] * up;
}
__device__ __forceinline__ float2 h2f(unsigned u) { return make_float2((float)__builtin_bit_cast(_Float16, (unsigned short)(u & 0xffffu)), (float)__builtin_bit_cast(_Float16, (unsigned short)(u >> 16))); }
__device__ __forceinline__ unsigned f2h(float2 v) { return __builtin_bit_cast(unsigned, __builtin_amdgcn_cvt_pkrtz(v.x, v.y)); }
__device__ __forceinline__ void hyena_unit(const Params& p, int l, int c, char* lds, const FFrag& FF) {
    float2* buf = (float2*)lds; const float2* thi = (const float2*)(lds + FFT_LDS_TAB); const float2* tlo = thi + 128; const float2* t2hi = thi + 256; const float2* t2lo = thi + 384;
    float* red = (float*)(lds + FFT_LDS_EXTRA);
    const bf16_t* HT = WSP(const bf16_t, OFF_HYFN); const float* sw = p.in[I_HYSW] + (size_t)l * 3 * 768;
    const bf16_t* FL = WSP(const bf16_t, OFF_FILT);
    const float d0 = -3.0701134573253945f, d1 = -15.350567286626973f;
    const float awin = fabsf(d0 + (float)c * ((d1 - d0) / 255.f)) * (1.f / 16383.f);
    unsigned* GS = WSP(unsigned, OFF_HYS) + (size_t)(bidx() & 255) * 65536; unsigned* YS = GS + 16384; unsigned* XS = YS + 16384;
    unsigned Zr[32];
#define HY_W2(n) cmulf(t2hi[(n) >> 7], t2lo[(n) & 127])
#define HY_ST(a, q, v) __hip_atomic_store((a) + (q), (v), __ATOMIC_RELAXED, __HIP_MEMORY_SCOPE_AGENT)
#define HY_LD(a, q) __hip_atomic_load((a) + (q), __ATOMIC_RELAXED, __HIP_MEMORY_SCOPE_AGENT)
    __syncthreads();
#pragma unroll 4
    for (int i = 0; i < 32; ++i) { const int n = tidx() + 512 * i; buf[FBI(n)] = make_float2(sconv_lat(HT, sw, 0, c, n), sconv_lat(HT, sw, 1, c, n)); }
#pragma unroll
    for (int i = 0; i < 32; ++i) Zr[i] = f2h(buf[FBI(tidx() + 512 * i)]);
#pragma unroll 1
    for (int order = 0; order < 2; ++order) {
        const bf16_t* ff = FL + (size_t)(order * 256 + c) * 16384; const bf16_t* fb = FL + (size_t)(512 + order * 256 + c) * 16384;
        float ss = 0.f;
#pragma unroll 4
        for (int i = 0; i < 32; ++i) { const int n = tidx() + 512 * i; const float win = __expf(-(float)n * awin); const float hf = bf2f(ff[n]) * win, hb = bf2f(fb[n]) * win; ss += hf * hf + (n ? hb * hb : 0.f);
            HY_ST(XS, n, f2h(make_float2(sconv_lat(HT, sw, 0, (order + 1) * 256 + c, n), sconv_lat(HT, sw, 1, (order + 1) * 256 + c, n)))); }
        const float tot = block_sum(ss, red);
        const float fac = rsqrtf(tot + 1e-6f) * (16.f / 32768.f);
        const float bias = p.in[I_HYBIAS][(size_t)l * 512 + order * 256 + c];
#pragma unroll 1
        for (int par = 0; par < 2; ++par) {
            __syncthreads();
#pragma unroll 8
            for (int i = 0; i < 32; ++i) { const int n = tidx() + 512 * i; const int nr = 16384 - n;
                const float hf = bf2f(ff[n]) * __expf(-(float)n * awin); const float hbr = n ? bf2f(fb[nr]) * __expf(-(float)nr * awin) : 0.f;
                float2 v; if (par == 0) v = make_float2(hf + hbr, 0.f); else { const float2 w = HY_W2(n); const float d = hf - hbr; v = make_float2(d * w.x, d * w.y); }
                buf[FBI(n)] = v; }
            __syncthreads();
            fft_fwd_blk(buf, FF, thi, tlo);
#pragma unroll 8
            for (int i = 0; i < 32; ++i) { const int q = tidx() + 512 * i; HY_ST(GS, q, f2h(buf[FBI(q)])); }
            __syncthreads();
#pragma unroll
            for (int i = 0; i < 32; ++i) { const int n = tidx() + 512 * i; float2 z = h2f(Zr[i]); z.x *= 0.0625f; z.y *= 0.0625f; if (par) z = cmulf(z, HY_W2(n)); buf[FBI(n)] = z; }
            __syncthreads();
            fft_fwd_blk(buf, FF, thi, tlo);
            asm volatile("s_waitcnt vmcnt(0)" ::: "memory");
#pragma unroll
            for (int hh = 0; hh < 2; ++hh) { unsigned g[16];
#pragma unroll
              for (int i = 0; i < 16; ++i) g[i] = HY_LD(GS, tidx() + 512 * (hh * 16 + i));
#pragma unroll
              for (int i = 0; i < 16; ++i) { const int q = tidx() + 512 * (hh * 16 + i); const float2 pr = cmulf(buf[FBI(q)], h2f(g[i])); buf[FBI(q)] = make_float2(pr.x * fac, pr.y * fac);        }
              __builtin_amdgcn_sched_barrier(0); }
            __syncthreads();
            fft_inv_blk(buf, FF, thi, tlo);
            if (par == 0) {
#pragma unroll 8
                for (int i = 0; i < 32; ++i) { const int q = tidx() + 512 * i; const float2 v = buf[FBI(q)]; HY_ST(YS, q, f2h(v)); }
            } else {
                asm volatile("s_waitcnt vmcnt(0)" ::: "memory");
#pragma unroll
                for (int hh = 0; hh < 2; ++hh) {
                    unsigned y[16], xg[16];
#pragma unroll
                    for (int i = 0; i < 16; ++i) { y[i] = HY_LD(YS, tidx() + 512 * (hh * 16 + i)); xg[i] = HY_LD(XS, tidx() + 512 * (hh * 16 + i)); }
#pragma unroll
                    for (int i = 0; i < 16; ++i) { const int n = tidx() + 512 * (hh * 16 + i); const float2 v = buf[FBI(n)];
                        const float2 t2 = cmulcf(v, HY_W2(n)); const float2 y0 = h2f(y[i]); const float2 z = h2f(Zr[hh * 16 + i]); const float2 g = h2f(xg[i]);
                        Zr[hh * 16 + i] = f2h(make_float2(g.x * (y0.x + t2.x + bias * z.x), g.y * (y0.y + t2.y + bias * z.y))); }
                    __builtin_amdgcn_sched_barrier(0);
                }
            }
        }
    }
#undef HY_W2
#undef HY_ST
#undef HY_LD
    bf16_t* OB = WSP(bf16_t, OFF_OBT);
#pragma unroll
    for (int i = 0; i < 32; ++i) { const int n = tidx() + 512 * i; const float2 z = h2f(Zr[i]); OB[((size_t)0 * 256 + c) * TPB + n] = f2bf(z.x); OB[((size_t)1 * 256 + c) * TPB + n] = f2bf(z.y); }
    __syncthreads();
}
__device__ __forceinline__ void fnet_unit(const Params& p, int c, char* lds, const FFrag& FF) {
    float2* buf = (float2*)lds; const float2* thi = (const float2*)(lds + FFT_LDS_TAB); const float2* tlo = thi + 128;
    const int tid = tidx();
    const bf16_t* HT = WSP(const bf16_t, OFF_HYFN); bf16_t* OC = WSP(bf16_t, OFF_OCT);
    const bf16_t* r0 = HT + ((size_t)0 * 1024 + 768 + c) * TPB; const bf16_t* r1 = HT + ((size_t)1 * 1024 + 768 + c) * TPB;
    if (DBG_FN_COPY) {
        for (int i = 0; i < 32; ++i) { const int n = tid + 512 * i; OC[((size_t)0 * 512 + c) * TPB + n] = r0[n]; OC[((size_t)0 * 512 + 256 + c) * TPB + n] = r1[n]; OC[((size_t)1 * 512 + c) * TPB + n] = r1[n]; OC[((size_t)1 * 512 + 256 + c) * TPB + n] = r0[n]; }
        return;
    }
    __syncthreads();
#pragma unroll 4
    for (int i = 0; i < 32; ++i) { const int n = tid + 512 * i; buf[FBI(n)] = make_float2(bf2f(r0[n]), bf2f(r1[n])); }
    __syncthreads();
    fft_fwd_blk(buf, FF, thi, tlo);
#pragma unroll 4
    for (int i = 0; i < 32; ++i) { const int k = tid + 512 * i; const int km = (16384 - k) & 16383; const float2 X = buf[(k & 127) * FRS + (k >> 7)], Xm = buf[(km & 127) * FRS + (km >> 7)];
        OC[((size_t)0 * 512 + c) * TPB + k] = f2bf(0.5f * (X.x + Xm.x)); OC[((size_t)0 * 512 + 256 + c) * TPB + k] = f2bf(0.5f * (X.y - Xm.y));
        OC[((size_t)1 * 512 + c) * TPB + k] = f2bf(0.5f * (X.y + Xm.y)); OC[((size_t)1 * 512 + 256 + c) * TPB + k] = f2bf(-0.5f * (X.x - Xm.x)); }
    __syncthreads();
}
__device__ __forceinline__ void hyena_ctx_unit(const Params& p, int l, int c, char* lds) {
    float* zs = (float*)lds;
    float* hfs = zs + 512; float* hbs = hfs + 256; float* w3s = hbs + 256; float* red = w3s + 128;
    const int tid = tidx(), b = tid >> 8, t = tid & 255;
    const bf16_t* HT = WSP(const bf16_t, OFF_HYFN); const float* sw = p.in[I_HYSW] + (size_t)l * 3 * 768;
    const float* H2 = WSP(const float, OFF_H2C) + (size_t)l * 256 * 64; const float* w3 = p.in[I_HYW3] + (size_t)l * 64 * 1024;
    const float d0 = -3.0701134573253945f, d1 = -15.350567286626973f;
    const float adelta = fabsf(d0 + (float)c * ((d1 - d0) / 255.f));
    auto sc = [&](int ch) { const bf16_t* r = HT + ((size_t)b * 1024 + ch) * TPB + SEQ;
        const float um = t > 0 ? bf2f(r[t - 1]) : 0.f, u0 = bf2f(r[t]), up = t < 255 ? bf2f(r[t + 1]) : 0.f; return sw[ch] * um + sw[768 + ch] * u0 + sw[1536 + ch] * up; };
    __syncthreads();
    float z = sc(c);
    zs[b * 256 + t] = z;
    for (int order = 0; order < 2; ++order) {
        __syncthreads();
        if (tid < 128) w3s[tid] = w3[(size_t)(tid & 63) * 1024 + (tid >> 6) * 512 + order * 256 + c];
        __syncthreads();
        float ss = 0.f;
        if (tid < 256) { const float* hr = H2 + (size_t)tid * 64; float sf = 0.f, sb = 0.f;
#pragma unroll 16
            for (int j = 0; j < 64; ++j) { sf += hr[j] * w3s[j]; sb += hr[j] * w3s[64 + j]; }
            const float win = __expf(-((float)tid * (1.f / 255.f)) * adelta); const float hf = sf * win, hb = sb * win;
            hfs[tid] = hf; hbs[tid] = hb; ss = hf * hf + (tid ? hb * hb : 0.f); }
        const float tot = block_sum(ss, red);
        const float scale = rsqrtf(tot + 1e-6f);
        __syncthreads();
        float y = 0.f;
        for (int s = 0; s <= t; ++s) y += hfs[t - s] * zs[b * 256 + s];
        for (int s = t + 1; s < 256; ++s) y += hbs[s - t] * zs[b * 256 + s];
        const float bias = p.in[I_HYBIAS][(size_t)l * 512 + order * 256 + c];
        const float g = sc((order + 1) * 256 + c);
        z = g * (y * scale + bias * z);
        __syncthreads();
        zs[b * 256 + t] = z;
    }
    WSP(bf16_t, OFF_OBT)[((size_t)b * 256 + c) * TPB + SEQ + t] = f2bf(z);
    __syncthreads();
}
__device__ __forceinline__ void fnet_ctx_unit(const Params& p, int c, char* lds) {
    float* us = (float*)lds; float* cs = us + 512;
    const int tid = tidx(), b = tid >> 8, k = tid & 255;
    const bf16_t* HT = WSP(const bf16_t, OFF_HYFN);
    __syncthreads();
    us[tid] = bf2f(HT[((size_t)b * 1024 + 768 + c) * TPB + SEQ + k]);
    if (tid < 256) { float s, cc; sincospif(2.f * (float)tid / 256.f, &s, &cc); cs[tid] = cc; cs[256 + tid] = s; }
    __syncthreads();
    float ur = 0.f, ui = 0.f;
    for (int n = 0; n < 256; ++n) { const int m = (k * n) & 255; const float u = us[b * 256 + n]; ur += u * cs[m]; ui -= u * cs[256 + m]; }
    bf16_t* OC = WSP(bf16_t, OFF_OCT);
    OC[((size_t)b * 512 + c) * TPB + SEQ + k] = f2bf(8.f * ur); OC[((size_t)b * 512 + 256 + c) * TPB + SEQ + k] = f2bf(8.f * ui);
    __syncthreads();
}
__device__ __forceinline__ void na_unit(const Params& p, int l, int u, char* lds) {
    const int b = u >> 8, h = (u >> 6) & 3, rb = u & 63, r0 = rb * 4;
    float* biasL = (float*)(lds + ATT_LDS);
    __syncthreads();
    for (int i = tidx(); i < 465; i += 512) biasL[i] = p.in[I_RPB][((size_t)l * 4 + h) * 465 + i] * 8.f;
    const bf16_t* P = WSP(const bf16_t, OFF_P);
    int lo = r0 - 4; lo = lo < 0 ? 0 : (lo > 248 ? 248 : lo);
    int hr = r0 + 3 - 4; hr = hr < 0 ? 0 : (hr > 248 ? 248 : hr); hr += 7;
    const int nloc = hr - lo + 1;
    const size_t tb = (size_t)b * TPB;
    attn_unit<64, 1>(P + (tb + r0 * 64) * PLD + h * 64, PLD, P + tb * PLD + 256 + h * 64, PLD, P + tb * PLD + 512 + h * 64, PLD,
                     WSP(bf16_t, OFF_OAD) + (tb + r0 * 64) * 512 + 256 + h * 64, 512, 4 + nloc, 4, SEQ, lo * 64, lds, biasL, r0, lo);
}
__device__ __forceinline__ void na_ctx_unit(const Params& p, int u, char* lds) {
    const int b = u >> 2, h = u & 3; const bf16_t* P = WSP(const bf16_t, OFF_P); const size_t tb = (size_t)b * TPB;
    attn_unit<64, 0>(P + (tb + SEQ) * PLD + h * 64, PLD, P + tb * PLD + 256 + h * 64, PLD, P + tb * PLD + 512 + h * 64, PLD,
                     WSP(bf16_t, OFF_OAD) + (tb + SEQ) * 512 + 256 + h * 64, 512, 4, 4, SEQ, 0, lds, nullptr, 0, 0);
}
PHASE_FN void ph_mixers(const Params& p, int l, char* lds_unused) {
    char* lds = lds_dyn; (void)lds_unused;
    const int bid = bidx(), G = gdim(); const bool upd_ctx = (l != NLAYER - 1);
    fft_tables(lds);
    { FFrag FF; mfft_frags(FF, (const float2*)(lds + FFT_LDS_TAB));
      for (int rep = 0; rep < (REP_PHASE == 31 ? 2 : 1); ++rep) for (int c = bid; c < 256; c += G) hyena_unit(p, l, c, lds, FF);
      for (int rep = 0; rep < (REP_PHASE == 32 ? 2 : 1); ++rep) for (int c = bid; c < 256; c += G) fnet_unit(p, c, lds, FF); }
    __syncthreads();
    if (upd_ctx) { for (int c = bid; c < 256; c += G) hyena_ctx_unit(p, l, c, lds);
                   for (int c = bid; c < 256; c += G) fnet_ctx_unit(p, c, lds); }
    for (int rep = 0; rep < (REP_PHASE == 33 ? 2 : 1); ++rep) for (int t = bid; t < NTILE * 7; t += G) upproj_tile(p, l, t / 7, t % 7, lds);
    __syncthreads();
    for (int rep = 0; rep < (REP_PHASE == 34 ? 2 : 1); ++rep) for (int u = bid; u < 512; u += G) na_unit(p, l, u, lds);
    if (upd_ctx) for (int u = bid; u < 8; u += G) na_ctx_unit(p, u, lds);
}

__device__ __forceinline__ void transp_unit(const Params& p, int u, char* lds) {
    const int tid = tidx(), rt = u / 12, cg = u % 12, r0 = rt * 128, b = r0 >= TPB ? 1 : 0, t0 = r0 - b * TPB;
    const bf16_t* src = cg < 4 ? WSP(const bf16_t, OFF_OBT) + ((size_t)b * 256 + cg * 64) * TPB + t0 : WSP(const bf16_t, OFF_OCT) + ((size_t)b * 512 + (cg - 4) * 64) * TPB + t0;
    bf16_t* dst = WSP(bf16_t, OFF_P) + (size_t)r0 * 768 + cg * 64;
    char* tl = lds;
    __syncthreads();
    { const int c = tid >> 3, sg = tid & 7; const u32x4 x0 = *(const u32x4*)(src + (size_t)c * TPB + sg * 16), x1 = *(const u32x4*)(src + (size_t)c * TPB + sg * 16 + 8);
      *(u32x4*)(tl + c * 272 + sg * 32) = x0; *(u32x4*)(tl + c * 272 + sg * 32 + 16) = x1; }
    __syncthreads();
    { const int t = tid >> 2, q = tid & 3; unsigned w[8];
#pragma unroll
      for (int i = 0; i < 8; ++i) { const unsigned lo = *(const bf16_t*)(tl + (q * 16 + 2 * i) * 272 + t * 2), hi = *(const bf16_t*)(tl + (q * 16 + 2 * i + 1) * 272 + t * 2); w[i] = lo | (hi << 16); }
      u32x4 y0 = {w[0], w[1], w[2], w[3]}, y1 = {w[4], w[5], w[6], w[7]};
      *(u32x4*)(dst + (size_t)t * 768 + q * 16) = y0; *(u32x4*)(dst + (size_t)t * 768 + q * 16 + 8) = y1; }
}
PHASE_FN void ph_mla(const Params& p, int l, char* lds_unused) {
    char* lds = lds_dyn; (void)lds_unused;
    const bool upd_ctx = (l != NLAYER - 1);
    const bf16_t* Q = WSP(const bf16_t, OFF_Q); const bf16_t* K = WSP(const bf16_t, OFF_K); const bf16_t* V = WSP(const bf16_t, OFF_V); bf16_t* O = WSP(bf16_t, OFF_OAD);
    if (upd_ctx) for (int u = bidx(); u < 8; u += gdim()) { const int b = u >> 2, h = u & 3; const size_t tb = (size_t)b * TPB;
        mla_unit(Q + (tb + SEQ) * 384 + h * 96, K + tb * 384 + h * 96, V + tb * 256 + h * 64, O + (tb + SEQ) * 512 + h * 64, 4, 4, SEQ, 0, lds); }
    for (int v = bidx() >> 3; v < 64; v += (gdim() >> 3)) { const int bh = bidx() & 7, b = bh >> 2, h = bh & 3, qb = v; const size_t tb = (size_t)b * TPB;
        mla_unit(Q + (tb + qb * 256) * 384 + h * 96, K + tb * 384 + h * 96, V + tb * 256 + h * 64, O + (tb + qb * 256) * 512 + h * 64, 260, 260, 0, 0, lds); }
    __syncthreads();
    for (int u = bidx(); u < NTILE * 12; u += gdim()) { if (skip_tile(l, u / 12)) continue; transp_unit(p, u, lds); }
    { const u32x4* Hs = WSP(const u32x4, OFF_H); u32x2* H8 = WSP(u32x2, OFF_HYS);
      for (int i = bidx() * 512 + tidx(); i < T * 128; i += gdim() * 512) { const u32x4 h = Hs[i]; u32x2 w; int t0 = 0, t1 = 0;
          t0 = __builtin_amdgcn_cvt_pk_fp8_f32(__uint_as_float(h.x << 16), __uint_as_float(h.x & 0xffff0000u), t0, false); t0 = __builtin_amdgcn_cvt_pk_fp8_f32(__uint_as_float(h.y << 16), __uint_as_float(h.y & 0xffff0000u), t0, true);
          t1 = __builtin_amdgcn_cvt_pk_fp8_f32(__uint_as_float(h.z << 16), __uint_as_float(h.z & 0xffff0000u), t1, false); t1 = __builtin_amdgcn_cvt_pk_fp8_f32(__uint_as_float(h.w << 16), __uint_as_float(h.w & 0xffff0000u), t1, true);
          w.x = (unsigned)t0; w.y = (unsigned)t1; H8[i] = w; } }
}

template <int FP8, int NKT, int SWAP = 1>
__device__ __forceinline__ void gate4_stream(f32x4 (&ag)[4][4][2], const char* a0, const char* a1, const char* Wb, size_t nstride, int rowstride, int a_rd, int b_rd, char* lds) {
    const int wid = __builtin_amdgcn_readfirstlane(tidx() >> 6);
    LAS char* L = (LAS char*)lds_dyn + ((wid >> 1) * 2 + (wid & 1)) * 1024;
    const int srow = g_srow(), skc = g_skc();
    i32x8 A8[4], B8[2][2];
#pragma unroll
    for (int mt = 0; mt < 4; ++mt) A8[mt] = (i32x8)(0);
    B8[1][0] = (i32x8)(0); B8[1][1] = (i32x8)(0);
    auto issue_h = [&](int s, int h) { const int kt = s >> 2, n = s & 3; LAS char* Bb = L + 32768 + n * 16384 + h * 8192;
        int eo = srow * rowstride + skc * 16; asm volatile("" : "+v"(eo));
        eo += (kt << 7) + h * 64 * rowstride;
        const char* w = Wb + (size_t)n * nstride + (unsigned)eo;
        __builtin_amdgcn_global_load_lds((const unsigned*)(w), (LAS unsigned*)(Bb), 16, 0, 0);
        if (n == 0) { LAS char* Ab = L + (kt & 1) * 16384 + h * 8192; const char* hp = (h ? a1 : a0) + (kt << 7);
            __builtin_amdgcn_global_load_lds((const unsigned*)(hp), (LAS unsigned*)(Ab), 16, 0, 0); } };
    auto issue = [&](int s) { issue_h(s, 0); issue_h(s, 1); };
    auto ld8 = [&](const char* base) { const u32x4 lo = *(const u32x4*)(base), hi = *(const u32x4*)(base + 1024);
        return (i32x8){(int)lo.x, (int)lo.y, (int)lo.z, (int)lo.w, (int)hi.x, (int)hi.y, (int)hi.z, (int)hi.w}; };
    constexpr int SC1 = 0x7f7f7f7f, SCW = 0x79797979;
    auto mm = [&](f32x4 c, const i32x8& b, const i32x8& a) {
        if (FP8) return __builtin_amdgcn_mfma_scale_f32_16x16x128_f8f6f4(b, a, c, 0, 0, 0, SCW, 0, SC1);
        typedef int i32x4_ __attribute__((ext_vector_type(4)));
        const i32x4_ bl = __builtin_shufflevector(b, b, 0, 1, 2, 3), bh = __builtin_shufflevector(b, b, 4, 5, 6, 7), al = __builtin_shufflevector(a, a, 0, 1, 2, 3), ah = __builtin_shufflevector(a, a, 4, 5, 6, 7);
        if (!SWAP) { c = __builtin_amdgcn_mfma_f32_16x16x32_bf16(__builtin_bit_cast(bf16x8, al), __builtin_bit_cast(bf16x8, bl), c, 0, 0, 0);
            return __builtin_amdgcn_mfma_f32_16x16x32_bf16(__builtin_bit_cast(bf16x8, ah), __builtin_bit_cast(bf16x8, bh), c, 0, 0, 0); }
        c = __builtin_amdgcn_mfma_f32_16x16x32_bf16(__builtin_bit_cast(bf16x8, bl), __builtin_bit_cast(bf16x8, al), c, 0, 0, 0);
        return __builtin_amdgcn_mfma_f32_16x16x32_bf16(__builtin_bit_cast(bf16x8, bh), __builtin_bit_cast(bf16x8, ah), c, 0, 0, 0); };
    issue(0); issue(1); issue(2);
#define MG8_SUB(N, PV, COND, SN) do { const char* Bs_ = lds + 32768 + (N) * 16384 + b_rd;                                       \
        B8[(N) & 1][0] = ld8(Bs_); B8[(N) & 1][1] = ld8(Bs_ + 2048); if (COND) issue_h((SN), 0); SB();                          \
        _Pragma("unroll") for (int mt = 0; mt < 4; ++mt) {                                                                     \
            _Pragma("unroll") for (int nt = 0; nt < 2; ++nt) ag[PV][mt][nt] = mm(ag[PV][mt][nt], B8[((N) & 1) ^ 1][nt], A8[mt]);  \
            if ((N) == 0) A8[mt] = ld8(As + a_rd + mt * 2048); }                                                               \
        if (COND) issue_h((SN), 1); SB(); } while (0)
#define MG8_KT(LASTK) do { const char* As = lds + (kt & 1) * 16384;                                                            \
        G_WAITV(4); __builtin_amdgcn_s_barrier(); asm volatile("" ::: "memory");                                               \
        MG8_SUB(0, 3, true, 4 * kt + 3);                                                                                       \
        G_WAITV(4); __builtin_amdgcn_s_barrier(); asm volatile("" ::: "memory");                                               \
        MG8_SUB(1, 0, !(LASTK), 4 * kt + 4);                                                                                   \
        if (!(LASTK)) G_WAITV(6); else G_WAITV(2);                                                                             \
        __builtin_amdgcn_s_barrier(); asm volatile("" ::: "memory");                                                           \
        MG8_SUB(2, 1, !(LASTK), 4 * kt + 5);                                                                                   \
        if (!(LASTK)) G_WAITV(6); else G_WAITV(0);                                                                             \
        __builtin_amdgcn_s_barrier(); asm volatile("" ::: "memory");                                                           \
        MG8_SUB(3, 2, !(LASTK), 4 * kt + 6); } while (0)
    int kt = 0;
#pragma unroll 1
    for (; kt < NKT - 1; ++kt) MG8_KT(false);
    MG8_KT(true);
#undef MG8_KT
#undef MG8_SUB
#pragma unroll
    for (int mt = 0; mt < 4; ++mt)
#pragma unroll
        for (int nt = 0; nt < 2; ++nt) ag[3][mt][nt] = mm(ag[3][mt][nt], B8[1][nt], A8[mt]);
    __syncthreads();
}

__device__ __forceinline__ void gate2_stream(f32x4 (&ag)[2][4][2], const char* a0, const char* a1, const char* Wb, size_t nstride, int rowstride, int a_rd, int b_rd, char* lds) {
    const int wid = __builtin_amdgcn_readfirstlane(tidx() >> 6);
    LAS char* L = (LAS char*)lds_dyn + ((wid >> 1) * 2 + (wid & 1)) * 1024;
    const int srow = g_srow(), skc = g_skc();
    constexpr int NKT = 16;
    i32x8 A8[4], B8[2][2];
#pragma unroll
    for (int mt = 0; mt < 4; ++mt) A8[mt] = (i32x8)(0);
    B8[1][0] = (i32x8)(0); B8[1][1] = (i32x8)(0);
    auto issue_h = [&](int s, int h) { const int kt = s >> 1, n = s & 1; LAS char* Bb = L + 32768 + (s & 3) * 16384 + h * 8192;
        int eo = srow * rowstride + skc * 16; asm volatile("" : "+v"(eo));
        eo += (kt << 7) + h * 64 * rowstride;
        const char* w = Wb + (size_t)n * nstride + (unsigned)eo;
        __builtin_amdgcn_global_load_lds((const unsigned*)(w), (LAS unsigned*)(Bb), 16, 0, 0);
        if (n == 0) { LAS char* Ab = L + (kt & 1) * 16384 + h * 8192; const char* hp = (h ? a1 : a0) + (kt << 7);
            __builtin_amdgcn_global_load_lds((const unsigned*)(hp), (LAS unsigned*)(Ab), 16, 0, 0); } };
    auto issue = [&](int s) { issue_h(s, 0); issue_h(s, 1); };
    auto ld8 = [&](const char* base) { const u32x4 lo = *(const u32x4*)(base), hi = *(const u32x4*)(base + 1024);
        return (i32x8){(int)lo.x, (int)lo.y, (int)lo.z, (int)lo.w, (int)hi.x, (int)hi.y, (int)hi.z, (int)hi.w}; };
    auto mm = [&](f32x4 c, const i32x8& b, const i32x8& a) {
        typedef int i32x4_ __attribute__((ext_vector_type(4)));
        const i32x4_ bl = __builtin_shufflevector(b, b, 0, 1, 2, 3), bh = __builtin_shufflevector(b, b, 4, 5, 6, 7), al = __builtin_shufflevector(a, a, 0, 1, 2, 3), ah = __builtin_shufflevector(a, a, 4, 5, 6, 7);
        c = __builtin_amdgcn_mfma_f32_16x16x32_bf16(__builtin_bit_cast(bf16x8, bl), __builtin_bit_cast(bf16x8, al), c, 0, 0, 0);
        return __builtin_amdgcn_mfma_f32_16x16x32_bf16(__builtin_bit_cast(bf16x8, bh), __builtin_bit_cast(bf16x8, ah), c, 0, 0, 0); };
    issue(0); issue(1); issue(2);
#define MG2_SUB(N, COND, SN) do { const char* Bs_ = lds + 32768 + sb + (N) * 16384 + b_rd;                                      \
        B8[N][0] = ld8(Bs_); B8[N][1] = ld8(Bs_ + 2048); if (COND) issue_h((SN), 0); SB();                                      \
        _Pragma("unroll") for (int mt = 0; mt < 4; ++mt) {                                                                     \
            _Pragma("unroll") for (int nt = 0; nt < 2; ++nt) ag[(N) ^ 1][mt][nt] = mm(ag[(N) ^ 1][mt][nt], B8[(N) ^ 1][nt], A8[mt]);  \
            if ((N) == 0) A8[mt] = ld8(As + a_rd + mt * 2048); }                                                               \
        if (COND) issue_h((SN), 1); SB(); } while (0)
#define MG2_KT(L1, L2) do { const char* As = lds + (kt & 1) * 16384; const int sb = (kt & 1) * 32768;                           \
        if (!(L1)) G_WAITV(6); else G_WAITV(2);                                                                                \
        __builtin_amdgcn_s_barrier(); asm volatile("" ::: "memory");                                                           \
        MG2_SUB(0, !(L1), 2 * kt + 3);                                                                                         \
        if (!(L1)) G_WAITV(6); else G_WAITV(0);                                                                                \
        __builtin_amdgcn_s_barrier(); asm volatile("" ::: "memory");                                                           \
        MG2_SUB(1, !(L2), 2 * kt + 4); } while (0)
    int kt = 0;
#pragma unroll 1
    for (; kt < NKT - 2; ++kt) MG2_KT(false, false);
    MG2_KT(false, true); ++kt;
    MG2_KT(true, true);
#undef MG2_KT
#undef MG2_SUB
#pragma unroll
    for (int mt = 0; mt < 4; ++mt)
#pragma unroll
        for (int nt = 0; nt < 2; ++nt) ag[1][mt][nt] = mm(ag[1][mt][nt], B8[1][nt], A8[mt]);
    __syncthreads();
}

PHASE_FN void ph_gemm1(const Params& p, int l, char* lds_unused) {
    char* lds = lds_dyn; (void)lds_unused;
    const bf16_t* H = WSP(bf16_t, OFF_H); const bf16_t* W = wts(p, l, WE_W1T);
#define G1_IDS const int tid = tidx(), lane = tid & 63, wid = tid >> 6, wm = wid >> 2, wn = wid & 3, fr = lane & 15, fq = lane >> 4
    auto epiP = [&](const f32x4 (&acc)[4][2], int r0, int n0) { G1_IDS; bf16_t* P = WSP(bf16_t, OFF_P);
#pragma unroll
        for (int mt = 0; mt < 4; ++mt)
#pragma unroll
            for (int nt = 0; nt < 2; ++nt) { const int row = r0 + wm * 64 + mt * 16 + fr, col = n0 + wn * 32 + nt * 16 + fq * 4;
                u32x2 w; w.x = cvt_pk_bf16(acc[mt][nt][0], acc[mt][nt][1]); w.y = cvt_pk_bf16(acc[mt][nt][2], acc[mt][nt][3]);
                *(u32x2*)(P + (size_t)row * PLD + col) = w; } };
    auto epiHT = [&](const f32x4 (&acc)[4][2], int r0, int ch0) { G1_IDS; const int b = r0 >= TPB ? 1 : 0, t0 = r0 - b * TPB; bf16_t* HT = WSP(bf16_t, OFF_HYFN) + (size_t)b * 1024 * TPB;
#pragma unroll
        for (int mt = 0; mt < 4; ++mt)
#pragma unroll
            for (int nt = 0; nt < 2; ++nt) { const int t = t0 + wm * 64 + mt * 16 + fq * 4, ch = ch0 + wn * 32 + nt * 16 + fr;
                u32x2 w; w.x = cvt_pk_bf16(acc[mt][nt][0], acc[mt][nt][1]); w.y = cvt_pk_bf16(acc[mt][nt][2], acc[mt][nt][3]);
                *(u32x2*)(HT + (size_t)ch * TPB + t) = w; } };
    for (int v = bidx() >> 3; v < 128; v += (gdim() >> 3)) {
        G1_IDS; const int a_rd = g_lds_byte(wm * 64 + fr, fq * 8), b_rd = g_lds_byte(wn * 32 + fr, fq * 8);
        const int lt = (v >> 2) * 8 + (bidx() & 7), g4 = v & 3, rt = lt + (lt >> 7) * 2, r0 = rt * 128, ct0 = g4 < 2 ? g4 * 4 : 10 + (g4 - 2) * 4;
        const char* a0 = (const char*)(H + (size_t)(r0 + g_srow()) * 1024 + g_skc() * 8);
        const char* Wb = (const char*)(W + (size_t)ct0 * 128 * 1024);
        f32x4 ag[4][4][2];
#pragma unroll
        for (int n = 0; n < 4; ++n) acc_zero(ag[n]);
        if (g4 < 2) { gate4_stream<0, 16, 1>(ag, a0, a0 + (size_t)64 * 2048, Wb, (size_t)128 * 2048, 2048, a_rd, b_rd, lds);
#pragma unroll
            for (int n = 0; n < 4; ++n) epiP(ag[n], r0, (ct0 + n) * 128); }
        else { gate4_stream<0, 16, 0>(ag, a0, a0 + (size_t)64 * 2048, Wb, (size_t)128 * 2048, 2048, a_rd, b_rd, lds);
#pragma unroll
            for (int n = 0; n < 4; ++n) epiHT(ag[n], r0, (ct0 + n - 10) * 128); }
    }
    for (int lt = bidx(); lt < 256; lt += gdim()) {
        G1_IDS; const int a_rd = g_lds_byte(wm * 64 + fr, fq * 8), b_rd = g_lds_byte(wn * 32 + fr, fq * 8);
        const int rt = lt + (lt >> 7) * 2, r0 = rt * 128;
        const char* a0 = (const char*)(H + (size_t)(r0 + g_srow()) * 1024 + g_skc() * 8);
        const char* Wb = (const char*)(W + (size_t)8 * 128 * 1024);
        f32x4 ag[2][4][2]; acc_zero(ag[0]); acc_zero(ag[1]);
        gate2_stream(ag, a0, a0 + (size_t)64 * 2048, Wb, (size_t)128 * 2048, 2048, a_rd, b_rd, lds);
        epiP(ag[0], r0, 8 * 128); epiP(ag[1], r0, 9 * 128);
    }
    for (int u = bidx(); u < 72; u += gdim()) {
        const int ci = u / 18, ct = u % 18, rt = 128 + (ci >> 1) * 130 + (ci & 1), r0 = rt * 128, n0 = ct * 128;
        const bf16_t* a0 = H + (size_t)(r0 + g_srow()) * 1024 + g_skc() * 8; const bf16_t* b0 = W + (size_t)(n0 + g_srow()) * 1024 + g_skc() * 8;
        f32x4 acc[4][2]; acc_zero(acc);
        if (ct < 10) { mma_seg<1, 0>(acc, a0, a0 + (size_t)64 * 1024, 0, b0, b0 + (size_t)64 * 1024, 1024, lds); epiP(acc, r0, n0); }
        else { mma_seg<0, 0>(acc, a0, a0 + (size_t)64 * 1024, 0, b0, b0 + (size_t)64 * 1024, 1024, lds); epiHT(acc, r0, n0 - 1280); }
    }
#undef G1_IDS
}

__device__ __forceinline__ void merge_unit(const Params& p, int l, int rt, int ct, char* lds) {
    const int tid = tidx(), lane = tid & 63, wid = __builtin_amdgcn_readfirstlane(tid >> 6), wm = wid >> 2, wn = wid & 3, fr = lane & 15, fq = lane >> 4;
    const int a_rd = g_lds_byte(wm * 64 + fr, fq * 8), b_rd = g_lds_byte(wn * 32 + fr, fq * 8);
    const int r0 = rt * 128, n0 = ct * 128;
    LAS char* L = (LAS char*)lds_dyn + ((wid >> 1) * 2 + (wid & 1)) * 1024;
    const int srow = g_srow(), skc = g_skc();
    GFrag f0, f1;
    unsigned gp[4][4][2][2];
    {
        const char* Hb = WSP(const char, OFF_HYS) + (size_t)(r0 + srow) * 1024 + skc * 16;
        const char* Wb = (const char*)wts(p, l, WE_WGT) + (size_t)n0 * 1024;
        f32x4 ag[4][4][2];
#pragma unroll
        for (int n = 0; n < 4; ++n) acc_zero(ag[n]);
        gate4_stream<1, 8>(ag, Hb, Hb + (size_t)64 * 1024, Wb, (size_t)1024 * 1024, 1024, a_rd, b_rd, lds);
#pragma unroll
        for (int n = 0; n < 4; ++n) {
#pragma unroll
            for (int mt = 0; mt < 4; ++mt) {
#pragma unroll
                for (int nt = 0; nt < 2; ++nt) { gp[n][mt][nt][0] = cvt_pk_bf16(sigmoid_f(ag[n][mt][nt][0]), sigmoid_f(ag[n][mt][nt][1])); gp[n][mt][nt][1] = cvt_pk_bf16(sigmoid_f(ag[n][mt][nt][2]), sigmoid_f(ag[n][mt][nt][3]));
                    asm volatile("" : "+v"(gp[n][mt][nt][0]), "+v"(gp[n][mt][nt][1])); }
            }
        }
    }
    SB();
    f32x4 am[4][2], ap[4][2]; acc_zero(am); acc_zero(ap);
    {
        const bf16_t* OAD = WSP(const bf16_t, OFF_OAD); const bf16_t* OBC = WSP(const bf16_t, OFF_P);
        auto issue = [&](int s) { const bf16_t* a; const bf16_t* b; unsigned as, bs; int k0;
            int so = srow, sk = skc * 8; asm volatile("" : "+v"(so), "+v"(sk));
            if (s < 4)       { k0 = (s << 6) + sk;        a = OAD + (unsigned)((r0 + so) * 512 + k0);       as = 64 * 512; b = wts(p, l, WE_WBA) + (unsigned)((n0 + so) * 256 + k0); bs = 64 * 256; }
            else if (s < 8)  { k0 = ((s - 4) << 6) + sk;  a = OBC + (unsigned)((r0 + so) * 768 + k0);       as = 64 * 768; b = wts(p, l, WE_WBB) + (unsigned)((n0 + so) * 256 + k0); bs = 64 * 256; }
            else if (s < 16) { k0 = ((s - 8) << 6) + sk;  a = OBC + (unsigned)((r0 + so) * 768 + 256 + k0); as = 64 * 768; b = wts(p, l, WE_WBC) + (unsigned)((n0 + so) * 512 + k0); bs = 64 * 512; }
            else             { k0 = ((s - 16) << 6) + sk; a = OAD + (unsigned)((r0 + so) * 512 + 256 + k0); as = 64 * 512; b = wts(p, l, WE_WBD) + (unsigned)((n0 + so) * 256 + k0); bs = 64 * 256; }
            LAS char* Lb = L + (s & 3) * G_STAGE;
            __builtin_amdgcn_global_load_lds((const unsigned*)(a), (LAS unsigned*)(Lb), 16, 0, 0);
            __builtin_amdgcn_global_load_lds((const unsigned*)(a + as), (LAS unsigned*)(Lb + 8192), 16, 0, 0);
            __builtin_amdgcn_global_load_lds((const unsigned*)(b), (LAS unsigned*)(Lb + G_TILE), 16, 0, 0);
            __builtin_amdgcn_global_load_lds((const unsigned*)(b + bs), (LAS unsigned*)(Lb + G_TILE + 8192), 16, 0, 0); };
        auto combine = [&](const unsigned (&g)[4][2][2]) {
#pragma unroll
            for (int mt = 0; mt < 4; ++mt)
#pragma unroll
                for (int nt = 0; nt < 2; ++nt) {
                    const unsigned g0 = g[mt][nt][0], g1 = g[mt][nt][1];
                    am[mt][nt][0] += __uint_as_float(g0 << 16) * ap[mt][nt][0]; am[mt][nt][1] += __uint_as_float(g0 & 0xffff0000u) * ap[mt][nt][1];
                    am[mt][nt][2] += __uint_as_float(g1 << 16) * ap[mt][nt][2]; am[mt][nt][3] += __uint_as_float(g1 & 0xffff0000u) * ap[mt][nt][3];
                    ap[mt][nt] = (f32x4){0.f, 0.f, 0.f, 0.f};
                    asm volatile("" : "+v"(am[mt][nt])); } };
        gf_zero(f1);
        issue(0); issue(1); issue(2);
        int s = 0;
#pragma unroll
        for (int n = 0; n < 4; ++n) {
            const int send = n == 0 ? 4 : n == 1 ? 8 : n == 2 ? 16 : 20;
#pragma unroll 1
            for (; s < send; ++s) {
                if (s + 2 < 20) G_WAITV(8); else if (s + 1 < 20) G_WAITV(4); else G_WAITV(0);
                __builtin_amdgcn_s_barrier(); asm volatile("" ::: "memory");
                if (s + 3 < 20) issue(s + 3);
                const char* As = lds + (s & 3) * G_STAGE;
                GF_STAGE(ap, ap, As, As + G_TILE);
            }
            gf_mma(ap, f1); SB();
            combine(gp[n]); gf_zero(f1); SB();
        }
        __syncthreads();
    }
    bf16_t* M = WSP(bf16_t, OFF_HYFN);
    const int t2 = tidx(), w2 = t2 >> 6, l2 = t2 & 63;
    int so = (r0 + (w2 >> 2) * 64 + (l2 & 15)) * 1024 + n0 + (w2 & 3) * 32 + (l2 >> 4) * 4;
#pragma unroll
    for (int mt = 0; mt < 4; ++mt)
#pragma unroll
        for (int nt = 0; nt < 2; ++nt) {
            u32x2 w; w.x = cvt_pk_bf16(am[mt][nt][0], am[mt][nt][1]); w.y = cvt_pk_bf16(am[mt][nt][2], am[mt][nt][3]);
            *(u32x2*)(M + (unsigned)(so + mt * 16 * 1024 + nt * 16)) = w; }
    SB();
}
PHASE_FN void ph_merge(const Params& p, int l, char* lds_unused) {
    char* lds = lds_dyn; (void)lds_unused;
    { const int xcd = bidx() & 7, ctp = xcd & 3, par = xcd >> 2;
      for (int v = bidx() >> 3; v < NTILE; v += (gdim() >> 3)) {
          const int rt = (v >> 1) * 2 + par, ct = ctp * 2 + (v & 1); if (skip_tile(l, rt)) continue;
          merge_unit(p, l, rt, ct, lds);
      } }
}

PHASE_FN void ph_wout(const Params& p, int l, char* lds_unused) {
    char* lds = lds_dyn; (void)lds_unused;
    const int tid = tidx(), lane = tid & 63, wid = tid >> 6, wm = wid >> 2, wn = wid & 3, fr = lane & 15, fq = lane >> 4;
    const int a_rd = g_lds_byte(wm * 64 + fr, fq * 8), b_rd = g_lds_byte(wn * 32 + fr, fq * 8);
    const bf16_t* M = WSP(const bf16_t, OFF_HYFN);
    auto epi = [&](const f32x4 (&acc)[4][2], int r0, int n0) {
        const float* gt = modvec(p, l, r0) + 2048;
#pragma unroll
        for (int mt = 0; mt < 4; ++mt) { const int row = r0 + wm * 64 + mt * 16 + fr; const float* xs = (l == 0) ? xrow_in(p, row) : xrow_st(p, row); float* xd = xrow_st(p, row);
#pragma unroll
            for (int nt = 0; nt < 2; ++nt) { const int col = n0 + wn * 32 + nt * 16 + fq * 4; const f32x4 x = *(const f32x4*)(xs + col), g = *(const f32x4*)(gt + col);
                f32x4 o; o[0] = x[0] + g[0] * acc[mt][nt][0]; o[1] = x[1] + g[1] * acc[mt][nt][1]; o[2] = x[2] + g[2] * acc[mt][nt][2]; o[3] = x[3] + g[3] * acc[mt][nt][3];
                if (DBG_NO_MIX) o = x;
                *(f32x4*)(xd + col) = o; } } };
    for (int u = bidx(); u < 512; u += gdim()) {
        const int lt = u >> 1, half = u & 1, rt = lt + (lt >> 7) * 2, r0 = rt * 128;
        const char* a0 = (const char*)(M + (size_t)(r0 + g_srow()) * 1024 + g_skc() * 8);
        const char* Wb = (const char*)(wts(p, l, WE_WOUT) + (size_t)half * 512 * 1024);
        f32x4 ag[4][4][2];
#pragma unroll
        for (int n = 0; n < 4; ++n) acc_zero(ag[n]);
        gate4_stream<0, 16>(ag, a0, a0 + (size_t)64 * 2048, Wb, (size_t)128 * 2048, 2048, a_rd, b_rd, lds);
#pragma unroll
        for (int n = 0; n < 4; ++n) epi(ag[n], r0, half * 512 + n * 128);
    }
    if (l != NLAYER - 1) for (int u = bidx(); u < 32; u += gdim()) {
        const int rt = 128 + (u >> 4) * 130 + ((u >> 3) & 1), ct = u & 7, r0 = rt * 128, n0 = ct * 128;
        const bf16_t* a0 = M + (size_t)(r0 + g_srow()) * 1024 + g_skc() * 8; const bf16_t* b0 = wts(p, l, WE_WOUT) + (size_t)(n0 + g_srow()) * 1024 + g_skc() * 8;
        f32x4 acc[4][2]; acc_zero(acc);
        mma_seg<1, 0>(acc, a0, a0 + (size_t)64 * 1024, 0, b0, b0 + (size_t)64 * 1024, 1024, lds);
        epi(acc, r0, n0);
    }
}

__device__ __forceinline__ int* moe_sched(const Params& p, int l, char* lds) {
    int* s = (int*)(lds + G_LDS);
    __syncthreads();
    if (tidx() == 0) { int acc = 0; for (int i = 0; i < 24; ++i) { const int c = WSP(const int, OFF_CNT)[l * 32 + i]; s[32 + i] = c; s[i] = acc; acc += (c + 127) >> 7; } s[24] = acc; }
    __syncthreads();
    return s;
}
__device__ __forceinline__ void moe_decode(const int* s, int tg, int& pid, int& tl, int& cnt) {
    pid = 0;
    for (int i = 1; i < 24; ++i) if (tg >= s[i]) pid = i;
    tl = tg - s[pid]; cnt = s[32 + pid];
}
__device__ __forceinline__ void pair_experts(int pid, int& elo, int& ehi) { const int g = pid / 6, pi = pid % 6; const int lo = pi < 3 ? 0 : (pi < 5 ? 1 : 2); const int hi = pi < 3 ? pi + 1 : (pi < 5 ? pi - 1 : 3); elo = g * 4 + lo; ehi = g * 4 + hi; }
PHASE_FN void ph_moe1(const Params& p, int l, char* lds_unused) {
    char* lds = lds_dyn; (void)lds_unused;
    const int tid = tidx(), lane = tid & 63, wid = tid >> 6, wm = wid >> 2, wn = wid & 3, fr = lane & 15, fq = lane >> 4;
    const int a_rd = g_lds_byte(wm * 64 + fr, fq * 8), b_rd = g_lds_byte(wn * 32 + fr, fq * 8);
    const int* s = moe_sched(p, l, lds);
    const bf16_t* H = WSP(const bf16_t, OFF_H); bf16_t* ACT = WSP(bf16_t, OFF_P); const int* lists = WSP(const int, OFF_LISTS); const float* tokw = WSP(const float, OFF_TOKW);
    const int ntiles = s[24];
    const int U = ntiles * 2, UF = (U >> 8) << 8;
    for (int u = bidx(); u < UF; u += gdim()) {
        const int tg = u >> 1, half = u & 1; int pid, tl, cnt; moe_decode(s, tg, pid, tl, cnt); int elo, ehi; pair_experts(pid, elo, ehi);
        const int e = half ? ehi : elo;
        const int* lst = lists + (size_t)pid * T;
        auto tok = [&](int rowi) { const int sl = tl * 128 + rowi; return lst[sl < cnt ? sl : 0]; };
        const char* a0 = (const char*)(H + (size_t)tok(g_srow()) * 1024 + g_skc() * 8); const char* a1 = (const char*)(H + (size_t)tok(g_srow() + 64) * 1024 + g_skc() * 8);
        const char* Wb = (const char*)(wts(p, l, WE_WGU) + (size_t)e * 512 * 1024);
        f32x4 ag[4][4][2];
#pragma unroll
        for (int n = 0; n < 4; ++n) acc_zero(ag[n]);
        gate4_stream<0, 16>(ag, a0, a1, Wb, (size_t)128 * 1024 * 2, 2048, a_rd, b_rd, lds);
#pragma unroll
        for (int tt = 0; tt < 4; ++tt)
#pragma unroll
            for (int mt = 0; mt < 4; ++mt) { const int rowi = wm * 64 + mt * 16 + fr; const float w = tokw[(size_t)tok(rowi) * 2 + half];
                float o[4];
#pragma unroll
                for (int j = 0; j < 4; ++j) o[j] = silu_f(ag[tt][mt][0][j]) * ag[tt][mt][1][j] * w;
                u32x2 pk; pk.x = cvt_pk_bf16(o[0], o[1]); pk.y = cvt_pk_bf16(o[2], o[3]);
                *(u32x2*)(ACT + (size_t)(tg * 128 + rowi) * 512 + half * 256 + tt * 64 + wn * 16 + fq * 4) = pk; }
    }
    for (int v = bidx(); v < (U - UF) * 4; v += gdim()) {
        const int tid = tidx(), lane = tid & 63, wid = tid >> 6, wm = wid >> 2, wn = wid & 3, fr = lane & 15, fq = lane >> 4;
        const int u4 = UF + (v >> 2), tt = v & 3, tg = u4 >> 1, half = u4 & 1; int pid, tl, cnt; moe_decode(s, tg, pid, tl, cnt); int elo, ehi; pair_experts(pid, elo, ehi);
        const int e = half ? ehi : elo;
        const int* lst = lists + (size_t)pid * T;
        auto tok = [&](int rowi) { const int sl = tl * 128 + rowi; return lst[sl < cnt ? sl : 0]; };
        const bf16_t* a0 = H + (size_t)tok(g_srow()) * 1024 + g_skc() * 8; const bf16_t* a1 = H + (size_t)tok(g_srow() + 64) * 1024 + g_skc() * 8;
        const bf16_t* b0 = wts(p, l, WE_WGU) + ((size_t)e * 512 + tt * 128 + g_srow()) * 1024 + g_skc() * 8;
        f32x4 acc[4][2]; acc_zero(acc);
        mma_seg<1, 0>(acc, a0, a1, 0, b0, b0 + (size_t)64 * 1024, 1024, lds);
#pragma unroll
        for (int mt = 0; mt < 4; ++mt) { const int rowi = wm * 64 + mt * 16 + fr; const float w = tokw[(size_t)tok(rowi) * 2 + half];
            float o[4];
#pragma unroll
            for (int j = 0; j < 4; ++j) o[j] = silu_f(acc[mt][0][j]) * acc[mt][1][j] * w;
            u32x2 pk; pk.x = cvt_pk_bf16(o[0], o[1]); pk.y = cvt_pk_bf16(o[2], o[3]);
            *(u32x2*)(ACT + (size_t)(tg * 128 + rowi) * 512 + half * 256 + tt * 64 + wn * 16 + fq * 4) = pk; }
    }
}
PHASE_FN void ph_moe2(const Params& p, int l, char* lds_unused) {
    char* lds = lds_dyn; (void)lds_unused;
    const int tid = tidx(), lane = tid & 63, wid = tid >> 6, wm = wid >> 2, wn = wid & 3, fr = lane & 15, fq = lane >> 4;
    const int* s = moe_sched(p, l, lds);
    const bf16_t* ACT = WSP(const bf16_t, OFF_P); const int* lists = WSP(const int, OFF_LISTS);
    const int ntiles = s[24];
    for (int u = bidx(); u < ntiles * 8; u += gdim()) {
        const int tg = u >> 3, ct = u & 7; int pid, tl, cnt; moe_decode(s, tg, pid, tl, cnt); int elo, ehi; pair_experts(pid, elo, ehi);
        const int* lst = lists + (size_t)pid * T;
        f32x4 acc[4][2]; acc_zero(acc);
        { const bf16_t* a0 = ACT + (size_t)(tg * 128 + g_srow()) * 512 + g_skc() * 8; const bf16_t* b0 = wts(p, l, WE_WDN) + ((size_t)elo * 1024 + ct * 128 + g_srow()) * 256 + g_skc() * 8;
          mma_seg<1, 0>(acc, a0, a0 + (size_t)64 * 512, 0, b0, b0 + (size_t)64 * 256, 256, lds); }
        { const bf16_t* a0 = ACT + (size_t)(tg * 128 + g_srow()) * 512 + 256 + g_skc() * 8; const bf16_t* b0 = wts(p, l, WE_WDN) + ((size_t)ehi * 1024 + ct * 128 + g_srow()) * 256 + g_skc() * 8;
          mma_seg<1, 0>(acc, a0, a0 + (size_t)64 * 512, 0, b0, b0 + (size_t)64 * 256, 256, lds); }
#pragma unroll
        for (int mt = 0; mt < 4; ++mt) { const int sl = tl * 128 + wm * 64 + mt * 16 + fr;
            if (sl < cnt) { const int r = lst[sl]; float* xd = xrow_st(p, r); const float* gt = modvec(p, l, r) + 5120;
#pragma unroll
                for (int nt = 0; nt < 2; ++nt) { const int col = ct * 128 + wn * 32 + nt * 16 + fq * 4; const f32x4 x = *(const f32x4*)(xd + col), g = *(const f32x4*)(gt + col);
                    f32x4 o; o[0] = x[0] + g[0] * acc[mt][nt][0]; o[1] = x[1] + g[1] * acc[mt][nt][1]; o[2] = x[2] + g[2] * acc[mt][nt][2]; o[3] = x[3] + g[3] * acc[mt][nt][3];
                    if (DBG_NO_MOE) o = x;
                    *(f32x4*)(xd + col) = o; } } }
    }
}

PHASE_FN void ph_final(const Params& p) {
    const int wid = tidx() >> 6, lane = tidx() & 63; const float* g = p.in[I_FNG];
    for (int r = bidx() * 8 + wid; r < 2 * SEQ; r += gdim() * 8) {
        float* xr = p.out + (size_t)r * D; f32x4 v[4]; float ss = 0.f;
#pragma unroll
        for (int i = 0; i < 4; ++i) { v[i] = *(const f32x4*)(xr + i * 256 + lane * 4); ss += v[i][0] * v[i][0] + v[i][1] * v[i][1] + v[i][2] * v[i][2] + v[i][3] * v[i][3]; }
        ss = wave_sum(ss); const float rinv = rsqrtf(ss * (1.f / 1024.f) + 1e-6f);
#pragma unroll
        for (int i = 0; i < 4; ++i) { const f32x4 gg = *(const f32x4*)(g + i * 256 + lane * 4); f32x4 o; o[0] = v[i][0] * rinv * gg[0]; o[1] = v[i][1] * rinv * gg[1]; o[2] = v[i][2] * rinv * gg[2]; o[3] = v[i][3] * rinv * gg[3];
            *(f32x4*)(xr + i * 256 + lane * 4) = o; }
    }
}

__device__ __forceinline__ void ph_dbgcmp(const Params& p, size_t oa, size_t ob, int slot) {
    const u32x4* a = WSP(const u32x4, oa); const u32x4* b = WSP(const u32x4, ob); int bad = 0;
    const size_t n = (size_t)2 * 1024 * TPB * 2 / 16;
    for (size_t i = (size_t)bidx() * 512 + tidx(); i < n; i += (size_t)gdim() * 512) { const u32x4 x = a[i], y = b[i]; if (x.x != y.x || x.y != y.y || x.z != y.z || x.w != y.w) bad = 1; }
    if (bad) atomicAdd(WSP(int, OFF_CNT) + slot, 1);
}
constexpr int LDS_BYTES = 150 * 1024;
template <int PH>
__global__ void __launch_bounds__(512) k_phase(Params p, int l) {
    char* lds = lds_dyn;
    if (PH == 0) ph_prologue(p, lds);
    if (PH == 1) { ph_wconv(p, l, lds); __syncthreads(); ph_filt(p, l, lds); __syncthreads(); ph_norm<0>(p, l, lds); }
    if (PH == 2) ph_gemm1(p, l, lds);
    if (PH == 3) ph_mixers(p, l, lds);
    if (PH == 4) ph_mla(p, l, lds);
    if (PH == 5) ph_merge(p, l, lds);
    if (PH == 6) ph_wout(p, l, lds);
    if (PH == 7) ph_norm<1>(p, l, lds);
    if (PH == 8) ph_moe1(p, l, lds);
    if (PH == 9) ph_moe2(p, l, lds);
    if (PH == 10) ph_final(p);
}

#if ONE_LAUNCH
__global__ void __launch_bounds__(512) k_fused(Params p0) {
    char* lds = lds_dyn;
    volatile LAS unsigned* xbw = (volatile LAS unsigned*)(lds + LDS_BYTES - 16);
    if (threadIdx.x == 0) { xbw[0] = 0u; xbw[1] = 0u; xbw[2] = 0u; xbw[3] = 0u; }
    __syncthreads();
    (void)xcd_barrier_post((unsigned*)(p0.ws + OFF_BAR), xbw);
#define PQ() ({ Params q_ = p0; asm volatile("" : "+s"(q_.ws)); q_; })
#define GRID_BARRIER() do { XcdBarrier bar_; bar_.bar = (unsigned*)(p0.ws + OFF_BAR); bar_.x = xb_xcc_id(); bar_.st = (volatile LAS unsigned*)(lds_dyn + LDS_BYTES - 16); xcd_barrier(bar_); } while (0)
    asm volatile("; PHASE_MARK 0" ::: "memory"); ph_prologue(PQ(), lds);
    if (REP_PHASE == 100) { GRID_BARRIER(); ph_prologue(PQ(), lds); }
    GRID_BARRIER();
#pragma unroll
    for (int l = 0; l < NLAYER; ++l) {
        asm volatile("; PHASE_MARK 1" ::: "memory"); ph_wconv(PQ(), l, lds); __syncthreads(); ph_filt(PQ(), l, lds); __syncthreads(); ph_norm<0>(PQ(), l, lds);
        GRID_BARRIER();
        if (REP_PHASE == 1) { ph_wconv(PQ(), l, lds); __syncthreads(); ph_norm<0>(PQ(), l, lds); GRID_BARRIER(); }
        asm volatile("; PHASE_MARK 2" ::: "memory"); ph_gemm1(PQ(), l, lds);
        GRID_BARRIER();
        if (REP_PHASE == 2) { ph_gemm1(PQ(), l, lds); GRID_BARRIER(); }

        asm volatile("; PHASE_MARK 3" ::: "memory"); ph_mixers(PQ(), l, lds);
        GRID_BARRIER();
        if (REP_PHASE == 3) { ph_mixers(PQ(), l, lds); GRID_BARRIER(); }
        asm volatile("; PHASE_MARK 4" ::: "memory"); ph_mla(PQ(), l, lds);
        GRID_BARRIER();
        if (REP_PHASE == 4) { ph_mla(PQ(), l, lds); GRID_BARRIER(); }
        asm volatile("; PHASE_MARK 5" ::: "memory"); ph_merge(PQ(), l, lds);
        GRID_BARRIER();
        if (REP_PHASE == 5) { ph_merge(PQ(), l, lds); GRID_BARRIER(); }
        asm volatile("; PHASE_MARK 6" ::: "memory"); ph_wout(PQ(), l, lds);
        GRID_BARRIER();
        if (REP_PHASE == 6 && l == 0) { ph_wout(PQ(), l, lds); GRID_BARRIER(); }
        asm volatile("; PHASE_MARK 7" ::: "memory"); ph_norm<1>(PQ(), l, lds);
        GRID_BARRIER();
        if (REP_PHASE == 7) { ph_norm<2>(PQ(), l, lds); GRID_BARRIER(); }
        asm volatile("; PHASE_MARK 8" ::: "memory"); ph_moe1(PQ(), l, lds);
        GRID_BARRIER();
        if (REP_PHASE == 8) { ph_moe1(PQ(), l, lds); GRID_BARRIER(); }
        asm volatile("; PHASE_MARK 9" ::: "memory"); ph_moe2(PQ(), l, lds);
        GRID_BARRIER();
    }
    asm volatile("; PHASE_MARK 10" ::: "memory"); ph_final(PQ());
}
#endif
template <int PH> static void launch_phase(const Params& p, int l, int grid, hipStream_t stream) {
    static bool attr = false;
    if (!attr) { hipFuncSetAttribute((const void*)k_phase<PH>, hipFuncAttributeMaxDynamicSharedMemorySize, LDS_BYTES); attr = true; }
    hipLaunchKernelGGL(k_phase<PH>, dim3(grid), dim3(512), LDS_BYTES, stream, p, l);
}

extern "C" void kernel_launch(void* const* d_in, const int* in_sizes, int n_in, void* d_out, int out_size, void* d_ws, size_t ws_size, hipStream_t stream) {
    if (n_in != 33 || ws_size < WS_TOTAL || out_size != 2 * SEQ * D) { fprintf(stderr, "kernel_launch: unexpected shapes: n_in %d ws %zu (need %zu) out %d\n", n_in, ws_size, WS_TOTAL, out_size); return; }
    Params p{};
    for (int i = 0; i < 33; ++i) p.in[i] = (const float*)d_in[i];
    p.out = (float*)d_out; p.ws = (unsigned char*)d_ws;
    hipMemsetAsync(d_ws, 0, ZERO_BYTES, stream);
#if ONE_LAUNCH
    static int grid1 = 0;
    if (!grid1) {
        int dev = 0, cus = 0, per_cu = 0;
        hipGetDevice(&dev); hipDeviceGetAttribute(&cus, hipDeviceAttributeMultiprocessorCount, dev);
        hipFuncSetAttribute((const void*)k_fused, hipFuncAttributeMaxDynamicSharedMemorySize, LDS_BYTES);
        hipOccupancyMaxActiveBlocksPerMultiprocessor(&per_cu, k_fused, 512, LDS_BYTES);
        if (per_cu < 1 || cus < 256) { fprintf(stderr, "kernel_launch: cannot make the grid resident (cus %d, blocks/cu %d)\n", cus, per_cu); return; }
        grid1 = 256;
    }
    hipLaunchKernelGGL(k_fused, dim3(grid1), dim3(512), LDS_BYTES, stream, p);
    { const hipError_t le = hipPeekAtLastError(); if (le != hipSuccess) fprintf(stderr, "kernel_launch: launch failed: %s\n", hipGetErrorName(le)); }
    return;
#endif
    const int grid = 256;
    launch_phase<0>(p, 0, grid, stream);
    for (int l = 0; l < NLAYER; ++l) {
        launch_phase<1>(p, l, grid, stream);
        launch_phase<2>(p, l, grid, stream);
        launch_phase<3>(p, l, grid, stream);
        launch_phase<4>(p, l, grid, stream);
        launch_phase<5>(p, l, grid, stream);
        launch_phase<6>(p, l, grid, stream);
        launch_phase<7>(p, l, grid, stream);
        launch_phase<8>(p, l, grid, stream);
        launch_phase<9>(p, l, grid, stream);
    }
    launch_phase<10>(p, 0, grid, stream);
    const hipError_t le = hipPeekAtLastError();
    if (le != hipSuccess) fprintf(stderr, "kernel_launch: launch failed: %s\n", hipGetErrorName(le));
}
```

```cpp
#include <hip/hip_runtime.h>
#include <cstdio>
#include <cstdint>

#ifndef ONE_LAUNCH
#define ONE_LAUNCH 1
#endif
#ifndef REP_PHASE
#define REP_PHASE 0
#endif
#ifndef DBG_NO_MIX
#define DBG_NO_MIX 0
#endif
#ifndef DBG_BR
#define DBG_BR 15
#endif
#ifndef DBG_FN_COPY
#define DBG_FN_COPY 0
#endif
#ifndef DBG_NO_MOE
#define DBG_NO_MOE 0
#endif

constexpr int D = 1024, SEQ = 16384, NCTX = 256, TPB = SEQ + NCTX, T = 2 * TPB, NLAYER = 2;
constexpr int NTILE = T / 128;
constexpr int PLD = 1280;
constexpr int IN_W = 6304;

typedef unsigned short bf16_t;
typedef short bf16x8 __attribute__((ext_vector_type(8)));
typedef short s16x4 __attribute__((ext_vector_type(4)));
typedef float f32x4 __attribute__((ext_vector_type(4)));
typedef float f32x16 __attribute__((ext_vector_type(16)));
typedef unsigned u32x4 __attribute__((ext_vector_type(4)));
typedef unsigned u32x2 __attribute__((ext_vector_type(2)));
typedef _Float16 h16x2 __attribute__((ext_vector_type(2)));

constexpr size_t al256(size_t x) { return (x + 255) & ~(size_t)255; }
constexpr size_t OFF_BAR = 0;
constexpr size_t OFF_CNT = 16384;
constexpr size_t ZERO_BYTES = 32768;
constexpr size_t OFF_MOD = 32768;
constexpr size_t OFF_ROPE = OFF_MOD + al256((size_t)2 * 3 * 6144 * 4);
constexpr size_t OFF_H2L = OFF_ROPE + al256(256 * 8 * 8);
constexpr size_t OFF_W3T = OFF_H2L + (size_t)2 * 16384 * 64 * 2;
constexpr size_t OFF_H2C = OFF_H2L + al256((size_t)2 * 16384 * 64 * 4);
constexpr size_t OFF_CTXS = OFF_H2C + al256((size_t)2 * 256 * 64 * 4);
constexpr size_t OFF_TOKW = OFF_CTXS + al256((size_t)512 * 1024 * 4);
constexpr size_t OFF_LISTS = OFF_TOKW + al256((size_t)T * 2 * 4);
constexpr size_t OFF_WTS_OLD = OFF_LISTS + al256((size_t)24 * T * 4);
constexpr size_t WE_W1T = 0;
constexpr size_t WE_WGT = WE_W1T + (size_t)2304 * 1024;
constexpr size_t WE_WUQ = WE_WGT + (size_t)4096 * 1024;
constexpr size_t WE_WUKV = WE_WUQ + (size_t)384 * 256;
constexpr size_t WE_WBA = WE_WUKV + (size_t)512 * 128;
constexpr size_t WE_WBB = WE_WBA + (size_t)1024 * 256;
constexpr size_t WE_WBD = WE_WBB + (size_t)1024 * 256;
constexpr size_t WE_WBC = WE_WBD + (size_t)1024 * 256;
constexpr size_t WE_WOUT = WE_WBC + (size_t)1024 * 512;
constexpr size_t WE_WGU = WE_WOUT + (size_t)1024 * 1024;
constexpr size_t WE_WDN = WE_WGU + (size_t)16 * 512 * 1024;
constexpr size_t WE_TOTAL = WE_WDN + (size_t)16 * 1024 * 256;
constexpr size_t OFF_H = OFF_WTS_OLD;
constexpr size_t OFF_P = OFF_H + al256((size_t)T * 1024 * 2);
constexpr size_t OFF_HYFN = OFF_P + al256((size_t)T * PLD * 2);
constexpr size_t OFF_Q = OFF_HYFN + al256((size_t)2 * 1024 * TPB * 2);
constexpr size_t OFF_K = OFF_Q + al256((size_t)T * 384 * 2);
constexpr size_t OFF_V = OFF_K + al256((size_t)T * 384 * 2);
constexpr size_t OFF_OAD = OFF_V + al256((size_t)T * 256 * 2);
constexpr size_t OFF_OBT = OFF_OAD + al256((size_t)T * 512 * 2);
constexpr size_t OFF_OCT = OFF_OBT + al256((size_t)2 * 256 * TPB * 2);
constexpr size_t OFF_HYS = OFF_OCT + al256((size_t)2 * 512 * TPB * 2);
constexpr size_t OFF_WTS = OFF_HYS + al256((size_t)256 * 4 * 16384 * 4);
constexpr size_t OFF_FILT = OFF_WTS + al256(WE_TOTAL * 2);
constexpr size_t WS_TOTAL = OFF_FILT + al256((size_t)1024 * 16384 * 2);
constexpr int ACT_ROWS = 36352;
static_assert((size_t)ACT_ROWS * 512 * 2 <= (size_t)T * PLD * 2, "act must fit in P");

struct Params { const float* in[33]; float* out; unsigned char* ws; };
enum { I_X = 0, I_C, I_CTX, I_CCTX, I_ADAW, I_ADAB, I_N1G, I_N2G, I_WIN, I_QNORM, I_WUQ, I_KVNORM, I_WUKV, I_HYSW, I_HYW1, I_HYB1, I_HYF1, I_HYW2, I_HYB2, I_HYF2, I_HYW3, I_HYBIAS,
       I_RPB, I_WBR, I_WOUT, I_MWG, I_MBG, I_MWE, I_MBE, I_MGATE, I_MUP, I_MDOWN, I_FNG };

#define WSP(TYPE, off) ((TYPE*)(p.ws + (off)))
__device__ __forceinline__ bf16_t* wts(const Params& p, int l, size_t we) { (void)l; return (bf16_t*)(p.ws + OFF_WTS) + we; }

typedef float f32x2 __attribute__((ext_vector_type(2))); typedef int i32x8 __attribute__((ext_vector_type(8)));
typedef __bf16 bf16x2_t __attribute__((ext_vector_type(2)));
__device__ __forceinline__ unsigned cvt_pk_bf16(float lo, float hi) { const f32x2 v = {lo, hi}; return __builtin_bit_cast(unsigned, __builtin_convertvector(v, bf16x2_t)); }
__device__ __forceinline__ bf16_t f2bf(float x) { return (bf16_t)(cvt_pk_bf16(x, 0.f) & 0xffffu); }
__device__ __forceinline__ float bf2f(bf16_t v) { return __uint_as_float((unsigned)v << 16); }
__device__ __forceinline__ float wave_sum(float v) {
#pragma unroll
    for (int o = 32; o >= 1; o >>= 1) v += __shfl_xor(v, o);
    return v;
}
__device__ __forceinline__ float silu_f(float x) { return x / (1.f + __expf(-x)); }
__device__ __forceinline__ float sigmoid_f(float x) { return __builtin_amdgcn_rcpf(1.f + __builtin_amdgcn_exp2f(x * -1.4426950408889634f)); }
__device__ __forceinline__ void sincos_turns(float turns, float& s, float& c) { const float f = turns - floorf(turns); sincospif(2.f * f, &s, &c); }
__device__ __forceinline__ void sincos_rad(float x, float& s, float& c) { sincos_turns(x * 0.15915494309189535f, s, c); }

__device__ __forceinline__ const float* xrow_in(const Params& p, int r) {
    const int b = r >= TPB ? 1 : 0, t = r - b * TPB;
    return t < SEQ ? p.in[I_X] + ((size_t)b * SEQ + t) * D : p.in[I_CTX] + ((size_t)b * NCTX + (t - SEQ)) * D;
}
__device__ __forceinline__ float* xrow_st(const Params& p, int r) {
    const int b = r >= TPB ? 1 : 0, t = r - b * TPB;
    return t < SEQ ? p.out + ((size_t)b * SEQ + t) * D : WSP(float, OFF_CTXS) + ((size_t)b * NCTX + (t - SEQ)) * D;
}
__device__ __forceinline__ bool row_is_ctx(int r) { const int b = r >= TPB ? 1 : 0; return (r - b * TPB) >= SEQ; }
__device__ __forceinline__ const float* modvec(const Params& p, int l, int r) {
    const int b = r >= TPB ? 1 : 0, t = r - b * TPB; const int mi = t < SEQ ? b : 2;
    return WSP(float, OFF_MOD) + ((size_t)l * 3 + mi) * 6144;
}

#define XB_TMO      128
#define XB_XCNT(j)  (256  + 64 * (j))
#define XB_XSUB(j)  (1280 + 64 * (j))
#define XB_XGEN(j)  (2304 + 64 * (j))
#define XB_TOP      3328
#define XB_TOPGEN   3392
#define XCD_BAR_WORDS 3456
#define XB_SPIN_CAP (1u << 22)
#define LAS __attribute__((address_space(3)))
__device__ __forceinline__ unsigned xb_ld(unsigned* p)              { return __hip_atomic_load(p, __ATOMIC_RELAXED, __HIP_MEMORY_SCOPE_AGENT); }
__device__ __forceinline__ unsigned xb_add(unsigned* p, unsigned v) { return __hip_atomic_fetch_add(p, v, __ATOMIC_RELAXED, __HIP_MEMORY_SCOPE_AGENT); }
__device__ __forceinline__ unsigned xb_xcc_id() { return (unsigned)__builtin_amdgcn_s_getreg((3 << 11) | 20) & 0xFu; }
#define XB_SPIN(cond, bar) do { unsigned _sp = 0; while (cond) { __builtin_amdgcn_s_sleep(1); \
    if ((++_sp & 255u) == 0u) { if (xb_ld(&(bar)[XB_TMO])) break; if (_sp > XB_SPIN_CAP) { atomicAdd(&(bar)[XB_TMO], 1u); break; } } } } while (0)
struct XcdBarrier { unsigned* bar; unsigned x; volatile LAS unsigned* st; };
__device__ __forceinline__ XcdBarrier xcd_barrier_post(unsigned* bar, volatile LAS unsigned* st) {
    XcdBarrier b; b.bar = bar; b.x = xb_xcc_id(); b.st = st;
    if (threadIdx.x == 0) (void)xb_add(&bar[XB_XCNT(b.x)], 1u);
    return b;
}
__device__ __forceinline__ void xcd_barrier_complete(unsigned* bar, unsigned x, unsigned& nloc, unsigned& nx) {
    const unsigned G = gridDim.x * gridDim.y * gridDim.z;
    unsigned sum, cnt, mine, sp = 0u;
    for (;;) {
        sum = 0u; cnt = 0u; mine = 0u;
#pragma unroll
        for (unsigned j = 0; j < 16; ++j) { const unsigned c = xb_ld(&bar[XB_XCNT(j)]); sum += c; cnt += (c > 0u) ? 1u : 0u; mine = (j == x) ? c : mine; }
        if (sum == G) break;
        __builtin_amdgcn_s_sleep(1);
        if ((++sp & 255u) == 0u) { if (xb_ld(&bar[XB_TMO])) break; if (sp > XB_SPIN_CAP) { atomicAdd(&bar[XB_TMO], 1u); break; } }
    }
    nloc = mine > 0u ? mine : 1u; nx = cnt > 0u ? cnt : 1u;
}
__device__ __forceinline__ void xcd_barrier(const XcdBarrier& b) {
    asm volatile("s_waitcnt vmcnt(0)" ::: "memory");
    __syncthreads();
    if (threadIdx.x == 0) {
        unsigned* bar = b.bar;
        __builtin_amdgcn_s_waitcnt(0);
        unsigned nloc = b.st[0], nx = b.st[1];
        if (nloc == 0u) { xcd_barrier_complete(bar, b.x, nloc, nx); b.st[0] = nloc; b.st[1] = nx; }
        const unsigned old = xb_add(&bar[XB_XSUB(b.x)], 1u);
        const unsigned gen = old / nloc;
        if (old + 1u == (gen + 1u) * nloc) {
            __builtin_amdgcn_fence(__ATOMIC_RELEASE, "agent");
            asm volatile("s_waitcnt vmcnt(0)" ::: "memory");
            const unsigned og = xb_add(&bar[XB_TOP], 1u);
            const unsigned tg = og / nx;
            if (og + 1u == (tg + 1u) * nx) xb_add(&bar[XB_TOPGEN], 1u);
            else XB_SPIN(xb_ld(&bar[XB_TOPGEN]) == tg, bar);
            __builtin_amdgcn_fence(__ATOMIC_ACQUIRE, "agent");
            xb_add(&bar[XB_XGEN(b.x)], 1u);
            asm volatile("s_waitcnt vmcnt(0)" ::: "memory");
        } else {
            XB_SPIN(xb_ld(&bar[XB_XGEN(b.x)]) == gen, bar);
            __builtin_amdgcn_fence(__ATOMIC_ACQUIRE, "agent");
            asm volatile("s_waitcnt vmcnt(0)" ::: "memory");
        }
    }
    __syncthreads();
}

__device__ __forceinline__ int tidx() { int r; asm volatile("v_mov_b32 %0, %1" : "=v"(r) : "v"((int)threadIdx.x)); return r; }
__device__ __forceinline__ int bidx() { int r; asm volatile("s_mov_b32 %0, %1" : "=s"(r) : "s"((int)blockIdx.x)); return r; }
__device__ __forceinline__ int gdim() { int r; asm volatile("s_mov_b32 %0, %1" : "=s"(r) : "s"((int)gridDim.x)); return r; }
extern __shared__ __attribute__((aligned(16))) char lds_dyn[];
constexpr int G_TILE = 128 * 128;
constexpr int G_STAGE = 2 * G_TILE;
constexpr int G_LDS = 4 * G_STAGE;
__device__ __forceinline__ int g_lds_byte(int r, int c) { const int ob = (r & 15) * 64 + (c & 31) * 2; return ((r >> 4) * 2 + (c >> 5)) * 1024 + (ob ^ (((ob >> 9) & 1) << 5)); }
__device__ __forceinline__ int g_srow() { const int t = tidx(), ln = t & 63, p = ln * 16, ob = p ^ (((p >> 9) & 1) << 5); return ((t >> 6) >> 1) * 16 + (ob >> 6); }
__device__ __forceinline__ int g_skc() { const int t = tidx(), ln = t & 63, p = ln * 16, ob = p ^ (((p >> 9) & 1) << 5); return ((t >> 6) & 1) * 4 + ((ob & 63) >> 4); }

template <int SWAP>
__device__ __forceinline__ void mma_tile(f32x4 (&acc)[4][2], const char* As, const char* Bs, int a_rd, int b_rd) {
#pragma unroll
    for (int ks = 0; ks < 2; ++ks) {
        bf16x8 af[4], bfr[2];
#pragma unroll
        for (int mt = 0; mt < 4; ++mt) af[mt] = *(const bf16x8*)(As + a_rd + mt * 2048 + ks * 1024);
#pragma unroll
        for (int nt = 0; nt < 2; ++nt) bfr[nt] = *(const bf16x8*)(Bs + b_rd + nt * 2048 + ks * 1024);
#pragma unroll
        for (int mt = 0; mt < 4; ++mt)
#pragma unroll
            for (int nt = 0; nt < 2; ++nt)
                acc[mt][nt] = SWAP ? __builtin_amdgcn_mfma_f32_16x16x32_bf16(bfr[nt], af[mt], acc[mt][nt], 0, 0, 0)
                                   : __builtin_amdgcn_mfma_f32_16x16x32_bf16(af[mt], bfr[nt], acc[mt][nt], 0, 0, 0);
    }
}
struct GFrag { bf16x8 a[4], b[2]; };
__device__ __forceinline__ void gf_load(GFrag& f, const char* As, const char* Bs, int a_rd, int b_rd, int ks) {
#pragma unroll
    for (int mt = 0; mt < 4; ++mt) f.a[mt] = *(const bf16x8*)(As + a_rd + mt * 2048 + ks * 1024);
#pragma unroll
    for (int nt = 0; nt < 2; ++nt) f.b[nt] = *(const bf16x8*)(Bs + b_rd + nt * 2048 + ks * 1024);
}
template <int SWAP = 1>
__device__ __forceinline__ void gf_mma(f32x4 (&acc)[4][2], const GFrag& f) {
#pragma unroll
    for (int mt = 0; mt < 4; ++mt)
#pragma unroll
        for (int nt = 0; nt < 2; ++nt) acc[mt][nt] = SWAP ? __builtin_amdgcn_mfma_f32_16x16x32_bf16(f.b[nt], f.a[mt], acc[mt][nt], 0, 0, 0)
                                                           : __builtin_amdgcn_mfma_f32_16x16x32_bf16(f.a[mt], f.b[nt], acc[mt][nt], 0, 0, 0);
}
__device__ __forceinline__ void gf_zero(GFrag& f) {
#pragma unroll
    for (int mt = 0; mt < 4; ++mt) f.a[mt] = (bf16x8)(0);
#pragma unroll
    for (int nt = 0; nt < 2; ++nt) f.b[nt] = (bf16x8)(0);
}
#define SB() __builtin_amdgcn_sched_barrier(0)
#define GF_STAGE(ACCP, ACC, AS, BS) do { gf_load(f0, (AS), (BS), a_rd, b_rd, 0); SB(); gf_mma(ACCP, f1); SB(); gf_load(f1, (AS), (BS), a_rd, b_rd, 1); SB(); gf_mma(ACC, f0); SB(); } while (0)

struct GFrag2 { bf16x8 a[4], b[4]; };
__device__ __forceinline__ void gf2_load(GFrag2& f, const char* As, const char* Bs, int a_rd, int b_rd, int ks) {
#pragma unroll
    for (int mt = 0; mt < 4; ++mt) f.a[mt] = *(const bf16x8*)(As + a_rd + mt * 2048 + ks * 1024);
#pragma unroll
    for (int nt = 0; nt < 4; ++nt) f.b[nt] = *(const bf16x8*)(Bs + b_rd + nt * 2048 + ks * 1024);
}
template <int SWAP>
__device__ __forceinline__ void gf2_mma(f32x4 (&acc)[4][4], const GFrag2& f) {
#pragma unroll
    for (int mt = 0; mt < 4; ++mt)
#pragma unroll
        for (int nt = 0; nt < 4; ++nt) acc[mt][nt] = SWAP ? __builtin_amdgcn_mfma_f32_16x16x32_bf16(f.b[nt], f.a[mt], acc[mt][nt], 0, 0, 0)
                                                           : __builtin_amdgcn_mfma_f32_16x16x32_bf16(f.a[mt], f.b[nt], acc[mt][nt], 0, 0, 0);
}
__device__ __forceinline__ void gf2_zero(GFrag2& f) {
#pragma unroll
    for (int mt = 0; mt < 4; ++mt) f.a[mt] = (bf16x8)(0);
#pragma unroll
    for (int nt = 0; nt < 4; ++nt) f.b[nt] = (bf16x8)(0);
}
#define G_WAITV(n) asm volatile("s_waitcnt vmcnt(" #n ")\n\ts_waitcnt lgkmcnt(0)" ::: "memory")
template <int SWAP, int AT>
__device__ __forceinline__ void mma_seg(f32x4 (&acc)[4][2], const bf16_t* __restrict__ a0, const bf16_t* __restrict__ a1, long ldt,
                                        const bf16_t* __restrict__ b0, const bf16_t* __restrict__ b1, int K, char* lds) {
    const int tid = tidx(), lane = tid & 63, wid = __builtin_amdgcn_readfirstlane(tid >> 6), wm = wid >> 2, wn = wid & 3;
    const int fr = lane & 15, fq = lane >> 4;
    const int a_rd = g_lds_byte(wm * 64 + fr, fq * 8), b_rd = g_lds_byte(wn * 32 + fr, fq * 8);
    const int nk = K >> 6;
    if (!AT) {
        LAS char* L = (LAS char*)lds_dyn + ((wid >> 1) * 2 + (wid & 1)) * 1024;
        auto issue = [&](int st) { const int k0 = st << 6; LAS char* Lb = L + (st & 3) * G_STAGE;
            __builtin_amdgcn_global_load_lds((const unsigned*)(a0 + k0), (LAS unsigned*)(Lb), 16, 0, 0);
            __builtin_amdgcn_global_load_lds((const unsigned*)(a1 + k0), (LAS unsigned*)(Lb + 8192), 16, 0, 0);
            __builtin_amdgcn_global_load_lds((const unsigned*)(b0 + k0), (LAS unsigned*)(Lb + G_TILE), 16, 0, 0);
            __builtin_amdgcn_global_load_lds((const unsigned*)(b1 + k0), (LAS unsigned*)(Lb + G_TILE + 8192), 16, 0, 0); };
        GFrag f0, f1; gf_zero(f1);
        issue(0); if (nk > 1) issue(1); if (nk > 2) issue(2);
        for (int kt = 0; kt < nk; ++kt) {
            if (kt + 2 < nk) G_WAITV(8); else if (kt + 1 < nk) G_WAITV(4); else G_WAITV(0);
            __builtin_amdgcn_s_barrier();
            asm volatile("" ::: "memory");
            if (kt + 3 < nk) issue(kt + 3);
            const char* As = lds + (kt & 3) * G_STAGE;
            gf_load(f0, As, As + G_TILE, a_rd, b_rd, 0); SB(); gf_mma<SWAP>(acc, f1); SB(); gf_load(f1, As, As + G_TILE, a_rd, b_rd, 1); SB(); gf_mma<SWAP>(acc, f0); SB();
        }
        gf_mma<SWAP>(acc, f1);
        __syncthreads();
    } else {
        const int w0 = g_lds_byte(g_srow(), g_skc() * 8), w1 = w0 + 4 * 2048;
        const int tk = tid >> 4, tt = tid & 15;
        u32x4 ra0, ra1, rb0, rb1;
        auto gld = [&](int k0) {
            ra0 = *(const u32x4*)(a0 + (long)(k0 + tk) * ldt + tt * 8); ra1 = *(const u32x4*)(a0 + (long)(k0 + tk + 32) * ldt + tt * 8);
            rb0 = *(const u32x4*)(b0 + k0); rb1 = *(const u32x4*)(b1 + k0);
        };
        auto lst = [&](int buf) {
            char* A = lds + buf * G_STAGE; char* B = A + G_TILE;
#pragma unroll
            for (int i = 0; i < 8; ++i) {
                const unsigned wa = ra0[i >> 1], wb = ra1[i >> 1];
                *(bf16_t*)(A + g_lds_byte(tt * 8 + i, tk)) = (bf16_t)((i & 1) ? (wa >> 16) : (wa & 0xffffu));
                *(bf16_t*)(A + g_lds_byte(tt * 8 + i, tk + 32)) = (bf16_t)((i & 1) ? (wb >> 16) : (wb & 0xffffu));
            }
            *(u32x4*)(B + w0) = rb0; *(u32x4*)(B + w1) = rb1;
        };
        gld(0); lst(0); __syncthreads();
        for (int kt = 0; kt < nk; ++kt) {
            if (kt + 1 < nk) gld((kt + 1) << 6);
            __builtin_amdgcn_sched_barrier(0);
            mma_tile<SWAP>(acc, lds + (kt & 1) * G_STAGE, lds + (kt & 1) * G_STAGE + G_TILE, a_rd, b_rd);
            __builtin_amdgcn_sched_barrier(0);
            if (kt + 1 < nk) lst((kt + 1) & 1);
            __syncthreads();
        }
    }
}
__device__ __forceinline__ void mma_pair(f32x4 (&ag)[4][2], f32x4 (&ap)[4][2], const bf16_t* __restrict__ ga0, const bf16_t* __restrict__ ga1, const bf16_t* __restrict__ gb0, const bf16_t* __restrict__ gb1, int nkg,
                                         const bf16_t* __restrict__ pa0, const bf16_t* __restrict__ pa1, const bf16_t* __restrict__ pb0, const bf16_t* __restrict__ pb1, int nkp, char* lds) {
    const int tid = tidx(), lane = tid & 63, wid = __builtin_amdgcn_readfirstlane(tid >> 6), wm = wid >> 2, wn = wid & 3;
    const int fr = lane & 15, fq = lane >> 4;
    const int a_rd = g_lds_byte(wm * 64 + fr, fq * 8), b_rd = g_lds_byte(wn * 32 + fr, fq * 8);
    const int ns = nkg + nkp;
    LAS char* L = (LAS char*)lds_dyn + ((wid >> 1) * 2 + (wid & 1)) * 1024;
    auto issue = [&](int st) { const bool g = st < nkg; const int k0 = (g ? st : st - nkg) << 6; LAS char* Lb = L + (st & 3) * G_STAGE;
        __builtin_amdgcn_global_load_lds((const unsigned*)((g ? ga0 : pa0) + k0), (LAS unsigned*)(Lb), 16, 0, 0);
        __builtin_amdgcn_global_load_lds((const unsigned*)((g ? ga1 : pa1) + k0), (LAS unsigned*)(Lb + 8192), 16, 0, 0);
        __builtin_amdgcn_global_load_lds((const unsigned*)((g ? gb0 : pb0) + k0), (LAS unsigned*)(Lb + G_TILE), 16, 0, 0);
        __builtin_amdgcn_global_load_lds((const unsigned*)((g ? gb1 : pb1) + k0), (LAS unsigned*)(Lb + G_TILE + 8192), 16, 0, 0); };
    issue(0); issue(1); issue(2);
    for (int st = 0; st < nkg; ++st) {
        if (st + 2 < ns) G_WAITV(8); else if (st + 1 < ns) G_WAITV(4); else G_WAITV(0);
        __builtin_amdgcn_s_barrier(); asm volatile("" ::: "memory");
        if (st + 3 < ns) issue(st + 3);
        mma_tile<1>(ag, lds + (st & 3) * G_STAGE, lds + (st & 3) * G_STAGE + G_TILE, a_rd, b_rd);
    }
    for (int st = nkg; st < ns; ++st) {
        if (st + 2 < ns) G_WAITV(8); else if (st + 1 < ns) G_WAITV(4); else G_WAITV(0);
        __builtin_amdgcn_s_barrier(); asm volatile("" ::: "memory");
        if (st + 3 < ns) issue(st + 3);
        mma_tile<1>(ap, lds + (st & 3) * G_STAGE, lds + (st & 3) * G_STAGE + G_TILE, a_rd, b_rd);
    }
    __syncthreads();
}
constexpr int G2_STAGE = 3 * G_TILE;
constexpr int G2_LDS = 3 * G2_STAGE;
template <int SWAP>
__device__ __forceinline__ void mma_tile256(f32x4 (&acc)[4][4], const char* As, const char* Bs, int a_rd, int b_rd) {
#pragma unroll
    for (int ks = 0; ks < 2; ++ks) {
        bf16x8 af[4], bfr[4];
#pragma unroll
        for (int mt = 0; mt < 4; ++mt) af[mt] = *(const bf16x8*)(As + a_rd + mt * 2048 + ks * 1024);
#pragma unroll
        for (int nt = 0; nt < 4; ++nt) bfr[nt] = *(const bf16x8*)(Bs + b_rd + nt * 2048 + ks * 1024);
#pragma unroll
        for (int mt = 0; mt < 4; ++mt)
#pragma unroll
            for (int nt = 0; nt < 4; ++nt)
                acc[mt][nt] = SWAP ? __builtin_amdgcn_mfma_f32_16x16x32_bf16(bfr[nt], af[mt], acc[mt][nt], 0, 0, 0)
                                   : __builtin_amdgcn_mfma_f32_16x16x32_bf16(af[mt], bfr[nt], acc[mt][nt], 0, 0, 0);
    }
}
#define G2_WAITV(n) asm volatile("s_waitcnt vmcnt(" #n ")\n\ts_waitcnt lgkmcnt(0)" ::: "memory")
template <int SWAP>
__device__ __forceinline__ void mma_seg256(f32x4 (&acc)[4][4], const bf16_t* __restrict__ a0, size_t astep, const bf16_t* __restrict__ b0, size_t bstep, int K, char* lds) {
    const int tid = tidx(), lane = tid & 63, wid = __builtin_amdgcn_readfirstlane(tid >> 6), wm = wid >> 1, wn = wid & 1;
    const int fr = lane & 15, fq = lane >> 4;
    const int a_rd = g_lds_byte(wm * 64 + fr, fq * 8), b_rd = g_lds_byte(wn * 64 + fr, fq * 8);
    const int nk = K >> 6;
    LAS char* L = (LAS char*)lds_dyn + ((wid >> 1) * 2 + (wid & 1)) * 1024;
    auto issue = [&](int st) { const int k0 = st << 6; LAS char* Lb = L + (st % 3) * G2_STAGE;
#pragma unroll
        for (int i = 0; i < 4; ++i) __builtin_amdgcn_global_load_lds((const unsigned*)(a0 + i * astep + k0), (LAS unsigned*)(Lb + i * 8192), 16, 0, 0);
#pragma unroll
        for (int i = 0; i < 2; ++i) __builtin_amdgcn_global_load_lds((const unsigned*)(b0 + i * bstep + k0), (LAS unsigned*)(Lb + 2 * G_TILE + i * 8192), 16, 0, 0); };
    GFrag2 f0, f1; gf2_zero(f1);
    issue(0); if (nk > 1) issue(1);
    for (int kt = 0; kt < nk; ++kt) {
        if (kt + 1 < nk) G2_WAITV(6); else G2_WAITV(0);
        __builtin_amdgcn_s_barrier(); asm volatile("" ::: "memory");
        if (kt + 2 < nk) issue(kt + 2);
        const char* As = lds + (kt % 3) * G2_STAGE; const char* Bs = As + 2 * G_TILE;
        gf2_load(f0, As, Bs, a_rd, b_rd, 0); SB(); gf2_mma<SWAP>(acc, f1); SB(); gf2_load(f1, As, Bs, a_rd, b_rd, 1); SB(); gf2_mma<SWAP>(acc, f0); SB();
    }
    gf2_mma<SWAP>(acc, f1);
    __syncthreads();
}
__device__ __forceinline__ void acc_zero256(f32x4 (&acc)[4][4]) {
#pragma unroll
    for (int mt = 0; mt < 4; ++mt)
#pragma unroll
        for (int nt = 0; nt < 4; ++nt) acc[mt][nt] = (f32x4){0.f, 0.f, 0.f, 0.f};
}
__device__ __forceinline__ void acc_zero(f32x4 (&acc)[4][2]) {
#pragma unroll
    for (int mt = 0; mt < 4; ++mt)
#pragma unroll
        for (int nt = 0; nt < 2; ++nt) acc[mt][nt] = (f32x4){0.f, 0.f, 0.f, 0.f};
}

typedef _Float16 f16x8 __attribute__((ext_vector_type(8)));
constexpr int FRS = 130;
#define FBI(n) ((((n) >> 7) * FRS) + ((n) & 127))
constexpr int FFT_BUF_BYTES = 128 * FRS * 8;
struct FFrag { int unused; };
__device__ __forceinline__ float2 cmulf(float2 a, float2 b) { return make_float2(a.x * b.x - a.y * b.y, a.x * b.y + a.y * b.x); }
__device__ __forceinline__ float2 cmulcf(float2 a, float2 b) { return make_float2(a.x * b.x + a.y * b.y, a.y * b.x - a.x * b.y); }
__device__ __forceinline__ float2 tw16k(const float2* thi, const float2* tlo, int idx) { return cmulf(thi[idx >> 7], tlo[idx & 127]); }
__device__ __forceinline__ void mfft_frags(FFrag& F, const float2*) { F.unused = 0; }
template <int CONJ, int TW>
__device__ __forceinline__ void mfft_left(float2* buf, const FFrag& F, const float2* thi, const float2* tlo) {
    const int tid = tidx(), lane = tid & 63, wid = tid >> 6, i = wid >> 1, hi = lane >> 5, l31 = lane & 31, fa = 32 * i + l31;
    f32x16 yr0 = {}, yi0 = {}, yr1 = {}, yi1 = {};
#pragma unroll
    for (int ks = 0; ks < 8; ++ks) {
        f16x8 fr, fi;
#pragma unroll
        for (int j = 0; j < 8; ++j) { const float2 w = thi[(fa * (16 * ks + 8 * hi + j)) & 127]; fr[j] = (_Float16)w.x; fi[j] = (_Float16)(CONJ ? -w.y : w.y); }
        const f16x8 nfi = -fi;
#pragma unroll
        for (int t = 0; t < 2; ++t) {
            const float2* xp = buf + (16 * ks + 8 * hi) * FRS + 32 * (2 * (wid & 1) + t) + l31;
            f16x8 xr, xi;
#pragma unroll
            for (int j = 0; j < 8; ++j) { const float2 v = xp[j * FRS]; xr[j] = (_Float16)v.x; xi[j] = (_Float16)v.y; }
            if (t == 0) { yr0 = __builtin_amdgcn_mfma_f32_32x32x16_f16(fr, xr, yr0, 0, 0, 0); yr0 = __builtin_amdgcn_mfma_f32_32x32x16_f16(nfi, xi, yr0, 0, 0, 0);
                          yi0 = __builtin_amdgcn_mfma_f32_32x32x16_f16(fr, xi, yi0, 0, 0, 0); yi0 = __builtin_amdgcn_mfma_f32_32x32x16_f16(fi, xr, yi0, 0, 0, 0); }
            else        { yr1 = __builtin_amdgcn_mfma_f32_32x32x16_f16(fr, xr, yr1, 0, 0, 0); yr1 = __builtin_amdgcn_mfma_f32_32x32x16_f16(nfi, xi, yr1, 0, 0, 0);
                          yi1 = __builtin_amdgcn_mfma_f32_32x32x16_f16(fr, xi, yi1, 0, 0, 0); yi1 = __builtin_amdgcn_mfma_f32_32x32x16_f16(fi, xr, yi1, 0, 0, 0); }
        }
    }
    __syncthreads();
#pragma unroll
    for (int t = 0; t < 2; ++t)
#pragma unroll
        for (int r = 0; r < 16; ++r) { const int row = 32 * i + (r & 3) + 8 * (r >> 2) + 4 * hi, col = 32 * (2 * (wid & 1) + t) + l31;
            float2 v = t == 0 ? make_float2(yr0[r], yi0[r]) : make_float2(yr1[r], yi1[r]);
            if (TW) { const float2 tv = tw16k(thi, tlo, row * col); v = TW > 0 ? cmulf(v, tv) : cmulcf(v, tv); }
            buf[row * FRS + col] = v; }
    __syncthreads();
}
template <int CONJ, int TW>
__device__ __forceinline__ void mfft_right(float2* buf, const FFrag& F, const float2* thi, const float2* tlo) {
    const int tid = tidx(), lane = tid & 63, wid = tid >> 6, jb = wid >> 1, hi = lane >> 5, l31 = lane & 31, fa = 32 * jb + l31;
    f32x16 yr0 = {}, yi0 = {}, yr1 = {}, yi1 = {};
#pragma unroll
    for (int ks = 0; ks < 8; ++ks) {
        f16x8 fr, fi;
#pragma unroll
        for (int j = 0; j < 8; ++j) { const float2 w = thi[(fa * (16 * ks + 8 * hi + j)) & 127]; fr[j] = (_Float16)w.x; fi[j] = (_Float16)(CONJ ? -w.y : w.y); }
        const f16x8 nfi = -fi;
#pragma unroll
        for (int t = 0; t < 2; ++t) {
            const f32x4* xp = (const f32x4*)(buf + (32 * (2 * (wid & 1) + t) + l31) * FRS + 16 * ks + 8 * hi);
            const f32x4 q0 = xp[0], q1 = xp[1], q2 = xp[2], q3 = xp[3];
            f16x8 xr, xi;
            xr[0] = (_Float16)q0[0]; xi[0] = (_Float16)q0[1]; xr[1] = (_Float16)q0[2]; xi[1] = (_Float16)q0[3]; xr[2] = (_Float16)q1[0]; xi[2] = (_Float16)q1[1]; xr[3] = (_Float16)q1[2]; xi[3] = (_Float16)q1[3];
            xr[4] = (_Float16)q2[0]; xi[4] = (_Float16)q2[1]; xr[5] = (_Float16)q2[2]; xi[5] = (_Float16)q2[3]; xr[6] = (_Float16)q3[0]; xi[6] = (_Float16)q3[1]; xr[7] = (_Float16)q3[2]; xi[7] = (_Float16)q3[3];
            if (t == 0) { yr0 = __builtin_amdgcn_mfma_f32_32x32x16_f16(xr, fr, yr0, 0, 0, 0); yr0 = __builtin_amdgcn_mfma_f32_32x32x16_f16(xi, nfi, yr0, 0, 0, 0);
                          yi0 = __builtin_amdgcn_mfma_f32_32x32x16_f16(xr, fi, yi0, 0, 0, 0); yi0 = __builtin_amdgcn_mfma_f32_32x32x16_f16(xi, fr, yi0, 0, 0, 0); }
            else        { yr1 = __builtin_amdgcn_mfma_f32_32x32x16_f16(xr, fr, yr1, 0, 0, 0); yr1 = __builtin_amdgcn_mfma_f32_32x32x16_f16(xi, nfi, yr1, 0, 0, 0);
                          yi1 = __builtin_amdgcn_mfma_f32_32x32x16_f16(xr, fi, yi1, 0, 0, 0); yi1 = __builtin_amdgcn_mfma_f32_32x32x16_f16(xi, fr, yi1, 0, 0, 0); }
        }
    }
    __syncthreads();
#pragma unroll
    for (int t = 0; t < 2; ++t)
#pragma unroll
        for (int r = 0; r < 16; ++r) { const int row = 32 * (2 * (wid & 1) + t) + (r & 3) + 8 * (r >> 2) + 4 * hi, col = 32 * jb + l31;
            float2 v = t == 0 ? make_float2(yr0[r], yi0[r]) : make_float2(yr1[r], yi1[r]);
            if (TW) { const float2 tv = tw16k(thi, tlo, row * col); v = TW > 0 ? cmulf(v, tv) : cmulcf(v, tv); }
            buf[row * FRS + col] = v; }
    __syncthreads();
}
__device__ __forceinline__ void fft_fwd_blk(float2* buf, const FFrag& F, const float2* thi, const float2* tlo) { mfft_left<0, 1>(buf, F, thi, tlo); mfft_right<0, 0>(buf, F, thi, tlo); }
__device__ __forceinline__ void fft_inv_blk(float2* buf, const FFrag& F, const float2* thi, const float2* tlo) { mfft_right<1, -1>(buf, F, thi, tlo); mfft_left<1, 0>(buf, F, thi, tlo); }
constexpr int FFT_LDS_TAB = FFT_BUF_BYTES;
constexpr int FFT_LDS_EXTRA = FFT_LDS_TAB + 4096;
__device__ __forceinline__ void fft_tables(char* lds) {
    float2* thi = (float2*)(lds + FFT_LDS_TAB); float2* tlo = thi + 128;
    const int t = tidx();
    if (t < 128) { float s, c; sincospif(2.f * (float)t / 128.f, &s, &c); thi[t] = make_float2(c, -s); }
    else if (t < 256) { float s, c; sincospif(2.f * (float)(t - 128) / 16384.f, &s, &c); tlo[t - 128] = make_float2(c, -s); }
    else if (t < 384) { float s, c; sincospif((float)(t - 256) / 128.f, &s, &c); tlo[128 + (t - 256)] = make_float2(c, -s); }
    else { float s, c; sincospif((float)(t - 384) / 16384.f, &s, &c); tlo[256 + (t - 384)] = make_float2(c, -s); }
    __syncthreads();
}
__device__ __forceinline__ float block_sum(float v, float* red) {
    v = wave_sum(v);
    __syncthreads();
    if ((tidx() & 63) == 0) red[tidx() >> 6] = v;
    __syncthreads();
    float s = 0.f;
#pragma unroll
    for (int i = 0; i < 8; ++i) s += red[i];
    return s;
}

#if ONE_LAUNCH
#define PHASE_FN __device__ __forceinline__
#else
#define PHASE_FN __device__
#endif
__device__ __forceinline__ const float* wsrc(const Params& p, int l, int job, int n, int& ld) {
    switch (job) {
    case 0: { ld = IN_W; const float* w = p.in[I_WIN] + (size_t)l * 1024 * IN_W; int c;
        if (n < 768) c = 1440 + n; else if (n < 1024) c = n - 768; else if (n < 1152) c = 256 + (n - 1024); else if (n < 1184) c = 384 + (n - 1152);
        else if (n < 1280) return nullptr; else if (n < 2048) c = 416 + (n - 1280); else c = 1184 + (n - 2048);
        return w + c; }
    case 1: ld = IN_W; return p.in[I_WIN] + (size_t)l * 1024 * IN_W + 2208 + n;
    case 2: ld = 384; return p.in[I_WUQ] + (size_t)l * 256 * 384 + n;
    case 3: ld = 512; return p.in[I_WUKV] + (size_t)l * 128 * 512 + n;
    case 4: ld = 1024; return p.in[I_WBR] + ((size_t)l * 4 + 0) * 256 * 1024 + n;
    case 5: ld = 1024; return p.in[I_WBR] + ((size_t)l * 4 + 1) * 256 * 1024 + n;
    case 6: ld = 1024; return p.in[I_WBR] + ((size_t)l * 4 + 3) * 256 * 1024 + n;
    case 7: ld = 1024; return p.in[I_WOUT] + (size_t)l * 1024 * 1024 + n;
    case 8: { ld = 256; const int e = n >> 9, r = n & 511; const int t = r >> 7, wn = (r & 127) >> 5, nt = (r & 31) >> 4, i = r & 15; const int f = t * 64 + wn * 16 + i;
        return (nt ? p.in[I_MUP] : p.in[I_MGATE]) + ((size_t)l * 16 + e) * 1024 * 256 + f; }
    default: { ld = 1024; const int e = n >> 10, c = n & 1023; return p.in[I_MDOWN] + ((size_t)l * 16 + e) * 256 * 1024 + c; }
    }
}
PHASE_FN void ph_prologue(const Params& p, char* lds_unused) {
    char* lds = lds_dyn; (void)lds_unused;
    const int tid = tidx(), bid = bidx(), G = gdim();
    {
        float* sc = (float*)lds;
        float* red = sc + 3072;
        for (int i = tid; i < 3072; i += 512) { const int v = i >> 10, k = i & 1023; const float x = v < 2 ? p.in[I_C][v * 1024 + k] : p.in[I_CCTX][k]; sc[i] = silu_f(x); }
        __syncthreads();
        for (int u = bid; u < 192; u += G) {
            const int l = u / 96, j0 = (u % 96) * 64, kg = tid >> 6, j = tid & 63;
            const float* w = p.in[I_ADAW] + (size_t)l * 1024 * 6144 + j0 + j;
            float a0 = 0.f, a1 = 0.f, a2 = 0.f;
#pragma unroll 8
            for (int k = kg * 128; k < kg * 128 + 128; ++k) { const float wv = w[(size_t)k * 6144]; a0 += sc[k] * wv; a1 += sc[1024 + k] * wv; a2 += sc[2048 + k] * wv; }
            red[(0 * 8 + kg) * 64 + j] = a0; red[(1 * 8 + kg) * 64 + j] = a1; red[(2 * 8 + kg) * 64 + j] = a2;
            __syncthreads();
            if (tid < 192) { const int v = tid >> 6, jj = tid & 63; float s = p.in[I_ADAB][(size_t)l * 6144 + j0 + jj];
#pragma unroll
                for (int g = 0; g < 8; ++g) s += red[(v * 8 + g) * 64 + jj];
                WSP(float, OFF_MOD)[((size_t)l * 3 + v) * 6144 + j0 + jj] = s; }
            __syncthreads();
        }
    }
    for (int i = bid * 512 + tid; i < 2048; i += G * 512) {
        const int pos = i >> 3, f = i & 7; const float inv = powf(10000.f, -(float)f / 8.f); float s, c; sincos_rad((float)pos * inv, s, c);
        WSP(float2, OFF_ROPE)[i] = make_float2(c, s);
    }
    for (int i = bid * 512 + tidx(); i < NLAYER * 1024 * 64; i += G * 512) { const int l = i >> 16, col = (i >> 6) & 1023, j = i & 63;
        WSP(bf16_t, OFF_W3T)[i] = f2bf(p.in[I_HYW3][(size_t)l * 64 * 1024 + (size_t)j * 1024 + col]); }
    {
        float* w1 = (float*)lds;
        float* w2 = w1 + 33 * 64;
        float* vb = w2 + 64 * 64;
        float* zz = vb + 256;
        float* h1 = zz + 8 * 36;
        for (int l = 0; l < NLAYER; ++l) {
            __syncthreads();
            for (int i = tid; i < 33 * 64; i += 512) w1[i] = p.in[I_HYW1][(size_t)l * 33 * 64 + i];
            for (int i = tid; i < 64 * 64; i += 512) w2[i] = p.in[I_HYW2][(size_t)l * 64 * 64 + i];
            if (tid < 64) { vb[tid] = p.in[I_HYB1][l * 64 + tid]; vb[64 + tid] = p.in[I_HYF1][l * 64 + tid]; vb[128 + tid] = p.in[I_HYB2][l * 64 + tid]; vb[192 + tid] = p.in[I_HYF2][l * 64 + tid]; }
            __syncthreads();
            const int nchunks = (16384 + 256) / 8;
            for (int ch = bid; ch < nchunks; ch += G) {
                const bool isc = ch >= 2048; const int L = isc ? 256 : 16384; const int n = (isc ? ch - 2048 : ch) * 8 + (tid >> 6);
                const int nl = tid >> 6, j = tid & 63;
                if (j < 33) {
                    float v;
                    if (j == 0) v = (float)n / (float)(L - 1);
                    else { const int bi = (j - 1) & 15; const float band = 1e-4f + (float)bi * ((15.f - 1e-4f) / 15.f); float s, c; sincos_turns((float)n * band / (float)L, s, c); v = j <= 16 ? c : -s; }
                    zz[nl * 36 + j] = v;
                }
                __syncthreads();
                { float a = vb[j];
#pragma unroll
                  for (int i = 0; i < 33; ++i) a += zz[nl * 36 + i] * w1[i * 64 + j];
                  h1[nl * 64 + j] = sinf(vb[64 + j] * a); }
                __syncthreads();
                { float a = vb[128 + j];
#pragma unroll 16
                  for (int i = 0; i < 64; ++i) a += h1[nl * 64 + i] * w2[i * 64 + j];
                  const float r = sinf(vb[192 + j] * a);
                  if (isc) WSP(float, OFF_H2C)[((size_t)l * 256 + n) * 64 + j] = r; else WSP(bf16_t, OFF_H2L)[((size_t)l * 16384 + n) * 64 + j] = f2bf(r); }
                __syncthreads();
            }
        }
    }
}
template <int JOB, int N, int K>
__device__ __forceinline__ void wconv_job(const Params& p, int l, size_t we, const float* scale, char* lds) {
    float* tile = (float*)lds;
    const int tid = tidx();
    constexpr int NKT = K / 64, NT = (N / 64) * NKT;
    float xa[8], xb[8];
    auto fetch = [&](int v, float (&x)[8]) { const int n0 = (v / NKT) * 64, k0 = (v % NKT) * 64; const int nn = tid & 63, kk = tid >> 6; int ld; const float* src = wsrc(p, l, JOB, n0 + nn, ld);
#pragma unroll
        for (int i = 0; i < 8; ++i) { const int k = kk + 8 * i; float t = src ? src[(size_t)(k0 + k) * ld] : 0.f; if (scale) t *= scale[k0 + k]; x[i] = t; } };
    if (bidx() < NT) fetch(bidx(), xa);
    for (int v = bidx(); v < NT; v += gdim()) {
        const int n0 = (v / NKT) * 64, k0 = (v % NKT) * 64;
        if (v + gdim() < NT) fetch(v + gdim(), xb);
        __syncthreads();
        { const int nn = tid & 63, kk = tid >> 6;
#pragma unroll
          for (int i = 0; i < 8; ++i) { const int k = kk + 8 * i; tile[k * 65 + nn] = xa[i]; } }
#pragma unroll
        for (int i = 0; i < 8; ++i) xa[i] = xb[i];
        __syncthreads();
        if (JOB == 1) {
          const int nn = tid >> 3, kc = tid & 7; float v[8];
#pragma unroll
          for (int i = 0; i < 8; ++i) v[i] = tile[(kc * 8 + i) * 65 + nn] * 64.f;
          u32x2 w; int t0 = 0, t1 = 0;
          t0 = __builtin_amdgcn_cvt_pk_fp8_f32(v[0], v[1], t0, false); t0 = __builtin_amdgcn_cvt_pk_fp8_f32(v[2], v[3], t0, true);
          t1 = __builtin_amdgcn_cvt_pk_fp8_f32(v[4], v[5], t1, false); t1 = __builtin_amdgcn_cvt_pk_fp8_f32(v[6], v[7], t1, true);
          w.x = (unsigned)t0; w.y = (unsigned)t1;
          *(u32x2*)((char*)wts(p, l, we) + (size_t)(n0 + nn) * K + k0 + kc * 8) = w;
        } else
        { const int nn = tid >> 3, kc = tid & 7; u32x4 w;
          w.x = cvt_pk_bf16(tile[(kc * 8 + 0) * 65 + nn], tile[(kc * 8 + 1) * 65 + nn]); w.y = cvt_pk_bf16(tile[(kc * 8 + 2) * 65 + nn], tile[(kc * 8 + 3) * 65 + nn]);
          w.z = cvt_pk_bf16(tile[(kc * 8 + 4) * 65 + nn], tile[(kc * 8 + 5) * 65 + nn]); w.w = cvt_pk_bf16(tile[(kc * 8 + 6) * 65 + nn], tile[(kc * 8 + 7) * 65 + nn]);
          *(u32x4*)(wts(p, l, we) + (size_t)(n0 + nn) * K + k0 + kc * 8) = w; }
    }
}
PHASE_FN void ph_wconv(const Params& p, int l, char* lds_unused) {
    char* lds = lds_dyn; (void)lds_unused;
    const int tid = tidx(), bid = bidx(), G = gdim();
    wconv_job<0, 2304, 1024>(p, l, WE_W1T, nullptr, lds);
    wconv_job<1, 4096, 1024>(p, l, WE_WGT, nullptr, lds);
    wconv_job<2, 384, 256>(p, l, WE_WUQ, p.in[I_QNORM] + l * 256, lds);
    wconv_job<3, 512, 128>(p, l, WE_WUKV, p.in[I_KVNORM] + l * 128, lds);
    wconv_job<4, 1024, 256>(p, l, WE_WBA, nullptr, lds);
    wconv_job<5, 1024, 256>(p, l, WE_WBB, nullptr, lds);
    wconv_job<6, 1024, 256>(p, l, WE_WBD, nullptr, lds);
    wconv_job<7, 1024, 1024>(p, l, WE_WOUT, nullptr, lds);
    wconv_job<8, 8192, 1024>(p, l, WE_WGU, nullptr, lds);
    wconv_job<9, 16384, 256>(p, l, WE_WDN, nullptr, lds);
    __syncthreads();
    {
        float* cs = (float*)lds;
        __syncthreads();
        if (tid < 64) { float s, c; sincospif(2.f * (float)tid / 64.f, &s, &c); cs[tid] = c; cs[64 + tid] = s; }
        __syncthreads();
        for (int idx = bid * 512 + tid; idx < 512 * 1024; idx += G * 512) {
            const int r = idx; const int n = r & 1023, kp = r >> 10; const int part = kp >> 8, g = (kp & 255) >> 6, c = kp & 63;
            const float* wb = p.in[I_WBR] + ((size_t)l * 4 + 2) * 256 * 1024 + (size_t)(g * 64) * 1024 + n;
            float s = 0.f;
#pragma unroll 8
            for (int k2 = 0; k2 < 64; ++k2) s += cs[part * 64 + ((k2 * c) & 63)] * wb[(size_t)k2 * 1024];
            wts(p, l, WE_WBC)[(size_t)n * 512 + kp] = f2bf(s * (1.f / 1024.f));
        }
    }
}

__device__ __forceinline__ bool skip_tile(int l, int tile) { return (l == NLAYER - 1) && ((tile % 130) >= 128); }
__device__ __forceinline__ float row16_sum(float x) {
    x += __int_as_float(__builtin_amdgcn_update_dpp(0, __float_as_int(x), 0xB1, 0xf, 0xf, true));
    x += __int_as_float(__builtin_amdgcn_update_dpp(0, __float_as_int(x), 0x4E, 0xf, 0xf, true));
    x += __int_as_float(__builtin_amdgcn_update_dpp(0, __float_as_int(x), 0x141, 0xf, 0xf, true));
    x += __int_as_float(__builtin_amdgcn_update_dpp(0, __float_as_int(x), 0x140, 0xf, 0xf, true));
    return x;
}
template <int WHICH>
PHASE_FN void ph_norm(const Params& p, int l, char* lds_unused) {
    char* lds = lds_dyn; (void)lds_unused;
    const int tid = tidx(), wid = tid >> 6, lane = tid & 63, sub = lane >> 4, l16 = lane & 15;
    float* Wr = (float*)lds;
    int* lcount = (int*)(lds + 81920);
    int* lbase = lcount + 32;
    int* pidl = lbase + 32;
    int* rankl = pidl + 128;
    if (WHICH >= 1) {
        for (int i = tid; i < 20 * 1024; i += 512) { const int j = i >> 10, k = i & 1023;
            Wr[i] = j < 4 ? p.in[I_MWG][(size_t)l * 4096 + k * 4 + j] : p.in[I_MWE][(size_t)l * 16384 + k * 16 + (j - 4)]; }
        __syncthreads();
    }
    const float* gain = (WHICH == 0 ? p.in[I_N1G] : p.in[I_N2G]) + l * 1024; float sink = 0.f;
    bf16_t* H = WSP(bf16_t, OFF_H);
    float* At = (float*)(lds + 90112); float* Bt = At + 3072;
    for (int i = tid; i < 3072; i += 512) { const int mi = i >> 10, c = i & 1023; const float* mvb = WSP(float, OFF_MOD) + ((size_t)l * 3 + mi) * 6144 + (WHICH == 0 ? 0 : 3072);
        At[i] = gain[c] * (1.f + mvb[1024 + c]); Bt[i] = mvb[c]; }
    __syncthreads();
    f32x4 vn[16]; bool have = false;
#pragma unroll
    for (int i = 0; i < 16; ++i) vn[i] = (f32x4){0.f, 0.f, 0.f, 0.f};
    for (int tile = bidx(); tile < NTILE * 4; tile += gdim()) {
        if (WHICH >= 1 && skip_tile(l, tile >> 2)) continue;
        if (WHICH == 1) { __syncthreads(); if (tid < 24) lcount[tid] = 0; __syncthreads(); }
        {
            const int rloc = wid * 4 + sub, r = tile * 32 + rloc;
            const float* xr = (WHICH == 0 && l == 0) ? xrow_in(p, r) : xrow_st(p, r);
            const int mi = ((tile * 32) % TPB) < SEQ ? (tile * 32 >= TPB ? 1 : 0) : 2;
            f32x4 v[16]; float ss = 0.f;
            if (have) {
#pragma unroll
                for (int i = 0; i < 16; ++i) { v[i] = vn[i]; ss += v[i][0] * v[i][0] + v[i][1] * v[i][1] + v[i][2] * v[i][2] + v[i][3] * v[i][3]; }
            } else {
#pragma unroll
                for (int i = 0; i < 16; ++i) { v[i] = *(const f32x4*)(xr + 4 * (l16 + 16 * i)); ss += v[i][0] * v[i][0] + v[i][1] * v[i][1] + v[i][2] * v[i][2] + v[i][3] * v[i][3]; }
            }
            { int nt_ = tile + gdim(); while (WHICH >= 1 && nt_ < NTILE * 4 && skip_tile(l, nt_ >> 2)) nt_ += gdim();
              have = nt_ < NTILE * 4;
              if (have) { const int rn = nt_ * 32 + rloc; const float* xn = (WHICH == 0 && l == 0) ? xrow_in(p, rn) : xrow_st(p, rn);
#pragma unroll
                  for (int i = 0; i < 16; ++i) vn[i] = *(const f32x4*)(xn + 4 * (l16 + 16 * i)); }
              else {
#pragma unroll
                  for (int i = 0; i < 16; ++i) vn[i] = (f32x4){0.f, 0.f, 0.f, 0.f}; } }
            __builtin_amdgcn_sched_barrier(0);
            ss = row16_sum(ss);
            const float rinv = rsqrtf(ss * (1.f / 1024.f) + 1e-6f);
#pragma unroll
            for (int i = 0; i < 16; ++i) {
                const int c0 = 4 * (l16 + 16 * i);
                const f32x4 a4 = *(const f32x4*)(At + mi * 1024 + c0), b4 = *(const f32x4*)(Bt + mi * 1024 + c0);
#pragma unroll
                for (int e = 0; e < 4; ++e) v[i][e] = (v[i][e] * rinv) * a4[e] + b4[e];
                u32x2 w; w.x = cvt_pk_bf16(v[i][0], v[i][1]); w.y = cvt_pk_bf16(v[i][2], v[i][3]);
                *(u32x2*)(H + (size_t)r * 1024 + c0) = w;
                if ((i & 3) == 3) __builtin_amdgcn_sched_barrier(0);
            }
            if (WHICH >= 1) {
                float lg[20];
                int wofs = 4 * l16; asm volatile("" : "+v"(wofs));
#pragma unroll
                for (int j = 0; j < 20; ++j) { f32x2 a2 = {0.f, 0.f};
#pragma unroll
                    for (int i = 0; i < 16; ++i) { const f32x4 w = *(const f32x4*)(Wr + j * 1024 + wofs + 64 * i);
                        a2 = __builtin_elementwise_fma(__builtin_shufflevector(v[i], v[i], 0, 1), __builtin_shufflevector(w, w, 0, 1), a2);
                        a2 = __builtin_elementwise_fma(__builtin_shufflevector(v[i], v[i], 2, 3), __builtin_shufflevector(w, w, 2, 3), a2);
                        if ((i & 7) == 7) __builtin_amdgcn_sched_barrier(0); }
                    lg[j] = row16_sum(a2[0] + a2[1]); __builtin_amdgcn_sched_barrier(0); }
#pragma unroll
                for (int j = 0; j < 4; ++j) lg[j] += p.in[I_MBG][l * 4 + j];
#pragma unroll
                for (int j = 0; j < 16; ++j) lg[4 + j] += p.in[I_MBE][l * 16 + j];
                int g = 0; float gm = lg[0];
#pragma unroll
                for (int j = 1; j < 4; ++j) if (lg[j] > gm) { gm = lg[j]; g = j; }
                float gs = 0.f;
#pragma unroll
                for (int j = 0; j < 4; ++j) gs += __expf(lg[j] - gm);
                const float gp = 1.f / gs;
                float e4[4];
#pragma unroll
                for (int j = 0; j < 4; ++j) e4[j] = g == 0 ? lg[4 + j] : g == 1 ? lg[8 + j] : g == 2 ? lg[12 + j] : lg[16 + j];
                int i1 = 0; float m1 = e4[0];
#pragma unroll
                for (int j = 1; j < 4; ++j) if (e4[j] > m1) { m1 = e4[j]; i1 = j; }
                int i2 = -1; float m2 = -3.4e38f;
#pragma unroll
                for (int j = 0; j < 4; ++j) if (j != i1 && e4[j] > m2) { m2 = e4[j]; i2 = j; }
                const float x2 = __expf(m2 - m1); const float pw1 = gp / (1.f + x2), pw2 = gp * x2 / (1.f + x2);
                const int lo = i1 < i2 ? i1 : i2, hi = i1 < i2 ? i2 : i1;
                const float wlo = i1 < i2 ? pw1 : pw2, whi = i1 < i2 ? pw2 : pw1;
                const int pairidx = lo == 0 ? hi - 1 : lo == 1 ? hi + 1 : 5;
                if (WHICH == 2) sink += wlo + whi + (float)pairidx;
                if (l16 == 0 && WHICH == 1) { pidl[rloc] = g * 6 + pairidx; WSP(float, OFF_TOKW)[(size_t)r * 2] = wlo; WSP(float, OFF_TOKW)[(size_t)r * 2 + 1] = whi; }
            }
        }
        if (WHICH == 2) asm volatile("" :: "v"(sink));
        if (WHICH == 1) {
            __syncthreads();
            int mypid = 0;
            if (tid < 32) { mypid = pidl[tid]; rankl[tid] = atomicAdd(&lcount[mypid], 1); }
            __syncthreads();
            if (tid < 24) lbase[tid] = lcount[tid] ? atomicAdd(WSP(int, OFF_CNT) + l * 32 + tid, lcount[tid]) : 0;
            __syncthreads();
            if (tid < 32) WSP(int, OFF_LISTS)[(size_t)mypid * T + lbase[mypid] + rankl[tid]] = tile * 32 + tid;
        }
    }
}

PHASE_FN void ph_filt(const Params& p, int l, char* lds_unused) {
    char* lds = lds_dyn; (void)lds_unused;
    const int tid = tidx(), lane = tid & 63, wid = tid >> 6, wm = wid >> 2, wn = wid & 3, fr = lane & 15, fq = lane >> 4;
    const bf16_t* A = WSP(const bf16_t, OFF_H2L) + (size_t)l * 16384 * 64; const bf16_t* B = WSP(const bf16_t, OFF_W3T) + (size_t)l * 1024 * 64;
    bf16_t* F = WSP(bf16_t, OFF_FILT);
    for (int u = bidx(); u < 128 * 8; u += gdim()) {
        const int n0 = (u >> 3) * 128, c0 = (u & 7) * 128;
        const bf16_t* a0 = A + (size_t)(n0 + g_srow()) * 64 + g_skc() * 8; const bf16_t* b0 = B + (size_t)(c0 + g_srow()) * 64 + g_skc() * 8;
        f32x4 acc[4][2]; acc_zero(acc);
        mma_seg<0, 0>(acc, a0, a0 + (size_t)64 * 64, 0, b0, b0 + (size_t)64 * 64, 64, lds);
#pragma unroll
        for (int mt = 0; mt < 4; ++mt)
#pragma unroll
            for (int nt = 0; nt < 2; ++nt) { const int n = n0 + wm * 64 + mt * 16 + fq * 4, col = c0 + wn * 32 + nt * 16 + fr;
                u32x2 w; w.x = cvt_pk_bf16(acc[mt][nt][0], acc[mt][nt][1]); w.y = cvt_pk_bf16(acc[mt][nt][2], acc[mt][nt][3]);
                *(u32x2*)(F + (size_t)col * 16384 + n) = w; }
    }
}

PHASE_FN void ph_gemm1(const Params& p, int l, char* lds_unused);

#define KSWZ(row, colB) ((row) * 256 + ((colB) ^ (((row) & 7) << 4)))
#define SBAR() __builtin_amdgcn_sched_barrier(0)
__device__ __forceinline__ int crow(int r, int hi) { return (r & 3) + 8 * (r >> 2) + 4 * hi; }
__device__ __forceinline__ int v_st(int k, int c) { const int kk = (k & ~0xC) | ((k & 4) << 1) | ((k & 8) >> 1); return ((kk >> 3) * 2 + (c >> 5)) * 512 + ((kk & 7) * 32 + (c & 31)) * 2; }
__device__ __forceinline__ int v_rd_base(int lane) { return ((lane & 3) << 3) | (((lane >> 2) & 3) << 6) | (((lane >> 4) & 1) << 5) | (((lane >> 5) & 1) << 8); }
constexpr int v_rd_off(int d0, int ks, int half) { return d0 * 512 + ks * 2048 + half * 1024; }
template <int OFF> __device__ __forceinline__ s16x4 tr_read(int vb) {
    s16x4 r; asm volatile("ds_read_b64_tr_b16 %0, %1 offset:%2" : "=&v"(r) : "v"(vb), "i"(OFF) : "memory"); return r;
}
template <int D0> __device__ __forceinline__ void pv_one(f32x16& od, int vb, bf16x8 pa0, bf16x8 pa1, bf16x8 pa2, bf16x8 pa3) {
    const s16x4 l0 = tr_read<v_rd_off(D0, 0, 0)>(vb), h0 = tr_read<v_rd_off(D0, 0, 1)>(vb), l1 = tr_read<v_rd_off(D0, 1, 0)>(vb), h1 = tr_read<v_rd_off(D0, 1, 1)>(vb);
    const s16x4 l2 = tr_read<v_rd_off(D0, 2, 0)>(vb), h2 = tr_read<v_rd_off(D0, 2, 1)>(vb), l3 = tr_read<v_rd_off(D0, 3, 0)>(vb), h3 = tr_read<v_rd_off(D0, 3, 1)>(vb);
    asm volatile("s_waitcnt lgkmcnt(0)" ::: "memory"); SBAR();
#define PKV(L, H) (bf16x8){L[0], L[1], L[2], L[3], H[0], H[1], H[2], H[3]}
    od = __builtin_amdgcn_mfma_f32_32x32x16_bf16(pa0, PKV(l0, h0), od, 0, 0, 0);
    od = __builtin_amdgcn_mfma_f32_32x32x16_bf16(pa1, PKV(l1, h1), od, 0, 0, 0);
    od = __builtin_amdgcn_mfma_f32_32x32x16_bf16(pa2, PKV(l2, h2), od, 0, 0, 0);
    od = __builtin_amdgcn_mfma_f32_32x32x16_bf16(pa3, PKV(l3, h3), od, 0, 0, 0);
#undef PKV
}
constexpr int ATT_LDS = 16384 + 32768 + 2048;
constexpr float ATT_THR = 8.f;
template <int DQK, int NA>
__device__ __forceinline__ void attn_unit(const bf16_t* __restrict__ Qb, int ldq, const bf16_t* __restrict__ Kb, int ldk, const bf16_t* __restrict__ Vb, int ldv,
                                          bf16_t* __restrict__ Ob, int ldo, int NT, int nA, int baseA, int baseB, char* lds, const float* biasL, int qrow0, int krow_lo) {
    constexpr float SCALE = DQK == 96 ? 0.10206207261596575f : 0.125f;
    constexpr float C = SCALE * 1.4426950408889634f;
    constexpr int ND = DQK / 16, NKC = DQK / 8;
    const int tid = tidx(), wid = tid >> 6, lane = tid & 63, r32 = lane & 31, hi = lane >> 5;
    char* V_lds = lds; char* K_lds = lds + 16384;
    float* wsf = (float*)(lds + 49152) + wid * 64; float* al_l = wsf; float* li_l = wsf + 32;
    bf16x8 qr[ND];
    { const bf16_t* Qw = Qb + (size_t)(wid * 32 + r32) * ldq + hi * 8;
#pragma unroll
      for (int d0 = 0; d0 < ND; ++d0) qr[d0] = *(const bf16x8*)(Qw + d0 * 16); }
    const int vrow = tid >> 3, vc = (tid & 7) * 8, vst = v_st(vrow, vc);
    const int k0row = tid / NKC, k0c = tid % NKC, kst0 = KSWZ(k0row, k0c * 16);
    const int id1 = tid + 512; const bool has1 = (DQK == 96) && (id1 < 64 * NKC);
    const int k1row = has1 ? id1 / NKC : 0, k1c = has1 ? id1 % NKC : 0, kst1 = KSWZ(k1row, k1c * 16);
    const int vb0 = (int)(uintptr_t)V_lds + v_rd_base(lane);
    bf16x8 sv, sk0, sk1;
    auto SLOAD = [&](int j) { const size_t t0 = (size_t)(j < nA ? baseA + 64 * j : baseB + 64 * (j - nA));
        sv = *(const bf16x8*)(Vb + (t0 + vrow) * ldv + vc); sk0 = *(const bf16x8*)(Kb + (t0 + k0row) * ldk + k0c * 8);
        if (has1) sk1 = *(const bf16x8*)(Kb + (t0 + k1row) * ldk + k1c * 8); };
    auto SWRITE = [&](int b) { *(bf16x8*)(V_lds + b * 8192 + vst) = sv; *(bf16x8*)(K_lds + b * 16384 + kst0) = sk0; if (has1) *(bf16x8*)(K_lds + b * 16384 + kst1) = sk1; };
    float m_reg = -1e30f, l_reg = 0.f; f32x16 o0 = {}, o1 = {};
    __syncthreads();
    SLOAD(0); SWRITE(0); __syncthreads();
    for (int j = 0; j < NT; ++j) {
        const int bsel = j & 1;
        if (j + 1 < NT) SLOAD(j + 1);
        f32x16 p0 = {}, p1 = {};
        { const char* Ks = K_lds + bsel * 16384;
#pragma unroll
          for (int d0 = 0; d0 < ND; ++d0) { const int cb = d0 * 32 + hi * 16;
            const bf16x8 b0 = *(const bf16x8*)(Ks + KSWZ(r32, cb)); const bf16x8 b1 = *(const bf16x8*)(Ks + KSWZ(32 + r32, cb));
            p0 = __builtin_amdgcn_mfma_f32_32x32x16_bf16(b0, qr[d0], p0, 0, 0, 0);
            p1 = __builtin_amdgcn_mfma_f32_32x32x16_bf16(b1, qr[d0], p1, 0, 0, 0); } }
        if (NA) {
            if (j >= nA) {
                const int krow = krow_lo + (j - nA), qrow = qrow0 + (wid >> 1);
                int ws = qrow - 4; ws = ws < 0 ? 0 : (ws > 248 ? 248 : ws);
                const bool rowok = (krow >= ws) && (krow < ws + 8);
                const int qc = 32 * (wid & 1) + r32; int cs = qc - 8; cs = cs < 0 ? 0 : (cs > 48 ? 48 : cs);
                int dri = krow - qrow + 7; dri = dri < 0 ? 0 : (dri > 14 ? 14 : dri);
                const float* brow = biasL + dri * 31 + 15 - qc;
#pragma unroll
                for (int r = 0; r < 16; ++r) { const int kc = crow(r, hi); const bool ok = rowok && kc >= cs && kc < cs + 16; float bv = 0.f; if (ok) bv = brow[kc]; p0[r] = ok ? p0[r] + bv : -1e30f; }
#pragma unroll
                for (int r = 0; r < 16; ++r) { const int kc = 32 + crow(r, hi); const bool ok = rowok && kc >= cs && kc < cs + 16; float bv = 0.f; if (ok) bv = brow[kc]; p1[r] = ok ? p1[r] + bv : -1e30f; }
            }
        }
        float pmax = p0[0];
#pragma unroll
        for (int r = 1; r < 16; ++r) pmax = fmaxf(pmax, p0[r]);
#pragma unroll
        for (int r = 0; r < 16; ++r) pmax = fmaxf(pmax, p1[r]);
        { auto rr = __builtin_amdgcn_permlane32_swap(__float_as_uint(pmax), __float_as_uint(pmax), false, false); pmax = fmaxf(__uint_as_float(rr[0]), __uint_as_float(rr[1])); }
        float mn, alpha;
        if (__all(pmax - m_reg <= ATT_THR / SCALE)) { mn = m_reg; alpha = 1.f; }
        else { mn = fmaxf(m_reg, pmax); alpha = __builtin_amdgcn_exp2f((m_reg - mn) * C); m_reg = mn; }
        const float mnC = -mn * C;
        float ps = 0.f;
#pragma unroll
        for (int r = 0; r < 16; ++r) { p0[r] = __builtin_amdgcn_exp2f(fmaf(p0[r], C, mnC)); ps += p0[r]; }
#pragma unroll
        for (int r = 0; r < 16; ++r) { p1[r] = __builtin_amdgcn_exp2f(fmaf(p1[r], C, mnC)); ps += p1[r]; }
        { auto rr = __builtin_amdgcn_permlane32_swap(__float_as_uint(ps), __float_as_uint(ps), false, false); ps = __uint_as_float(rr[0]) + __uint_as_float(rr[1]); }
        l_reg = l_reg * alpha + ps;
        bf16x8 pa0, pa1, pa2, pa3;
#define PK4(P, BASE, OUT) do { unsigned a0_ = cvt_pk_bf16(P[BASE + 0], P[BASE + 1]), a1_ = cvt_pk_bf16(P[BASE + 2], P[BASE + 3]);   \
        unsigned b0_ = cvt_pk_bf16(P[BASE + 4], P[BASE + 5]), b1_ = cvt_pk_bf16(P[BASE + 6], P[BASE + 7]);                              \
        auto r0_ = __builtin_amdgcn_permlane32_swap(a0_, b0_, false, false); auto r1_ = __builtin_amdgcn_permlane32_swap(a1_, b1_, false, false); \
        u32x4 w_ = {r0_[0], r1_[0], r0_[1], r1_[1]}; OUT = *reinterpret_cast<bf16x8*>(&w_); } while (0)
        PK4(p0, 0, pa0); PK4(p0, 8, pa1); PK4(p1, 0, pa2); PK4(p1, 8, pa3);
#undef PK4
        if (__any(alpha < 1.f)) {
            if (hi == 0) al_l[r32] = alpha;
            asm volatile("s_waitcnt lgkmcnt(0)" ::: "memory");
#pragma unroll
            for (int r = 0; r < 16; ++r) { const float a = al_l[crow(r, hi)]; o0[r] *= a; o1[r] *= a; }
        }
        pv_one<0>(o0, vb0 + bsel * 8192, pa0, pa1, pa2, pa3);
        pv_one<1>(o1, vb0 + bsel * 8192, pa0, pa1, pa2, pa3);
        if (j + 1 < NT) SWRITE(bsel ^ 1);
        __syncthreads();
    }
    if (hi == 0) li_l[r32] = l_reg;
    asm volatile("s_waitcnt lgkmcnt(0)" ::: "memory");
    bf16_t* Ow = Ob + (size_t)(wid * 32) * ldo;
#pragma unroll
    for (int r = 0; r < 16; ++r) { const int orow = crow(r, hi); const float rl = __builtin_amdgcn_rcpf(li_l[orow]);
        Ow[(size_t)orow * ldo + r32] = f2bf(o0[r] * rl); Ow[(size_t)orow * ldo + 32 + r32] = f2bf(o1[r] * rl); }
    __syncthreads();
}

__device__ __forceinline__ void mla_partialSM(f32x16& p0, f32x16& p1, float& m_reg, float& alpha, bool first) {
    constexpr float THR2 = ATT_THR * 1.4426950408889634f;
    float pmax = p0[0];
#pragma unroll
    for (int r = 1; r < 16; ++r) pmax = fmaxf(pmax, p0[r]);
#pragma unroll
    for (int r = 0; r < 16; ++r) pmax = fmaxf(pmax, p1[r]);
    { auto rr = __builtin_amdgcn_permlane32_swap(__float_as_uint(pmax), __float_as_uint(pmax), false, false); pmax = fmaxf(__uint_as_float(rr[0]), __uint_as_float(rr[1])); }
    if (__builtin_expect(!first && __all(pmax <= THR2), 1)) { alpha = 1.f; }
    else { const float d = first ? pmax : fmaxf(pmax, 0.f); alpha = first ? 1.f : __builtin_amdgcn_exp2f(-d); m_reg += d;
#pragma unroll
        for (int r = 0; r < 16; ++r) { p0[r] -= d; p1[r] -= d; } }
#pragma unroll
    for (int r = 0; r < 16; ++r) p0[r] = __builtin_amdgcn_exp2f(p0[r]);
}
__device__ __forceinline__ void mla_finishSM(f32x16& p0, f32x16& p1, float alpha, float& l_reg, bf16x8& pa0, bf16x8& pa1, bf16x8& pa2, bf16x8& pa3) {
#pragma unroll
    for (int r = 0; r < 16; ++r) p1[r] = __builtin_amdgcn_exp2f(p1[r]);
    f32x2 s2 = {p0[0], p0[1]}, t2 = {p1[0], p1[1]};
#pragma unroll
    for (int r = 2; r < 16; r += 2) { s2 += (f32x2){p0[r], p0[r + 1]}; t2 += (f32x2){p1[r], p1[r + 1]}; }
    s2 += t2; float ps = s2[0] + s2[1];
    { auto rr = __builtin_amdgcn_permlane32_swap(__float_as_uint(ps), __float_as_uint(ps), false, false); ps = __uint_as_float(rr[0]) + __uint_as_float(rr[1]); }
    l_reg = l_reg * alpha + ps;
#define PK4(P, BASE, OUT) do { unsigned a0_ = cvt_pk_bf16(P[BASE + 0], P[BASE + 1]), a1_ = cvt_pk_bf16(P[BASE + 2], P[BASE + 3]);   \
    unsigned b0_ = cvt_pk_bf16(P[BASE + 4], P[BASE + 5]), b1_ = cvt_pk_bf16(P[BASE + 6], P[BASE + 7]);                              \
    auto r0_ = __builtin_amdgcn_permlane32_swap(a0_, b0_, false, false); auto r1_ = __builtin_amdgcn_permlane32_swap(a1_, b1_, false, false); \
    u32x4 w_ = {r0_[0], r1_[0], r0_[1], r1_[1]}; OUT = *reinterpret_cast<bf16x8*>(&w_); } while (0)
    PK4(p0, 0, pa0); PK4(p0, 8, pa1); PK4(p1, 0, pa2); PK4(p1, 8, pa3);
#undef PK4
}
__device__ __forceinline__ void mla_qkt(f32x16& p0, f32x16& p1, const char* Ks, const bf16x8* qr, int r32, int hi, float init) {
#pragma unroll
    for (int r = 0; r < 16; ++r) { p0[r] = init; p1[r] = init; }
#pragma unroll
    for (int d0 = 0; d0 < 6; ++d0) { const int cb = d0 * 32 + hi * 16;
        const bf16x8 b0 = *(const bf16x8*)(Ks + KSWZ(r32, cb)); const bf16x8 b1 = *(const bf16x8*)(Ks + KSWZ(32 + r32, cb));
        p0 = __builtin_amdgcn_mfma_f32_32x32x16_bf16(b0, qr[d0], p0, 0, 0, 0);
        p1 = __builtin_amdgcn_mfma_f32_32x32x16_bf16(b1, qr[d0], p1, 0, 0, 0); }
}
__device__ __forceinline__ void mla_unit(const bf16_t* __restrict__ Qb, const bf16_t* __restrict__ Kb, const bf16_t* __restrict__ Vb, bf16_t* __restrict__ Ob,
                                         int NT, int nA, int baseA, int baseB, char* lds) {
    constexpr int ldq = 384, ldk = 384, ldv = 256, ldo = 512;
    const int tid = tidx(), wid = tid >> 6, lane = tid & 63, r32 = lane & 31, hi = lane >> 5;
    char* V_lds = lds; char* K_lds = lds + 16384;
    float* wsf = (float*)(lds + 49152) + wid * 64; float* al_l = wsf; float* li_l = wsf + 32;
    bf16x8 qr[6];
    { const bf16_t* Qw = Qb + (size_t)(wid * 32 + r32) * ldq + hi * 8;
#pragma unroll
      for (int d0 = 0; d0 < 6; ++d0) qr[d0] = *(const bf16x8*)(Qw + d0 * 16); }
    const int vrow = tid >> 3, vc = (tid & 7) * 8, vst = v_st(vrow, vc);
    const int k0row = tid / 12, k0c = tid % 12, kst0 = KSWZ(k0row, k0c * 16);
    const int id1 = tid + 512; const bool has1 = id1 < 768;
    const int k1row = has1 ? id1 / 12 : 0, k1c = has1 ? id1 % 12 : 0, kst1 = KSWZ(k1row, k1c * 16);
    const int vb0 = (int)(uintptr_t)V_lds + v_rd_base(lane);
    bf16x8 sv, sk0, sk1;
    auto SLOAD = [&](int j) { const size_t t0 = (size_t)(j < nA ? baseA + 64 * j : baseB + 64 * (j - nA));
        sv = *(const bf16x8*)(Vb + (t0 + vrow) * ldv + vc); sk0 = *(const bf16x8*)(Kb + (t0 + k0row) * ldk + k0c * 8);
        if (has1) sk1 = *(const bf16x8*)(Kb + (t0 + k1row) * ldk + k1c * 8); };
    auto SWRITE = [&](int b) { *(bf16x8*)(V_lds + b * 8192 + vst) = sv; *(bf16x8*)(K_lds + b * 16384 + kst0) = sk0; if (has1) *(bf16x8*)(K_lds + b * 16384 + kst1) = sk1; };
#define MLA_RESC(a) do { if (__any((a) < 1.f)) { if (hi == 0) al_l[r32] = (a); asm volatile("s_waitcnt lgkmcnt(0)" ::: "memory"); \
    _Pragma("unroll") for (int r = 0; r < 16; ++r) { const float a_ = al_l[crow(r, hi)]; o0[r] *= a_; o1[r] *= a_; } } } while (0)
    float m_reg = 0.f, l_reg = 0.f; f32x16 o0 = {}, o1 = {};
    f32x16 pA0, pA1, pB0, pB1; float alA, alB; bf16x8 pa0, pa1, pa2, pa3;
    __syncthreads();
    SLOAD(0); SWRITE(0); __syncthreads();
    mla_qkt(pA0, pA1, K_lds, qr, r32, hi, 0.f); mla_partialSM(pA0, pA1, m_reg, alA, true);
    SLOAD(1); SWRITE(1); __syncthreads();
    for (int j = 1; j + 1 < NT; j += 2) {
        SBAR(); mla_qkt(pB0, pB1, K_lds + 16384, qr, r32, hi, -m_reg);
        mla_finishSM(pA0, pA1, alA, l_reg, pa0, pa1, pa2, pa3); SBAR();
        SLOAD(j + 1); SBAR();
        pv_one<0>(o0, vb0, pa0, pa1, pa2, pa3); pv_one<1>(o1, vb0, pa0, pa1, pa2, pa3); mla_partialSM(pB0, pB1, m_reg, alB, false);
        __syncthreads(); SWRITE(0);
        MLA_RESC(alB); __syncthreads();
        SBAR(); mla_qkt(pA0, pA1, K_lds, qr, r32, hi, -m_reg);
        mla_finishSM(pB0, pB1, alB, l_reg, pa0, pa1, pa2, pa3); SBAR();
        SLOAD(j + 2); SBAR();
        pv_one<0>(o0, vb0 + 8192, pa0, pa1, pa2, pa3); pv_one<1>(o1, vb0 + 8192, pa0, pa1, pa2, pa3); mla_partialSM(pA0, pA1, m_reg, alA, false);
        __syncthreads(); SWRITE(1);
        MLA_RESC(alA); __syncthreads();
    }
    SBAR(); mla_qkt(pB0, pB1, K_lds + 16384, qr, r32, hi, -m_reg);
    mla_finishSM(pA0, pA1, alA, l_reg, pa0, pa1, pa2, pa3); SBAR();
    pv_one<0>(o0, vb0, pa0, pa1, pa2, pa3); pv_one<1>(o1, vb0, pa0, pa1, pa2, pa3); mla_partialSM(pB0, pB1, m_reg, alB, false);
    __syncthreads(); MLA_RESC(alB);
    mla_finishSM(pB0, pB1, alB, l_reg, pa0, pa1, pa2, pa3); SBAR();
    pv_one<0>(o0, vb0 + 8192, pa0, pa1, pa2, pa3); pv_one<1>(o1, vb0 + 8192, pa0, pa1, pa2, pa3);
#undef MLA_RESC
    if (hi == 0) li_l[r32] = l_reg;
    asm volatile("s_waitcnt lgkmcnt(0)" ::: "memory");
    bf16_t* Ow = Ob + (size_t)(wid * 32) * ldo;
#pragma unroll
    for (int r = 0; r < 16; ++r) { const int orow = crow(r, hi); const float rl = __builtin_amdgcn_rcpf(li_l[orow]);
        Ow[(size_t)orow * ldo + r32] = f2bf(o0[r] * rl); Ow[(size_t)orow * ldo + 32 + r32] = f2bf(o1[r] * rl); }
    __syncthreads();
}

__device__ __forceinline__ void mla_unit2(const bf16_t* __restrict__ Qb, const bf16_t* __restrict__ Kb, const bf16_t* __restrict__ Vb, bf16_t* __restrict__ Ob, int NT, char* lds) {
    constexpr int ldq = 384, ldk = 384, ldv = 256, ldo = 512;
    const int tid = tidx(), wid = tid >> 6, lane = tid & 63, r32 = lane & 31, hi = lane >> 5;
    char* V_lds = lds; char* K_lds = lds + 16384;
    float* wsf = (float*)(lds + 49152) + wid * 128; float* al_l = wsf; float* li_l = wsf + 32;
    bf16x8 q0[6], q1[6];
    { const bf16_t* Qw = Qb + (size_t)(wid * 64 + r32) * ldq + hi * 8;
#pragma unroll
      for (int d0 = 0; d0 < 6; ++d0) { q0[d0] = *(const bf16x8*)(Qw + d0 * 16); q1[d0] = *(const bf16x8*)(Qw + (size_t)32 * ldq + d0 * 16); } }
    const int vrow = tid >> 3, vc = (tid & 7) * 8, vst = v_st(vrow, vc);
    const int k0row = tid / 12, k0c = tid % 12, kst0 = KSWZ(k0row, k0c * 16);
    const int id1 = tid + 512; const bool has1 = id1 < 768;
    const int k1row = has1 ? id1 / 12 : 0, k1c = has1 ? id1 % 12 : 0, kst1 = KSWZ(k1row, k1c * 16);
    const int vb0 = (int)(uintptr_t)V_lds + v_rd_base(lane);
    bf16x8 sv, sk0, sk1;
    auto SLOAD = [&](int j) { const size_t t0 = (size_t)64 * j;
        sv = *(const bf16x8*)(Vb + (t0 + vrow) * ldv + vc); sk0 = *(const bf16x8*)(Kb + (t0 + k0row) * ldk + k0c * 8);
        if (has1) sk1 = *(const bf16x8*)(Kb + (t0 + k1row) * ldk + k1c * 8); };
    auto SWRITE = [&](int b) { *(bf16x8*)(V_lds + b * 8192 + vst) = sv; *(bf16x8*)(K_lds + b * 16384 + kst0) = sk0; if (has1) *(bf16x8*)(K_lds + b * 16384 + kst1) = sk1; };
#define MLA2_RESC(a, OX, OY) do { if (__any((a) < 1.f)) { if (hi == 0) al_l[r32] = (a); asm volatile("s_waitcnt lgkmcnt(0)" ::: "memory"); \
    _Pragma("unroll") for (int r = 0; r < 16; ++r) { const float a_ = al_l[crow(r, hi)]; OX[r] *= a_; OY[r] *= a_; } asm volatile("s_waitcnt lgkmcnt(0)" ::: "memory"); } } while (0)
    float m0 = 0.f, l0 = 0.f, m1 = 0.f, l1 = 0.f; f32x16 oa0 = {}, oa1 = {}, ob0 = {}, ob1 = {};
    f32x16 pA0, pA1, pB0, pB1; float alA, alB; bf16x8 pa0, pa1, pa2, pa3;
    __syncthreads();
    SLOAD(0); SWRITE(0); SLOAD(1); __syncthreads();
    for (int j = 0; j < NT; ++j) {
        const int b = j & 1; const char* Kj = K_lds + b * 16384; const int vbj = vb0 + b * 8192; const bool first = (j == 0);
        SBAR(); mla_qkt(pA0, pA1, Kj, q0, r32, hi, -m0); mla_partialSM(pA0, pA1, m0, alA, first);
        SBAR(); mla_qkt(pB0, pB1, Kj, q1, r32, hi, -m1);
        mla_finishSM(pA0, pA1, alA, l0, pa0, pa1, pa2, pa3); SBAR();
        MLA2_RESC(alA, oa0, oa1);
        pv_one<0>(oa0, vbj, pa0, pa1, pa2, pa3); pv_one<1>(oa1, vbj, pa0, pa1, pa2, pa3); mla_partialSM(pB0, pB1, m1, alB, first);
        SBAR();
        if (j + 1 < NT) SWRITE(b ^ 1);
        if (j + 2 < NT) SLOAD(j + 2);
        SBAR();
        mla_finishSM(pB0, pB1, alB, l1, pa0, pa1, pa2, pa3); SBAR();
        MLA2_RESC(alB, ob0, ob1);
        pv_one<0>(ob0, vbj, pa0, pa1, pa2, pa3); pv_one<1>(ob1, vbj, pa0, pa1, pa2, pa3);
        __syncthreads();
    }
#undef MLA2_RESC
    if (hi == 0) { li_l[r32] = l0; li_l[32 + r32] = l1; }
    asm volatile("s_waitcnt lgkmcnt(0)" ::: "memory");
    bf16_t* Ow = Ob + (size_t)(wid * 64) * ldo;
#pragma unroll
    for (int r = 0; r < 16; ++r) { const int orow = crow(r, hi); const float ra = __builtin_amdgcn_rcpf(li_l[orow]), rb = __builtin_amdgcn_rcpf(li_l[32 + orow]);
        Ow[(size_t)orow * ldo + r32] = f2bf(oa0[r] * ra); Ow[(size_t)orow * ldo + 32 + r32] = f2bf(oa1[r] * ra);
        Ow[(size_t)(32 + orow) * ldo + r32] = f2bf(ob0[r] * rb); Ow[(size_t)(32 + orow) * ldo + 32 + r32] = f2bf(ob1[r] * rb); }
    __syncthreads();
}

__device__ __forceinline__ void upproj_tile(const Params& p, int l, int tile, int part, char* lds) {
    const int tid = tidx(), lane = tid & 63, wid = tid >> 6, wm = wid >> 2, wn = wid & 3, fr = lane & 15, fq = lane >> 4;
    const int r0 = tile * 128; const bool ctx = row_is_ctx(r0); const int b = r0 >= TPB ? 1 : 0, t0 = r0 - b * TPB;
    float* rq = (float*)(lds + G_LDS); float* rkv = rq + 128;
    const bf16_t* P = WSP(bf16_t, OFF_P); bf16_t* Qo = WSP(bf16_t, OFF_Q); bf16_t* Ko = WSP(bf16_t, OFF_K); bf16_t* Vo = WSP(bf16_t, OFF_V);
    const float2* rope = WSP(float2, OFF_ROPE);
    __syncthreads();
    {
        const int row = tid >> 2, qd = tid & 3; const bf16_t* pr = P + (size_t)(r0 + row) * PLD;
        float sq = 0.f, sk = 0.f;
#pragma unroll
        for (int i = 0; i < 8; ++i) { const bf16x8 v = *(const bf16x8*)(pr + 768 + qd * 64 + i * 8);
#pragma unroll
            for (int e = 0; e < 8; ++e) { const float x = bf2f((bf16_t)v[e]); sq += x * x; } }
#pragma unroll
        for (int i = 0; i < 4; ++i) { const bf16x8 v = *(const bf16x8*)(pr + 1024 + qd * 32 + i * 8);
#pragma unroll
            for (int e = 0; e < 8; ++e) { const float x = bf2f((bf16_t)v[e]); sk += x * x; } }
        sq += __shfl_xor(sq, 1); sq += __shfl_xor(sq, 2); sk += __shfl_xor(sk, 1); sk += __shfl_xor(sk, 2);
        if (qd == 0) { rq[row] = rsqrtf(sq * (1.f / 256.f) + 1e-6f); rkv[row] = rsqrtf(sk * (1.f / 128.f) + 1e-6f); }
    }
    if (part == 0) for (int it = tid; it < 128 * 16; it += 512) {
        const int row = it >> 4, pi = it & 15; const bf16_t* pr = P + (size_t)(r0 + row) * PLD + 1152 + 2 * pi;
        float xe = bf2f(pr[0]), xo = bf2f(pr[1]);
        if (!ctx) { const int t = t0 + row; const int pos = pi < 8 ? (t >> 6) : (t & 63); const float2 cs = rope[pos * 8 + (pi & 7)];
            const float ne = xe * cs.x - xo * cs.y, no = xe * cs.y + xo * cs.x; xe = ne; xo = no; }
        const unsigned w = cvt_pk_bf16(xe, xo);
#pragma unroll
        for (int h = 0; h < 4; ++h) *(unsigned*)(Ko + (size_t)(r0 + row) * 384 + h * 96 + 64 + 2 * pi) = w;
    }
    __syncthreads();
    if (part < 3) { const int ct = part;
        const bf16_t* a0 = P + (size_t)(r0 + g_srow()) * PLD + 768 + g_skc() * 8; const bf16_t* a1 = a0 + (size_t)64 * PLD;
        const bf16_t* b0 = wts(p, l, WE_WUQ) + (size_t)(ct * 128 + g_srow()) * 256 + g_skc() * 8; const bf16_t* b1 = b0 + (size_t)64 * 256;
        f32x4 acc[4][2]; acc_zero(acc);
        mma_seg<1, 0>(acc, a0, a1, 0, b0, b1, 256, lds);
#pragma unroll
        for (int mt = 0; mt < 4; ++mt) { const int row = wm * 64 + mt * 16 + fr; const float rs = rq[row] * 0.14724260355f; const int t = t0 + row;
#pragma unroll
            for (int nt = 0; nt < 2; ++nt) { const int col = ct * 128 + wn * 32 + nt * 16 + fq * 4; const int dd = col % 96;
                float v0 = acc[mt][nt][0] * rs, v1 = acc[mt][nt][1] * rs, v2 = acc[mt][nt][2] * rs, v3 = acc[mt][nt][3] * rs;
                if (dd >= 64 && !ctx) { const int pi = (dd - 64) >> 1;
                    const int posa = pi < 8 ? (t >> 6) : (t & 63), posb = (pi + 1) < 8 ? (t >> 6) : (t & 63);
                    const float2 ca = rope[posa * 8 + (pi & 7)], cb = rope[posb * 8 + ((pi + 1) & 7)];
                    const float n0 = v0 * ca.x - v1 * ca.y, n1 = v0 * ca.y + v1 * ca.x, n2 = v2 * cb.x - v3 * cb.y, n3 = v2 * cb.y + v3 * cb.x; v0 = n0; v1 = n1; v2 = n2; v3 = n3; }
                u32x2 w; w.x = cvt_pk_bf16(v0, v1); w.y = cvt_pk_bf16(v2, v3);
                *(u32x2*)(Qo + (size_t)(r0 + row) * 384 + col) = w; } }
    }
    if (part >= 3) { const int ct = part - 3;
        const bf16_t* a0 = P + (size_t)(r0 + g_srow()) * PLD + 1024 + g_skc() * 8; const bf16_t* a1 = a0 + (size_t)64 * PLD;
        const bf16_t* b0 = wts(p, l, WE_WUKV) + (size_t)(ct * 128 + g_srow()) * 128 + g_skc() * 8; const bf16_t* b1 = b0 + (size_t)64 * 128;
        f32x4 acc[4][2]; acc_zero(acc);
        mma_seg<1, 0>(acc, a0, a1, 0, b0, b1, 128, lds);
#pragma unroll
        for (int mt = 0; mt < 4; ++mt) { const int row = wm * 64 + mt * 16 + fr; const float rs = rkv[row];
#pragma unroll
            for (int nt = 0; nt < 2; ++nt) { const int cc = wn * 32 + nt * 16 + fq * 4;
                u32x2 w; w.x = cvt_pk_bf16(acc[mt][nt][0] * rs, acc[mt][nt][1] * rs); w.y = cvt_pk_bf16(acc[mt][nt][2] * rs, acc[mt][nt][3] * rs);
                if (cc < 64) *(u32x2*)(Ko + (size_t)(r0 + row) * 384 + ct * 96 + cc) = w;
                else *(u32x2*)(Vo + (size_t)(r0 + row) * 256 + ct * 64 + (cc - 64)) = w; } }
    }
}
__device__ __forceinline__ float sconv_lat(const bf16_t* HT, const float* sw, int b, int ch, int n) {
    const bf16_t* r = HT + ((size_t)b * 1024 + ch) * TPB;
    const float um = n > 0 ? bf2f(r[n - 1]) : 0.f, u0 = bf2f(r[n]), up = n < SEQ - 1 ? bf2f(r[n + 1]) : 0.f;
    return sw[ch] * um + sw[768 + ch] * u0 + sw[1536 + ch] * up;
}
__device__ __forceinline__ float2 h2f(unsigned u) { return make_float2((float)__builtin_bit_cast(_Float16, (unsigned short)(u & 0xffffu)), (float)__builtin_bit_cast(_Float16, (unsigned short)(u >> 16))); }
__device__ __forceinline__ unsigned f2h(float2 v) { return __builtin_bit_cast(unsigned, __builtin_amdgcn_cvt_pkrtz(v.x, v.y)); }
__device__ __forceinline__ void hyena_unit(const Params& p, int l, int c, char* lds, const FFrag& FF) {
    float2* buf = (float2*)lds; const float2* thi = (const float2*)(lds + FFT_LDS_TAB); const float2* tlo = thi + 128; const float2* t2hi = thi + 256; const float2* t2lo = thi + 384;
    float* red = (float*)(lds + FFT_LDS_EXTRA);
    const bf16_t* HT = WSP(const bf16_t, OFF_HYFN); const float* sw = p.in[I_HYSW] + (size_t)l * 3 * 768;
    const bf16_t* FL = WSP(const bf16_t, OFF_FILT);
    const float d0 = -3.0701134573253945f, d1 = -15.350567286626973f;
    const float awin = fabsf(d0 + (float)c * ((d1 - d0) / 255.f)) * (1.f / 16383.f);
    unsigned* GS = WSP(unsigned, OFF_HYS) + (size_t)(bidx() & 255) * 65536; unsigned* YS = GS + 16384; unsigned* XS = YS + 16384;
    unsigned Zr[32];
#define HY_W2(n) cmulf(t2hi[(n) >> 7], t2lo[(n) & 127])
#define HY_ST(a, q, v) __hip_atomic_store((a) + (q), (v), __ATOMIC_RELAXED, __HIP_MEMORY_SCOPE_AGENT)
#define HY_LD(a, q) __hip_atomic_load((a) + (q), __ATOMIC_RELAXED, __HIP_MEMORY_SCOPE_AGENT)
    __syncthreads();
#pragma unroll 4
    for (int i = 0; i < 32; ++i) { const int n = tidx() + 512 * i; buf[FBI(n)] = make_float2(sconv_lat(HT, sw, 0, c, n), sconv_lat(HT, sw, 1, c, n)); }
#pragma unroll
    for (int i = 0; i < 32; ++i) Zr[i] = f2h(buf[FBI(tidx() + 512 * i)]);
#pragma unroll 1
    for (int order = 0; order < 2; ++order) {
        const bf16_t* ff = FL + (size_t)(order * 256 + c) * 16384; const bf16_t* fb = FL + (size_t)(512 + order * 256 + c) * 16384;
        float ss = 0.f;
#pragma unroll 4
        for (int i = 0; i < 32; ++i) { const int n = tidx() + 512 * i; const float win = __expf(-(float)n * awin); const float hf = bf2f(ff[n]) * win, hb = bf2f(fb[n]) * win; ss += hf * hf + (n ? hb * hb : 0.f);
            HY_ST(XS, n, f2h(make_float2(sconv_lat(HT, sw, 0, (order + 1) * 256 + c, n), sconv_lat(HT, sw, 1, (order + 1) * 256 + c, n)))); }
        const float tot = block_sum(ss, red);
        const float fac = rsqrtf(tot + 1e-6f) * (16.f / 32768.f);
        const float bias = p.in[I_HYBIAS][(size_t)l * 512 + order * 256 + c];
#pragma unroll 1
        for (int par = 0; par < 2; ++par) {
            __syncthreads();
#pragma unroll 8
            for (int i = 0; i < 32; ++i) { const int n = tidx() + 512 * i; const int nr = 16384 - n;
                const float hf = bf2f(ff[n]) * __expf(-(float)n * awin); const float hbr = n ? bf2f(fb[nr]) * __expf(-(float)nr * awin) : 0.f;
                float2 v; if (par == 0) v = make_float2(hf + hbr, 0.f); else { const float2 w = HY_W2(n); const float d = hf - hbr; v = make_float2(d * w.x, d * w.y); }
                buf[FBI(n)] = v; }
            __syncthreads();
            fft_fwd_blk(buf, FF, thi, tlo);
#pragma unroll 8
            for (int i = 0; i < 32; ++i) { const int q = tidx() + 512 * i; HY_ST(GS, q, f2h(buf[FBI(q)])); }
            __syncthreads();
#pragma unroll
            for (int i = 0; i < 32; ++i) { const int n = tidx() + 512 * i; float2 z = h2f(Zr[i]); z.x *= 0.0625f; z.y *= 0.0625f; if (par) z = cmulf(z, HY_W2(n)); buf[FBI(n)] = z; }
            __syncthreads();
            fft_fwd_blk(buf, FF, thi, tlo);
            asm volatile("s_waitcnt vmcnt(0)" ::: "memory");
#pragma unroll
            for (int hh = 0; hh < 2; ++hh) { unsigned g[16];
#pragma unroll
              for (int i = 0; i < 16; ++i) g[i] = HY_LD(GS, tidx() + 512 * (hh * 16 + i));
#pragma unroll
              for (int i = 0; i < 16; ++i) { const int q = tidx() + 512 * (hh * 16 + i); const float2 pr = cmulf(buf[FBI(q)], h2f(g[i])); buf[FBI(q)] = make_float2(pr.x * fac, pr.y * fac);        }
              __builtin_amdgcn_sched_barrier(0); }
            __syncthreads();
            fft_inv_blk(buf, FF, thi, tlo);
            if (par == 0) {
#pragma unroll 8
                for (int i = 0; i < 32; ++i) { const int q = tidx() + 512 * i; const float2 v = buf[FBI(q)]; HY_ST(YS, q, f2h(v)); }
            } else {
                asm volatile("s_waitcnt vmcnt(0)" ::: "memory");
#pragma unroll
                for (int hh = 0; hh < 2; ++hh) {
                    unsigned y[16], xg[16];
#pragma unroll
                    for (int i = 0; i < 16; ++i) { y[i] = HY_LD(YS, tidx() + 512 * (hh * 16 + i)); xg[i] = HY_LD(XS, tidx() + 512 * (hh * 16 + i)); }
#pragma unroll
                    for (int i = 0; i < 16; ++i) { const int n = tidx() + 512 * (hh * 16 + i); const float2 v = buf[FBI(n)];
                        const float2 t2 = cmulcf(v, HY_W2(n)); const float2 y0 = h2f(y[i]); const float2 z = h2f(Zr[hh * 16 + i]); const float2 g = h2f(xg[i]);
                        Zr[hh * 16 + i] = f2h(make_float2(g.x * (y0.x + t2.x + bias * z.x), g.y * (y0.y + t2.y + bias * z.y))); }
                    __builtin_amdgcn_sched_barrier(0);
                }
            }
        }
    }
#undef HY_W2
#undef HY_ST
#undef HY_LD
    bf16_t* OB = WSP(bf16_t, OFF_OBT);
#pragma unroll
    for (int i = 0; i < 32; ++i) { const int n = tidx() + 512 * i; const float2 z = h2f(Zr[i]); OB[((size_t)0 * 256 + c) * TPB + n] = f2bf(z.x); OB[((size_t)1 * 256 + c) * TPB + n] = f2bf(z.y); }
    __syncthreads();
}
__device__ __forceinline__ void fnet_unit(const Params& p, int c, char* lds, const FFrag& FF) {
    float2* buf = (float2*)lds; const float2* thi = (const float2*)(lds + FFT_LDS_TAB); const float2* tlo = thi + 128;
    const int tid = tidx();
    const bf16_t* HT = WSP(const bf16_t, OFF_HYFN); bf16_t* OC = WSP(bf16_t, OFF_OCT);
    const bf16_t* r0 = HT + ((size_t)0 * 1024 + 768 + c) * TPB; const bf16_t* r1 = HT + ((size_t)1 * 1024 + 768 + c) * TPB;
    if (DBG_FN_COPY) {
        for (int i = 0; i < 32; ++i) { const int n = tid + 512 * i; OC[((size_t)0 * 512 + c) * TPB + n] = r0[n]; OC[((size_t)0 * 512 + 256 + c) * TPB + n] = r1[n]; OC[((size_t)1 * 512 + c) * TPB + n] = r1[n]; OC[((size_t)1 * 512 + 256 + c) * TPB + n] = r0[n]; }
        return;
    }
    __syncthreads();
#pragma unroll 4
    for (int i = 0; i < 32; ++i) { const int n = tid + 512 * i; buf[FBI(n)] = make_float2(bf2f(r0[n]), bf2f(r1[n])); }
    __syncthreads();
    fft_fwd_blk(buf, FF, thi, tlo);
#pragma unroll 4
    for (int i = 0; i < 32; ++i) { const int k = tid + 512 * i; const int km = (16384 - k) & 16383; const float2 X = buf[(k & 127) * FRS + (k >> 7)], Xm = buf[(km & 127) * FRS + (km >> 7)];
        OC[((size_t)0 * 512 + c) * TPB + k] = f2bf(0.5f * (X.x + Xm.x)); OC[((size_t)0 * 512 + 256 + c) * TPB + k] = f2bf(0.5f * (X.y - Xm.y));
        OC[((size_t)1 * 512 + c) * TPB + k] = f2bf(0.5f * (X.y + Xm.y)); OC[((size_t)1 * 512 + 256 + c) * TPB + k] = f2bf(-0.5f * (X.x - Xm.x)); }
    __syncthreads();
}
__device__ __forceinline__ void hyena_ctx_unit(const Params& p, int l, int c, char* lds) {
    float* zs = (float*)lds;
    float* hfs = zs + 512; float* hbs = hfs + 256; float* w3s = hbs + 256; float* red = w3s + 128;
    const int tid = tidx(), b = tid >> 8, t = tid & 255;
    const bf16_t* HT = WSP(const bf16_t, OFF_HYFN); const float* sw = p.in[I_HYSW] + (size_t)l * 3 * 768;
    const float* H2 = WSP(const float, OFF_H2C) + (size_t)l * 256 * 64; const float* w3 = p.in[I_HYW3] + (size_t)l * 64 * 1024;
    const float d0 = -3.0701134573253945f, d1 = -15.350567286626973f;
    const float adelta = fabsf(d0 + (float)c * ((d1 - d0) / 255.f));
    auto sc = [&](int ch) { const bf16_t* r = HT + ((size_t)b * 1024 + ch) * TPB + SEQ;
        const float um = t > 0 ? bf2f(r[t - 1]) : 0.f, u0 = bf2f(r[t]), up = t < 255 ? bf2f(r[t + 1]) : 0.f; return sw[ch] * um + sw[768 + ch] * u0 + sw[1536 + ch] * up; };
    __syncthreads();
    float z = sc(c);
    zs[b * 256 + t] = z;
    for (int order = 0; order < 2; ++order) {
        __syncthreads();
        if (tid < 128) w3s[tid] = w3[(size_t)(tid & 63) * 1024 + (tid >> 6) * 512 + order * 256 + c];
        __syncthreads();
        float ss = 0.f;
        if (tid < 256) { const float* hr = H2 + (size_t)tid * 64; float sf = 0.f, sb = 0.f;
#pragma unroll 16
            for (int j = 0; j < 64; ++j) { sf += hr[j] * w3s[j]; sb += hr[j] * w3s[64 + j]; }
            const float win = __expf(-((float)tid * (1.f / 255.f)) * adelta); const float hf = sf * win, hb = sb * win;
            hfs[tid] = hf; hbs[tid] = hb; ss = hf * hf + (tid ? hb * hb : 0.f); }
        const float tot = block_sum(ss, red);
        const float scale = rsqrtf(tot + 1e-6f);
        __syncthreads();
        float y = 0.f;
        for (int s = 0; s <= t; ++s) y += hfs[t - s] * zs[b * 256 + s];
        for (int s = t + 1; s < 256; ++s) y += hbs[s - t] * zs[b * 256 + s];
        const float bias = p.in[I_HYBIAS][(size_t)l * 512 + order * 256 + c];
        const float g = sc((order + 1) * 256 + c);
        z = g * (y * scale + bias * z);
        __syncthreads();
        zs[b * 256 + t] = z;
    }
    WSP(bf16_t, OFF_OBT)[((size_t)b * 256 + c) * TPB + SEQ + t] = f2bf(z);
    __syncthreads();
}
__device__ __forceinline__ void fnet_ctx_unit(const Params& p, int c, char* lds) {
    float* us = (float*)lds; float* cs = us + 512;
    const int tid = tidx(), b = tid >> 8, k = tid & 255;
    const bf16_t* HT = WSP(const bf16_t, OFF_HYFN);
    __syncthreads();
    us[tid] = bf2f(HT[((size_t)b * 1024 + 768 + c) * TPB + SEQ + k]);
    if (tid < 256) { float s, cc; sincospif(2.f * (float)tid / 256.f, &s, &cc); cs[tid] = cc; cs[256 + tid] = s; }
    __syncthreads();
    float ur = 0.f, ui = 0.f;
    for (int n = 0; n < 256; ++n) { const int m = (k * n) & 255; const float u = us[b * 256 + n]; ur += u * cs[m]; ui -= u * cs[256 + m]; }
    bf16_t* OC = WSP(bf16_t, OFF_OCT);
    OC[((size_t)b * 512 + c) * TPB + SEQ + k] = f2bf(8.f * ur); OC[((size_t)b * 512 + 256 + c) * TPB + SEQ + k] = f2bf(8.f * ui);
    __syncthreads();
}
__device__ __forceinline__ void na_unit(const Params& p, int l, int u, char* lds) {
    const int b = u >> 8, h = (u >> 6) & 3, rb = u & 63, r0 = rb * 4;
    float* biasL = (float*)(lds + ATT_LDS);
    __syncthreads();
    for (int i = tidx(); i < 465; i += 512) biasL[i] = p.in[I_RPB][((size_t)l * 4 + h) * 465 + i] * 8.f;
    const bf16_t* P = WSP(const bf16_t, OFF_P);
    int lo = r0 - 4; lo = lo < 0 ? 0 : (lo > 248 ? 248 : lo);
    int hr = r0 + 3 - 4; hr = hr < 0 ? 0 : (hr > 248 ? 248 : hr); hr += 7;
    const int nloc = hr - lo + 1;
    const size_t tb = (size_t)b * TPB;
    attn_unit<64, 1>(P + (tb + r0 * 64) * PLD + h * 64, PLD, P + tb * PLD + 256 + h * 64, PLD, P + tb * PLD + 512 + h * 64, PLD,
                     WSP(bf16_t, OFF_OAD) + (tb + r0 * 64) * 512 + 256 + h * 64, 512, 4 + nloc, 4, SEQ, lo * 64, lds, biasL, r0, lo);
}
__device__ __forceinline__ void na_ctx_unit(const Params& p, int u, char* lds) {
    const int b = u >> 2, h = u & 3; const bf16_t* P = WSP(const bf16_t, OFF_P); const size_t tb = (size_t)b * TPB;
    attn_unit<64, 0>(P + (tb + SEQ) * PLD + h * 64, PLD, P + tb * PLD + 256 + h * 64, PLD, P + tb * PLD + 512 + h * 64, PLD,
                     WSP(bf16_t, OFF_OAD) + (tb + SEQ) * 512 + 256 + h * 64, 512, 4, 4, SEQ, 0, lds, nullptr, 0, 0);
}
PHASE_FN void ph_mixers(const Params& p, int l, char* lds_unused) {
    char* lds = lds_dyn; (void)lds_unused;
    const int bid = bidx(), G = gdim(); const bool upd_ctx = (l != NLAYER - 1);
    fft_tables(lds);
    { FFrag FF; mfft_frags(FF, (const float2*)(lds + FFT_LDS_TAB));
      for (int rep = 0; rep < (REP_PHASE == 31 ? 2 : 1); ++rep) for (int c = bid; c < 256; c += G) hyena_unit(p, l, c, lds, FF);
      for (int rep = 0; rep < (REP_PHASE == 32 ? 2 : 1); ++rep) for (int c = bid; c < 256; c += G) fnet_unit(p, c, lds, FF); }
    __syncthreads();
    if (upd_ctx) { for (int c = bid; c < 256; c += G) hyena_ctx_unit(p, l, c, lds);
                   for (int c = bid; c < 256; c += G) fnet_ctx_unit(p, c, lds); }
    for (int rep = 0; rep < (REP_PHASE == 33 ? 2 : 1); ++rep) for (int t = bid; t < NTILE * 7; t += G) upproj_tile(p, l, t / 7, t % 7, lds);
    __syncthreads();
    for (int rep = 0; rep < (REP_PHASE == 34 ? 2 : 1); ++rep) for (int u = bid; u < 512; u += G) na_unit(p, l, u, lds);
    if (upd_ctx) for (int u = bid; u < 8; u += G) na_ctx_unit(p, u, lds);
}

__device__ __forceinline__ void transp_unit(const Params& p, int u, char* lds) {
    const int tid = tidx(), rt = u / 12, cg = u % 12, r0 = rt * 128, b = r0 >= TPB ? 1 : 0, t0 = r0 - b * TPB;
    const bf16_t* src = cg < 4 ? WSP(const bf16_t, OFF_OBT) + ((size_t)b * 256 + cg * 64) * TPB + t0 : WSP(const bf16_t, OFF_OCT) + ((size_t)b * 512 + (cg - 4) * 64) * TPB + t0;
    bf16_t* dst = WSP(bf16_t, OFF_P) + (size_t)r0 * 768 + cg * 64;
    char* tl = lds;
    __syncthreads();
    { const int c = tid >> 3, sg = tid & 7; const u32x4 x0 = *(const u32x4*)(src + (size_t)c * TPB + sg * 16), x1 = *(const u32x4*)(src + (size_t)c * TPB + sg * 16 + 8);
      *(u32x4*)(tl + c * 272 + sg * 32) = x0; *(u32x4*)(tl + c * 272 + sg * 32 + 16) = x1; }
    __syncthreads();
    { const int t = tid >> 2, q = tid & 3; unsigned w[8];
#pragma unroll
      for (int i = 0; i < 8; ++i) { const unsigned lo = *(const bf16_t*)(tl + (q * 16 + 2 * i) * 272 + t * 2), hi = *(const bf16_t*)(tl + (q * 16 + 2 * i + 1) * 272 + t * 2); w[i] = lo | (hi << 16); }
      u32x4 y0 = {w[0], w[1], w[2], w[3]}, y1 = {w[4], w[5], w[6], w[7]};
      *(u32x4*)(dst + (size_t)t * 768 + q * 16) = y0; *(u32x4*)(dst + (size_t)t * 768 + q * 16 + 8) = y1; }
}
PHASE_FN void ph_mla(const Params& p, int l, char* lds_unused) {
    char* lds = lds_dyn; (void)lds_unused;
    const bool upd_ctx = (l != NLAYER - 1);
    const bf16_t* Q = WSP(const bf16_t, OFF_Q); const bf16_t* K = WSP(const bf16_t, OFF_K); const bf16_t* V = WSP(const bf16_t, OFF_V); bf16_t* O = WSP(bf16_t, OFF_OAD);
    if (upd_ctx) for (int u = bidx(); u < 8; u += gdim()) { const int b = u >> 2, h = u & 3; const size_t tb = (size_t)b * TPB;
        mla_unit(Q + (tb + SEQ) * 384 + h * 96, K + tb * 384 + h * 96, V + tb * 256 + h * 64, O + (tb + SEQ) * 512 + h * 64, 4, 4, SEQ, 0, lds); }
    for (int v = bidx() >> 3; v < 32; v += (gdim() >> 3)) { const int bh = bidx() & 7, b = bh >> 2, h = bh & 3, qb = v; const size_t tb = (size_t)b * TPB;
        mla_unit2(Q + (tb + qb * 512) * 384 + h * 96, K + tb * 384 + h * 96, V + tb * 256 + h * 64, O + (tb + qb * 512) * 512 + h * 64, 260, lds); }
    __syncthreads();
    for (int u = bidx(); u < NTILE * 12; u += gdim()) { if (skip_tile(l, u / 12)) continue; transp_unit(p, u, lds); }
    { const u32x4* Hs = WSP(const u32x4, OFF_H); u32x2* H8 = WSP(u32x2, OFF_HYS);
      for (int i = bidx() * 512 + tidx(); i < T * 128; i += gdim() * 512) { const u32x4 h = Hs[i]; u32x2 w; int t0 = 0, t1 = 0;
          t0 = __builtin_amdgcn_cvt_pk_fp8_f32(__uint_as_float(h.x << 16), __uint_as_float(h.x & 0xffff0000u), t0, false); t0 = __builtin_amdgcn_cvt_pk_fp8_f32(__uint_as_float(h.y << 16), __uint_as_float(h.y & 0xffff0000u), t0, true);
          t1 = __builtin_amdgcn_cvt_pk_fp8_f32(__uint_as_float(h.z << 16), __uint_as_float(h.z & 0xffff0000u), t1, false); t1 = __builtin_amdgcn_cvt_pk_fp8_f32(__uint_as_float(h.w << 16), __uint_as_float(h.w & 0xffff0000u), t1, true);
          w.x = (unsigned)t0; w.y = (unsigned)t1; H8[i] = w; } }
}

template <int FP8, int NKT, int SWAP = 1>
__device__ __forceinline__ void gate4_stream(f32x4 (&ag)[4][4][2], const char* a0, const char* a1, const char* Wb, size_t nstride, int rowstride, int a_rd, int b_rd, char* lds) {
    const int wid = __builtin_amdgcn_readfirstlane(tidx() >> 6);
    LAS char* L = (LAS char*)lds_dyn + ((wid >> 1) * 2 + (wid & 1)) * 1024;
    const int srow = g_srow(), skc = g_skc();
    i32x8 A8[4], B8[2][2];
#pragma unroll
    for (int mt = 0; mt < 4; ++mt) A8[mt] = (i32x8)(0);
    B8[1][0] = (i32x8)(0); B8[1][1] = (i32x8)(0);
    auto issue_h = [&](int s, int h) { const int kt = s >> 2, n = s & 3; LAS char* Bb = L + 32768 + n * 16384 + h * 8192;
        int eo = srow * rowstride + skc * 16; asm volatile("" : "+v"(eo));
        eo += (kt << 7) + h * 64 * rowstride;
        const char* w = Wb + (size_t)n * nstride + (unsigned)eo;
        __builtin_amdgcn_global_load_lds((const unsigned*)(w), (LAS unsigned*)(Bb), 16, 0, 0);
        if (n == 0) { LAS char* Ab = L + (kt & 1) * 16384 + h * 8192; const char* hp = (h ? a1 : a0) + (kt << 7);
            __builtin_amdgcn_global_load_lds((const unsigned*)(hp), (LAS unsigned*)(Ab), 16, 0, 0); } };
    auto issue = [&](int s) { issue_h(s, 0); issue_h(s, 1); };
    auto ld8 = [&](const char* base) { const u32x4 lo = *(const u32x4*)(base), hi = *(const u32x4*)(base + 1024);
        return (i32x8){(int)lo.x, (int)lo.y, (int)lo.z, (int)lo.w, (int)hi.x, (int)hi.y, (int)hi.z, (int)hi.w}; };
    constexpr int SC1 = 0x7f7f7f7f, SCW = 0x79797979;
    auto mm = [&](f32x4 c, const i32x8& b, const i32x8& a) {
        if (FP8) return __builtin_amdgcn_mfma_scale_f32_16x16x128_f8f6f4(b, a, c, 0, 0, 0, SCW, 0, SC1);
        typedef int i32x4_ __attribute__((ext_vector_type(4)));
        const i32x4_ bl = __builtin_shufflevector(b, b, 0, 1, 2, 3), bh = __builtin_shufflevector(b, b, 4, 5, 6, 7), al = __builtin_shufflevector(a, a, 0, 1, 2, 3), ah = __builtin_shufflevector(a, a, 4, 5, 6, 7);
        if (!SWAP) { c = __builtin_amdgcn_mfma_f32_16x16x32_bf16(__builtin_bit_cast(bf16x8, al), __builtin_bit_cast(bf16x8, bl), c, 0, 0, 0);
            return __builtin_amdgcn_mfma_f32_16x16x32_bf16(__builtin_bit_cast(bf16x8, ah), __builtin_bit_cast(bf16x8, bh), c, 0, 0, 0); }
        c = __builtin_amdgcn_mfma_f32_16x16x32_bf16(__builtin_bit_cast(bf16x8, bl), __builtin_bit_cast(bf16x8, al), c, 0, 0, 0);
        return __builtin_amdgcn_mfma_f32_16x16x32_bf16(__builtin_bit_cast(bf16x8, bh), __builtin_bit_cast(bf16x8, ah), c, 0, 0, 0); };
    issue(0); issue(1); issue(2);
#define MG8_SUB(N, PV, COND, SN) do { const char* Bs_ = lds + 32768 + (N) * 16384 + b_rd;                                       \
        B8[(N) & 1][0] = ld8(Bs_); B8[(N) & 1][1] = ld8(Bs_ + 2048); if (COND) issue_h((SN), 0); SB();                          \
        _Pragma("unroll") for (int mt = 0; mt < 4; ++mt) {                                                                     \
            _Pragma("unroll") for (int nt = 0; nt < 2; ++nt) ag[PV][mt][nt] = mm(ag[PV][mt][nt], B8[((N) & 1) ^ 1][nt], A8[mt]);  \
            if ((N) == 0) A8[mt] = ld8(As + a_rd + mt * 2048); }                                                               \
        if (COND) issue_h((SN), 1); SB(); } while (0)
#define MG8_KT(LASTK) do { const char* As = lds + (kt & 1) * 16384;                                                            \
        G_WAITV(4); __builtin_amdgcn_s_barrier(); asm volatile("" ::: "memory");                                               \
        MG8_SUB(0, 3, true, 4 * kt + 3);                                                                                       \
        G_WAITV(4); __builtin_amdgcn_s_barrier(); asm volatile("" ::: "memory");                                               \
        MG8_SUB(1, 0, !(LASTK), 4 * kt + 4);                                                                                   \
        if (!(LASTK)) G_WAITV(6); else G_WAITV(2);                                                                             \
        __builtin_amdgcn_s_barrier(); asm volatile("" ::: "memory");                                                           \
        MG8_SUB(2, 1, !(LASTK), 4 * kt + 5);                                                                                   \
        if (!(LASTK)) G_WAITV(6); else G_WAITV(0);                                                                             \
        __builtin_amdgcn_s_barrier(); asm volatile("" ::: "memory");                                                           \
        MG8_SUB(3, 2, !(LASTK), 4 * kt + 6); } while (0)
    int kt = 0;
#pragma unroll 1
    for (; kt < NKT - 1; ++kt) MG8_KT(false);
    MG8_KT(true);
#undef MG8_KT
#undef MG8_SUB
#pragma unroll
    for (int mt = 0; mt < 4; ++mt)
#pragma unroll
        for (int nt = 0; nt < 2; ++nt) ag[3][mt][nt] = mm(ag[3][mt][nt], B8[1][nt], A8[mt]);
    __syncthreads();
}

__device__ __forceinline__ void gate2_stream(f32x4 (&ag)[2][4][2], const char* a0, const char* a1, const char* Wb, size_t nstride, int rowstride, int a_rd, int b_rd, char* lds) {
    const int wid = __builtin_amdgcn_readfirstlane(tidx() >> 6);
    LAS char* L = (LAS char*)lds_dyn + ((wid >> 1) * 2 + (wid & 1)) * 1024;
    const int srow = g_srow(), skc = g_skc();
    constexpr int NKT = 16;
    i32x8 A8[4], B8[2][2];
#pragma unroll
    for (int mt = 0; mt < 4; ++mt) A8[mt] = (i32x8)(0);
    B8[1][0] = (i32x8)(0); B8[1][1] = (i32x8)(0);
    auto issue_h = [&](int s, int h) { const int kt = s >> 1, n = s & 1; LAS char* Bb = L + 32768 + (s & 3) * 16384 + h * 8192;
        int eo = srow * rowstride + skc * 16; asm volatile("" : "+v"(eo));
        eo += (kt << 7) + h * 64 * rowstride;
        const char* w = Wb + (size_t)n * nstride + (unsigned)eo;
        __builtin_amdgcn_global_load_lds((const unsigned*)(w), (LAS unsigned*)(Bb), 16, 0, 0);
        if (n == 0) { LAS char* Ab = L + (kt & 1) * 16384 + h * 8192; const char* hp = (h ? a1 : a0) + (kt << 7);
            __builtin_amdgcn_global_load_lds((const unsigned*)(hp), (LAS unsigned*)(Ab), 16, 0, 0); } };
    auto issue = [&](int s) { issue_h(s, 0); issue_h(s, 1); };
    auto ld8 = [&](const char* base) { const u32x4 lo = *(const u32x4*)(base), hi = *(const u32x4*)(base + 1024);
        return (i32x8){(int)lo.x, (int)lo.y, (int)lo.z, (int)lo.w, (int)hi.x, (int)hi.y, (int)hi.z, (int)hi.w}; };
    auto mm = [&](f32x4 c, const i32x8& b, const i32x8& a) {
        typedef int i32x4_ __attribute__((ext_vector_type(4)));
        const i32x4_ bl = __builtin_shufflevector(b, b, 0, 1, 2, 3), bh = __builtin_shufflevector(b, b, 4, 5, 6, 7), al = __builtin_shufflevector(a, a, 0, 1, 2, 3), ah = __builtin_shufflevector(a, a, 4, 5, 6, 7);
        c = __builtin_amdgcn_mfma_f32_16x16x32_bf16(__builtin_bit_cast(bf16x8, bl), __builtin_bit_cast(bf16x8, al), c, 0, 0, 0);
        return __builtin_amdgcn_mfma_f32_16x16x32_bf16(__builtin_bit_cast(bf16x8, bh), __builtin_bit_cast(bf16x8, ah), c, 0, 0, 0); };
    issue(0); issue(1); issue(2);
#define MG2_SUB(N, COND, SN) do { const char* Bs_ = lds + 32768 + sb + (N) * 16384 + b_rd;                                      \
        B8[N][0] = ld8(Bs_); B8[N][1] = ld8(Bs_ + 2048); if (COND) issue_h((SN), 0); SB();                                      \
        _Pragma("unroll") for (int mt = 0; mt < 4; ++mt) {                                                                     \
            _Pragma("unroll") for (int nt = 0; nt < 2; ++nt) ag[(N) ^ 1][mt][nt] = mm(ag[(N) ^ 1][mt][nt], B8[(N) ^ 1][nt], A8[mt]);  \
            if ((N) == 0) A8[mt] = ld8(As + a_rd + mt * 2048); }                                                               \
        if (COND) issue_h((SN), 1); SB(); } while (0)
#define MG2_KT(L1, L2) do { const char* As = lds + (kt & 1) * 16384; const int sb = (kt & 1) * 32768;                           \
        if (!(L1)) G_WAITV(6); else G_WAITV(2);                                                                                \
        __builtin_amdgcn_s_barrier(); asm volatile("" ::: "memory");                                                           \
        MG2_SUB(0, !(L1), 2 * kt + 3);                                                                                         \
        if (!(L1)) G_WAITV(6); else G_WAITV(0);                                                                                \
        __builtin_amdgcn_s_barrier(); asm volatile("" ::: "memory");                                                           \
        MG2_SUB(1, !(L2), 2 * kt + 4); } while (0)
    int kt = 0;
#pragma unroll 1
    for (; kt < NKT - 2; ++kt) MG2_KT(false, false);
    MG2_KT(false, true); ++kt;
    MG2_KT(true, true);
#undef MG2_KT
#undef MG2_SUB
#pragma unroll
    for (int mt = 0; mt < 4; ++mt)
#pragma unroll
        for (int nt = 0; nt < 2; ++nt) ag[1][mt][nt] = mm(ag[1][mt][nt], B8[1][nt], A8[mt]);
    __syncthreads();
}

PHASE_FN void ph_gemm1(const Params& p, int l, char* lds_unused) {
    char* lds = lds_dyn; (void)lds_unused;
    const bf16_t* H = WSP(bf16_t, OFF_H); const bf16_t* W = wts(p, l, WE_W1T);
#define G1_IDS const int tid = tidx(), lane = tid & 63, wid = tid >> 6, wm = wid >> 2, wn = wid & 3, fr = lane & 15, fq = lane >> 4
    auto epiP = [&](const f32x4 (&acc)[4][2], int r0, int n0) { G1_IDS; bf16_t* P = WSP(bf16_t, OFF_P);
#pragma unroll
        for (int mt = 0; mt < 4; ++mt)
#pragma unroll
            for (int nt = 0; nt < 2; ++nt) { const int row = r0 + wm * 64 + mt * 16 + fr, col = n0 + wn * 32 + nt * 16 + fq * 4;
                u32x2 w; w.x = cvt_pk_bf16(acc[mt][nt][0], acc[mt][nt][1]); w.y = cvt_pk_bf16(acc[mt][nt][2], acc[mt][nt][3]);
                *(u32x2*)(P + (size_t)row * PLD + col) = w; } };
    auto epiHT = [&](const f32x4 (&acc)[4][2], int r0, int ch0) { G1_IDS; const int b = r0 >= TPB ? 1 : 0, t0 = r0 - b * TPB; bf16_t* HT = WSP(bf16_t, OFF_HYFN) + (size_t)b * 1024 * TPB;
#pragma unroll
        for (int mt = 0; mt < 4; ++mt)
#pragma unroll
            for (int nt = 0; nt < 2; ++nt) { const int t = t0 + wm * 64 + mt * 16 + fq * 4, ch = ch0 + wn * 32 + nt * 16 + fr;
                u32x2 w; w.x = cvt_pk_bf16(acc[mt][nt][0], acc[mt][nt][1]); w.y = cvt_pk_bf16(acc[mt][nt][2], acc[mt][nt][3]);
                *(u32x2*)(HT + (size_t)ch * TPB + t) = w; } };
    for (int v = bidx() >> 3; v < 128; v += (gdim() >> 3)) {
        G1_IDS; const int a_rd = g_lds_byte(wm * 64 + fr, fq * 8), b_rd = g_lds_byte(wn * 32 + fr, fq * 8);
        const int lt = (v >> 2) * 8 + (bidx() & 7), g4 = v & 3, rt = lt + (lt >> 7) * 2, r0 = rt * 128, ct0 = g4 < 2 ? g4 * 4 : 10 + (g4 - 2) * 4;
        const char* a0 = (const char*)(H + (size_t)(r0 + g_srow()) * 1024 + g_skc() * 8);
        const char* Wb = (const char*)(W + (size_t)ct0 * 128 * 1024);
        f32x4 ag[4][4][2];
#pragma unroll
        for (int n = 0; n < 4; ++n) acc_zero(ag[n]);
        if (g4 < 2) { gate4_stream<0, 16, 1>(ag, a0, a0 + (size_t)64 * 2048, Wb, (size_t)128 * 2048, 2048, a_rd, b_rd, lds);
#pragma unroll
            for (int n = 0; n < 4; ++n) epiP(ag[n], r0, (ct0 + n) * 128); }
        else { gate4_stream<0, 16, 0>(ag, a0, a0 + (size_t)64 * 2048, Wb, (size_t)128 * 2048, 2048, a_rd, b_rd, lds);
#pragma unroll
            for (int n = 0; n < 4; ++n) epiHT(ag[n], r0, (ct0 + n - 10) * 128); }
    }
    for (int lt = bidx(); lt < 256; lt += gdim()) {
        G1_IDS; const int a_rd = g_lds_byte(wm * 64 + fr, fq * 8), b_rd = g_lds_byte(wn * 32 + fr, fq * 8);
        const int rt = lt + (lt >> 7) * 2, r0 = rt * 128;
        const char* a0 = (const char*)(H + (size_t)(r0 + g_srow()) * 1024 + g_skc() * 8);
        const char* Wb = (const char*)(W + (size_t)8 * 128 * 1024);
        f32x4 ag[2][4][2]; acc_zero(ag[0]); acc_zero(ag[1]);
        gate2_stream(ag, a0, a0 + (size_t)64 * 2048, Wb, (size_t)128 * 2048, 2048, a_rd, b_rd, lds);
        epiP(ag[0], r0, 8 * 128); epiP(ag[1], r0, 9 * 128);
    }
    for (int u = bidx(); u < 72; u += gdim()) {
        const int ci = u / 18, ct = u % 18, rt = 128 + (ci >> 1) * 130 + (ci & 1), r0 = rt * 128, n0 = ct * 128;
        const bf16_t* a0 = H + (size_t)(r0 + g_srow()) * 1024 + g_skc() * 8; const bf16_t* b0 = W + (size_t)(n0 + g_srow()) * 1024 + g_skc() * 8;
        f32x4 acc[4][2]; acc_zero(acc);
        if (ct < 10) { mma_seg<1, 0>(acc, a0, a0 + (size_t)64 * 1024, 0, b0, b0 + (size_t)64 * 1024, 1024, lds); epiP(acc, r0, n0); }
        else { mma_seg<0, 0>(acc, a0, a0 + (size_t)64 * 1024, 0, b0, b0 + (size_t)64 * 1024, 1024, lds); epiHT(acc, r0, n0 - 1280); }
    }
#undef G1_IDS
}

__device__ __forceinline__ void merge_unit(const Params& p, int l, int rt, int ct, char* lds) {
    const int tid = tidx(), lane = tid & 63, wid = __builtin_amdgcn_readfirstlane(tid >> 6), wm = wid >> 2, wn = wid & 3, fr = lane & 15, fq = lane >> 4;
    const int a_rd = g_lds_byte(wm * 64 + fr, fq * 8), b_rd = g_lds_byte(wn * 32 + fr, fq * 8);
    const int r0 = rt * 128, n0 = ct * 128;
    LAS char* L = (LAS char*)lds_dyn + ((wid >> 1) * 2 + (wid & 1)) * 1024;
    const int srow = g_srow(), skc = g_skc();
    GFrag f0, f1;
    unsigned gp[4][4][2][2];
    {
        const char* Hb = WSP(const char, OFF_HYS) + (size_t)(r0 + srow) * 1024 + skc * 16;
        const char* Wb = (const char*)wts(p, l, WE_WGT) + (size_t)n0 * 1024;
        f32x4 ag[4][4][2];
#pragma unroll
        for (int n = 0; n < 4; ++n) acc_zero(ag[n]);
        gate4_stream<1, 8>(ag, Hb, Hb + (size_t)64 * 1024, Wb, (size_t)1024 * 1024, 1024, a_rd, b_rd, lds);
#pragma unroll
        for (int n = 0; n < 4; ++n) {
#pragma unroll
            for (int mt = 0; mt < 4; ++mt) {
#pragma unroll
                for (int nt = 0; nt < 2; ++nt) { gp[n][mt][nt][0] = cvt_pk_bf16(sigmoid_f(ag[n][mt][nt][0]), sigmoid_f(ag[n][mt][nt][1])); gp[n][mt][nt][1] = cvt_pk_bf16(sigmoid_f(ag[n][mt][nt][2]), sigmoid_f(ag[n][mt][nt][3]));
                    asm volatile("" : "+v"(gp[n][mt][nt][0]), "+v"(gp[n][mt][nt][1])); }
            }
        }
    }
    SB();
    f32x4 am[4][2], ap[4][2]; acc_zero(am); acc_zero(ap);
    {
        const bf16_t* OAD = WSP(const bf16_t, OFF_OAD); const bf16_t* OBC = WSP(const bf16_t, OFF_P);
        auto issue = [&](int s) { const bf16_t* a; const bf16_t* b; unsigned as, bs; int k0;
            int so = srow, sk = skc * 8; asm volatile("" : "+v"(so), "+v"(sk));
            if (s < 4)       { k0 = (s << 6) + sk;        a = OAD + (unsigned)((r0 + so) * 512 + k0);       as = 64 * 512; b = wts(p, l, WE_WBA) + (unsigned)((n0 + so) * 256 + k0); bs = 64 * 256; }
            else if (s < 8)  { k0 = ((s - 4) << 6) + sk;  a = OBC + (unsigned)((r0 + so) * 768 + k0);       as = 64 * 768; b = wts(p, l, WE_WBB) + (unsigned)((n0 + so) * 256 + k0); bs = 64 * 256; }
            else if (s < 16) { k0 = ((s - 8) << 6) + sk;  a = OBC + (unsigned)((r0 + so) * 768 + 256 + k0); as = 64 * 768; b = wts(p, l, WE_WBC) + (unsigned)((n0 + so) * 512 + k0); bs = 64 * 512; }
            else             { k0 = ((s - 16) << 6) + sk; a = OAD + (unsigned)((r0 + so) * 512 + 256 + k0); as = 64 * 512; b = wts(p, l, WE_WBD) + (unsigned)((n0 + so) * 256 + k0); bs = 64 * 256; }
            LAS char* Lb = L + (s & 3) * G_STAGE;
            __builtin_amdgcn_global_load_lds((const unsigned*)(a), (LAS unsigned*)(Lb), 16, 0, 0);
            __builtin_amdgcn_global_load_lds((const unsigned*)(a + as), (LAS unsigned*)(Lb + 8192), 16, 0, 0);
            __builtin_amdgcn_global_load_lds((const unsigned*)(b), (LAS unsigned*)(Lb + G_TILE), 16, 0, 0);
            __builtin_amdgcn_global_load_lds((const unsigned*)(b + bs), (LAS unsigned*)(Lb + G_TILE + 8192), 16, 0, 0); };
        auto combine = [&](const unsigned (&g)[4][2][2]) {
#pragma unroll
            for (int mt = 0; mt < 4; ++mt)
#pragma unroll
                for (int nt = 0; nt < 2; ++nt) {
                    const unsigned g0 = g[mt][nt][0], g1 = g[mt][nt][1];
                    am[mt][nt][0] += __uint_as_float(g0 << 16) * ap[mt][nt][0]; am[mt][nt][1] += __uint_as_float(g0 & 0xffff0000u) * ap[mt][nt][1];
                    am[mt][nt][2] += __uint_as_float(g1 << 16) * ap[mt][nt][2]; am[mt][nt][3] += __uint_as_float(g1 & 0xffff0000u) * ap[mt][nt][3];
                    ap[mt][nt] = (f32x4){0.f, 0.f, 0.f, 0.f};
                    asm volatile("" : "+v"(am[mt][nt])); } };
        gf_zero(f1);
        issue(0); issue(1); issue(2);
        int s = 0;
#pragma unroll
        for (int n = 0; n < 4; ++n) {
            const int send = n == 0 ? 4 : n == 1 ? 8 : n == 2 ? 16 : 20;
#pragma unroll 1
            for (; s < send; ++s) {
                if (s + 2 < 20) G_WAITV(8); else if (s + 1 < 20) G_WAITV(4); else G_WAITV(0);
                __builtin_amdgcn_s_barrier(); asm volatile("" ::: "memory");
                if (s + 3 < 20) issue(s + 3);
                const char* As = lds + (s & 3) * G_STAGE;
                GF_STAGE(ap, ap, As, As + G_TILE);
            }
            gf_mma(ap, f1); SB();
            combine(gp[n]); gf_zero(f1); SB();
        }
        __syncthreads();
    }
    bf16_t* M = WSP(bf16_t, OFF_HYFN);
    const int t2 = tidx(), w2 = t2 >> 6, l2 = t2 & 63;
    int so = (r0 + (w2 >> 2) * 64 + (l2 & 15)) * 1024 + n0 + (w2 & 3) * 32 + (l2 >> 4) * 4;
#pragma unroll
    for (int mt = 0; mt < 4; ++mt)
#pragma unroll
        for (int nt = 0; nt < 2; ++nt) {
            u32x2 w; w.x = cvt_pk_bf16(am[mt][nt][0], am[mt][nt][1]); w.y = cvt_pk_bf16(am[mt][nt][2], am[mt][nt][3]);
            *(u32x2*)(M + (unsigned)(so + mt * 16 * 1024 + nt * 16)) = w; }
    SB();
}
PHASE_FN void ph_merge(const Params& p, int l, char* lds_unused) {
    char* lds = lds_dyn; (void)lds_unused;
    { const int xcd = bidx() & 7, ctp = xcd & 3, par = xcd >> 2;
      for (int v = bidx() >> 3; v < NTILE; v += (gdim() >> 3)) {
          const int rt = (v >> 1) * 2 + par, ct = ctp * 2 + (v & 1); if (skip_tile(l, rt)) continue;
          merge_unit(p, l, rt, ct, lds);
      } }
}

PHASE_FN void ph_wout(const Params& p, int l, char* lds_unused) {
    char* lds = lds_dyn; (void)lds_unused;
    const int tid = tidx(), lane = tid & 63, wid = tid >> 6, wm = wid >> 2, wn = wid & 3, fr = lane & 15, fq = lane >> 4;
    const int a_rd = g_lds_byte(wm * 64 + fr, fq * 8), b_rd = g_lds_byte(wn * 32 + fr, fq * 8);
    const bf16_t* M = WSP(const bf16_t, OFF_HYFN);
    auto epi = [&](const f32x4 (&acc)[4][2], int r0, int n0) {
        const float* gt = modvec(p, l, r0) + 2048;
#pragma unroll
        for (int mt = 0; mt < 4; ++mt) { const int row = r0 + wm * 64 + mt * 16 + fr; const float* xs = (l == 0) ? xrow_in(p, row) : xrow_st(p, row); float* xd = xrow_st(p, row);
#pragma unroll
            for (int nt = 0; nt < 2; ++nt) { const int col = n0 + wn * 32 + nt * 16 + fq * 4; const f32x4 x = *(const f32x4*)(xs + col), g = *(const f32x4*)(gt + col);
                f32x4 o; o[0] = x[0] + g[0] * acc[mt][nt][0]; o[1] = x[1] + g[1] * acc[mt][nt][1]; o[2] = x[2] + g[2] * acc[mt][nt][2]; o[3] = x[3] + g[3] * acc[mt][nt][3];
                if (DBG_NO_MIX) o = x;
                *(f32x4*)(xd + col) = o; } } };
    for (int u = bidx(); u < 512; u += gdim()) {
        const int lt = u >> 1, half = u & 1, rt = lt + (lt >> 7) * 2, r0 = rt * 128;
        const char* a0 = (const char*)(M + (size_t)(r0 + g_srow()) * 1024 + g_skc() * 8);
        const char* Wb = (const char*)(wts(p, l, WE_WOUT) + (size_t)half * 512 * 1024);
        f32x4 ag[4][4][2];
#pragma unroll
        for (int n = 0; n < 4; ++n) acc_zero(ag[n]);
        gate4_stream<0, 16>(ag, a0, a0 + (size_t)64 * 2048, Wb, (size_t)128 * 2048, 2048, a_rd, b_rd, lds);
#pragma unroll
        for (int n = 0; n < 4; ++n) epi(ag[n], r0, half * 512 + n * 128);
    }
    if (l != NLAYER - 1) for (int u = bidx(); u < 32; u += gdim()) {
        const int rt = 128 + (u >> 4) * 130 + ((u >> 3) & 1), ct = u & 7, r0 = rt * 128, n0 = ct * 128;
        const bf16_t* a0 = M + (size_t)(r0 + g_srow()) * 1024 + g_skc() * 8; const bf16_t* b0 = wts(p, l, WE_WOUT) + (size_t)(n0 + g_srow()) * 1024 + g_skc() * 8;
        f32x4 acc[4][2]; acc_zero(acc);
        mma_seg<1, 0>(acc, a0, a0 + (size_t)64 * 1024, 0, b0, b0 + (size_t)64 * 1024, 1024, lds);
        epi(acc, r0, n0);
    }
}

__device__ __forceinline__ int* moe_sched(const Params& p, int l, char* lds) {
    int* s = (int*)(lds + G_LDS);
    __syncthreads();
    if (tidx() == 0) { int acc = 0; for (int i = 0; i < 24; ++i) { const int c = WSP(const int, OFF_CNT)[l * 32 + i]; s[32 + i] = c; s[i] = acc; acc += (c + 127) >> 7; } s[24] = acc; }
    __syncthreads();
    return s;
}
__device__ __forceinline__ void moe_decode(const int* s, int tg, int& pid, int& tl, int& cnt) {
    pid = 0;
    for (int i = 1; i < 24; ++i) if (tg >= s[i]) pid = i;
    tl = tg - s[pid]; cnt = s[32 + pid];
}
__device__ __forceinline__ void pair_experts(int pid, int& elo, int& ehi) { const int g = pid / 6, pi = pid % 6; const int lo = pi < 3 ? 0 : (pi < 5 ? 1 : 2); const int hi = pi < 3 ? pi + 1 : (pi < 5 ? pi - 1 : 3); elo = g * 4 + lo; ehi = g * 4 + hi; }
PHASE_FN void ph_moe1(const Params& p, int l, char* lds_unused) {
    char* lds = lds_dyn; (void)lds_unused;
    const int tid = tidx(), lane = tid & 63, wid = tid >> 6, wm = wid >> 2, wn = wid & 3, fr = lane & 15, fq = lane >> 4;
    const int a_rd = g_lds_byte(wm * 64 + fr, fq * 8), b_rd = g_lds_byte(wn * 32 + fr, fq * 8);
    const int* s = moe_sched(p, l, lds);
    const bf16_t* H = WSP(const bf16_t, OFF_H); bf16_t* ACT = WSP(bf16_t, OFF_P); const int* lists = WSP(const int, OFF_LISTS); const float* tokw = WSP(const float, OFF_TOKW);
    const int ntiles = s[24];
    const int U = ntiles * 2, UF = (U >> 8) << 8;
    for (int u = bidx(); u < UF; u += gdim()) {
        const int tg = u >> 1, half = u & 1; int pid, tl, cnt; moe_decode(s, tg, pid, tl, cnt); int elo, ehi; pair_experts(pid, elo, ehi);
        const int e = half ? ehi : elo;
        const int* lst = lists + (size_t)pid * T;
        auto tok = [&](int rowi) { const int sl = tl * 128 + rowi; return lst[sl < cnt ? sl : 0]; };
        const char* a0 = (const char*)(H + (size_t)tok(g_srow()) * 1024 + g_skc() * 8); const char* a1 = (const char*)(H + (size_t)tok(g_srow() + 64) * 1024 + g_skc() * 8);
        const char* Wb = (const char*)(wts(p, l, WE_WGU) + (size_t)e * 512 * 1024);
        f32x4 ag[4][4][2];
#pragma unroll
        for (int n = 0; n < 4; ++n) acc_zero(ag[n]);
        gate4_stream<0, 16>(ag, a0, a1, Wb, (size_t)128 * 1024 * 2, 2048, a_rd, b_rd, lds);
#pragma unroll
        for (int tt = 0; tt < 4; ++tt)
#pragma unroll
            for (int mt = 0; mt < 4; ++mt) { const int rowi = wm * 64 + mt * 16 + fr; const float w = tokw[(size_t)tok(rowi) * 2 + half];
                float o[4];
#pragma unroll
                for (int j = 0; j < 4; ++j) o[j] = silu_f(ag[tt][mt][0][j]) * ag[tt][mt][1][j] * w;
                u32x2 pk; pk.x = cvt_pk_bf16(o[0], o[1]); pk.y = cvt_pk_bf16(o[2], o[3]);
                *(u32x2*)(ACT + (size_t)(tg * 128 + rowi) * 512 + half * 256 + tt * 64 + wn * 16 + fq * 4) = pk; }
    }
    for (int v = bidx(); v < (U - UF) * 4; v += gdim()) {
        const int tid = tidx(), lane = tid & 63, wid = tid >> 6, wm = wid >> 2, wn = wid & 3, fr = lane & 15, fq = lane >> 4;
        const int u4 = UF + (v >> 2), tt = v & 3, tg = u4 >> 1, half = u4 & 1; int pid, tl, cnt; moe_decode(s, tg, pid, tl, cnt); int elo, ehi; pair_experts(pid, elo, ehi);
        const int e = half ? ehi : elo;
        const int* lst = lists + (size_t)pid * T;
        auto tok = [&](int rowi) { const int sl = tl * 128 + rowi; return lst[sl < cnt ? sl : 0]; };
        const bf16_t* a0 = H + (size_t)tok(g_srow()) * 1024 + g_skc() * 8; const bf16_t* a1 = H + (size_t)tok(g_srow() + 64) * 1024 + g_skc() * 8;
        const bf16_t* b0 = wts(p, l, WE_WGU) + ((size_t)e * 512 + tt * 128 + g_srow()) * 1024 + g_skc() * 8;
        f32x4 acc[4][2]; acc_zero(acc);
        mma_seg<1, 0>(acc, a0, a1, 0, b0, b0 + (size_t)64 * 1024, 1024, lds);
#pragma unroll
        for (int mt = 0; mt < 4; ++mt) { const int rowi = wm * 64 + mt * 16 + fr; const float w = tokw[(size_t)tok(rowi) * 2 + half];
            float o[4];
#pragma unroll
            for (int j = 0; j < 4; ++j) o[j] = silu_f(acc[mt][0][j]) * acc[mt][1][j] * w;
            u32x2 pk; pk.x = cvt_pk_bf16(o[0], o[1]); pk.y = cvt_pk_bf16(o[2], o[3]);
            *(u32x2*)(ACT + (size_t)(tg * 128 + rowi) * 512 + half * 256 + tt * 64 + wn * 16 + fq * 4) = pk; }
    }
}
PHASE_FN void ph_moe2(const Params& p, int l, char* lds_unused) {
    char* lds = lds_dyn; (void)lds_unused;
    const int tid = tidx(), lane = tid & 63, wid = tid >> 6, wm = wid >> 2, wn = wid & 3, fr = lane & 15, fq = lane >> 4;
    const int* s = moe_sched(p, l, lds);
    const bf16_t* ACT = WSP(const bf16_t, OFF_P); const int* lists = WSP(const int, OFF_LISTS);
    const int ntiles = s[24];
    for (int u = bidx(); u < ntiles * 8; u += gdim()) {
        const int tg = u >> 3, ct = u & 7; int pid, tl, cnt; moe_decode(s, tg, pid, tl, cnt); int elo, ehi; pair_experts(pid, elo, ehi);
        const int* lst = lists + (size_t)pid * T;
        f32x4 acc[4][2]; acc_zero(acc);
        { const bf16_t* a0 = ACT + (size_t)(tg * 128 + g_srow()) * 512 + g_skc() * 8; const bf16_t* b0 = wts(p, l, WE_WDN) + ((size_t)elo * 1024 + ct * 128 + g_srow()) * 256 + g_skc() * 8;
          mma_seg<1, 0>(acc, a0, a0 + (size_t)64 * 512, 0, b0, b0 + (size_t)64 * 256, 256, lds); }
        { const bf16_t* a0 = ACT + (size_t)(tg * 128 + g_srow()) * 512 + 256 + g_skc() * 8; const bf16_t* b0 = wts(p, l, WE_WDN) + ((size_t)ehi * 1024 + ct * 128 + g_srow()) * 256 + g_skc() * 8;
          mma_seg<1, 0>(acc, a0, a0 + (size_t)64 * 512, 0, b0, b0 + (size_t)64 * 256, 256, lds); }
#pragma unroll
        for (int mt = 0; mt < 4; ++mt) { const int sl = tl * 128 + wm * 64 + mt * 16 + fr;
            if (sl < cnt) { const int r = lst[sl]; float* xd = xrow_st(p, r); const float* gt = modvec(p, l, r) + 5120;
#pragma unroll
                for (int nt = 0; nt < 2; ++nt) { const int col = ct * 128 + wn * 32 + nt * 16 + fq * 4; const f32x4 x = *(const f32x4*)(xd + col), g = *(const f32x4*)(gt + col);
                    f32x4 o; o[0] = x[0] + g[0] * acc[mt][nt][0]; o[1] = x[1] + g[1] * acc[mt][nt][1]; o[2] = x[2] + g[2] * acc[mt][nt][2]; o[3] = x[3] + g[3] * acc[mt][nt][3];
                    if (DBG_NO_MOE) o = x;
                    *(f32x4*)(xd + col) = o; } } }
    }
}

PHASE_FN void ph_final(const Params& p) {
    const int wid = tidx() >> 6, lane = tidx() & 63; const float* g = p.in[I_FNG];
    for (int r = bidx() * 8 + wid; r < 2 * SEQ; r += gdim() * 8) {
        float* xr = p.out + (size_t)r * D; f32x4 v[4]; float ss = 0.f;
#pragma unroll
        for (int i = 0; i < 4; ++i) { v[i] = *(const f32x4*)(xr + i * 256 + lane * 4); ss += v[i][0] * v[i][0] + v[i][1] * v[i][1] + v[i][2] * v[i][2] + v[i][3] * v[i][3]; }
        ss = wave_sum(ss); const float rinv = rsqrtf(ss * (1.f / 1024.f) + 1e-6f);
#pragma unroll
        for (int i = 0; i < 4; ++i) { const f32x4 gg = *(const f32x4*)(g + i * 256 + lane * 4); f32x4 o; o[0] = v[i][0] * rinv * gg[0]; o[1] = v[i][1] * rinv * gg[1]; o[2] = v[i][2] * rinv * gg[2]; o[3] = v[i][3] * rinv * gg[3];
            *(f32x4*)(xr + i * 256 + lane * 4) = o; }
    }
}

__device__ __forceinline__ void ph_dbgcmp(const Params& p, size_t oa, size_t ob, int slot) {
    const u32x4* a = WSP(const u32x4, oa); const u32x4* b = WSP(const u32x4, ob); int bad = 0;
    const size_t n = (size_t)2 * 1024 * TPB * 2 / 16;
    for (size_t i = (size_t)bidx() * 512 + tidx(); i < n; i += (size_t)gdim() * 512) { const u32x4 x = a[i], y = b[i]; if (x.x != y.x || x.y != y.y || x.z != y.z || x.w != y.w) bad = 1; }
    if (bad) atomicAdd(WSP(int, OFF_CNT) + slot, 1);
}
constexpr int LDS_BYTES = 150 * 1024;
template <int PH>
__global__ void __launch_bounds__(512) k_phase(Params p, int l) {
    char* lds = lds_dyn;
    if (PH == 0) ph_prologue(p, lds);
    if (PH == 1) { ph_wconv(p, l, lds); __syncthreads(); ph_filt(p, l, lds); __syncthreads(); ph_norm<0>(p, l, lds); }
    if (PH == 2) ph_gemm1(p, l, lds);
    if (PH == 3) ph_mixers(p, l, lds);
    if (PH == 4) ph_mla(p, l, lds);
    if (PH == 5) ph_merge(p, l, lds);
    if (PH == 6) ph_wout(p, l, lds);
    if (PH == 7) ph_norm<1>(p, l, lds);
    if (PH == 8) ph_moe1(p, l, lds);
    if (PH == 9) ph_moe2(p, l, lds);
    if (PH == 10) ph_final(p);
}

#if ONE_LAUNCH
__global__ void __launch_bounds__(512) k_fused(Params p0) {
    char* lds = lds_dyn;
    volatile LAS unsigned* xbw = (volatile LAS unsigned*)(lds + LDS_BYTES - 16);
    if (threadIdx.x == 0) { xbw[0] = 0u; xbw[1] = 0u; xbw[2] = 0u; xbw[3] = 0u; }
    __syncthreads();
    (void)xcd_barrier_post((unsigned*)(p0.ws + OFF_BAR), xbw);
#define PQ() ({ Params q_ = p0; asm volatile("" : "+s"(q_.ws)); q_; })
#define GRID_BARRIER() do { XcdBarrier bar_; bar_.bar = (unsigned*)(p0.ws + OFF_BAR); bar_.x = xb_xcc_id(); bar_.st = (volatile LAS unsigned*)(lds_dyn + LDS_BYTES - 16); xcd_barrier(bar_); } while (0)
    asm volatile("; PHASE_MARK 0" ::: "memory"); ph_prologue(PQ(), lds);
    if (REP_PHASE == 100) { GRID_BARRIER(); ph_prologue(PQ(), lds); }
    GRID_BARRIER();
#pragma unroll
    for (int l = 0; l < NLAYER; ++l) {
        asm volatile("; PHASE_MARK 1" ::: "memory"); ph_wconv(PQ(), l, lds); __syncthreads(); ph_filt(PQ(), l, lds); __syncthreads(); ph_norm<0>(PQ(), l, lds);
        GRID_BARRIER();
        if (REP_PHASE == 1) { ph_wconv(PQ(), l, lds); __syncthreads(); ph_norm<0>(PQ(), l, lds); GRID_BARRIER(); }
        asm volatile("; PHASE_MARK 2" ::: "memory"); ph_gemm1(PQ(), l, lds);
        GRID_BARRIER();
        if (REP_PHASE == 2) { ph_gemm1(PQ(), l, lds); GRID_BARRIER(); }

        asm volatile("; PHASE_MARK 3" ::: "memory"); ph_mixers(PQ(), l, lds);
        GRID_BARRIER();
        if (REP_PHASE == 3) { ph_mixers(PQ(), l, lds); GRID_BARRIER(); }
        asm volatile("; PHASE_MARK 4" ::: "memory"); ph_mla(PQ(), l, lds);
        GRID_BARRIER();
        if (REP_PHASE == 4) { ph_mla(PQ(), l, lds); GRID_BARRIER(); }
        asm volatile("; PHASE_MARK 5" ::: "memory"); ph_merge(PQ(), l, lds);
        GRID_BARRIER();
        if (REP_PHASE == 5) { ph_merge(PQ(), l, lds); GRID_BARRIER(); }
        asm volatile("; PHASE_MARK 6" ::: "memory"); ph_wout(PQ(), l, lds);
        GRID_BARRIER();
        if (REP_PHASE == 6 && l == 0) { ph_wout(PQ(), l, lds); GRID_BARRIER(); }
        asm volatile("; PHASE_MARK 7" ::: "memory"); ph_norm<1>(PQ(), l, lds);
        GRID_BARRIER();
        if (REP_PHASE == 7) { ph_norm<2>(PQ(), l, lds); GRID_BARRIER(); }
        asm volatile("; PHASE_MARK 8" ::: "memory"); ph_moe1(PQ(), l, lds);
        GRID_BARRIER();
        if (REP_PHASE == 8) { ph_moe1(PQ(), l, lds); GRID_BARRIER(); }
        asm volatile("; PHASE_MARK 9" ::: "memory"); ph_moe2(PQ(), l, lds);
        GRID_BARRIER();
    }
    asm volatile("; PHASE_MARK 10" ::: "memory"); ph_final(PQ());
}
#endif
template <int PH> static void launch_phase(const Params& p, int l, int grid, hipStream_t stream) {
    static bool attr = false;
    if (!attr) { hipFuncSetAttribute((const void*)k_phase<PH>, hipFuncAttributeMaxDynamicSharedMemorySize, LDS_BYTES); attr = true; }
    hipLaunchKernelGGL(k_phase<PH>, dim3(grid), dim3(512), LDS_BYTES, stream, p, l);
}

extern "C" void kernel_launch(void* const* d_in, const int* in_sizes, int n_in, void* d_out, int out_size, void* d_ws, size_t ws_size, hipStream_t stream) {
    if (n_in != 33 || ws_size < WS_TOTAL || out_size != 2 * SEQ * D) { fprintf(stderr, "kernel_launch: unexpected shapes: n_in %d ws %zu (need %zu) out %d\n", n_in, ws_size, WS_TOTAL, out_size); return; }
    Params p{};
    for (int i = 0; i < 33; ++i) p.in[i] = (const float*)d_in[i];
    p.out = (float*)d_out; p.ws = (unsigned char*)d_ws;
    hipMemsetAsync(d_ws, 0, ZERO_BYTES, stream);
#if ONE_LAUNCH
    static int grid1 = 0;
    if (!grid1) {
        int dev = 0, cus = 0, per_cu = 0;
        hipGetDevice(&dev); hipDeviceGetAttribute(&cus, hipDeviceAttributeMultiprocessorCount, dev);
        hipFuncSetAttribute((const void*)k_fused, hipFuncAttributeMaxDynamicSharedMemorySize, LDS_BYTES);
        hipOccupancyMaxActiveBlocksPerMultiprocessor(&per_cu, k_fused, 512, LDS_BYTES);
        if (per_cu < 1 || cus < 256) { fprintf(stderr, "kernel_launch: cannot make the grid resident (cus %d, blocks/cu %d)\n", cus, per_cu); return; }
        grid1 = 256;
    }
    hipLaunchKernelGGL(k_fused, dim3(grid1), dim3(512), LDS_BYTES, stream, p);
    { const hipError_t le = hipPeekAtLastError(); if (le != hipSuccess) fprintf(stderr, "kernel_launch: launch failed: %s\n", hipGetErrorName(le)); }
    return;
#endif
    const int grid = 256;
    launch_phase<0>(p, 0, grid, stream);
    for (int l = 0; l < NLAYER; ++l) {
        launch_phase<1>(p, l, grid, stream);
        launch_phase<2>(p, l, grid, stream);
        launch_phase<3>(p, l, grid, stream);
        launch_phase<4>(p, l, grid, stream);
        launch_phase<5>(p, l, grid, stream);
        launch_phase<6>(p, l, grid, stream);
        launch_phase<7>(p, l, grid, stream);
        launch_phase<8>(p, l, grid, stream);
        launch_phase<9>(p, l, grid, stream);
    }
    launch_phase<10>(p, 0, grid, stream);
    const hipError_t le = hipPeekAtLastError();
    if (le != hipSuccess) fprintf(stderr, "kernel_launch: launch failed: %s\n", hipGetErrorName(le));
}
```
